# Optimizing an MI355X kernel written in HIP

```python
import math
import jax, jax.numpy as jnp
from jax import lax
import numpy as np

D_MODEL = 2048
BATCH = 4
SEQ = 2048
DEPTH = 1
DEC_BATCH = 128
DEC_SEQ = 8
PAST_LEN = 16384
PAGE_SIZE = 128

N_MEM = 256
D_CONV = 1024
CONV_WIDTH = 31
CONV_TAIL = CONV_WIDTH - 1
HGRN_HEADS = 8
HGRN_DK = 128
HGRN_DV = 128
D_HGRN = HGRN_HEADS * HGRN_DV
D_HGRN_F = HGRN_HEADS * HGRN_DK
ATTN_HEADS = 4
ATTN_HEAD_DIM = 256
D_ATTN = ATTN_HEADS * ATTN_HEAD_DIM
N_BRANCH = 3
HGRN_CHUNK = 64
EPS = 1e-6
SPLITS = (D_CONV, D_CONV, D_CONV, D_HGRN_F, D_HGRN_F, D_HGRN, D_HGRN, D_ATTN, D_ATTN, N_BRANCH * D_MODEL)
D_IN = sum(SPLITS)

kernel_name = "hybrid_conformer_hgrn2_memattn_step"


def rmsnorm(x, g):
    xf = x.astype(jnp.float32)
    y = xf * lax.rsqrt(jnp.mean(xf * xf, axis=-1, keepdims=True) + EPS)
    return (y * g.astype(jnp.float32)).astype(x.dtype)


def layernorm(x, g, b):
    xf = x.astype(jnp.float32)
    mu = jnp.mean(xf, axis=-1, keepdims=True)
    var = jnp.mean(jnp.square(xf - mu), axis=-1, keepdims=True)
    y = (xf - mu) * lax.rsqrt(var + EPS)
    return (y * g.astype(jnp.float32) + b.astype(jnp.float32)).astype(x.dtype)


def causal_dwconv(u, tail, w, b):
    up = jnp.concatenate([tail, u], axis=1)
    y = lax.conv_general_dilated(up, w[:, None, :], window_strides=(1,), padding='VALID',
                                 dimension_numbers=('NWC', 'WIO', 'NWC'), feature_group_count=D_CONV)
    return y + b, up[:, -CONV_TAIL:]


def hgrn2_scan(q, f, v, S0):
    N, L = q.shape[0], q.shape[1]
    C = math.gcd(L, HGRN_CHUNK)
    nc = L // C
    g = jnp.log(f)
    k = 1.0 - f

    def to_chunks(t):
        return t.reshape(N, nc, C, HGRN_HEADS, t.shape[-1]).transpose(1, 0, 3, 2, 4)

    mask = jnp.tril(jnp.ones((C, C), dtype=bool))

    def step(S, xs):
        qc, kc, gc, vc = xs
        b = jnp.cumsum(gc, axis=2)
        diff = b[:, :, :, None, :] - b[:, :, None, :, :]
        decay = jnp.exp(jnp.where(mask[None, None, :, :, None], diff, -jnp.inf))
        A = jnp.einsum('nhtk,nhtsk,nhsk->nhts', qc, decay, kc)
        o = jnp.einsum('nhts,nhsv->nhtv', A, vc) + jnp.einsum('nhtk,nhkv->nhtv', qc * jnp.exp(b), S)
        bC = b[:, :, -1]
        S_new = jnp.exp(bC)[..., None] * S + jnp.einsum('nhsk,nhsv->nhkv', kc * jnp.exp(bC[:, :, None, :] - b), vc)
        return S_new, o

    S_fin, o = lax.scan(step, S0.astype(jnp.float32), (to_chunks(q), to_chunks(k), to_chunks(g), to_chunks(v)))
    o = o.transpose(1, 0, 3, 2, 4).reshape(N, L, HGRN_HEADS, HGRN_DV)
    return o, S_fin


def mem_kv(mem, g_mem, w_mem_kv):
    m = rmsnorm(mem, g_mem) @ w_mem_kv
    mk, mv = jnp.split(m, 2, axis=-1)
    N = mem.shape[0]
    return (mk.reshape(N, N_MEM, ATTN_HEADS, ATTN_HEAD_DIM), mv.reshape(N, N_MEM, ATTN_HEADS, ATTN_HEAD_DIM))


def mixer_layer(h, conv_tail, S0, mk, mv, lb, w_in, conv_w, conv_b, ln_conv_g, ln_conv_b, w_conv_out,
                g_hgrn_norm, w_hgrn_out, w_attn_out, b_gate, w_out):
    N, L = h.shape[0], h.shape[1]
    proj = h @ w_in
    idx = [int(s) for s in np.cumsum(SPLITS)[:-1]]
    c_val, c_glu, c_silu, hq, hf, hi, hog, aq, a_silu, gate_logits = jnp.split(proj, idx, axis=-1)

    u = c_val * jax.nn.sigmoid(c_glu)
    dc, new_tail = causal_dwconv(u, conv_tail, conv_w, conv_b)
    a = jax.nn.silu(layernorm(dc, ln_conv_g, ln_conv_b)) * jax.nn.silu(c_silu)
    pA = a @ w_conv_out

    f = lb + (1.0 - lb) * jax.nn.sigmoid(hf.astype(jnp.float32))
    q = hq.astype(jnp.float32).reshape(N, L, HGRN_HEADS, HGRN_DK) * (HGRN_DK ** -0.5)
    f = f.reshape(N, L, HGRN_HEADS, HGRN_DK)
    v = hi.astype(jnp.float32).reshape(N, L, HGRN_HEADS, HGRN_DV)
    o, S_new = hgrn2_scan(q, f, v, S0)
    o = rmsnorm(o, g_hgrn_norm.reshape(HGRN_HEADS, HGRN_DV)).reshape(N, L, D_HGRN).astype(h.dtype)
    pB = (o * jax.nn.silu(hog)) @ w_hgrn_out

    aqh = aq.reshape(N, L, ATTN_HEADS, ATTN_HEAD_DIM).astype(jnp.float32)
    s = jnp.einsum('nlhd,nmhd->nhlm', aqh, mk.astype(jnp.float32)) * (ATTN_HEAD_DIM ** -0.5)
    pr = jax.nn.softmax(s, axis=-1)
    ao = jnp.einsum('nhlm,nmhd->nlhd', pr, mv.astype(jnp.float32)).reshape(N, L, D_ATTN).astype(h.dtype)
    pC = (ao * jax.nn.silu(a_silu)) @ w_attn_out

    gt = jax.nn.sigmoid(gate_logits.reshape(N, L, N_BRANCH, D_MODEL) + b_gate)
    merged = gt[:, :, 0] * pA + gt[:, :, 1] * pB + gt[:, :, 2] * pC
    return merged @ w_out, new_tail, S_new.astype(S0.dtype)


def setup_inputs(seed: int = 0) -> dict:
    key = jax.random.key(seed)
    ks = jax.random.split(key, 24)
    nrm = jax.random.normal
    f32 = jnp.float32
    return {
        "x_prompt": nrm(ks[0], (BATCH, SEQ, D_MODEL), f32),
        "x_sample": nrm(ks[1], (DEC_BATCH, DEC_SEQ, D_MODEL), f32),
        "state_conv": 0.5 * nrm(ks[2], (DEPTH, DEC_BATCH, CONV_TAIL, D_CONV), f32),
        "state_hgrn": 0.5 * nrm(ks[3], (DEPTH, DEC_BATCH, HGRN_HEADS, HGRN_DK, HGRN_DV), f32),
        "cache_mem_k": nrm(ks[4], (DEPTH, DEC_BATCH, N_MEM, ATTN_HEADS, ATTN_HEAD_DIM), f32),
        "cache_mem_v": nrm(ks[5], (DEPTH, DEC_BATCH, N_MEM, ATTN_HEADS, ATTN_HEAD_DIM), f32),
        "mem_prompt": nrm(ks[6], (BATCH, N_MEM, D_MODEL), f32),
        "g_pre": 1.0 + 0.02 * nrm(ks[7], (DEPTH, D_MODEL), f32),
        "w_in": nrm(ks[8], (DEPTH, D_MODEL, D_IN), f32) * D_MODEL ** -0.5,
        "conv_w": nrm(ks[9], (DEPTH, CONV_WIDTH, D_CONV), f32) * CONV_WIDTH ** -0.5,
        "conv_b": 0.01 * nrm(ks[10], (DEPTH, D_CONV), f32),
        "ln_conv_g": 1.0 + 0.02 * nrm(ks[11], (DEPTH, D_CONV), f32),
        "ln_conv_b": 0.01 * nrm(ks[12], (DEPTH, D_CONV), f32),
        "w_conv_out": nrm(ks[13], (DEPTH, D_CONV, D_MODEL), f32) * D_CONV ** -0.5,
        "lb_logits": 0.1 * nrm(ks[14], (DEPTH + 1, D_HGRN_F), f32),
        "g_hgrn_norm": 1.0 + 0.02 * nrm(ks[15], (DEPTH, D_HGRN), f32),
        "w_hgrn_out": nrm(ks[16], (DEPTH, D_HGRN, D_MODEL), f32) * D_HGRN ** -0.5,
        "g_mem": 1.0 + 0.02 * nrm(ks[17], (DEPTH, D_MODEL), f32),
        "w_mem_kv": nrm(ks[18], (DEPTH, D_MODEL, 2 * D_ATTN), f32) * D_MODEL ** -0.5,
        "w_attn_out": nrm(ks[19], (DEPTH, D_ATTN, D_MODEL), f32) * D_ATTN ** -0.5,
        "b_gate": 0.01 * nrm(ks[20], (DEPTH, N_BRANCH, D_MODEL), f32),
        "w_out": nrm(ks[21], (DEPTH, D_MODEL, D_MODEL), f32) * D_MODEL ** -0.5,
        "g_final": 1.0 + 0.02 * nrm(ks[22], (D_MODEL,), f32),
    }


def reference(x_prompt, x_sample, state_conv, state_hgrn, cache_mem_k, cache_mem_v, mem_prompt,
              g_pre, w_in, conv_w, conv_b, ln_conv_g, ln_conv_b, w_conv_out, lb_logits, g_hgrn_norm,
              w_hgrn_out, g_mem, w_mem_kv, w_attn_out, b_gate, w_out, g_final):
    lb_all = jnp.cumsum(jax.nn.softmax(lb_logits.astype(jnp.float32), axis=0), axis=0)
    hp, hs = x_prompt, x_sample
    tails_p, S_p, mk_p, mv_p, tails_s, S_s = [], [], [], [], [], []
    for l in range(DEPTH):
        layer_w = (w_in[l], conv_w[l], conv_b[l], ln_conv_g[l], ln_conv_b[l], w_conv_out[l],
                   g_hgrn_norm[l], w_hgrn_out[l], w_attn_out[l], b_gate[l], w_out[l])
        mk, mv = mem_kv(mem_prompt, g_mem[l], w_mem_kv[l])
        tail0 = jnp.zeros((hp.shape[0], CONV_TAIL, D_CONV), hp.dtype)
        S0 = jnp.zeros((hp.shape[0], HGRN_HEADS, HGRN_DK, HGRN_DV), hp.dtype)
        yp, tp, sp = mixer_layer(rmsnorm(hp, g_pre[l]), tail0, S0, mk, mv, lb_all[l], *layer_w)
        hp = hp + yp
        ys, ts, ss = mixer_layer(rmsnorm(hs, g_pre[l]), state_conv[l], state_hgrn[l],
                                 cache_mem_k[l], cache_mem_v[l], lb_all[l], *layer_w)
        hs = hs + ys
        tails_p.append(tp); S_p.append(sp); mk_p.append(mk); mv_p.append(mv)
        tails_s.append(ts); S_s.append(ss)
    y_prompt = rmsnorm(hp, g_final)
    y_sample = rmsnorm(hs, g_final)
    return (y_prompt, y_sample, jnp.stack(tails_p), jnp.stack(S_p), jnp.stack(mk_p), jnp.stack(mv_p),
            jnp.stack(tails_s), jnp.stack(S_s))
```

```cpp
#include <hip/hip_runtime.h>
#include <hip/hip_cooperative_groups.h>
#include <cstdio>
namespace cg = cooperative_groups;

#define LAS __attribute__((address_space(3)))
typedef unsigned short bf16_t;
typedef short bf16x8 __attribute__((ext_vector_type(8)));
typedef float f32x4 __attribute__((ext_vector_type(4)));
typedef float f32x2 __attribute__((ext_vector_type(2)));
typedef unsigned u32x4 __attribute__((ext_vector_type(4)));
typedef unsigned u32x2 __attribute__((ext_vector_type(2)));

#ifndef REP_MASK
#define REP_MASK 0
#endif
#ifndef N_LAUNCH_MODE
#define N_LAUNCH_MODE 1
#endif

constexpr int DM = 2048, NTP = 8192, NTS = 1024, NTOK = 9216, SEQ = 2048;
constexpr int LDP = 9216;
constexpr int C_CV = 0, C_CG = 1024, C_CS = 2048, C_HQ = 3072, C_HF = 4096, C_HI = 5120, C_HOG = 6144, C_AQ = 7168, C_AS = 8192;
constexpr int LDG = 6144;
constexpr float EPS = 1e-6f;
constexpr size_t O_YP = 0, O_YS = 16777216, O_CONV_P = 18874368, O_HGRN_P = 18997248, O_MK = 19521536, O_MV = 20570112, O_CONV_S = 21618688, O_HGRN_S = 25550848;
constexpr size_t WS_WT1 = 0;
constexpr size_t WS_WT3 = WS_WT1 + (size_t)17408 * 2048 * 2;
constexpr size_t WS_WTO = WS_WT3 + (size_t)3 * 2048 * 1024 * 2;
constexpr size_t WS_HA = WS_WTO + (size_t)2048 * 2048 * 2;
constexpr size_t WS_ORAW = WS_HA;
constexpr size_t WS_PROJ9 = WS_HA + (size_t)10240 * 2048 * 2;
constexpr size_t WS_MF = WS_PROJ9;
constexpr size_t WS_MERGED = WS_MF + (size_t)9216 * 2048 * 4;
constexpr size_t WS_GATE = WS_PROJ9 + (size_t)9216 * 9216 * 2;
constexpr size_t WS_F = WS_GATE + (size_t)9216 * 6144 * 2;
constexpr size_t WS_MKB = WS_F + (size_t)9216 * 1024 * 4;
constexpr size_t WS_MVT = WS_MKB + (size_t)2097152;
constexpr size_t WS_ACT3 = WS_MVT + (size_t)2097152;
constexpr size_t WS_LB = WS_ACT3 + (size_t)3 * 9216 * 1024 * 2;
constexpr size_t WS_END = WS_LB + 4096;
constexpr int LDS_BYTES = 131072;
constexpr int N_PHASES = 11;

struct Params {
    const float *x_prompt, *x_sample, *state_conv, *state_hgrn, *cache_k, *cache_v, *mem_prompt, *g_pre, *w_in, *conv_w, *conv_b, *ln_g, *ln_b,
        *w_conv_out, *lb_logits, *g_hgrn, *w_hgrn_out, *g_mem, *w_mem_kv, *w_attn_out, *b_gate, *w_out, *g_final;
    float* out; unsigned char* ws; int ph_lo, ph_hi, coop, pad;
};

__device__ __forceinline__ unsigned f2bf(float f) { unsigned u = __builtin_bit_cast(unsigned, f); return (u + 0x7fffu + ((u >> 16) & 1u)) >> 16; }
typedef __bf16 bf16x2_t __attribute__((ext_vector_type(2)));
__device__ __forceinline__ unsigned pk2(float lo, float hi) { const f32x2 v = {lo, hi}; const bf16x2_t r = __builtin_convertvector(v, bf16x2_t); return __builtin_bit_cast(unsigned, r); }
__device__ __forceinline__ float bflo(unsigned w) { return __builtin_bit_cast(float, w << 16); }
__device__ __forceinline__ float bfhi(unsigned w) { return __builtin_bit_cast(float, w & 0xffff0000u); }
__device__ __forceinline__ float bf2f(unsigned short b) { return __builtin_bit_cast(float, ((unsigned)b) << 16); }
__device__ __forceinline__ float sigm(float x) { return __builtin_amdgcn_rcpf(1.f + __expf(-x)); }
__device__ __forceinline__ float siluf(float x) { return x * sigm(x); }
__device__ __forceinline__ float wave_sum(float v) {
#pragma unroll
    for (int o = 1; o < 64; o <<= 1) v += __shfl_xor(v, o);
    return v;
}
__device__ __forceinline__ float wave_max(float v) {
#pragma unroll
    for (int o = 1; o < 64; o <<= 1) v = fmaxf(v, __shfl_xor(v, o));
    return v;
}

namespace pg8 {
constexpr int BM = 256, BK = 64, HALF = 128, HTB = HALF * BK * 2, STAGE_BYTES = 8 * HTB, NXCD = 8, WGM = 8;
__host__ __device__ __forceinline__ int lds_byte(int r, int c) { const int st = (r >> 4) * 2 + (c >> 5), rr = r & 15, cc = c & 31, ob = rr * 64 + cc * 2; return st * 1024 + (ob ^ (((ob >> 9) & 1) << 5)); }
__host__ __device__ __forceinline__ void stage_rc(int b, int& R, int& C) { const int st = b / 1024, sb = b % 1024, swz = sb ^ (((sb >> 9) & 1) << 5); R = (st >> 1) * 16 + swz / 64; C = (st & 1) * 32 + (swz % 64) / 2; }
__host__ __device__ __forceinline__ int perm32(int rho) { const int n = rho >> 4, i = rho & 15; return 8 * (i >> 2) + 4 * n + (i & 3); }
struct Unit { int pm, pn, br; };
__device__ __forceinline__ void tile_of(int wgid, int nM, int nN, int& pm, int& pn) {
    const int nwg = nM * nN;
    { const int q = nwg / NXCD, r = nwg % NXCD, xcd = wgid % NXCD, off = wgid / NXCD; wgid = (xcd < r ? xcd * (q + 1) : r * (q + 1) + (xcd - r) * q) + off; }
    const int nig = WGM * nN, gid = wgid / nig, fm = gid * WGM, gsz = (nM - fm) < WGM ? (nM - fm) : WGM;
    pm = fm + ((wgid % nig) % gsz); pn = (wgid % nig) / gsz;
}

template <class Epi, class Sched>
__device__ __forceinline__ void gemm_phase(LAS unsigned char* lds, const int K, const Sched& S, const Epi& E) {
    const int tid = threadIdx.x, wid = __builtin_amdgcn_readfirstlane(tid >> 6), lane = tid & 63, wr = wid >> 2, wc = wid & 3, fr = lane & 15, fq = lane >> 4;
    const int nt = K / BK;
    unsigned voffA[2], voffB[2];
#pragma unroll
    for (int i = 0; i < 2; ++i) { int R, C; stage_rc(tid * 16 + i * 8192, R, C); const int Rb = (R & ~31) + perm32(R & 31);
        voffA[i] = (unsigned)(R * K + C) * 2u; voffB[i] = (unsigned)(Rb * K + C) * 2u; }
    const size_t kstep = (size_t)(BK * 2);
    const size_t hstep = (size_t)HALF * K * 2;
    const unsigned ldsw = (unsigned)wid * 1024u;
    const int aoff = lds_byte(wr * 64 + fr, fq * 8), boff = lds_byte(wc * 32 + fr, fq * 8);
#define PG8_SA(b, h) (((b) * 2 + (h)) * HTB)
#define PG8_SB(b, h) ((4 + (b) * 2 + (h)) * HTB)
#define PG8_STAGE(bufoff, gbase, voff) do { _Pragma("unroll") for (int _i = 0; _i < 2; ++_i) \
        __builtin_amdgcn_global_load_lds((const unsigned*)((const char*)(gbase) + (voff)[_i]), (LAS unsigned*)(lds + (bufoff) + ldsw + _i * 8192), 16, 0, 0); } while (0)
#define PG8_LDA(dst, b, h) do { _Pragma("unroll") for (int m = 0; m < 4; ++m) _Pragma("unroll") for (int k = 0; k < 2; ++k) dst[m][k] = *(const LAS bf16x8*)(lds + PG8_SA(b, h) + aoff + m * 2048 + k * 1024); } while (0)
#define PG8_LDB(dst, b, h) do { _Pragma("unroll") for (int n = 0; n < 2; ++n) _Pragma("unroll") for (int k = 0; k < 2; ++k) dst[n][k] = *(const LAS bf16x8*)(lds + PG8_SB(b, h) + boff + n * 2048 + k * 1024); } while (0)
#define PG8_MMA(ai, bj, At, Bt) do { __builtin_amdgcn_s_setprio(1); _Pragma("unroll") for (int m = 0; m < 4; ++m) _Pragma("unroll") for (int n = 0; n < 2; ++n) _Pragma("unroll") for (int k = 0; k < 2; ++k) \
        acc[ai][bj][m][n] = __builtin_amdgcn_mfma_f32_16x16x32_bf16(Bt[n][k], At[m][k], acc[ai][bj][m][n], 0, 0, 0); __builtin_amdgcn_s_setprio(0); } while (0)
#define PG8_WAIT_V(n) asm volatile("s_waitcnt vmcnt(" #n ")" ::: "memory")
#define PG8_WAIT_L(n) asm volatile("s_waitcnt lgkmcnt(" #n ")" ::: "memory")
#define PG8_BAR __builtin_amdgcn_s_barrier()
#define PG8_SCHED __builtin_amdgcn_sched_barrier(0)
    Unit cur, nxt; int ui = 0;
    if (!S.next(0, cur)) return;
    f32x4 acc[2][2][4][2];
#pragma unroll
    for (int a = 0; a < 2; ++a)
#pragma unroll
        for (int b = 0; b < 2; ++b)
#pragma unroll
            for (int m = 0; m < 4; ++m)
#pragma unroll
                for (int n = 0; n < 2; ++n) acc[a][b][m][n] = (f32x4){0.f, 0.f, 0.f, 0.f};
    bf16x8 At[4][2], B0[2][2], B1[2][2];
    const char* cA = S.a_base(cur); const char* cB = S.b_base(cur);
    PG8_STAGE(PG8_SB(0, 0), cB, voffB); PG8_STAGE(PG8_SA(0, 0), cA, voffA); PG8_STAGE(PG8_SB(0, 1), cB + hstep, voffB); PG8_STAGE(PG8_SA(0, 1), cA + hstep, voffA);
    if (wr == 1) PG8_BAR;
    PG8_WAIT_V(4); PG8_BAR;
    PG8_STAGE(PG8_SB(1, 0), cB + kstep, voffB); PG8_STAGE(PG8_SA(1, 0), cA + kstep, voffA); PG8_STAGE(PG8_SB(1, 1), cB + hstep + kstep, voffB);
    PG8_WAIT_V(6); PG8_BAR;
    for (;;) {
        const bool has_next = S.next(ui + 1, nxt);
        const char* nA = has_next ? S.a_base(nxt) : cA; const char* nB = has_next ? S.b_base(nxt) : cB;
        for (int t = 0; t < nt; t += 2) {
            const bool last = (t == nt - 2);
            const char* a1 = cA + (size_t)(t + 1) * kstep;
            const char* a2 = last ? nA : cA + (size_t)(t + 2) * kstep; const char* b2 = last ? nB : cB + (size_t)(t + 2) * kstep;
            const char* a3 = a2 + kstep; const char* b3 = b2 + kstep;
            PG8_LDB(B0, 0, 0); PG8_SCHED; PG8_LDA(At, 0, 0); PG8_STAGE(PG8_SA(1, 1), a1 + hstep, voffA);
            PG8_WAIT_L(8); PG8_BAR; PG8_WAIT_L(0); PG8_MMA(0, 0, At, B0); PG8_BAR; PG8_SCHED;
            PG8_LDB(B1, 0, 1); PG8_STAGE(PG8_SB(0, 0), b2, voffB);
            PG8_BAR; PG8_WAIT_L(0); PG8_MMA(0, 1, At, B1); PG8_BAR;
            PG8_LDA(At, 0, 1); PG8_STAGE(PG8_SA(0, 0), a2, voffA);
            PG8_BAR; PG8_WAIT_L(0); PG8_MMA(1, 0, At, B0); PG8_BAR; PG8_SCHED;
            PG8_STAGE(PG8_SB(0, 1), b2 + hstep, voffB);
            PG8_WAIT_V(6); PG8_BAR; PG8_MMA(1, 1, At, B1); PG8_BAR;
            PG8_LDB(B0, 1, 0); PG8_SCHED; PG8_LDA(At, 1, 0); PG8_STAGE(PG8_SA(0, 1), a2 + hstep, voffA);
            PG8_WAIT_L(8); PG8_BAR; PG8_WAIT_L(0); PG8_MMA(0, 0, At, B0); PG8_BAR; PG8_SCHED;
            PG8_LDB(B1, 1, 1); PG8_STAGE(PG8_SB(1, 0), b3, voffB);
            PG8_BAR; PG8_WAIT_L(0); PG8_MMA(0, 1, At, B1); PG8_BAR;
            PG8_LDA(At, 1, 1); PG8_STAGE(PG8_SA(1, 0), a3, voffA);
            PG8_BAR; PG8_WAIT_L(0); PG8_MMA(1, 0, At, B0); PG8_BAR; PG8_SCHED;
            PG8_STAGE(PG8_SB(1, 1), b3 + hstep, voffB);
            PG8_WAIT_V(6); PG8_BAR; PG8_MMA(1, 1, At, B1); PG8_BAR;
        }
        E(acc, cur, wr, wc, fr, fq);
        if (!has_next) break;
#pragma unroll
        for (int a = 0; a < 2; ++a)
#pragma unroll
            for (int b = 0; b < 2; ++b)
#pragma unroll
                for (int m = 0; m < 4; ++m)
#pragma unroll
                    for (int n = 0; n < 2; ++n) acc[a][b][m][n] = (f32x4){0.f, 0.f, 0.f, 0.f};
        cur = nxt; cA = nA; cB = nB; ++ui;
    }
    PG8_WAIT_V(0);
    if (wr == 0) PG8_BAR;
    PG8_BAR;
#undef PG8_SA
#undef PG8_SB
#undef PG8_STAGE
#undef PG8_LDA
#undef PG8_LDB
#undef PG8_MMA
#undef PG8_WAIT_V
#undef PG8_WAIT_L
#undef PG8_BAR
#undef PG8_SCHED
}
}
using pg8::Unit;

struct SchedP1 {
    int G, c; const char* A; const char* Bt;
    __device__ __forceinline__ bool next(int i, Unit& u) const {
        const int L = i * G + c; if (L >= 2192) return false;
        u.br = 0;
        if (L >= 2160) { const int idx = L - 2160; u.pm = 36 + (idx >> 3); u.pn = 60 + (idx & 7); return true; }
        pg8::tile_of(L, 36, 60, u.pm, u.pn); return true;
    }
    __device__ __forceinline__ const char* a_base(const Unit& u) const { return A + (size_t)u.pm * (256 * 2048 * 2); }
    __device__ __forceinline__ const char* b_base(const Unit& u) const { return Bt + (size_t)u.pn * (256 * 2048 * 2); }
};
struct EpiP1 {
    bf16_t* proj; bf16_t* gate; float* F; const float* lb; const float* b_gate; float* out; bf16_t* mkb; bf16_t* mvt;
    __device__ __forceinline__ void operator()(const f32x4 (&acc)[2][2][4][2], const Unit& u, int wr, int wc, int fr, int fq) const {
        const int rloc = wr * 64 + fr, cloc = wc * 32 + 8 * fq;
        if (u.pn < 36) {
            const int seg = u.pn >> 2;
#pragma unroll
            for (int bj = 0; bj < 2; ++bj) {
                const int col = u.pn * 256 + bj * 128 + cloc;
                f32x4 l0 = (f32x4){0.f, 0.f, 0.f, 0.f}, l1 = l0;
                if (seg == 4) { l0 = *(const f32x4*)(lb + (col - C_HF)); l1 = *(const f32x4*)(lb + (col - C_HF) + 4); }
#pragma unroll
                for (int ai = 0; ai < 2; ++ai)
#pragma unroll
                    for (int m = 0; m < 4; ++m) {
                        const size_t row = (size_t)u.pm * 256 + ai * 128 + m * 16 + rloc;
                        f32x4 v0 = acc[ai][bj][m][0], v1 = acc[ai][bj][m][1];
                        if (seg == 4) {
#pragma unroll
                            for (int e = 0; e < 4; ++e) { v0[e] = l0[e] + (1.f - l0[e]) * sigm(v0[e]); v1[e] = l1[e] + (1.f - l1[e]) * sigm(v1[e]); }
                            float* fp = F + row * 1024 + (col - C_HF);
                            *(f32x4*)fp = v0; *(f32x4*)(fp + 4) = v1;
                        } else {
                            if (seg == 1) {
#pragma unroll
                                for (int e = 0; e < 4; ++e) { v0[e] = sigm(v0[e]); v1[e] = sigm(v1[e]); }
                            } else if (seg == 2 || seg == 6 || seg == 8) {
#pragma unroll
                                for (int e = 0; e < 4; ++e) { v0[e] = siluf(v0[e]); v1[e] = siluf(v1[e]); }
                            } else if (seg == 3) { v0 *= 0.08838834764831845f; v1 *= 0.08838834764831845f; }
                            else if (seg == 7) { v0 *= 0.0625f; v1 *= 0.0625f; }
                            u32x4 o; o.x = pk2(v0[0], v0[1]); o.y = pk2(v0[2], v0[3]); o.z = pk2(v1[0], v1[1]); o.w = pk2(v1[2], v1[3]);
                            *(u32x4*)(proj + row * LDP + col) = o;
                        }
                    }
            }
        } else if (u.pn < 60) {
#pragma unroll
            for (int bj = 0; bj < 2; ++bj) {
                const int col = (u.pn - 36) * 256 + bj * 128 + cloc;
                const f32x4 b0 = *(const f32x4*)(b_gate + col), b1 = *(const f32x4*)(b_gate + col + 4);
#pragma unroll
                for (int ai = 0; ai < 2; ++ai)
#pragma unroll
                    for (int m = 0; m < 4; ++m) {
                        const size_t row = (size_t)u.pm * 256 + ai * 128 + m * 16 + rloc;
                        f32x4 v0 = acc[ai][bj][m][0] + b0, v1 = acc[ai][bj][m][1] + b1;
#pragma unroll
                        for (int e = 0; e < 4; ++e) { v0[e] = sigm(v0[e]); v1[e] = sigm(v1[e]); }
                        u32x4 o; o.x = pk2(v0[0], v0[1]); o.y = pk2(v0[2], v0[3]); o.z = pk2(v1[0], v1[1]); o.w = pk2(v1[2], v1[3]);
                        *(u32x4*)(gate + row * LDG + col) = o;
                    }
            }
        } else {
            const int n = u.pm - 36, isv = (u.pn >= 64) ? 1 : 0, h = (u.pn - 60) & 3;
            float* ob = out + (isv ? O_MV : O_MK);
#pragma unroll
            for (int bj = 0; bj < 2; ++bj) {
                const int d = bj * 128 + cloc;
#pragma unroll
                for (int ai = 0; ai < 2; ++ai)
#pragma unroll
                    for (int m = 0; m < 4; ++m) {
                        const int key = ai * 128 + m * 16 + rloc;
                        const f32x4 v0 = acc[ai][bj][m][0], v1 = acc[ai][bj][m][1];
                        float* op = ob + ((size_t)(n * 256 + key) * 4 + h) * 256 + d;
                        *(f32x4*)op = v0; *(f32x4*)(op + 4) = v1;
                        if (!isv) {
                            u32x4 o; o.x = pk2(v0[0], v0[1]); o.y = pk2(v0[2], v0[3]); o.z = pk2(v1[0], v1[1]); o.w = pk2(v1[2], v1[3]);
                            *(u32x4*)(mkb + ((size_t)(n * 4 + h) * 256 + key) * 256 + d) = o;
                        } else {
                            bf16_t* vp = mvt + ((size_t)(n * 4 + h) * 256 + d) * 256 + key;
#pragma unroll
                            for (int e = 0; e < 4; ++e) { vp[(size_t)e * 256] = (bf16_t)f2bf(v0[e]); vp[(size_t)(e + 4) * 256] = (bf16_t)f2bf(v1[e]); }
                        }
                    }
            }
        }
    }
};

struct SchedP4 {
    int G, c; const char* A; const char* Bt;
    __device__ __forceinline__ bool next(int i, Unit& u) const {
        const int tri = i / 3, L = tri * G + c; if (L >= 288) return false;
        u.br = i - tri * 3; pg8::tile_of(L, 36, 8, u.pm, u.pn); return true;
    }
    __device__ __forceinline__ const char* a_base(const Unit& u) const { return A + (size_t)u.br * ((size_t)9216 * 1024 * 2) + (size_t)u.pm * (256 * 1024 * 2); }
    __device__ __forceinline__ const char* b_base(const Unit& u) const { return Bt + (size_t)u.br * ((size_t)2048 * 1024 * 2) + (size_t)u.pn * (256 * 1024 * 2); }
};
struct EpiP4 {
    const bf16_t* gate; float* mf; bf16_t* merged;
    __device__ __forceinline__ void operator()(const f32x4 (&acc)[2][2][4][2], const Unit& u, int wr, int wc, int fr, int fq) const {
        const int rloc = wr * 64 + fr, cloc = wc * 32 + 8 * fq;
#pragma unroll
        for (int bj = 0; bj < 2; ++bj) {
            const int col = u.pn * 256 + bj * 128 + cloc;
#pragma unroll
            for (int ai = 0; ai < 2; ++ai)
#pragma unroll
                for (int m = 0; m < 4; ++m) {
                    const size_t row = (size_t)u.pm * 256 + ai * 128 + m * 16 + rloc;
                    const u32x4 g = *(const u32x4*)(gate + row * LDG + u.br * 2048 + col);
                    f32x4 v0 = acc[ai][bj][m][0], v1 = acc[ai][bj][m][1];
                    v0[0] *= bflo(g.x); v0[1] *= bfhi(g.x); v0[2] *= bflo(g.y); v0[3] *= bfhi(g.y);
                    v1[0] *= bflo(g.z); v1[1] *= bfhi(g.z); v1[2] *= bflo(g.w); v1[3] *= bfhi(g.w);
                    float* mp = mf + row * 2048 + col;
                    if (u.br > 0) { v0 += *(const f32x4*)mp; v1 += *(const f32x4*)(mp + 4); }
                    if (u.br < 2) { *(f32x4*)mp = v0; *(f32x4*)(mp + 4) = v1; }
                    else { u32x4 o; o.x = pk2(v0[0], v0[1]); o.y = pk2(v0[2], v0[3]); o.z = pk2(v1[0], v1[1]); o.w = pk2(v1[2], v1[3]);
                        *(u32x4*)(merged + row * 2048 + col) = o; }
                }
        }
    }
};

struct SchedP5 {
    int G, c; const char* A; const char* Bt;
    __device__ __forceinline__ bool next(int i, Unit& u) const {
        const int L = i * G + c; if (L >= 288) return false;
        u.br = 0; pg8::tile_of(L, 36, 8, u.pm, u.pn); return true;
    }
    __device__ __forceinline__ const char* a_base(const Unit& u) const { return A + (size_t)u.pm * (256 * 2048 * 2); }
    __device__ __forceinline__ const char* b_base(const Unit& u) const { return Bt + (size_t)u.pn * (256 * 2048 * 2); }
};
struct EpiP5 {
    const float* xp; const float* xs; float* out;
    __device__ __forceinline__ void operator()(const f32x4 (&acc)[2][2][4][2], const Unit& u, int wr, int wc, int fr, int fq) const {
        const int rloc = wr * 64 + fr, cloc = wc * 32 + 8 * fq;
#pragma unroll
        for (int bj = 0; bj < 2; ++bj) {
            const int col = u.pn * 256 + bj * 128 + cloc;
#pragma unroll
            for (int ai = 0; ai < 2; ++ai)
#pragma unroll
                for (int m = 0; m < 4; ++m) {
                    const size_t row = (size_t)u.pm * 256 + ai * 128 + m * 16 + rloc;
                    const float* xr = (row < (size_t)NTP) ? (xp + row * 2048 + col) : (xs + (row - NTP) * 2048 + col);
                    const f32x4 v0 = acc[ai][bj][m][0] + *(const f32x4*)xr, v1 = acc[ai][bj][m][1] + *(const f32x4*)(xr + 4);
                    float* op = out + row * 2048 + col;
                    *(f32x4*)op = v0; *(f32x4*)(op + 4) = v1;
                }
        }
    }
};

struct EpiNull {
    __device__ __forceinline__ void operator()(const f32x4 (&acc)[2][2][4][2], const Unit& u, int wr, int wc, int fr, int fq) const {
        f32x4 t = (f32x4){0.f, 0.f, 0.f, 0.f};
#pragma unroll
        for (int ai = 0; ai < 2; ++ai)
#pragma unroll
            for (int bj = 0; bj < 2; ++bj)
#pragma unroll
                for (int m = 0; m < 4; ++m) t += acc[ai][bj][m][0] + acc[ai][bj][m][1];
        asm volatile("" :: "v"(t[0]), "v"(t[1]), "v"(t[2]), "v"(t[3]));
    }
};
__device__ __forceinline__ void transpose_tile(const float* W, int K, int N, bf16_t* WT, int row_off, int kb, int nb, LAS unsigned* T32, int tid) {
    const int nq = tid & 31, kp0 = tid >> 5;
#pragma unroll
    for (int i = 0; i < 4; ++i) {
        const int kpair = kp0 + 16 * i;
        const float* src = W + (size_t)(kb * 128 + 2 * kpair) * N + nb * 128 + 4 * nq;
        const f32x4 r0 = *(const f32x4*)src, r1 = *(const f32x4*)(src + N);
        T32[(4 * nq + 0) * 65 + kpair] = pk2(r0[0], r1[0]); T32[(4 * nq + 1) * 65 + kpair] = pk2(r0[1], r1[1]);
        T32[(4 * nq + 2) * 65 + kpair] = pk2(r0[2], r1[2]); T32[(4 * nq + 3) * 65 + kpair] = pk2(r0[3], r1[3]);
    }
    __syncthreads();
#pragma unroll
    for (int i = 0; i < 4; ++i) {
        const int id = tid + 512 * i, n = id >> 4, c = id & 15;
        u32x4 o; o.x = T32[n * 65 + 4 * c]; o.y = T32[n * 65 + 4 * c + 1]; o.z = T32[n * 65 + 4 * c + 2]; o.w = T32[n * 65 + 4 * c + 3];
        *(u32x4*)(WT + (size_t)(row_off + nb * 128 + n) * K + kb * 128 + 8 * c) = o;
    }
    __syncthreads();
}
__device__ __forceinline__ void rms_row_to_bf16(const float* xrow, const float* g, bf16_t* orow, int lane) {
    f32x4 v[8]; float ss = 0.f;
#pragma unroll
    for (int j = 0; j < 8; ++j) { v[j] = ((const f32x4*)xrow)[lane + 64 * j]; ss += (v[j][0] * v[j][0] + v[j][1] * v[j][1]) + (v[j][2] * v[j][2] + v[j][3] * v[j][3]); }
    ss = wave_sum(ss);
    const float rinv = rsqrtf(ss * (1.f / 2048.f) + EPS);
#pragma unroll
    for (int j = 0; j < 8; ++j) { const f32x4 gg = ((const f32x4*)g)[lane + 64 * j];
        u32x2 o; o.x = pk2(v[j][0] * rinv * gg[0], v[j][1] * rinv * gg[1]); o.y = pk2(v[j][2] * rinv * gg[2], v[j][3] * rinv * gg[3]);
        ((u32x2*)orow)[lane + 64 * j] = o; }
}
__device__ __forceinline__ void p0_prologue(const Params& p, LAS unsigned char* lds) {
    const int tid = threadIdx.x, lane = tid & 63, wave = tid >> 6, G = gridDim.x, c = blockIdx.x;
    LAS unsigned* T32 = (LAS unsigned*)lds;
    bf16_t* WT1 = (bf16_t*)(p.ws + WS_WT1); bf16_t* WT3 = (bf16_t*)(p.ws + WS_WT3); bf16_t* WTO = (bf16_t*)(p.ws + WS_WTO);
    constexpr int T_IN = 1920, T_MKV = 256, T_BR = 128, T_OUT = 256, T_ALL = T_IN + T_MKV + 3 * T_BR + T_OUT;
    for (int it = c; it < T_ALL; it += G) {
        int r = it;
        if (r < T_IN) { transpose_tile(p.w_in, 2048, 15360, WT1, 0, r / 120, r % 120, T32, tid); continue; } r -= T_IN;
        if (r < T_MKV) { transpose_tile(p.w_mem_kv, 2048, 2048, WT1, 15360, r / 16, r % 16, T32, tid); continue; } r -= T_MKV;
        if (r < T_BR) { transpose_tile(p.w_conv_out, 1024, 2048, WT3, 0, r / 16, r % 16, T32, tid); continue; } r -= T_BR;
        if (r < T_BR) { transpose_tile(p.w_hgrn_out, 1024, 2048, WT3 + (size_t)2048 * 1024, 0, r / 16, r % 16, T32, tid); continue; } r -= T_BR;
        if (r < T_BR) { transpose_tile(p.w_attn_out, 1024, 2048, WT3 + (size_t)2 * 2048 * 1024, 0, r / 16, r % 16, T32, tid); continue; } r -= T_BR;
        transpose_tile(p.w_out, 2048, 2048, WTO, 0, r / 16, r % 16, T32, tid);
    }
    bf16_t* HA = (bf16_t*)(p.ws + WS_HA);
    const int gw = c * 8 + wave, NGW = G * 8;
    for (int m = gw; m < 10240; m += NGW) {
        if (m < NTP) rms_row_to_bf16(p.x_prompt + (size_t)m * 2048, p.g_pre, HA + (size_t)m * 2048, lane);
        else if (m < NTOK) rms_row_to_bf16(p.x_sample + (size_t)(m - NTP) * 2048, p.g_pre, HA + (size_t)m * 2048, lane);
        else rms_row_to_bf16(p.mem_prompt + (size_t)(m - NTOK) * 2048, p.g_mem, HA + (size_t)m * 2048, lane);
    }
    if (c == 0) { float* LB = (float*)(p.ws + WS_LB);
        for (int i = tid; i < 1024; i += 512) LB[i] = 1.f / (1.f + __expf(p.lb_logits[1024 + i] - p.lb_logits[i])); }
}

__device__ __forceinline__ void hgrn_prompt_item(const Params& p, int item, LAS unsigned char* lds, int tid) {
    LAS float* qs = (LAS float*)lds;
    LAS float* fs = qs + 4096;
    LAS float* vs = fs + 4096;
    LAS float* part = vs + 512;
    const int s = item >> 3, n = s >> 3, h = s & 7, dvg = item & 7;
    const int vcol = tid & 15, kg = tid >> 4;
    const bf16_t* proj = (const bf16_t*)(p.ws + WS_PROJ9);
    const float* F = (const float*)(p.ws + WS_F);
    float* oraw = (float*)(p.ws + WS_ORAW);
    const size_t row0 = (size_t)n * SEQ;
    const bf16_t* qsrc = proj + (row0 + kg) * LDP + C_HQ + h * 128 + vcol * 8;
    const float* fsrc = F + (row0 + kg) * 1024 + h * 128 + vcol * 8;
    const bf16_t* vsrc = proj + (row0 + kg) * LDP + C_HI + h * 128 + dvg * 16 + vcol;
    float S0 = 0.f, S1 = 0.f, S2 = 0.f, S3 = 0.f;
    u32x4 rq = *(const u32x4*)qsrc; f32x4 rf0 = *(const f32x4*)fsrc, rf1 = *(const f32x4*)(fsrc + 4); bf16_t rv = *vsrc;
    for (int t0 = 0; t0 < SEQ; t0 += 32) {
        { LAS float* qd = qs + kg * 128 + vcol * 8;
          *(LAS f32x4*)qd = (f32x4){bflo(rq.x), bfhi(rq.x), bflo(rq.y), bfhi(rq.y)}; *(LAS f32x4*)(qd + 4) = (f32x4){bflo(rq.z), bfhi(rq.z), bflo(rq.w), bfhi(rq.w)};
          LAS float* fd = fs + kg * 128 + vcol * 8; *(LAS f32x4*)fd = rf0; *(LAS f32x4*)(fd + 4) = rf1;
          vs[kg * 16 + vcol] = bf2f(rv); }
        __syncthreads();
        if (t0 + 32 < SEQ) { const size_t adv = (size_t)(t0 + 32);
            rq = *(const u32x4*)(qsrc + adv * LDP); rf0 = *(const f32x4*)(fsrc + adv * 1024); rf1 = *(const f32x4*)(fsrc + adv * 1024 + 4); rv = *(vsrc + adv * LDP); }
#pragma unroll 4
        for (int tt = 0; tt < 32; ++tt) {
            const f32x4 f4 = *(const LAS f32x4*)(fs + tt * 128 + kg * 4), q4 = *(const LAS f32x4*)(qs + tt * 128 + kg * 4);
            const float vv = vs[tt * 16 + vcol];
            S0 = f4[0] * S0 + (1.f - f4[0]) * vv; S1 = f4[1] * S1 + (1.f - f4[1]) * vv; S2 = f4[2] * S2 + (1.f - f4[2]) * vv; S3 = f4[3] * S3 + (1.f - f4[3]) * vv;
            part[tt * 528 + tid] = (S0 * q4[0] + S1 * q4[1]) + (S2 * q4[2] + S3 * q4[3]);
        }
        __syncthreads();
        { float a = 0.f;
#pragma unroll 8
          for (int k2 = 0; k2 < 32; ++k2) a += part[kg * 528 + k2 * 16 + vcol];
          oraw[(row0 + t0 + kg) * 1024 + h * 128 + dvg * 16 + vcol] = a; }
    }
    float* so = p.out + O_HGRN_P + ((size_t)(n * 8 + h) * 128 + kg * 4) * 128 + dvg * 16 + vcol;
    so[0] = S0; so[128] = S1; so[256] = S2; so[384] = S3;
    __syncthreads();
}

__device__ __forceinline__ void hgrn_sample_item(const Params& p, int item, LAS unsigned char* lds, int tid) {
    LAS float* qs = (LAS float*)lds;
    LAS float* fs = qs + 1024;
    LAS float* vs = fs + 1024;
    LAS float* opart = vs + 1024;
    const int n = item >> 3, h = item & 7, lane = tid & 63, wave = tid >> 6;
    const bf16_t* proj = (const bf16_t*)(p.ws + WS_PROJ9);
    const float* F = (const float*)(p.ws + WS_F);
    const size_t row0 = (size_t)NTP + (size_t)n * 8;
    { const int tt = tid >> 6, k2 = (tid & 63) * 2; const size_t r = row0 + tt;
      const unsigned qw = *(const unsigned*)(proj + r * LDP + C_HQ + h * 128 + k2); const f32x2 ff = *(const f32x2*)(F + r * 1024 + h * 128 + k2);
      const unsigned vw = *(const unsigned*)(proj + r * LDP + C_HI + h * 128 + k2);
      qs[tt * 128 + k2] = bflo(qw); qs[tt * 128 + k2 + 1] = bfhi(qw); fs[tt * 128 + k2] = ff[0]; fs[tt * 128 + k2 + 1] = ff[1];
      vs[tt * 128 + k2] = bflo(vw); vs[tt * 128 + k2 + 1] = bfhi(vw); }
    const int v4 = tid & 31, kg = tid >> 5;
    const size_t sbase = ((size_t)(n * 8 + h) * 128 + kg * 8) * 128 + v4 * 4;
    f32x4 S[8];
#pragma unroll
    for (int i = 0; i < 8; ++i) S[i] = *(const f32x4*)(p.state_hgrn + sbase + (size_t)i * 128);
    __syncthreads();
#pragma unroll
    for (int tt = 0; tt < 8; ++tt) {
        const f32x4 fa = *(const LAS f32x4*)(fs + tt * 128 + kg * 8), fb = *(const LAS f32x4*)(fs + tt * 128 + kg * 8 + 4);
        const f32x4 qa = *(const LAS f32x4*)(qs + tt * 128 + kg * 8), qb = *(const LAS f32x4*)(qs + tt * 128 + kg * 8 + 4);
        const f32x4 vv = *(const LAS f32x4*)(vs + tt * 128 + v4 * 4);
        f32x4 po = (f32x4){0.f, 0.f, 0.f, 0.f};
#pragma unroll
        for (int i = 0; i < 8; ++i) { const float f = (i < 4) ? fa[i & 3] : fb[i & 3], q = (i < 4) ? qa[i & 3] : qb[i & 3];
            S[i] = S[i] * f + vv * (1.f - f); po += S[i] * q; }
#pragma unroll
        for (int e = 0; e < 4; ++e) po[e] += __shfl_xor(po[e], 32);
        if (lane < 32) *(LAS f32x4*)(opart + (tt * 8 + wave) * 128 + v4 * 4) = po;
    }
    float* so = p.out + O_HGRN_S + sbase;
#pragma unroll
    for (int i = 0; i < 8; ++i) *(f32x4*)(so + (size_t)i * 128) = S[i];
    __syncthreads();
    { const int tt = tid >> 6, v = (tid & 63) * 2; float o0 = 0.f, o1 = 0.f;
#pragma unroll
      for (int w = 0; w < 8; ++w) { const f32x2 t = *(const LAS f32x2*)(opart + (tt * 8 + w) * 128 + v); o0 += t[0]; o1 += t[1]; }
      const float ss = wave_sum(o0 * o0 + o1 * o1), rinv = rsqrtf(ss * (1.f / 128.f) + EPS);
      const size_t r = row0 + tt; const f32x2 gg = *(const f32x2*)(p.g_hgrn + h * 128 + v);
      const unsigned gw = *(const unsigned*)(proj + r * LDP + C_HOG + h * 128 + v);
      bf16_t* og = (bf16_t*)(p.ws + WS_ACT3) + (size_t)9216 * 1024 + r * 1024 + h * 128 + v;
      *(unsigned*)og = pk2(o0 * rinv * gg[0] * bflo(gw), o1 * rinv * gg[1] * bfhi(gw)); }
    __syncthreads();
}

__device__ __forceinline__ void hgrn_norm_rows(const Params& p) {
    const int tid = threadIdx.x, lane = tid & 63, gw = blockIdx.x * 8 + (tid >> 6), NGW = gridDim.x * 8;
    const bf16_t* proj = (const bf16_t*)(p.ws + WS_PROJ9); const float* oraw = (const float*)(p.ws + WS_ORAW);
    bf16_t* og = (bf16_t*)(p.ws + WS_ACT3) + (size_t)9216 * 1024;
    for (int r = gw; r < NTP; r += NGW) {
        f32x4 o[4]; float ss = 0.f;
#pragma unroll
        for (int j = 0; j < 4; ++j) { o[j] = *(const f32x4*)(oraw + (size_t)r * 1024 + lane * 16 + j * 4); ss += (o[j][0] * o[j][0] + o[j][1] * o[j][1]) + (o[j][2] * o[j][2] + o[j][3] * o[j][3]); }
        ss += __shfl_xor(ss, 1); ss += __shfl_xor(ss, 2); ss += __shfl_xor(ss, 4);
        const float rinv = rsqrtf(ss * (1.f / 128.f) + EPS);
        const u32x4 ga = *(const u32x4*)(proj + (size_t)r * LDP + C_HOG + lane * 16), gb = *(const u32x4*)(proj + (size_t)r * LDP + C_HOG + lane * 16 + 8);
        f32x4 g[4];
#pragma unroll
        for (int j = 0; j < 4; ++j) g[j] = *(const f32x4*)(p.g_hgrn + lane * 16 + j * 4);
        u32x4 oa, ob;
        oa.x = pk2(o[0][0] * rinv * g[0][0] * bflo(ga.x), o[0][1] * rinv * g[0][1] * bfhi(ga.x)); oa.y = pk2(o[0][2] * rinv * g[0][2] * bflo(ga.y), o[0][3] * rinv * g[0][3] * bfhi(ga.y));
        oa.z = pk2(o[1][0] * rinv * g[1][0] * bflo(ga.z), o[1][1] * rinv * g[1][1] * bfhi(ga.z)); oa.w = pk2(o[1][2] * rinv * g[1][2] * bflo(ga.w), o[1][3] * rinv * g[1][3] * bfhi(ga.w));
        ob.x = pk2(o[2][0] * rinv * g[2][0] * bflo(gb.x), o[2][1] * rinv * g[2][1] * bfhi(gb.x)); ob.y = pk2(o[2][2] * rinv * g[2][2] * bflo(gb.y), o[2][3] * rinv * g[2][3] * bfhi(gb.y));
        ob.z = pk2(o[3][0] * rinv * g[3][0] * bflo(gb.z), o[3][1] * rinv * g[3][1] * bfhi(gb.z)); ob.w = pk2(o[3][2] * rinv * g[3][2] * bflo(gb.w), o[3][3] * rinv * g[3][3] * bfhi(gb.w));
        *(u32x4*)(og + (size_t)r * 1024 + lane * 16) = oa; *(u32x4*)(og + (size_t)r * 1024 + lane * 16 + 8) = ob;
    }
}

template <bool SAMPLE>
__device__ __forceinline__ void conv_item(const Params& p, int item, LAS unsigned char* lds, int tid) {
    constexpr int T = SAMPLE ? 8 : 32;
    LAS float* dcs = (LAS float*)lds;
    const bf16_t* proj = (const bf16_t*)(p.ws + WS_PROJ9);
    const int n = SAMPLE ? item : (item >> 6), t0 = SAMPLE ? 0 : (item & 63) * 32;
    const size_t rowb = SAMPLE ? ((size_t)NTP + (size_t)n * 8) : ((size_t)n * SEQ);
    const int c0 = 2 * tid;
    float w0[31], w1[31], x0[31], x1[31];
#pragma unroll
    for (int j = 0; j < 31; ++j) { const f32x2 w = *(const f32x2*)(p.conv_w + j * 1024 + c0); w0[j] = w[0]; w1[j] = w[1]; x0[j] = 0.f; x1[j] = 0.f; }
    const f32x2 bias = *(const f32x2*)(p.conv_b + c0);
    for (int pp = -30; pp < T; ++pp) {
        const int t = t0 + pp;
        float u0 = 0.f, u1 = 0.f;
        if (t >= 0) {
            const unsigned a = *(const unsigned*)(proj + (rowb + t) * LDP + C_CV + c0), g = *(const unsigned*)(proj + (rowb + t) * LDP + C_CG + c0);
            u0 = bflo(a) * bflo(g); u1 = bfhi(a) * bfhi(g);
        } else if (SAMPLE) {
            const f32x2 tv = *(const f32x2*)(p.state_conv + ((size_t)n * 30 + (30 + t)) * 1024 + c0); u0 = tv[0]; u1 = tv[1];
        }
        if (SAMPLE) { if (pp >= -22) *(f32x2*)(p.out + O_CONV_S + ((size_t)n * 30 + (pp + 22)) * 1024 + c0) = (f32x2){u0, u1}; }
        else { if (t >= SEQ - 30) *(f32x2*)(p.out + O_CONV_P + ((size_t)n * 30 + (t - (SEQ - 30))) * 1024 + c0) = (f32x2){u0, u1}; }
#pragma unroll
        for (int j = 0; j < 30; ++j) { x0[j] = x0[j + 1]; x1[j] = x1[j + 1]; }
        x0[30] = u0; x1[30] = u1;
        if (pp >= 0) {
            float d0 = bias[0], d1 = bias[1];
#pragma unroll
            for (int j = 0; j < 31; ++j) { d0 += w0[j] * x0[j]; d1 += w1[j] * x1[j]; }
            *(LAS f32x2*)(dcs + pp * 1024 + c0) = (f32x2){d0, d1};
        }
    }
    __syncthreads();
    { const int lane = tid & 63, wave = tid >> 6;
      bf16_t* aact = (bf16_t*)(p.ws + WS_ACT3);
      for (int pp = wave; pp < T; pp += 8) {
          f32x4 v[4]; float s = 0.f;
#pragma unroll
          for (int j = 0; j < 4; ++j) { v[j] = *(const LAS f32x4*)(dcs + pp * 1024 + j * 256 + lane * 4); s += (v[j][0] + v[j][1]) + (v[j][2] + v[j][3]); }
          const float mean = wave_sum(s) * (1.f / 1024.f); float s2 = 0.f;
#pragma unroll
          for (int j = 0; j < 4; ++j) { v[j] = v[j] - mean; s2 += (v[j][0] * v[j][0] + v[j][1] * v[j][1]) + (v[j][2] * v[j][2] + v[j][3] * v[j][3]); }
          const float rstd = rsqrtf(wave_sum(s2) * (1.f / 1024.f) + EPS);
          const size_t r = rowb + t0 + pp;
#pragma unroll
          for (int j = 0; j < 4; ++j) { const int c = j * 256 + lane * 4;
              const f32x4 lg = *(const f32x4*)(p.ln_g + c), lbv = *(const f32x4*)(p.ln_b + c);
              const u32x2 sg = *(const u32x2*)(proj + r * LDP + C_CS + c);
              const float y0 = siluf(v[j][0] * rstd * lg[0] + lbv[0]) * bflo(sg.x), y1 = siluf(v[j][1] * rstd * lg[1] + lbv[1]) * bfhi(sg.x);
              const float y2 = siluf(v[j][2] * rstd * lg[2] + lbv[2]) * bflo(sg.y), y3 = siluf(v[j][3] * rstd * lg[3] + lbv[3]) * bfhi(sg.y);
              u32x2 o; o.x = pk2(y0, y1); o.y = pk2(y2, y3);
              *(u32x2*)(aact + r * 1024 + c) = o; }
      } }
    __syncthreads();
}

__device__ __forceinline__ void attn_prompt_item(const Params& p, int item, int tid) {
    const int lane = tid & 63, wave = tid >> 6, l15 = lane & 15, quad = lane >> 4;
    const int n = item >> 6, h = (item >> 4) & 3, qt = item & 15;
    const bf16_t* proj = (const bf16_t*)(p.ws + WS_PROJ9);
    const bf16_t* kb = (const bf16_t*)(p.ws + WS_MKB) + (size_t)(n * 4 + h) * 65536;
    const bf16_t* vt = (const bf16_t*)(p.ws + WS_MVT) + (size_t)(n * 4 + h) * 65536;
    const size_t qrow = (size_t)n * SEQ + qt * 128 + wave * 16 + l15;
    bf16x8 qf[8];
#pragma unroll
    for (int s = 0; s < 8; ++s) qf[s] = *(const bf16x8*)(proj + qrow * LDP + C_AQ + h * 256 + s * 32 + quad * 8);
    f32x4 sc[16];
#pragma unroll
    for (int T = 0; T < 16; ++T) {
        sc[T] = (f32x4){0.f, 0.f, 0.f, 0.f};
        const bf16_t* kr = kb + (size_t)(T * 16 + l15) * 256 + quad * 8;
#pragma unroll
        for (int s = 0; s < 8; ++s) { const bf16x8 a = *(const bf16x8*)(kr + s * 32); sc[T] = __builtin_amdgcn_mfma_f32_16x16x32_bf16(a, qf[s], sc[T], 0, 0, 0); }
    }
    float mx = -3.0e38f;
#pragma unroll
    for (int T = 0; T < 16; ++T) mx = fmaxf(mx, fmaxf(fmaxf(sc[T][0], sc[T][1]), fmaxf(sc[T][2], sc[T][3])));
    mx = fmaxf(mx, __shfl_xor(mx, 16)); mx = fmaxf(mx, __shfl_xor(mx, 32));
    float sum = 0.f;
#pragma unroll
    for (int T = 0; T < 16; ++T) {
#pragma unroll
        for (int e = 0; e < 4; ++e) { sc[T][e] = __expf(sc[T][e] - mx); sum += sc[T][e]; } }
    sum += __shfl_xor(sum, 16); sum += __shfl_xor(sum, 32);
    const float rs = 1.f / sum;
    bf16x8 pb[8];
#pragma unroll
    for (int s2 = 0; s2 < 8; ++s2) {
        u32x4 w; w.x = pk2(sc[2 * s2][0], sc[2 * s2][1]); w.y = pk2(sc[2 * s2][2], sc[2 * s2][3]); w.z = pk2(sc[2 * s2 + 1][0], sc[2 * s2 + 1][1]); w.w = pk2(sc[2 * s2 + 1][2], sc[2 * s2 + 1][3]);
        pb[s2] = __builtin_bit_cast(bf16x8, w);
    }
    bf16_t* aog = (bf16_t*)(p.ws + WS_ACT3) + (size_t)2 * 9216 * 1024;
#pragma unroll 2
    for (int Tv = 0; Tv < 16; ++Tv) {
        f32x4 oacc = (f32x4){0.f, 0.f, 0.f, 0.f};
        const bf16_t* vr = vt + (size_t)(Tv * 16 + l15) * 256 + quad * 4;
#pragma unroll
        for (int s2 = 0; s2 < 8; ++s2) {
            const u32x2 lo = *(const u32x2*)(vr + s2 * 32), hi = *(const u32x2*)(vr + s2 * 32 + 16);
            u32x4 w; w.x = lo.x; w.y = lo.y; w.z = hi.x; w.w = hi.y;
            oacc = __builtin_amdgcn_mfma_f32_16x16x32_bf16(__builtin_bit_cast(bf16x8, w), pb[s2], oacc, 0, 0, 0);
        }
        const int dv = Tv * 16 + quad * 4;
        const u32x2 sg = *(const u32x2*)(proj + qrow * LDP + C_AS + h * 256 + dv);
        u32x2 o; o.x = pk2(oacc[0] * rs * bflo(sg.x), oacc[1] * rs * bfhi(sg.x)); o.y = pk2(oacc[2] * rs * bflo(sg.y), oacc[3] * rs * bfhi(sg.y));
        *(u32x2*)(aog + qrow * 1024 + h * 256 + dv) = o;
    }
}

__device__ __forceinline__ void attn_sample_item(const Params& p, int item, LAS unsigned char* lds, int tid) {
    LAS float* Ssh = (LAS float*)lds;
    LAS float* Psh = Ssh + 2048;
    LAS float* Opart = Psh + 2048;
    const int lane = tid & 63, wave = tid >> 6, l15 = lane & 15, quad = lane >> 4;
    const int n = item >> 2, h = item & 3;
    const bf16_t* proj = (const bf16_t*)(p.ws + WS_PROJ9);
    const size_t row0 = (size_t)NTP + (size_t)n * 8;
    const float* kc = p.cache_k + ((size_t)n * 256 * 4 + h) * 256;
    const float* vc = p.cache_v + ((size_t)n * 256 * 4 + h) * 256;
    {
        bf16x8 qf[8];
        const size_t qrow = row0 + (lane & 7);
#pragma unroll
        for (int s = 0; s < 8; ++s) qf[s] = *(const bf16x8*)(proj + qrow * LDP + C_AQ + h * 256 + s * 32 + quad * 8);
#pragma unroll
        for (int tl = 0; tl < 2; ++tl) {
            const int T = wave * 2 + tl;
            f32x4 sc = (f32x4){0.f, 0.f, 0.f, 0.f};
            const float* kr = kc + (size_t)(T * 16 + l15) * 1024 + quad * 8;
#pragma unroll
            for (int s = 0; s < 8; ++s) {
                const f32x4 k0 = *(const f32x4*)(kr + s * 32), k1 = *(const f32x4*)(kr + s * 32 + 4);
                u32x4 w; w.x = pk2(k0[0], k0[1]); w.y = pk2(k0[2], k0[3]); w.z = pk2(k1[0], k1[1]); w.w = pk2(k1[2], k1[3]);
                sc = __builtin_amdgcn_mfma_f32_16x16x32_bf16(__builtin_bit_cast(bf16x8, w), qf[s], sc, 0, 0, 0);
            }
            if (l15 < 8) {
#pragma unroll
                for (int e = 0; e < 4; ++e) Ssh[l15 * 256 + T * 16 + quad * 4 + e] = sc[e];
            }
        }
    }
    __syncthreads();
    {
        const f32x4 s4 = *(const LAS f32x4*)(Ssh + wave * 256 + lane * 4);
        const float mx = wave_max(fmaxf(fmaxf(s4[0], s4[1]), fmaxf(s4[2], s4[3])));
        f32x4 e4; e4[0] = __expf(s4[0] - mx); e4[1] = __expf(s4[1] - mx); e4[2] = __expf(s4[2] - mx); e4[3] = __expf(s4[3] - mx);
        const float rs = 1.f / wave_sum((e4[0] + e4[1]) + (e4[2] + e4[3]));
#pragma unroll
        for (int e = 0; e < 4; ++e) Psh[(lane * 4 + e) * 8 + wave] = e4[e] * rs;
    }
    __syncthreads();
    {
        f32x4 acc[8];
#pragma unroll
        for (int q = 0; q < 8; ++q) acc[q] = (f32x4){0.f, 0.f, 0.f, 0.f};
        const float* vr = vc + (size_t)(wave * 32) * 1024 + lane * 4;
#pragma unroll 8
        for (int kk = 0; kk < 32; ++kk) {
            const f32x4 v4 = *(const f32x4*)(vr + (size_t)kk * 1024);
            const f32x4 pa = *(const LAS f32x4*)(Psh + (wave * 32 + kk) * 8), pb = *(const LAS f32x4*)(Psh + (wave * 32 + kk) * 8 + 4);
            acc[0] += v4 * pa[0]; acc[1] += v4 * pa[1]; acc[2] += v4 * pa[2]; acc[3] += v4 * pa[3];
            acc[4] += v4 * pb[0]; acc[5] += v4 * pb[1]; acc[6] += v4 * pb[2]; acc[7] += v4 * pb[3];
        }
#pragma unroll
        for (int q = 0; q < 8; ++q) *(LAS f32x4*)(Opart + (wave * 8 + q) * 256 + lane * 4) = acc[q];
    }
    __syncthreads();
    {
        f32x4 o = (f32x4){0.f, 0.f, 0.f, 0.f};
#pragma unroll
        for (int w = 0; w < 8; ++w) o += *(const LAS f32x4*)(Opart + (w * 8 + wave) * 256 + lane * 4);
        const size_t r = row0 + wave;
        const u32x2 sg = *(const u32x2*)(proj + r * LDP + C_AS + h * 256 + lane * 4);
        u32x2 ov; ov.x = pk2(o[0] * bflo(sg.x), o[1] * bfhi(sg.x)); ov.y = pk2(o[2] * bflo(sg.y), o[3] * bfhi(sg.y));
        bf16_t* aog = (bf16_t*)(p.ws + WS_ACT3) + (size_t)2 * 9216 * 1024;
        *(u32x2*)(aog + r * 1024 + h * 256 + lane * 4) = ov;
    }
    __syncthreads();
}

__device__ __forceinline__ void p2_mixers(const Params& p, LAS unsigned char* lds, int sub) {
    const int tid = threadIdx.x, G = gridDim.x, c = blockIdx.x;
    if (sub == 0) { for (int it = c; it < 256; it += G) hgrn_prompt_item(p, it, lds, tid); }
    else if (sub == 1) { for (int it = c; it < 256; it += G) conv_item<false>(p, it, lds, tid);
                         for (int it = c; it < 128; it += G) conv_item<true>(p, it, lds, tid); }
    else if (sub == 2) { for (int it = c; it < 256; it += G) attn_prompt_item(p, it, tid); }
    else if (sub == 3) { for (int it = c; it < 512; it += G) attn_sample_item(p, it, lds, tid); }
    else { for (int it = c; it < 1024; it += G) hgrn_sample_item(p, it, lds, tid); }
}

__device__ __forceinline__ void p6_final_norm(const Params& p) {
    const int tid = threadIdx.x, lane = tid & 63, gw = blockIdx.x * 8 + (tid >> 6), NGW = gridDim.x * 8;
    for (int r = gw; r < NTOK; r += NGW) {
        float* zr = p.out + (size_t)r * 2048;
        f32x4 v[8]; float ss = 0.f;
#pragma unroll
        for (int j = 0; j < 8; ++j) { v[j] = ((const f32x4*)zr)[lane + 64 * j]; ss += (v[j][0] * v[j][0] + v[j][1] * v[j][1]) + (v[j][2] * v[j][2] + v[j][3] * v[j][3]); }
        ss = wave_sum(ss);
        const float rinv = rsqrtf(ss * (1.f / 2048.f) + EPS);
#pragma unroll
        for (int j = 0; j < 8; ++j) { const f32x4 gg = ((const f32x4*)p.g_final)[lane + 64 * j]; ((f32x4*)zr)[lane + 64 * j] = v[j] * rinv * gg; }
    }
}

__global__ void __launch_bounds__(512, 2) fwd_megakernel(Params p) {
    extern __shared__ __attribute__((aligned(16))) unsigned char shm[];
    LAS unsigned char* lds = (LAS unsigned char*)shm;
    cg::grid_group grid = cg::this_grid();
    const int G = gridDim.x, c = blockIdx.x;
#define SEAM(ph) do { if (p.coop && (ph) + 1 < p.ph_hi) { \
        asm volatile("s_waitcnt vmcnt(0) lgkmcnt(0)" ::: "memory"); __syncthreads(); \
        grid.sync(); \
        __builtin_amdgcn_fence(__ATOMIC_ACQUIRE, "agent"); asm volatile("s_waitcnt vmcnt(0)" ::: "memory"); } } while (0)
#define RUNS(ph) (p.ph_lo <= (ph) && (ph) < p.ph_hi)
    if (RUNS(0)) { p0_prologue(p, lds); SEAM(0); }
    if (RUNS(1)) {
        SchedP1 S; S.G = G; S.c = c; S.A = (const char*)(p.ws + WS_HA); S.Bt = (const char*)(p.ws + WS_WT1);
        EpiP1 E; E.proj = (bf16_t*)(p.ws + WS_PROJ9); E.gate = (bf16_t*)(p.ws + WS_GATE); E.F = (float*)(p.ws + WS_F); E.lb = (const float*)(p.ws + WS_LB);
        E.b_gate = p.b_gate; E.out = p.out; E.mkb = (bf16_t*)(p.ws + WS_MKB); E.mvt = (bf16_t*)(p.ws + WS_MVT);
        pg8::gemm_phase(lds, 2048, S, E); SEAM(1);
    }
    if (RUNS(2)) p2_mixers(p, lds, 0);
    if (RUNS(3)) p2_mixers(p, lds, 1);
    if (RUNS(4)) p2_mixers(p, lds, 2);
    if (RUNS(5)) p2_mixers(p, lds, 3);
    if (RUNS(6)) { p2_mixers(p, lds, 4); SEAM(6); }
    if (RUNS(7)) { hgrn_norm_rows(p); SEAM(7); }
    if (RUNS(8)) {
        SchedP4 S; S.G = G; S.c = c; S.A = (const char*)(p.ws + WS_ACT3); S.Bt = (const char*)(p.ws + WS_WT3);
        EpiP4 E; E.gate = (const bf16_t*)(p.ws + WS_GATE); E.mf = (float*)(p.ws + WS_MF); E.merged = (bf16_t*)(p.ws + WS_MERGED);
        pg8::gemm_phase(lds, 1024, S, E); SEAM(8);
    }
    if (RUNS(9)) {
        SchedP5 S; S.G = G; S.c = c; S.A = (const char*)(p.ws + WS_MERGED); S.Bt = (const char*)(p.ws + WS_WTO);
        EpiP5 E; E.xp = p.x_prompt; E.xs = p.x_sample; E.out = p.out;
        pg8::gemm_phase(lds, 2048, S, E); SEAM(9);
    }
    if (RUNS(10)) { p6_final_norm(p); }
#if REP_MASK != 0
    if (RUNS(11)) { SchedP1 S; S.G = G; S.c = c; S.A = (const char*)(p.ws + WS_HA); S.Bt = (const char*)(p.ws + WS_WT1); EpiNull E; pg8::gemm_phase(lds, 2048, S, E); }
    if (RUNS(12)) { SchedP4 S; S.G = G; S.c = c; S.A = (const char*)(p.ws + WS_ACT3); S.Bt = (const char*)(p.ws + WS_WT3); EpiNull E; pg8::gemm_phase(lds, 1024, S, E); }
    if (RUNS(13)) { SchedP5 S; S.G = G; S.c = c; S.A = (const char*)(p.ws + WS_MERGED); S.Bt = (const char*)(p.ws + WS_WTO); EpiNull E; pg8::gemm_phase(lds, 2048, S, E); }
#endif
#undef RUNS
#undef SEAM
}

extern "C" void kernel_launch(void* const* d_in, const int* in_sizes, int n_in, void* d_out, int out_size, void* d_ws, size_t ws_size, hipStream_t stream) {
    static int grid = 0;
    if (grid == 0) {
        if (n_in != 23 || ws_size < WS_END) { fprintf(stderr, "kernel_launch: expected 23 inputs and >= %zu bytes of workspace, got %d / %zu\n", (size_t)WS_END, n_in, ws_size); grid = -1; return; }
        int dev = 0, cus = 0, per_cu = 0;
        hipGetDevice(&dev); hipDeviceGetAttribute(&cus, hipDeviceAttributeMultiprocessorCount, dev);
        if (hipFuncSetAttribute((const void*)fwd_megakernel, hipFuncAttributeMaxDynamicSharedMemorySize, LDS_BYTES) != hipSuccess) { fprintf(stderr, "kernel_launch: hipFuncSetAttribute failed\n"); grid = -1; return; }
        if (hipOccupancyMaxActiveBlocksPerMultiprocessor(&per_cu, (const void*)fwd_megakernel, 512, LDS_BYTES) != hipSuccess || per_cu < 1) { fprintf(stderr, "kernel_launch: occupancy query failed (%d)\n", per_cu); (void)hipGetLastError(); per_cu = 1; }
        grid = cus * 1;
        if (grid <= 0) grid = 256;
    }
    if (grid < 0) return;
    Params p{};
    const float** pp = (const float**)&p;
    for (int i = 0; i < 23; ++i) pp[i] = (const float*)d_in[i];
    p.out = (float*)d_out; p.ws = (unsigned char*)d_ws; p.pad = 0;
#if N_LAUNCH_MODE == 1
    p.ph_lo = 0; p.ph_hi = N_PHASES; p.coop = 1;
    void* args[] = {&p};
    hipError_t e = hipLaunchCooperativeKernel((const void*)fwd_megakernel, dim3(grid), dim3(512), args, LDS_BYTES, stream);
    if (e != hipSuccess) fprintf(stderr, "cooperative launch failed: %s (grid %d)\n", hipGetErrorString(e), grid);
#else
    for (int ph = 0; ph < 14; ++ph) {
        if (ph >= N_PHASES && !((REP_MASK >> ph) & 1)) continue;
        p.ph_lo = ph; p.ph_hi = ph + 1; p.coop = 0;
        hipLaunchKernelGGL(fwd_megakernel, dim3(grid), dim3(512), LDS_BYTES, stream, p);
        if (ph < N_PHASES && ((REP_MASK >> ph) & 1)) hipLaunchKernelGGL(fwd_megakernel, dim3(grid), dim3(512), LDS_BYTES, stream, p);
    }
#endif
}
```

```cpp
#include <hip/hip_runtime.h>
#include <hip/hip_cooperative_groups.h>
#include <cstdio>
namespace cg = cooperative_groups;

#define LAS __attribute__((address_space(3)))
typedef unsigned short bf16_t;
typedef short bf16x8 __attribute__((ext_vector_type(8)));
typedef float f32x4 __attribute__((ext_vector_type(4)));
typedef float f32x2 __attribute__((ext_vector_type(2)));
typedef unsigned u32x4 __attribute__((ext_vector_type(4)));
typedef unsigned u32x2 __attribute__((ext_vector_type(2)));

#ifndef REP_MASK
#define REP_MASK 0
#endif
#ifndef N_LAUNCH_MODE
#define N_LAUNCH_MODE 1
#endif

constexpr int DM = 2048, NTP = 8192, NTS = 1024, NTOK = 9216, SEQ = 2048;
constexpr int LDP = 9216;
constexpr int C_CV = 0, C_CG = 1024, C_CS = 2048, C_HQ = 3072, C_HF = 4096, C_HI = 5120, C_HOG = 6144, C_AQ = 7168, C_AS = 8192;
constexpr int LDG = 6144;
constexpr float EPS = 1e-6f;
constexpr size_t O_YP = 0, O_YS = 16777216, O_CONV_P = 18874368, O_HGRN_P = 18997248, O_MK = 19521536, O_MV = 20570112, O_CONV_S = 21618688, O_HGRN_S = 25550848;
constexpr size_t WS_WT1 = 0;
constexpr size_t WS_WT3 = WS_WT1 + (size_t)17408 * 2048 * 2;
constexpr size_t WS_WTO = WS_WT3 + (size_t)3 * 2048 * 1024 * 2;
constexpr size_t WS_HA = WS_WTO + (size_t)2048 * 2048 * 2;
constexpr size_t WS_ORAW = WS_HA;
constexpr size_t WS_PROJ9 = WS_HA + (size_t)10240 * 2048 * 2;
constexpr size_t WS_MF = WS_PROJ9;
constexpr size_t WS_MERGED = WS_MF + (size_t)9216 * 2048 * 4;
constexpr size_t WS_GATE = WS_PROJ9 + (size_t)9216 * 9216 * 2;
constexpr size_t WS_F = WS_GATE + (size_t)9216 * 6144 * 2;
constexpr size_t WS_MKB = WS_F + (size_t)9216 * 1024 * 4;
constexpr size_t WS_MVT = WS_MKB + (size_t)2097152;
constexpr size_t WS_ACT3 = WS_MVT + (size_t)2097152;
constexpr size_t WS_LB = WS_ACT3 + (size_t)3 * 9216 * 1024 * 2;
constexpr size_t WS_END = WS_LB + 4096;
constexpr int LDS_BYTES = 131072;
constexpr int N_PHASES = 7;

struct Params {
    const float *x_prompt, *x_sample, *state_conv, *state_hgrn, *cache_k, *cache_v, *mem_prompt, *g_pre, *w_in, *conv_w, *conv_b, *ln_g, *ln_b,
        *w_conv_out, *lb_logits, *g_hgrn, *w_hgrn_out, *g_mem, *w_mem_kv, *w_attn_out, *b_gate, *w_out, *g_final;
    float* out; unsigned char* ws; int ph_lo, ph_hi, coop, pad;
};

__device__ __forceinline__ unsigned f2bf(float f) { unsigned u = __builtin_bit_cast(unsigned, f); return (u + 0x7fffu + ((u >> 16) & 1u)) >> 16; }
typedef __bf16 bf16x2_t __attribute__((ext_vector_type(2)));
__device__ __forceinline__ unsigned pk2(float lo, float hi) { const f32x2 v = {lo, hi}; const bf16x2_t r = __builtin_convertvector(v, bf16x2_t); return __builtin_bit_cast(unsigned, r); }
__device__ __forceinline__ float bflo(unsigned w) { return __builtin_bit_cast(float, w << 16); }
__device__ __forceinline__ float bfhi(unsigned w) { return __builtin_bit_cast(float, w & 0xffff0000u); }
__device__ __forceinline__ float bf2f(unsigned short b) { return __builtin_bit_cast(float, ((unsigned)b) << 16); }
__device__ __forceinline__ float sigm(float x) { return __builtin_amdgcn_rcpf(1.f + __expf(-x)); }
__device__ __forceinline__ float siluf(float x) { return x * sigm(x); }
__device__ __forceinline__ float wave_sum(float v) {
#pragma unroll
    for (int o = 1; o < 64; o <<= 1) v += __shfl_xor(v, o);
    return v;
}
__device__ __forceinline__ float wave_max(float v) {
#pragma unroll
    for (int o = 1; o < 64; o <<= 1) v = fmaxf(v, __shfl_xor(v, o));
    return v;
}

namespace pg8 {
constexpr int BM = 256, BK = 64, HALF = 128, HTB = HALF * BK * 2, STAGE_BYTES = 8 * HTB, NXCD = 8, WGM = 8;
__host__ __device__ __forceinline__ int lds_byte(int r, int c) { const int st = (r >> 4) * 2 + (c >> 5), rr = r & 15, cc = c & 31, ob = rr * 64 + cc * 2; return st * 1024 + (ob ^ (((ob >> 9) & 1) << 5)); }
__host__ __device__ __forceinline__ void stage_rc(int b, int& R, int& C) { const int st = b / 1024, sb = b % 1024, swz = sb ^ (((sb >> 9) & 1) << 5); R = (st >> 1) * 16 + swz / 64; C = (st & 1) * 32 + (swz % 64) / 2; }
__host__ __device__ __forceinline__ int perm32(int rho) { const int n = rho >> 4, i = rho & 15; return 8 * (i >> 2) + 4 * n + (i & 3); }
struct Unit { int pm, pn, br; };
__device__ __forceinline__ void tile_of(int wgid, int nM, int nN, int& pm, int& pn) {
    const int nwg = nM * nN;
    { const int q = nwg / NXCD, r = nwg % NXCD, xcd = wgid % NXCD, off = wgid / NXCD; wgid = (xcd < r ? xcd * (q + 1) : r * (q + 1) + (xcd - r) * q) + off; }
    const int nig = WGM * nN, gid = wgid / nig, fm = gid * WGM, gsz = (nM - fm) < WGM ? (nM - fm) : WGM;
    pm = fm + ((wgid % nig) % gsz); pn = (wgid % nig) / gsz;
}

template <class Epi, class Sched>
__device__ __forceinline__ void gemm_phase(LAS unsigned char* lds, const int K, const Sched& S, const Epi& E) {
    const int tid = threadIdx.x, wid = __builtin_amdgcn_readfirstlane(tid >> 6), lane = tid & 63, wr = wid >> 2, wc = wid & 3, fr = lane & 15, fq = lane >> 4;
    const int nt = K / BK;
    unsigned voffA[2], voffB[2];
#pragma unroll
    for (int i = 0; i < 2; ++i) { int R, C; stage_rc(tid * 16 + i * 8192, R, C); const int Rb = (R & ~31) + perm32(R & 31);
        voffA[i] = (unsigned)(R * K + C) * 2u; voffB[i] = (unsigned)(Rb * K + C) * 2u; }
    const size_t kstep = (size_t)(BK * 2);
    const size_t hstep = (size_t)HALF * K * 2;
    const unsigned ldsw = (unsigned)wid * 1024u;
    const int aoff = lds_byte(wr * 64 + fr, fq * 8), boff = lds_byte(wc * 32 + fr, fq * 8);
#define PG8_SA(b, h) (((b) * 2 + (h)) * HTB)
#define PG8_SB(b, h) ((4 + (b) * 2 + (h)) * HTB)
#define PG8_STAGE(bufoff, gbase, voff) do { _Pragma("unroll") for (int _i = 0; _i < 2; ++_i) \
        __builtin_amdgcn_global_load_lds((const unsigned*)((const char*)(gbase) + (voff)[_i]), (LAS unsigned*)(lds + (bufoff) + ldsw + _i * 8192), 16, 0, 0); } while (0)
#define PG8_LDA(dst, b, h) do { _Pragma("unroll") for (int m = 0; m < 4; ++m) _Pragma("unroll") for (int k = 0; k < 2; ++k) dst[m][k] = *(const LAS bf16x8*)(lds + PG8_SA(b, h) + aoff + m * 2048 + k * 1024); } while (0)
#define PG8_LDB(dst, b, h) do { _Pragma("unroll") for (int n = 0; n < 2; ++n) _Pragma("unroll") for (int k = 0; k < 2; ++k) dst[n][k] = *(const LAS bf16x8*)(lds + PG8_SB(b, h) + boff + n * 2048 + k * 1024); } while (0)
#define PG8_MMA(ai, bj, At, Bt) do { __builtin_amdgcn_s_setprio(1); _Pragma("unroll") for (int m = 0; m < 4; ++m) _Pragma("unroll") for (int n = 0; n < 2; ++n) _Pragma("unroll") for (int k = 0; k < 2; ++k) \
        acc[ai][bj][m][n] = __builtin_amdgcn_mfma_f32_16x16x32_bf16(Bt[n][k], At[m][k], acc[ai][bj][m][n], 0, 0, 0); __builtin_amdgcn_s_setprio(0); } while (0)
#define PG8_WAIT_V(n) asm volatile("s_waitcnt vmcnt(" #n ")" ::: "memory")
#define PG8_WAIT_L(n) asm volatile("s_waitcnt lgkmcnt(" #n ")" ::: "memory")
#define PG8_BAR __builtin_amdgcn_s_barrier()
#define PG8_SCHED __builtin_amdgcn_sched_barrier(0)
    Unit cur, nxt; int ui = 0;
    if (!S.next(0, cur)) return;
    f32x4 acc[2][2][4][2];
#pragma unroll
    for (int a = 0; a < 2; ++a)
#pragma unroll
        for (int b = 0; b < 2; ++b)
#pragma unroll
            for (int m = 0; m < 4; ++m)
#pragma unroll
                for (int n = 0; n < 2; ++n) acc[a][b][m][n] = (f32x4){0.f, 0.f, 0.f, 0.f};
    bf16x8 At[4][2], B0[2][2], B1[2][2];
    const char* cA = S.a_base(cur); const char* cB = S.b_base(cur);
    PG8_STAGE(PG8_SB(0, 0), cB, voffB); PG8_STAGE(PG8_SA(0, 0), cA, voffA); PG8_STAGE(PG8_SB(0, 1), cB + hstep, voffB); PG8_STAGE(PG8_SA(0, 1), cA + hstep, voffA);
    if (wr == 1) PG8_BAR;
    PG8_WAIT_V(4); PG8_BAR;
    PG8_STAGE(PG8_SB(1, 0), cB + kstep, voffB); PG8_STAGE(PG8_SA(1, 0), cA + kstep, voffA); PG8_STAGE(PG8_SB(1, 1), cB + hstep + kstep, voffB);
    PG8_WAIT_V(6); PG8_BAR;
    for (;;) {
        const bool has_next = S.next(ui + 1, nxt);
        const char* nA = has_next ? S.a_base(nxt) : cA; const char* nB = has_next ? S.b_base(nxt) : cB;
        for (int t = 0; t < nt; t += 2) {
            const bool last = (t == nt - 2);
            const char* a1 = cA + (size_t)(t + 1) * kstep;
            const char* a2 = last ? nA : cA + (size_t)(t + 2) * kstep; const char* b2 = last ? nB : cB + (size_t)(t + 2) * kstep;
            const char* a3 = a2 + kstep; const char* b3 = b2 + kstep;
            PG8_LDB(B0, 0, 0); PG8_SCHED; PG8_LDA(At, 0, 0); PG8_STAGE(PG8_SA(1, 1), a1 + hstep, voffA);
            PG8_WAIT_L(8); PG8_BAR; PG8_WAIT_L(0); PG8_MMA(0, 0, At, B0); PG8_BAR; PG8_SCHED;
            PG8_LDB(B1, 0, 1); PG8_STAGE(PG8_SB(0, 0), b2, voffB);
            PG8_BAR; PG8_WAIT_L(0); PG8_MMA(0, 1, At, B1); PG8_BAR;
            PG8_LDA(At, 0, 1); PG8_STAGE(PG8_SA(0, 0), a2, voffA);
            PG8_BAR; PG8_WAIT_L(0); PG8_MMA(1, 0, At, B0); PG8_BAR; PG8_SCHED;
            PG8_STAGE(PG8_SB(0, 1), b2 + hstep, voffB);
            PG8_WAIT_V(6); PG8_BAR; PG8_MMA(1, 1, At, B1); PG8_BAR;
            PG8_LDB(B0, 1, 0); PG8_SCHED; PG8_LDA(At, 1, 0); PG8_STAGE(PG8_SA(0, 1), a2 + hstep, voffA);
            PG8_WAIT_L(8); PG8_BAR; PG8_WAIT_L(0); PG8_MMA(0, 0, At, B0); PG8_BAR; PG8_SCHED;
            PG8_LDB(B1, 1, 1); PG8_STAGE(PG8_SB(1, 0), b3, voffB);
            PG8_BAR; PG8_WAIT_L(0); PG8_MMA(0, 1, At, B1); PG8_BAR;
            PG8_LDA(At, 1, 1); PG8_STAGE(PG8_SA(1, 0), a3, voffA);
            PG8_BAR; PG8_WAIT_L(0); PG8_MMA(1, 0, At, B0); PG8_BAR; PG8_SCHED;
            PG8_STAGE(PG8_SB(1, 1), b3 + hstep, voffB);
            PG8_WAIT_V(6); PG8_BAR; PG8_MMA(1, 1, At, B1); PG8_BAR;
        }
        const bool keep = E(acc, cur, wr, wc, fr, fq);
        if (!has_next) break;
        if (!keep)
#pragma unroll
        for (int a = 0; a < 2; ++a)
#pragma unroll
            for (int b = 0; b < 2; ++b)
#pragma unroll
                for (int m = 0; m < 4; ++m)
#pragma unroll
                    for (int n = 0; n < 2; ++n) acc[a][b][m][n] = (f32x4){0.f, 0.f, 0.f, 0.f};
        cur = nxt; cA = nA; cB = nB; ++ui;
    }
    PG8_WAIT_V(0);
    if (wr == 0) PG8_BAR;
    PG8_BAR;
#undef PG8_SA
#undef PG8_SB
#undef PG8_STAGE
#undef PG8_LDA
#undef PG8_LDB
#undef PG8_MMA
#undef PG8_WAIT_V
#undef PG8_WAIT_L
#undef PG8_BAR
#undef PG8_SCHED
}
}
using pg8::Unit;

struct SchedP1 {
    int G, c; const char* A; const char* Bt;
    __device__ __forceinline__ bool next(int i, Unit& u) const {
        const int L = i * G + c; if (L >= 2192) return false;
        u.br = 0;
        if (L >= 2160) { const int idx = L - 2160; u.pm = 36 + (idx >> 3); u.pn = 60 + (idx & 7); return true; }
        pg8::tile_of(L, 36, 60, u.pm, u.pn); return true;
    }
    __device__ __forceinline__ const char* a_base(const Unit& u) const { return A + (size_t)u.pm * (256 * 2048 * 2); }
    __device__ __forceinline__ const char* b_base(const Unit& u) const { return Bt + (size_t)u.pn * (256 * 2048 * 2); }
};
struct EpiP1 {
    bf16_t* proj; bf16_t* gate; float* F; const float* lb; const float* b_gate; float* out; bf16_t* mkb; bf16_t* mvt;
    __device__ __forceinline__ bool operator()(f32x4 (&acc)[2][2][4][2], const Unit& u, int wr, int wc, int fr, int fq) const {
        const int rloc = wr * 64 + fr, cloc = wc * 32 + 8 * fq;
        if (u.pn < 36) {
            const int seg = u.pn >> 2;
#pragma unroll
            for (int bj = 0; bj < 2; ++bj) {
                const int col = u.pn * 256 + bj * 128 + cloc;
                f32x4 l0 = (f32x4){0.f, 0.f, 0.f, 0.f}, l1 = l0;
                if (seg == 4) { l0 = *(const f32x4*)(lb + (col - C_HF)); l1 = *(const f32x4*)(lb + (col - C_HF) + 4); }
#pragma unroll
                for (int ai = 0; ai < 2; ++ai)
#pragma unroll
                    for (int m = 0; m < 4; ++m) {
                        const size_t row = (size_t)u.pm * 256 + ai * 128 + m * 16 + rloc;
                        f32x4 v0 = acc[ai][bj][m][0], v1 = acc[ai][bj][m][1];
                        if (seg == 4) {
#pragma unroll
                            for (int e = 0; e < 4; ++e) { v0[e] = l0[e] + (1.f - l0[e]) * sigm(v0[e]); v1[e] = l1[e] + (1.f - l1[e]) * sigm(v1[e]); }
                            float* fp = F + row * 1024 + (col - C_HF);
                            *(f32x4*)fp = v0; *(f32x4*)(fp + 4) = v1;
                        } else {
                            if (seg == 1) {
#pragma unroll
                                for (int e = 0; e < 4; ++e) { v0[e] = sigm(v0[e]); v1[e] = sigm(v1[e]); }
                            } else if (seg == 2 || seg == 6 || seg == 8) {
#pragma unroll
                                for (int e = 0; e < 4; ++e) { v0[e] = siluf(v0[e]); v1[e] = siluf(v1[e]); }
                            } else if (seg == 3) { v0 *= 0.08838834764831845f; v1 *= 0.08838834764831845f; }
                            else if (seg == 7) { v0 *= 0.0625f; v1 *= 0.0625f; }
                            u32x4 o; o.x = pk2(v0[0], v0[1]); o.y = pk2(v0[2], v0[3]); o.z = pk2(v1[0], v1[1]); o.w = pk2(v1[2], v1[3]);
                            *(u32x4*)(proj + row * LDP + col) = o;
                        }
                    }
            }
        } else if (u.pn < 60) {
#pragma unroll
            for (int bj = 0; bj < 2; ++bj) {
                const int col = (u.pn - 36) * 256 + bj * 128 + cloc;
                const f32x4 b0 = *(const f32x4*)(b_gate + col), b1 = *(const f32x4*)(b_gate + col + 4);
#pragma unroll
                for (int ai = 0; ai < 2; ++ai)
#pragma unroll
                    for (int m = 0; m < 4; ++m) {
                        const size_t row = (size_t)u.pm * 256 + ai * 128 + m * 16 + rloc;
                        f32x4 v0 = acc[ai][bj][m][0] + b0, v1 = acc[ai][bj][m][1] + b1;
#pragma unroll
                        for (int e = 0; e < 4; ++e) { v0[e] = fmaxf(sigm(v0[e]), 1e-6f); v1[e] = fmaxf(sigm(v1[e]), 1e-6f); }
                        u32x4 o; o.x = pk2(v0[0], v0[1]); o.y = pk2(v0[2], v0[3]); o.z = pk2(v1[0], v1[1]); o.w = pk2(v1[2], v1[3]);
                        *(u32x4*)(gate + row * LDG + col) = o;
                    }
            }
        } else {
            const int n = u.pm - 36, isv = (u.pn >= 64) ? 1 : 0, h = (u.pn - 60) & 3;
            float* ob = out + (isv ? O_MV : O_MK);
#pragma unroll
            for (int bj = 0; bj < 2; ++bj) {
                const int d = bj * 128 + cloc;
#pragma unroll
                for (int ai = 0; ai < 2; ++ai)
#pragma unroll
                    for (int m = 0; m < 4; ++m) {
                        const int key = ai * 128 + m * 16 + rloc;
                        const f32x4 v0 = acc[ai][bj][m][0], v1 = acc[ai][bj][m][1];
                        float* op = ob + ((size_t)(n * 256 + key) * 4 + h) * 256 + d;
                        *(f32x4*)op = v0; *(f32x4*)(op + 4) = v1;
                        if (!isv) {
                            u32x4 o; o.x = pk2(v0[0], v0[1]); o.y = pk2(v0[2], v0[3]); o.z = pk2(v1[0], v1[1]); o.w = pk2(v1[2], v1[3]);
                            *(u32x4*)(mkb + ((size_t)(n * 4 + h) * 256 + key) * 256 + d) = o;
                        } else {
                            bf16_t* vp = mvt + ((size_t)(n * 4 + h) * 256 + d) * 256 + key;
#pragma unroll
                            for (int e = 0; e < 4; ++e) { vp[(size_t)e * 256] = (bf16_t)f2bf(v0[e]); vp[(size_t)(e + 4) * 256] = (bf16_t)f2bf(v1[e]); }
                        }
                    }
            }
        }
        return false;
    }
};

struct SchedP4 {
    int G, c; const char* A; const char* Bt;
    __device__ __forceinline__ bool next(int i, Unit& u) const {
        const int tri = i / 3, L = tri * G + c; if (L >= 288) return false;
        u.br = i - tri * 3; pg8::tile_of(L, 36, 8, u.pm, u.pn); return true;
    }
    __device__ __forceinline__ const char* a_base(const Unit& u) const { return A + (size_t)u.br * ((size_t)9216 * 1024 * 2) + (size_t)u.pm * (256 * 1024 * 2); }
    __device__ __forceinline__ const char* b_base(const Unit& u) const { return Bt + (size_t)u.br * ((size_t)2048 * 1024 * 2) + (size_t)u.pn * (256 * 1024 * 2); }
};
struct EpiP4 {
    const bf16_t* gate; bf16_t* merged;
    __device__ __forceinline__ bool operator()(f32x4 (&acc)[2][2][4][2], const Unit& u, int wr, int wc, int fr, int fq) const {
        const int rloc = wr * 64 + fr, cloc = wc * 32 + 8 * fq;
#pragma unroll
        for (int bj = 0; bj < 2; ++bj) {
            const int col = u.pn * 256 + bj * 128 + cloc;
#pragma unroll
            for (int ai = 0; ai < 2; ++ai)
#pragma unroll
                for (int m = 0; m < 4; ++m) {
                    const size_t row = (size_t)u.pm * 256 + ai * 128 + m * 16 + rloc;
                    const bf16_t* gp = gate + row * LDG + u.br * 2048 + col;
                    const u32x4 g = *(const u32x4*)gp;
                    f32x4 s0 = (f32x4){bflo(g.x), bfhi(g.x), bflo(g.y), bfhi(g.y)}, s1 = (f32x4){bflo(g.z), bfhi(g.z), bflo(g.w), bfhi(g.w)};
                    if (u.br < 2) {
                        const u32x4 h = *(const u32x4*)(gp + 2048);
                        s0[0] *= __builtin_amdgcn_rcpf(bflo(h.x)); s0[1] *= __builtin_amdgcn_rcpf(bfhi(h.x)); s0[2] *= __builtin_amdgcn_rcpf(bflo(h.y)); s0[3] *= __builtin_amdgcn_rcpf(bfhi(h.y));
                        s1[0] *= __builtin_amdgcn_rcpf(bflo(h.z)); s1[1] *= __builtin_amdgcn_rcpf(bfhi(h.z)); s1[2] *= __builtin_amdgcn_rcpf(bflo(h.w)); s1[3] *= __builtin_amdgcn_rcpf(bfhi(h.w));
                    }
                    acc[ai][bj][m][0] *= s0; acc[ai][bj][m][1] *= s1;
                    if (u.br == 2) { const f32x4 v0 = acc[ai][bj][m][0], v1 = acc[ai][bj][m][1];
                        u32x4 o; o.x = pk2(v0[0], v0[1]); o.y = pk2(v0[2], v0[3]); o.z = pk2(v1[0], v1[1]); o.w = pk2(v1[2], v1[3]);
                        *(u32x4*)(merged + row * 2048 + col) = o; }
                }
        }
        return u.br < 2;
    }
};

struct SchedP5 {
    int G, c; const char* A; const char* Bt;
    __device__ __forceinline__ bool next(int i, Unit& u) const {
        const int L = i * G + c; if (L >= 288) return false;
        u.br = 0; pg8::tile_of(L, 36, 8, u.pm, u.pn); return true;
    }
    __device__ __forceinline__ const char* a_base(const Unit& u) const { return A + (size_t)u.pm * (256 * 2048 * 2); }
    __device__ __forceinline__ const char* b_base(const Unit& u) const { return Bt + (size_t)u.pn * (256 * 2048 * 2); }
};
struct EpiP5 {
    const float* xp; const float* xs; float* out;
    __device__ __forceinline__ bool operator()(f32x4 (&acc)[2][2][4][2], const Unit& u, int wr, int wc, int fr, int fq) const {
        const int rloc = wr * 64 + fr, cloc = wc * 32 + 8 * fq;
#pragma unroll
        for (int bj = 0; bj < 2; ++bj) {
            const int col = u.pn * 256 + bj * 128 + cloc;
#pragma unroll
            for (int ai = 0; ai < 2; ++ai)
#pragma unroll
                for (int m = 0; m < 4; ++m) {
                    const size_t row = (size_t)u.pm * 256 + ai * 128 + m * 16 + rloc;
                    const float* xr = (row < (size_t)NTP) ? (xp + row * 2048 + col) : (xs + (row - NTP) * 2048 + col);
                    const f32x4 v0 = acc[ai][bj][m][0] + *(const f32x4*)xr, v1 = acc[ai][bj][m][1] + *(const f32x4*)(xr + 4);
                    float* op = out + row * 2048 + col;
                    *(f32x4*)op = v0; *(f32x4*)(op + 4) = v1;
                }
        }
        return false;
    }
};

struct EpiNull {
    __device__ __forceinline__ bool operator()(f32x4 (&acc)[2][2][4][2], const Unit& u, int wr, int wc, int fr, int fq) const {
        f32x4 t = (f32x4){0.f, 0.f, 0.f, 0.f};
#pragma unroll
        for (int ai = 0; ai < 2; ++ai)
#pragma unroll
            for (int bj = 0; bj < 2; ++bj)
#pragma unroll
                for (int m = 0; m < 4; ++m) t += acc[ai][bj][m][0] + acc[ai][bj][m][1];
        asm volatile("" :: "v"(t[0]), "v"(t[1]), "v"(t[2]), "v"(t[3]));
        return false;
    }
};
__device__ __forceinline__ void transpose_tile(const float* W, int K, int N, bf16_t* WT, int row_off, int kb, int nb, LAS unsigned* T32, int tid) {
    const int nq = tid & 31, kp0 = tid >> 5;
#pragma unroll
    for (int i = 0; i < 4; ++i) {
        const int kpair = kp0 + 16 * i;
        const float* src = W + (size_t)(kb * 128 + 2 * kpair) * N + nb * 128 + 4 * nq;
        const f32x4 r0 = *(const f32x4*)src, r1 = *(const f32x4*)(src + N);
        T32[(4 * nq + 0) * 65 + kpair] = pk2(r0[0], r1[0]); T32[(4 * nq + 1) * 65 + kpair] = pk2(r0[1], r1[1]);
        T32[(4 * nq + 2) * 65 + kpair] = pk2(r0[2], r1[2]); T32[(4 * nq + 3) * 65 + kpair] = pk2(r0[3], r1[3]);
    }
    __syncthreads();
#pragma unroll
    for (int i = 0; i < 4; ++i) {
        const int id = tid + 512 * i, n = id >> 4, c = id & 15;
        u32x4 o; o.x = T32[n * 65 + 4 * c]; o.y = T32[n * 65 + 4 * c + 1]; o.z = T32[n * 65 + 4 * c + 2]; o.w = T32[n * 65 + 4 * c + 3];
        *(u32x4*)(WT + (size_t)(row_off + nb * 128 + n) * K + kb * 128 + 8 * c) = o;
    }
    __syncthreads();
}
__device__ __forceinline__ void rms_row_to_bf16(const float* xrow, const float* g, bf16_t* orow, int lane) {
    f32x4 v[8]; float ss = 0.f;
#pragma unroll
    for (int j = 0; j < 8; ++j) { v[j] = ((const f32x4*)xrow)[lane + 64 * j]; ss += (v[j][0] * v[j][0] + v[j][1] * v[j][1]) + (v[j][2] * v[j][2] + v[j][3] * v[j][3]); }
    ss = wave_sum(ss);
    const float rinv = rsqrtf(ss * (1.f / 2048.f) + EPS);
#pragma unroll
    for (int j = 0; j < 8; ++j) { const f32x4 gg = ((const f32x4*)g)[lane + 64 * j];
        u32x2 o; o.x = pk2(v[j][0] * rinv * gg[0], v[j][1] * rinv * gg[1]); o.y = pk2(v[j][2] * rinv * gg[2], v[j][3] * rinv * gg[3]);
        ((u32x2*)orow)[lane + 64 * j] = o; }
}
__device__ __forceinline__ void p0_prologue(const Params& p, LAS unsigned char* lds) {
    const int tid = threadIdx.x, lane = tid & 63, wave = tid >> 6, G = gridDim.x, c = blockIdx.x;
    LAS unsigned* T32 = (LAS unsigned*)lds;
    bf16_t* WT1 = (bf16_t*)(p.ws + WS_WT1); bf16_t* WT3 = (bf16_t*)(p.ws + WS_WT3); bf16_t* WTO = (bf16_t*)(p.ws + WS_WTO);
    constexpr int T_IN = 1920, T_MKV = 256, T_BR = 128, T_OUT = 256, T_ALL = T_IN + T_MKV + 3 * T_BR + T_OUT;
    for (int it = c; it < T_ALL; it += G) {
        int r = it;
        if (r < T_IN) { transpose_tile(p.w_in, 2048, 15360, WT1, 0, r / 120, r % 120, T32, tid); continue; } r -= T_IN;
        if (r < T_MKV) { transpose_tile(p.w_mem_kv, 2048, 2048, WT1, 15360, r / 16, r % 16, T32, tid); continue; } r -= T_MKV;
        if (r < T_BR) { transpose_tile(p.w_conv_out, 1024, 2048, WT3, 0, r / 16, r % 16, T32, tid); continue; } r -= T_BR;
        if (r < T_BR) { transpose_tile(p.w_hgrn_out, 1024, 2048, WT3 + (size_t)2048 * 1024, 0, r / 16, r % 16, T32, tid); continue; } r -= T_BR;
        if (r < T_BR) { transpose_tile(p.w_attn_out, 1024, 2048, WT3 + (size_t)2 * 2048 * 1024, 0, r / 16, r % 16, T32, tid); continue; } r -= T_BR;
        transpose_tile(p.w_out, 2048, 2048, WTO, 0, r / 16, r % 16, T32, tid);
    }
    bf16_t* HA = (bf16_t*)(p.ws + WS_HA);
    const int gw = c * 8 + wave, NGW = G * 8;
    for (int m = gw; m < 10240; m += NGW) {
        if (m < NTP) rms_row_to_bf16(p.x_prompt + (size_t)m * 2048, p.g_pre, HA + (size_t)m * 2048, lane);
        else if (m < NTOK) rms_row_to_bf16(p.x_sample + (size_t)(m - NTP) * 2048, p.g_pre, HA + (size_t)m * 2048, lane);
        else rms_row_to_bf16(p.mem_prompt + (size_t)(m - NTOK) * 2048, p.g_mem, HA + (size_t)m * 2048, lane);
    }
    if (c == 0) { float* LB = (float*)(p.ws + WS_LB);
        for (int i = tid; i < 1024; i += 512) LB[i] = 1.f / (1.f + __expf(p.lb_logits[1024 + i] - p.lb_logits[i])); }
}

__device__ __forceinline__ void hgrn_prompt_item(const Params& p, int item, LAS unsigned char* lds, int tid) {
    LAS float* qs = (LAS float*)lds;
    LAS float* fs = qs + 4096;
    LAS float* vs = fs + 4096;
    LAS float* part = vs + 512;
    const int s = item >> 3, n = s >> 3, h = s & 7, dvg = item & 7;
    const int vcol = tid & 15, kg = tid >> 4;
    const bf16_t* proj = (const bf16_t*)(p.ws + WS_PROJ9);
    const float* F = (const float*)(p.ws + WS_F);
    float* oraw = (float*)(p.ws + WS_ORAW);
    const size_t row0 = (size_t)n * SEQ;
    const bf16_t* qsrc = proj + (row0 + kg) * LDP + C_HQ + h * 128 + vcol * 8;
    const float* fsrc = F + (row0 + kg) * 1024 + h * 128 + vcol * 8;
    const bf16_t* vsrc = proj + (row0 + kg) * LDP + C_HI + h * 128 + dvg * 16 + vcol;
    float S0 = 0.f, S1 = 0.f, S2 = 0.f, S3 = 0.f;
    u32x4 rq = *(const u32x4*)qsrc; f32x4 rf0 = *(const f32x4*)fsrc, rf1 = *(const f32x4*)(fsrc + 4); bf16_t rv = *vsrc;
    for (int t0 = 0; t0 < SEQ; t0 += 32) {
        { LAS float* qd = qs + kg * 128 + vcol * 8;
          *(LAS f32x4*)qd = (f32x4){bflo(rq.x), bfhi(rq.x), bflo(rq.y), bfhi(rq.y)}; *(LAS f32x4*)(qd + 4) = (f32x4){bflo(rq.z), bfhi(rq.z), bflo(rq.w), bfhi(rq.w)};
          LAS float* fd = fs + kg * 128 + vcol * 8; *(LAS f32x4*)fd = rf0; *(LAS f32x4*)(fd + 4) = rf1;
          vs[kg * 16 + vcol] = bf2f(rv); }
        __syncthreads();
        if (t0 + 32 < SEQ) { const size_t adv = (size_t)(t0 + 32);
            rq = *(const u32x4*)(qsrc + adv * LDP); rf0 = *(const f32x4*)(fsrc + adv * 1024); rf1 = *(const f32x4*)(fsrc + adv * 1024 + 4); rv = *(vsrc + adv * LDP); }
#pragma unroll 4
        for (int tt = 0; tt < 32; ++tt) {
            const f32x4 f4 = *(const LAS f32x4*)(fs + tt * 128 + kg * 4), q4 = *(const LAS f32x4*)(qs + tt * 128 + kg * 4);
            const float vv = vs[tt * 16 + vcol];
            S0 = f4[0] * S0 + (1.f - f4[0]) * vv; S1 = f4[1] * S1 + (1.f - f4[1]) * vv; S2 = f4[2] * S2 + (1.f - f4[2]) * vv; S3 = f4[3] * S3 + (1.f - f4[3]) * vv;
            part[tt * 528 + tid] = (S0 * q4[0] + S1 * q4[1]) + (S2 * q4[2] + S3 * q4[3]);
        }
        __syncthreads();
        { float a = 0.f;
#pragma unroll 8
          for (int k2 = 0; k2 < 32; ++k2) a += part[kg * 528 + k2 * 16 + vcol];
          oraw[(row0 + t0 + kg) * 1024 + h * 128 + dvg * 16 + vcol] = a; }
    }
    float* so = p.out + O_HGRN_P + ((size_t)(n * 8 + h) * 128 + kg * 4) * 128 + dvg * 16 + vcol;
    so[0] = S0; so[128] = S1; so[256] = S2; so[384] = S3;
    __syncthreads();
}

__device__ __forceinline__ void hgrn_sample_item(const Params& p, int item, LAS unsigned char* lds, int tid) {
    LAS float* qs = (LAS float*)lds;
    LAS float* fs = qs + 1024;
    LAS float* vs = fs + 1024;
    LAS float* opart = vs + 1024;
    const int n = item >> 3, h = item & 7, lane = tid & 63, wave = tid >> 6;
    const bf16_t* proj = (const bf16_t*)(p.ws + WS_PROJ9);
    const float* F = (const float*)(p.ws + WS_F);
    const size_t row0 = (size_t)NTP + (size_t)n * 8;
    { const int tt = tid >> 6, k2 = (tid & 63) * 2; const size_t r = row0 + tt;
      const unsigned qw = *(const unsigned*)(proj + r * LDP + C_HQ + h * 128 + k2); const f32x2 ff = *(const f32x2*)(F + r * 1024 + h * 128 + k2);
      const unsigned vw = *(const unsigned*)(proj + r * LDP + C_HI + h * 128 + k2);
      qs[tt * 128 + k2] = bflo(qw); qs[tt * 128 + k2 + 1] = bfhi(qw); fs[tt * 128 + k2] = ff[0]; fs[tt * 128 + k2 + 1] = ff[1];
      vs[tt * 128 + k2] = bflo(vw); vs[tt * 128 + k2 + 1] = bfhi(vw); }
    const int v4 = tid & 31, kg = tid >> 5;
    const size_t sbase = ((size_t)(n * 8 + h) * 128 + kg * 8) * 128 + v4 * 4;
    f32x4 S[8];
#pragma unroll
    for (int i = 0; i < 8; ++i) S[i] = *(const f32x4*)(p.state_hgrn + sbase + (size_t)i * 128);
    __syncthreads();
#pragma unroll
    for (int tt = 0; tt < 8; ++tt) {
        const f32x4 fa = *(const LAS f32x4*)(fs + tt * 128 + kg * 8), fb = *(const LAS f32x4*)(fs + tt * 128 + kg * 8 + 4);
        const f32x4 qa = *(const LAS f32x4*)(qs + tt * 128 + kg * 8), qb = *(const LAS f32x4*)(qs + tt * 128 + kg * 8 + 4);
        const f32x4 vv = *(const LAS f32x4*)(vs + tt * 128 + v4 * 4);
        f32x4 po = (f32x4){0.f, 0.f, 0.f, 0.f};
#pragma unroll
        for (int i = 0; i < 8; ++i) { const float f = (i < 4) ? fa[i & 3] : fb[i & 3], q = (i < 4) ? qa[i & 3] : qb[i & 3];
            S[i] = S[i] * f + vv * (1.f - f); po += S[i] * q; }
#pragma unroll
        for (int e = 0; e < 4; ++e) po[e] += __shfl_xor(po[e], 32);
        if (lane < 32) *(LAS f32x4*)(opart + (tt * 8 + wave) * 128 + v4 * 4) = po;
    }
    float* so = p.out + O_HGRN_S + sbase;
#pragma unroll
    for (int i = 0; i < 8; ++i) *(f32x4*)(so + (size_t)i * 128) = S[i];
    __syncthreads();
    { const int tt = tid >> 6, v = (tid & 63) * 2; float o0 = 0.f, o1 = 0.f;
#pragma unroll
      for (int w = 0; w < 8; ++w) { const f32x2 t = *(const LAS f32x2*)(opart + (tt * 8 + w) * 128 + v); o0 += t[0]; o1 += t[1]; }
      const float ss = wave_sum(o0 * o0 + o1 * o1), rinv = rsqrtf(ss * (1.f / 128.f) + EPS);
      const size_t r = row0 + tt; const f32x2 gg = *(const f32x2*)(p.g_hgrn + h * 128 + v);
      const unsigned gw = *(const unsigned*)(proj + r * LDP + C_HOG + h * 128 + v);
      bf16_t* og = (bf16_t*)(p.ws + WS_ACT3) + (size_t)9216 * 1024 + r * 1024 + h * 128 + v;
      *(unsigned*)og = pk2(o0 * rinv * gg[0] * bflo(gw), o1 * rinv * gg[1] * bfhi(gw)); }
    __syncthreads();
}

__device__ __forceinline__ void hgrn_norm_rows(const Params& p) {
    const int tid = threadIdx.x, lane = tid & 63, gw = blockIdx.x * 8 + (tid >> 6), NGW = gridDim.x * 8;
    const bf16_t* proj = (const bf16_t*)(p.ws + WS_PROJ9); const float* oraw = (const float*)(p.ws + WS_ORAW);
    bf16_t* og = (bf16_t*)(p.ws + WS_ACT3) + (size_t)9216 * 1024;
    for (int r = gw; r < NTP; r += NGW) {
        f32x4 o[4]; float ss = 0.f;
#pragma unroll
        for (int j = 0; j < 4; ++j) { o[j] = *(const f32x4*)(oraw + (size_t)r * 1024 + lane * 16 + j * 4); ss += (o[j][0] * o[j][0] + o[j][1] * o[j][1]) + (o[j][2] * o[j][2] + o[j][3] * o[j][3]); }
        ss += __shfl_xor(ss, 1); ss += __shfl_xor(ss, 2); ss += __shfl_xor(ss, 4);
        const float rinv = rsqrtf(ss * (1.f / 128.f) + EPS);
        const u32x4 ga = *(const u32x4*)(proj + (size_t)r * LDP + C_HOG + lane * 16), gb = *(const u32x4*)(proj + (size_t)r * LDP + C_HOG + lane * 16 + 8);
        f32x4 g[4];
#pragma unroll
        for (int j = 0; j < 4; ++j) g[j] = *(const f32x4*)(p.g_hgrn + lane * 16 + j * 4);
        u32x4 oa, ob;
        oa.x = pk2(o[0][0] * rinv * g[0][0] * bflo(ga.x), o[0][1] * rinv * g[0][1] * bfhi(ga.x)); oa.y = pk2(o[0][2] * rinv * g[0][2] * bflo(ga.y), o[0][3] * rinv * g[0][3] * bfhi(ga.y));
        oa.z = pk2(o[1][0] * rinv * g[1][0] * bflo(ga.z), o[1][1] * rinv * g[1][1] * bfhi(ga.z)); oa.w = pk2(o[1][2] * rinv * g[1][2] * bflo(ga.w), o[1][3] * rinv * g[1][3] * bfhi(ga.w));
        ob.x = pk2(o[2][0] * rinv * g[2][0] * bflo(gb.x), o[2][1] * rinv * g[2][1] * bfhi(gb.x)); ob.y = pk2(o[2][2] * rinv * g[2][2] * bflo(gb.y), o[2][3] * rinv * g[2][3] * bfhi(gb.y));
        ob.z = pk2(o[3][0] * rinv * g[3][0] * bflo(gb.z), o[3][1] * rinv * g[3][1] * bfhi(gb.z)); ob.w = pk2(o[3][2] * rinv * g[3][2] * bflo(gb.w), o[3][3] * rinv * g[3][3] * bfhi(gb.w));
        *(u32x4*)(og + (size_t)r * 1024 + lane * 16) = oa; *(u32x4*)(og + (size_t)r * 1024 + lane * 16 + 8) = ob;
    }
}

template <bool SAMPLE>
__device__ __forceinline__ void conv_item(const Params& p, int item, LAS unsigned char* lds, int tid) {
    constexpr int T = SAMPLE ? 8 : 32;
    constexpr int GP = 4, NG = (T + 32) / GP, G0 = 32 / GP;
    LAS float* dcs = (LAS float*)lds;
    const bf16_t* proj = (const bf16_t*)(p.ws + WS_PROJ9);
    const int n = SAMPLE ? item : (item >> 6), t0 = SAMPLE ? 0 : (item & 63) * 32;
    const size_t rowb = SAMPLE ? ((size_t)NTP + (size_t)n * 8) : ((size_t)n * SEQ);
    const int c0 = 2 * tid;
    float w0[31], w1[31], x0[31], x1[31];
#pragma unroll
    for (int j = 0; j < 31; ++j) { const f32x2 w = *(const f32x2*)(p.conv_w + j * 1024 + c0); w0[j] = w[0]; w1[j] = w[1]; x0[j] = 0.f; x1[j] = 0.f; }
    const f32x2 bias = *(const f32x2*)(p.conv_b + c0);
    unsigned ra[GP], rg[GP];
#define CONV_ISSUE(g) do { \
        if (SAMPLE && (g) < G0) { _Pragma("unroll") for (int i = 0; i < GP; ++i) { const int ti = -2 + GP * (g) + i; \
            const unsigned* tp = (const unsigned*)(p.state_conv + ((size_t)n * 30 + (ti < 0 ? 0 : ti)) * 1024 + c0); ra[i] = tp[0]; rg[i] = tp[1]; } } \
        else { _Pragma("unroll") for (int i = 0; i < GP; ++i) { const int t = t0 - 32 + GP * (g) + i; const bf16_t* rp = proj + (rowb + (t < 0 ? 0 : t)) * LDP + c0; \
            ra[i] = *(const unsigned*)(rp + C_CV); rg[i] = *(const unsigned*)(rp + C_CG); } } } while (0)
    CONV_ISSUE(0);
#pragma unroll 1
    for (int g = 0; g < NG; ++g) {
        float u0[GP], u1[GP];
        if (SAMPLE && g < G0) {
#pragma unroll
            for (int i = 0; i < GP; ++i) { const bool ok = (-2 + GP * g + i) >= 0; u0[i] = ok ? __builtin_bit_cast(float, ra[i]) : 0.f; u1[i] = ok ? __builtin_bit_cast(float, rg[i]) : 0.f; }
        } else {
#pragma unroll
            for (int i = 0; i < GP; ++i) { const bool ok = (t0 - 32 + GP * g + i) >= 0; u0[i] = ok ? bflo(ra[i]) * bflo(rg[i]) : 0.f; u1[i] = ok ? bfhi(ra[i]) * bfhi(rg[i]) : 0.f; }
        }
        if (g + 1 < NG) CONV_ISSUE(g + 1);
#pragma unroll
        for (int i = 0; i < GP; ++i) {
            const int pp = -32 + GP * g + i, t = t0 + pp;
            if (SAMPLE) { if (pp >= -22) *(f32x2*)(p.out + O_CONV_S + ((size_t)n * 30 + (pp + 22)) * 1024 + c0) = (f32x2){u0[i], u1[i]}; }
            else { if (t >= SEQ - 30) *(f32x2*)(p.out + O_CONV_P + ((size_t)n * 30 + (t - (SEQ - 30))) * 1024 + c0) = (f32x2){u0[i], u1[i]}; }
#pragma unroll
            for (int j = 0; j < 30; ++j) { x0[j] = x0[j + 1]; x1[j] = x1[j + 1]; }
            x0[30] = u0[i]; x1[30] = u1[i];
            if (g >= G0) {
                float d0 = bias[0], d1 = bias[1];
#pragma unroll
                for (int j = 0; j < 31; ++j) { d0 += w0[j] * x0[j]; d1 += w1[j] * x1[j]; }
                *(LAS f32x2*)(dcs + (pp) * 1024 + c0) = (f32x2){d0, d1};
            }
        }
    }
#undef CONV_ISSUE
    __syncthreads();
    { const int lane = tid & 63, wave = tid >> 6;
      bf16_t* aact = (bf16_t*)(p.ws + WS_ACT3);
      for (int pp = wave; pp < T; pp += 8) {
          f32x4 v[4]; float s = 0.f;
#pragma unroll
          for (int j = 0; j < 4; ++j) { v[j] = *(const LAS f32x4*)(dcs + pp * 1024 + j * 256 + lane * 4); s += (v[j][0] + v[j][1]) + (v[j][2] + v[j][3]); }
          const float mean = wave_sum(s) * (1.f / 1024.f); float s2 = 0.f;
#pragma unroll
          for (int j = 0; j < 4; ++j) { v[j] = v[j] - mean; s2 += (v[j][0] * v[j][0] + v[j][1] * v[j][1]) + (v[j][2] * v[j][2] + v[j][3] * v[j][3]); }
          const float rstd = rsqrtf(wave_sum(s2) * (1.f / 1024.f) + EPS);
          const size_t r = rowb + t0 + pp;
#pragma unroll
          for (int j = 0; j < 4; ++j) { const int c = j * 256 + lane * 4;
              const f32x4 lg = *(const f32x4*)(p.ln_g + c), lbv = *(const f32x4*)(p.ln_b + c);
              const u32x2 sg = *(const u32x2*)(proj + r * LDP + C_CS + c);
              const float y0 = siluf(v[j][0] * rstd * lg[0] + lbv[0]) * bflo(sg.x), y1 = siluf(v[j][1] * rstd * lg[1] + lbv[1]) * bfhi(sg.x);
              const float y2 = siluf(v[j][2] * rstd * lg[2] + lbv[2]) * bflo(sg.y), y3 = siluf(v[j][3] * rstd * lg[3] + lbv[3]) * bfhi(sg.y);
              u32x2 o; o.x = pk2(y0, y1); o.y = pk2(y2, y3);
              *(u32x2*)(aact + r * 1024 + c) = o; }
      } }
    __syncthreads();
}

__device__ __forceinline__ void attn_prompt_item(const Params& p, int item, int tid) {
    const int lane = tid & 63, wave = tid >> 6, l15 = lane & 15, quad = lane >> 4;
    const int n = item >> 6, h = (item >> 4) & 3, qt = item & 15;
    const bf16_t* proj = (const bf16_t*)(p.ws + WS_PROJ9);
    const bf16_t* kb = (const bf16_t*)(p.ws + WS_MKB) + (size_t)(n * 4 + h) * 65536;
    const bf16_t* vt = (const bf16_t*)(p.ws + WS_MVT) + (size_t)(n * 4 + h) * 65536;
    const size_t qrow = (size_t)n * SEQ + qt * 128 + wave * 16 + l15;
    bf16x8 qf[8];
#pragma unroll
    for (int s = 0; s < 8; ++s) qf[s] = *(const bf16x8*)(proj + qrow * LDP + C_AQ + h * 256 + s * 32 + quad * 8);
    f32x4 sc[16];
#pragma unroll
    for (int T = 0; T < 16; ++T) {
        sc[T] = (f32x4){0.f, 0.f, 0.f, 0.f};
        const bf16_t* kr = kb + (size_t)(T * 16 + l15) * 256 + quad * 8;
#pragma unroll
        for (int s = 0; s < 8; ++s) { const bf16x8 a = *(const bf16x8*)(kr + s * 32); sc[T] = __builtin_amdgcn_mfma_f32_16x16x32_bf16(a, qf[s], sc[T], 0, 0, 0); }
    }
    float mx = -3.0e38f;
#pragma unroll
    for (int T = 0; T < 16; ++T) mx = fmaxf(mx, fmaxf(fmaxf(sc[T][0], sc[T][1]), fmaxf(sc[T][2], sc[T][3])));
    mx = fmaxf(mx, __shfl_xor(mx, 16)); mx = fmaxf(mx, __shfl_xor(mx, 32));
    float sum = 0.f;
#pragma unroll
    for (int T = 0; T < 16; ++T) {
#pragma unroll
        for (int e = 0; e < 4; ++e) { sc[T][e] = __expf(sc[T][e] - mx); sum += sc[T][e]; } }
    sum += __shfl_xor(sum, 16); sum += __shfl_xor(sum, 32);
    const float rs = 1.f / sum;
    bf16x8 pb[8];
#pragma unroll
    for (int s2 = 0; s2 < 8; ++s2) {
        u32x4 w; w.x = pk2(sc[2 * s2][0], sc[2 * s2][1]); w.y = pk2(sc[2 * s2][2], sc[2 * s2][3]); w.z = pk2(sc[2 * s2 + 1][0], sc[2 * s2 + 1][1]); w.w = pk2(sc[2 * s2 + 1][2], sc[2 * s2 + 1][3]);
        pb[s2] = __builtin_bit_cast(bf16x8, w);
    }
    bf16_t* aog = (bf16_t*)(p.ws + WS_ACT3) + (size_t)2 * 9216 * 1024;
#pragma unroll 2
    for (int Tv = 0; Tv < 16; ++Tv) {
        f32x4 oacc = (f32x4){0.f, 0.f, 0.f, 0.f};
        const bf16_t* vr = vt + (size_t)(Tv * 16 + l15) * 256 + quad * 4;
#pragma unroll
        for (int s2 = 0; s2 < 8; ++s2) {
            const u32x2 lo = *(const u32x2*)(vr + s2 * 32), hi = *(const u32x2*)(vr + s2 * 32 + 16);
            u32x4 w; w.x = lo.x; w.y = lo.y; w.z = hi.x; w.w = hi.y;
            oacc = __builtin_amdgcn_mfma_f32_16x16x32_bf16(__builtin_bit_cast(bf16x8, w), pb[s2], oacc, 0, 0, 0);
        }
        const int dv = Tv * 16 + quad * 4;
        const u32x2 sg = *(const u32x2*)(proj + qrow * LDP + C_AS + h * 256 + dv);
        u32x2 o; o.x = pk2(oacc[0] * rs * bflo(sg.x), oacc[1] * rs * bfhi(sg.x)); o.y = pk2(oacc[2] * rs * bflo(sg.y), oacc[3] * rs * bfhi(sg.y));
        *(u32x2*)(aog + qrow * 1024 + h * 256 + dv) = o;
    }
}

__device__ __forceinline__ void attn_sample_item(const Params& p, int item, LAS unsigned char* lds, int tid) {
    LAS float* Ssh = (LAS float*)lds;
    LAS float* Psh = Ssh + 2048;
    LAS float* Opart = Psh + 2048;
    const int lane = tid & 63, wave = tid >> 6, l15 = lane & 15, quad = lane >> 4;
    const int n = item >> 2, h = item & 3;
    const bf16_t* proj = (const bf16_t*)(p.ws + WS_PROJ9);
    const size_t row0 = (size_t)NTP + (size_t)n * 8;
    const float* kc = p.cache_k + ((size_t)n * 256 * 4 + h) * 256;
    const float* vc = p.cache_v + ((size_t)n * 256 * 4 + h) * 256;
    {
        bf16x8 qf[8];
        const size_t qrow = row0 + (lane & 7);
#pragma unroll
        for (int s = 0; s < 8; ++s) qf[s] = *(const bf16x8*)(proj + qrow * LDP + C_AQ + h * 256 + s * 32 + quad * 8);
#pragma unroll
        for (int tl = 0; tl < 2; ++tl) {
            const int T = wave * 2 + tl;
            f32x4 sc = (f32x4){0.f, 0.f, 0.f, 0.f};
            const float* kr = kc + (size_t)(T * 16 + l15) * 1024 + quad * 8;
#pragma unroll
            for (int s = 0; s < 8; ++s) {
                const f32x4 k0 = *(const f32x4*)(kr + s * 32), k1 = *(const f32x4*)(kr + s * 32 + 4);
                u32x4 w; w.x = pk2(k0[0], k0[1]); w.y = pk2(k0[2], k0[3]); w.z = pk2(k1[0], k1[1]); w.w = pk2(k1[2], k1[3]);
                sc = __builtin_amdgcn_mfma_f32_16x16x32_bf16(__builtin_bit_cast(bf16x8, w), qf[s], sc, 0, 0, 0);
            }
            if (l15 < 8) {
#pragma unroll
                for (int e = 0; e < 4; ++e) Ssh[l15 * 256 + T * 16 + quad * 4 + e] = sc[e];
            }
        }
    }
    __syncthreads();
    {
        const f32x4 s4 = *(const LAS f32x4*)(Ssh + wave * 256 + lane * 4);
        const float mx = wave_max(fmaxf(fmaxf(s4[0], s4[1]), fmaxf(s4[2], s4[3])));
        f32x4 e4; e4[0] = __expf(s4[0] - mx); e4[1] = __expf(s4[1] - mx); e4[2] = __expf(s4[2] - mx); e4[3] = __expf(s4[3] - mx);
        const float rs = 1.f / wave_sum((e4[0] + e4[1]) + (e4[2] + e4[3]));
#pragma unroll
        for (int e = 0; e < 4; ++e) Psh[(lane * 4 + e) * 8 + wave] = e4[e] * rs;
    }
    __syncthreads();
    {
        f32x4 acc[8];
#pragma unroll
        for (int q = 0; q < 8; ++q) acc[q] = (f32x4){0.f, 0.f, 0.f, 0.f};
        const float* vr = vc + (size_t)(wave * 32) * 1024 + lane * 4;
#pragma unroll 8
        for (int kk = 0; kk < 32; ++kk) {
            const f32x4 v4 = *(const f32x4*)(vr + (size_t)kk * 1024);
            const f32x4 pa = *(const LAS f32x4*)(Psh + (wave * 32 + kk) * 8), pb = *(const LAS f32x4*)(Psh + (wave * 32 + kk) * 8 + 4);
            acc[0] += v4 * pa[0]; acc[1] += v4 * pa[1]; acc[2] += v4 * pa[2]; acc[3] += v4 * pa[3];
            acc[4] += v4 * pb[0]; acc[5] += v4 * pb[1]; acc[6] += v4 * pb[2]; acc[7] += v4 * pb[3];
        }
#pragma unroll
        for (int q = 0; q < 8; ++q) *(LAS f32x4*)(Opart + (wave * 8 + q) * 256 + lane * 4) = acc[q];
    }
    __syncthreads();
    {
        f32x4 o = (f32x4){0.f, 0.f, 0.f, 0.f};
#pragma unroll
        for (int w = 0; w < 8; ++w) o += *(const LAS f32x4*)(Opart + (w * 8 + wave) * 256 + lane * 4);
        const size_t r = row0 + wave;
        const u32x2 sg = *(const u32x2*)(proj + r * LDP + C_AS + h * 256 + lane * 4);
        u32x2 ov; ov.x = pk2(o[0] * bflo(sg.x), o[1] * bfhi(sg.x)); ov.y = pk2(o[2] * bflo(sg.y), o[3] * bfhi(sg.y));
        bf16_t* aog = (bf16_t*)(p.ws + WS_ACT3) + (size_t)2 * 9216 * 1024;
        *(u32x2*)(aog + r * 1024 + h * 256 + lane * 4) = ov;
    }
    __syncthreads();
}

__device__ __forceinline__ void p2_mixers(const Params& p, LAS unsigned char* lds) {
    const int tid = threadIdx.x, G = gridDim.x, c = blockIdx.x;
    for (int it = c; it < 256; it += G) hgrn_prompt_item(p, it, lds, tid);
    for (int it = c; it < 256; it += G) conv_item<false>(p, it, lds, tid);
    for (int it = c; it < 128; it += G) conv_item<true>(p, it, lds, tid);
    for (int it = c; it < 256; it += G) attn_prompt_item(p, it, tid);
    for (int it = c; it < 512; it += G) attn_sample_item(p, it, lds, tid);
    for (int it = c; it < 1024; it += G) hgrn_sample_item(p, it, lds, tid);
}

__device__ __forceinline__ void p6_final_norm(const Params& p) {
    const int tid = threadIdx.x, lane = tid & 63, gw = blockIdx.x * 8 + (tid >> 6), NGW = gridDim.x * 8;
    for (int r = gw; r < NTOK; r += NGW) {
        float* zr = p.out + (size_t)r * 2048;
        f32x4 v[8]; float ss = 0.f;
#pragma unroll
        for (int j = 0; j < 8; ++j) { v[j] = ((const f32x4*)zr)[lane + 64 * j]; ss += (v[j][0] * v[j][0] + v[j][1] * v[j][1]) + (v[j][2] * v[j][2] + v[j][3] * v[j][3]); }
        ss = wave_sum(ss);
        const float rinv = rsqrtf(ss * (1.f / 2048.f) + EPS);
#pragma unroll
        for (int j = 0; j < 8; ++j) { const f32x4 gg = ((const f32x4*)p.g_final)[lane + 64 * j]; ((f32x4*)zr)[lane + 64 * j] = v[j] * rinv * gg; }
    }
}

__global__ void __launch_bounds__(512, 2) fwd_megakernel(Params p) {
    extern __shared__ __attribute__((aligned(16))) unsigned char shm[];
    LAS unsigned char* lds = (LAS unsigned char*)shm;
    cg::grid_group grid = cg::this_grid();
    const int G = gridDim.x, c = blockIdx.x;
#define SEAM(ph) do { if (p.coop && (ph) + 1 < p.ph_hi) { \
        asm volatile("s_waitcnt vmcnt(0) lgkmcnt(0)" ::: "memory"); __syncthreads(); \
        grid.sync(); \
        __builtin_amdgcn_fence(__ATOMIC_ACQUIRE, "agent"); asm volatile("s_waitcnt vmcnt(0)" ::: "memory"); } } while (0)
#define RUNS(ph) (p.ph_lo <= (ph) && (ph) < p.ph_hi)
    if (RUNS(0)) { p0_prologue(p, lds); SEAM(0); }
    if (RUNS(1)) {
        SchedP1 S; S.G = G; S.c = c; S.A = (const char*)(p.ws + WS_HA); S.Bt = (const char*)(p.ws + WS_WT1);
        EpiP1 E; E.proj = (bf16_t*)(p.ws + WS_PROJ9); E.gate = (bf16_t*)(p.ws + WS_GATE); E.F = (float*)(p.ws + WS_F); E.lb = (const float*)(p.ws + WS_LB);
        E.b_gate = p.b_gate; E.out = p.out; E.mkb = (bf16_t*)(p.ws + WS_MKB); E.mvt = (bf16_t*)(p.ws + WS_MVT);
        pg8::gemm_phase(lds, 2048, S, E); SEAM(1);
    }
    if (RUNS(2)) { p2_mixers(p, lds); SEAM(2); }
    if (RUNS(3)) { hgrn_norm_rows(p); SEAM(3); }
    if (RUNS(4)) {
        SchedP4 S; S.G = G; S.c = c; S.A = (const char*)(p.ws + WS_ACT3); S.Bt = (const char*)(p.ws + WS_WT3);
        EpiP4 E; E.gate = (const bf16_t*)(p.ws + WS_GATE); E.merged = (bf16_t*)(p.ws + WS_MERGED);
        pg8::gemm_phase(lds, 1024, S, E); SEAM(4);
    }
    if (RUNS(5)) {
        SchedP5 S; S.G = G; S.c = c; S.A = (const char*)(p.ws + WS_MERGED); S.Bt = (const char*)(p.ws + WS_WTO);
        EpiP5 E; E.xp = p.x_prompt; E.xs = p.x_sample; E.out = p.out;
        pg8::gemm_phase(lds, 2048, S, E); SEAM(5);
    }
    if (RUNS(6)) { p6_final_norm(p); }
#undef RUNS
#undef SEAM
}

extern "C" void kernel_launch(void* const* d_in, const int* in_sizes, int n_in, void* d_out, int out_size, void* d_ws, size_t ws_size, hipStream_t stream) {
    static int grid = 0;
    if (grid == 0) {
        if (n_in != 23 || ws_size < WS_END) { fprintf(stderr, "kernel_launch: expected 23 inputs and >= %zu bytes of workspace, got %d / %zu\n", (size_t)WS_END, n_in, ws_size); grid = -1; return; }
        int dev = 0, cus = 0, per_cu = 0;
        hipGetDevice(&dev); hipDeviceGetAttribute(&cus, hipDeviceAttributeMultiprocessorCount, dev);
        if (hipFuncSetAttribute((const void*)fwd_megakernel, hipFuncAttributeMaxDynamicSharedMemorySize, LDS_BYTES) != hipSuccess) { fprintf(stderr, "kernel_launch: hipFuncSetAttribute failed\n"); grid = -1; return; }
        if (hipOccupancyMaxActiveBlocksPerMultiprocessor(&per_cu, (const void*)fwd_megakernel, 512, LDS_BYTES) != hipSuccess || per_cu < 1) { fprintf(stderr, "kernel_launch: occupancy query failed (%d)\n", per_cu); (void)hipGetLastError(); per_cu = 1; }
        grid = cus * 1;
        if (grid <= 0) grid = 256;
    }
    if (grid < 0) return;
    Params p{};
    const float** pp = (const float**)&p;
    for (int i = 0; i < 23; ++i) pp[i] = (const float*)d_in[i];
    p.out = (float*)d_out; p.ws = (unsigned char*)d_ws; p.pad = 0;
#if N_LAUNCH_MODE == 1
    p.ph_lo = 0; p.ph_hi = N_PHASES; p.coop = 1;
    void* args[] = {&p};
    hipError_t e = hipLaunchCooperativeKernel((const void*)fwd_megakernel, dim3(grid), dim3(512), args, LDS_BYTES, stream);
    if (e != hipSuccess) fprintf(stderr, "cooperative launch failed: %s (grid %d)\n", hipGetErrorString(e), grid);
#else
    for (int ph = 0; ph < N_PHASES; ++ph) {
        p.ph_lo = ph; p.ph_hi = ph + 1; p.coop = 0;
        hipLaunchKernelGGL(fwd_megakernel, dim3(grid), dim3(512), LDS_BYTES, stream, p);
        if ((REP_MASK >> ph) & 1) hipLaunchKernelGGL(fwd_megakernel, dim3(grid), dim3(512), LDS_BYTES, stream, p);
    }
#endif
}
```

```cpp
#include <hip/hip_runtime.h>
#include <hip/hip_cooperative_groups.h>
#include <cstdio>
namespace cg = cooperative_groups;

#define LAS __attribute__((address_space(3)))
typedef unsigned short bf16_t;
typedef short bf16x8 __attribute__((ext_vector_type(8)));
typedef float f32x4 __attribute__((ext_vector_type(4)));
typedef float f32x2 __attribute__((ext_vector_type(2)));
typedef unsigned u32x4 __attribute__((ext_vector_type(4)));
typedef unsigned u32x2 __attribute__((ext_vector_type(2)));

#ifndef REP_MASK
#define REP_MASK 0
#endif
#ifndef P2_SUBMASK
#define P2_SUBMASK 31
#endif
#ifndef N_LAUNCH_MODE
#define N_LAUNCH_MODE 1
#endif

constexpr int DM = 2048, NTP = 8192, NTS = 1024, NTOK = 9216, SEQ = 2048;
constexpr int LDP = 9216;
constexpr int C_CV = 0, C_CG = 1024, C_CS = 2048, C_HQ = 3072, C_HF = 4096, C_HI = 5120, C_HOG = 6144, C_AQ = 7168, C_AS = 8192;
constexpr int LDG = 6144;
constexpr float EPS = 1e-6f;
constexpr size_t O_YP = 0, O_YS = 16777216, O_CONV_P = 18874368, O_HGRN_P = 18997248, O_MK = 19521536, O_MV = 20570112, O_CONV_S = 21618688, O_HGRN_S = 25550848;
constexpr size_t WS_WT1 = 0;
constexpr size_t WS_WT3 = WS_WT1 + (size_t)17408 * 2048 * 2;
constexpr size_t WS_WTO = WS_WT3 + (size_t)3 * 2048 * 1024 * 2;
constexpr size_t WS_HA = WS_WTO + (size_t)2048 * 2048 * 2;
constexpr size_t WS_ORAW = WS_HA;
constexpr size_t WS_PROJ9 = WS_HA + (size_t)10240 * 2048 * 2;
constexpr size_t WS_MF = WS_PROJ9;
constexpr size_t WS_MERGED = WS_MF + (size_t)9216 * 2048 * 4;
constexpr size_t WS_GATE = WS_PROJ9 + (size_t)9216 * 9216 * 2;
constexpr size_t WS_F = WS_GATE + (size_t)9216 * 6144 * 2;
constexpr size_t WS_MKB = WS_F + (size_t)9216 * 1024 * 4;
constexpr size_t WS_MVT = WS_MKB + (size_t)2097152;
constexpr size_t WS_ACT3 = WS_MVT + (size_t)2097152;
constexpr size_t WS_LB = WS_ACT3 + (size_t)3 * 9216 * 1024 * 2;
constexpr size_t WS_END = WS_LB + 4096;
constexpr int LDS_BYTES = 131072;
constexpr int N_PHASES = 7;

struct Params {
    const float *x_prompt, *x_sample, *state_conv, *state_hgrn, *cache_k, *cache_v, *mem_prompt, *g_pre, *w_in, *conv_w, *conv_b, *ln_g, *ln_b,
        *w_conv_out, *lb_logits, *g_hgrn, *w_hgrn_out, *g_mem, *w_mem_kv, *w_attn_out, *b_gate, *w_out, *g_final;
    float* out; unsigned char* ws; int ph_lo, ph_hi, coop, pad;
};

__device__ __forceinline__ unsigned f2bf(float f) { unsigned u = __builtin_bit_cast(unsigned, f); return (u + 0x7fffu + ((u >> 16) & 1u)) >> 16; }
typedef __bf16 bf16x2_t __attribute__((ext_vector_type(2)));
__device__ __forceinline__ unsigned pk2(float lo, float hi) { const f32x2 v = {lo, hi}; const bf16x2_t r = __builtin_convertvector(v, bf16x2_t); return __builtin_bit_cast(unsigned, r); }
__device__ __forceinline__ float bflo(unsigned w) { return __builtin_bit_cast(float, w << 16); }
__device__ __forceinline__ float bfhi(unsigned w) { return __builtin_bit_cast(float, w & 0xffff0000u); }
__device__ __forceinline__ float bf2f(unsigned short b) { return __builtin_bit_cast(float, ((unsigned)b) << 16); }
__device__ __forceinline__ float sigm(float x) { return __builtin_amdgcn_rcpf(1.f + __expf(-x)); }
__device__ __forceinline__ float siluf(float x) { return x * sigm(x); }
__device__ __forceinline__ float wave_sum(float v) {
#pragma unroll
    for (int o = 1; o < 64; o <<= 1) v += __shfl_xor(v, o);
    return v;
}
__device__ __forceinline__ float wave_max(float v) {
#pragma unroll
    for (int o = 1; o < 64; o <<= 1) v = fmaxf(v, __shfl_xor(v, o));
    return v;
}

namespace pg8 {
constexpr int BM = 256, BK = 64, HALF = 128, HTB = HALF * BK * 2, STAGE_BYTES = 8 * HTB, NXCD = 8, WGM = 8;
__host__ __device__ __forceinline__ int lds_byte(int r, int c) { const int st = (r >> 4) * 2 + (c >> 5), rr = r & 15, cc = c & 31, ob = rr * 64 + cc * 2; return st * 1024 + (ob ^ (((ob >> 9) & 1) << 5)); }
__host__ __device__ __forceinline__ void stage_rc(int b, int& R, int& C) { const int st = b / 1024, sb = b % 1024, swz = sb ^ (((sb >> 9) & 1) << 5); R = (st >> 1) * 16 + swz / 64; C = (st & 1) * 32 + (swz % 64) / 2; }
__host__ __device__ __forceinline__ int perm32(int rho) { const int n = rho >> 4, i = rho & 15; return 8 * (i >> 2) + 4 * n + (i & 3); }
struct Unit { int pm, pn, br; };
__device__ __forceinline__ void tile_of(int wgid, int nM, int nN, int& pm, int& pn) {
    const int nwg = nM * nN;
    { const int q = nwg / NXCD, r = nwg % NXCD, xcd = wgid % NXCD, off = wgid / NXCD; wgid = (xcd < r ? xcd * (q + 1) : r * (q + 1) + (xcd - r) * q) + off; }
    const int nig = WGM * nN, gid = wgid / nig, fm = gid * WGM, gsz = (nM - fm) < WGM ? (nM - fm) : WGM;
    pm = fm + ((wgid % nig) % gsz); pn = (wgid % nig) / gsz;
}

template <class Epi, class Sched>
__device__ __forceinline__ void gemm_phase(LAS unsigned char* lds, const int K, const Sched& S, const Epi& E) {
    const int tid = threadIdx.x, wid = __builtin_amdgcn_readfirstlane(tid >> 6), lane = tid & 63, wr = wid >> 2, wc = wid & 3, fr = lane & 15, fq = lane >> 4;
    const int nt = K / BK;
    unsigned voffA[2], voffB[2];
#pragma unroll
    for (int i = 0; i < 2; ++i) { int R, C; stage_rc(tid * 16 + i * 8192, R, C); const int Rb = (R & ~31) + perm32(R & 31);
        voffA[i] = (unsigned)(R * K + C) * 2u; voffB[i] = (unsigned)(Rb * K + C) * 2u; }
    const size_t kstep = (size_t)(BK * 2);
    const size_t hstep = (size_t)HALF * K * 2;
    const unsigned ldsw = (unsigned)wid * 1024u;
    const int aoff = lds_byte(wr * 64 + fr, fq * 8), boff = lds_byte(wc * 32 + fr, fq * 8);
#define PG8_SA(b, h) (((b) * 2 + (h)) * HTB)
#define PG8_SB(b, h) ((4 + (b) * 2 + (h)) * HTB)
#define PG8_STAGE(bufoff, gbase, voff) do { _Pragma("unroll") for (int _i = 0; _i < 2; ++_i) \
        __builtin_amdgcn_global_load_lds((const unsigned*)((const char*)(gbase) + (voff)[_i]), (LAS unsigned*)(lds + (bufoff) + ldsw + _i * 8192), 16, 0, 0); } while (0)
#define PG8_LDA(dst, b, h) do { _Pragma("unroll") for (int m = 0; m < 4; ++m) _Pragma("unroll") for (int k = 0; k < 2; ++k) dst[m][k] = *(const LAS bf16x8*)(lds + PG8_SA(b, h) + aoff + m * 2048 + k * 1024); } while (0)
#define PG8_LDB(dst, b, h) do { _Pragma("unroll") for (int n = 0; n < 2; ++n) _Pragma("unroll") for (int k = 0; k < 2; ++k) dst[n][k] = *(const LAS bf16x8*)(lds + PG8_SB(b, h) + boff + n * 2048 + k * 1024); } while (0)
#define PG8_MMA(ai, bj, At, Bt) do { __builtin_amdgcn_s_setprio(1); _Pragma("unroll") for (int m = 0; m < 4; ++m) _Pragma("unroll") for (int n = 0; n < 2; ++n) _Pragma("unroll") for (int k = 0; k < 2; ++k) \
        acc[ai][bj][m][n] = __builtin_amdgcn_mfma_f32_16x16x32_bf16(Bt[n][k], At[m][k], acc[ai][bj][m][n], 0, 0, 0); __builtin_amdgcn_s_setprio(0); } while (0)
#define PG8_WAIT_V(n) asm volatile("s_waitcnt vmcnt(" #n ")" ::: "memory")
#define PG8_WAIT_L(n) asm volatile("s_waitcnt lgkmcnt(" #n ")" ::: "memory")
#define PG8_BAR __builtin_amdgcn_s_barrier()
#define PG8_SCHED __builtin_amdgcn_sched_barrier(0)
    Unit cur, nxt; int ui = 0;
    if (!S.next(0, cur)) return;
    f32x4 acc[2][2][4][2];
#pragma unroll
    for (int a = 0; a < 2; ++a)
#pragma unroll
        for (int b = 0; b < 2; ++b)
#pragma unroll
            for (int m = 0; m < 4; ++m)
#pragma unroll
                for (int n = 0; n < 2; ++n) acc[a][b][m][n] = (f32x4){0.f, 0.f, 0.f, 0.f};
    bf16x8 At[4][2], B0[2][2], B1[2][2];
    const char* cA = S.a_base(cur); const char* cB = S.b_base(cur);
    PG8_STAGE(PG8_SB(0, 0), cB, voffB); PG8_STAGE(PG8_SA(0, 0), cA, voffA); PG8_STAGE(PG8_SB(0, 1), cB + hstep, voffB); PG8_STAGE(PG8_SA(0, 1), cA + hstep, voffA);
    if (wr == 1) PG8_BAR;
    PG8_WAIT_V(4); PG8_BAR;
    PG8_STAGE(PG8_SB(1, 0), cB + kstep, voffB); PG8_STAGE(PG8_SA(1, 0), cA + kstep, voffA); PG8_STAGE(PG8_SB(1, 1), cB + hstep + kstep, voffB);
    PG8_WAIT_V(6); PG8_BAR;
    for (;;) {
        const bool has_next = S.next(ui + 1, nxt);
        const char* nA = has_next ? S.a_base(nxt) : cA; const char* nB = has_next ? S.b_base(nxt) : cB;
        for (int t = 0; t < nt; t += 2) {
            const bool last = (t == nt - 2);
            const char* a1 = cA + (size_t)(t + 1) * kstep;
            const char* a2 = last ? nA : cA + (size_t)(t + 2) * kstep; const char* b2 = last ? nB : cB + (size_t)(t + 2) * kstep;
            const char* a3 = a2 + kstep; const char* b3 = b2 + kstep;
            PG8_LDB(B0, 0, 0); PG8_SCHED; PG8_LDA(At, 0, 0); PG8_STAGE(PG8_SA(1, 1), a1 + hstep, voffA);
            PG8_WAIT_L(8); PG8_BAR; PG8_WAIT_L(0); PG8_MMA(0, 0, At, B0); PG8_BAR; PG8_SCHED;
            PG8_LDB(B1, 0, 1); PG8_STAGE(PG8_SB(0, 0), b2, voffB);
            PG8_BAR; PG8_WAIT_L(0); PG8_MMA(0, 1, At, B1); PG8_BAR;
            PG8_LDA(At, 0, 1); PG8_STAGE(PG8_SA(0, 0), a2, voffA);
            PG8_BAR; PG8_WAIT_L(0); PG8_MMA(1, 0, At, B0); PG8_BAR; PG8_SCHED;
            PG8_STAGE(PG8_SB(0, 1), b2 + hstep, voffB);
            PG8_WAIT_V(6); PG8_BAR; PG8_MMA(1, 1, At, B1); PG8_BAR;
            PG8_LDB(B0, 1, 0); PG8_SCHED; PG8_LDA(At, 1, 0); PG8_STAGE(PG8_SA(0, 1), a2 + hstep, voffA);
            PG8_WAIT_L(8); PG8_BAR; PG8_WAIT_L(0); PG8_MMA(0, 0, At, B0); PG8_BAR; PG8_SCHED;
            PG8_LDB(B1, 1, 1); PG8_STAGE(PG8_SB(1, 0), b3, voffB);
            PG8_BAR; PG8_WAIT_L(0); PG8_MMA(0, 1, At, B1); PG8_BAR;
            PG8_LDA(At, 1, 1); PG8_STAGE(PG8_SA(1, 0), a3, voffA);
            PG8_BAR; PG8_WAIT_L(0); PG8_MMA(1, 0, At, B0); PG8_BAR; PG8_SCHED;
            PG8_STAGE(PG8_SB(1, 1), b3 + hstep, voffB);
            PG8_WAIT_V(6); PG8_BAR; PG8_MMA(1, 1, At, B1); PG8_BAR;
        }
        const bool keep = E(acc, cur, wr, wc, fr, fq);
        if (!has_next) break;
        if (!keep)
#pragma unroll
        for (int a = 0; a < 2; ++a)
#pragma unroll
            for (int b = 0; b < 2; ++b)
#pragma unroll
                for (int m = 0; m < 4; ++m)
#pragma unroll
                    for (int n = 0; n < 2; ++n) acc[a][b][m][n] = (f32x4){0.f, 0.f, 0.f, 0.f};
        cur = nxt; cA = nA; cB = nB; ++ui;
    }
    PG8_WAIT_V(0);
    if (wr == 0) PG8_BAR;
    PG8_BAR;
#undef PG8_SA
#undef PG8_SB
#undef PG8_STAGE
#undef PG8_LDA
#undef PG8_LDB
#undef PG8_MMA
#undef PG8_WAIT_V
#undef PG8_WAIT_L
#undef PG8_BAR
#undef PG8_SCHED
}
}
using pg8::Unit;

struct SchedP1 {
    int G, c; const char* A; const char* Bt;
    __device__ __forceinline__ bool next(int i, Unit& u) const {
        const int L = i * G + c; if (L >= 2192) return false;
        u.br = 0;
        if (L >= 2160) { const int idx = L - 2160; u.pm = 36 + (idx >> 3); u.pn = 60 + (idx & 7); return true; }
        pg8::tile_of(L, 36, 60, u.pm, u.pn); return true;
    }
    __device__ __forceinline__ const char* a_base(const Unit& u) const { return A + (size_t)u.pm * (256 * 2048 * 2); }
    __device__ __forceinline__ const char* b_base(const Unit& u) const { return Bt + (size_t)u.pn * (256 * 2048 * 2); }
};
struct EpiP1 {
    bf16_t* proj; bf16_t* gate; float* F; const float* lb; const float* b_gate; float* out; bf16_t* mkb; bf16_t* mvt;
    __device__ __forceinline__ bool operator()(f32x4 (&acc)[2][2][4][2], const Unit& u, int wr, int wc, int fr, int fq) const {
        const int rloc = wr * 64 + fr, cloc = wc * 32 + 8 * fq;
        if (u.pn < 36) {
            const int seg = u.pn >> 2;
#pragma unroll
            for (int bj = 0; bj < 2; ++bj) {
                const int col = u.pn * 256 + bj * 128 + cloc;
                f32x4 l0 = (f32x4){0.f, 0.f, 0.f, 0.f}, l1 = l0;
                if (seg == 4) { l0 = *(const f32x4*)(lb + (col - C_HF)); l1 = *(const f32x4*)(lb + (col - C_HF) + 4); }
#pragma unroll
                for (int ai = 0; ai < 2; ++ai)
#pragma unroll
                    for (int m = 0; m < 4; ++m) {
                        const size_t row = (size_t)u.pm * 256 + ai * 128 + m * 16 + rloc;
                        f32x4 v0 = acc[ai][bj][m][0], v1 = acc[ai][bj][m][1];
                        if (seg == 4) {
#pragma unroll
                            for (int e = 0; e < 4; ++e) { v0[e] = l0[e] + (1.f - l0[e]) * sigm(v0[e]); v1[e] = l1[e] + (1.f - l1[e]) * sigm(v1[e]); }
                            float* fp = F + row * 1024 + (col - C_HF);
                            *(f32x4*)fp = v0; *(f32x4*)(fp + 4) = v1;
                        } else {
                            if (seg == 1) {
#pragma unroll
                                for (int e = 0; e < 4; ++e) { v0[e] = sigm(v0[e]); v1[e] = sigm(v1[e]); }
                            } else if (seg == 2 || seg == 6 || seg == 8) {
#pragma unroll
                                for (int e = 0; e < 4; ++e) { v0[e] = siluf(v0[e]); v1[e] = siluf(v1[e]); }
                            } else if (seg == 3) { v0 *= 0.08838834764831845f; v1 *= 0.08838834764831845f; }
                            else if (seg == 7) { v0 *= 0.0625f; v1 *= 0.0625f; }
                            u32x4 o; o.x = pk2(v0[0], v0[1]); o.y = pk2(v0[2], v0[3]); o.z = pk2(v1[0], v1[1]); o.w = pk2(v1[2], v1[3]);
                            *(u32x4*)(proj + row * LDP + col) = o;
                        }
                    }
            }
        } else if (u.pn < 60) {
#pragma unroll
            for (int bj = 0; bj < 2; ++bj) {
                const int col = (u.pn - 36) * 256 + bj * 128 + cloc;
                const f32x4 b0 = *(const f32x4*)(b_gate + col), b1 = *(const f32x4*)(b_gate + col + 4);
#pragma unroll
                for (int ai = 0; ai < 2; ++ai)
#pragma unroll
                    for (int m = 0; m < 4; ++m) {
                        const size_t row = (size_t)u.pm * 256 + ai * 128 + m * 16 + rloc;
                        f32x4 v0 = acc[ai][bj][m][0] + b0, v1 = acc[ai][bj][m][1] + b1;
#pragma unroll
                        for (int e = 0; e < 4; ++e) { v0[e] = fmaxf(sigm(v0[e]), 1e-6f); v1[e] = fmaxf(sigm(v1[e]), 1e-6f); }
                        u32x4 o; o.x = pk2(v0[0], v0[1]); o.y = pk2(v0[2], v0[3]); o.z = pk2(v1[0], v1[1]); o.w = pk2(v1[2], v1[3]);
                        *(u32x4*)(gate + row * LDG + col) = o;
                    }
            }
        } else {
            const int n = u.pm - 36, isv = (u.pn >= 64) ? 1 : 0, h = (u.pn - 60) & 3;
            float* ob = out + (isv ? O_MV : O_MK);
#pragma unroll
            for (int bj = 0; bj < 2; ++bj) {
                const int d = bj * 128 + cloc;
#pragma unroll
                for (int ai = 0; ai < 2; ++ai)
#pragma unroll
                    for (int m = 0; m < 4; ++m) {
                        const int key = ai * 128 + m * 16 + rloc;
                        const f32x4 v0 = acc[ai][bj][m][0], v1 = acc[ai][bj][m][1];
                        float* op = ob + ((size_t)(n * 256 + key) * 4 + h) * 256 + d;
                        *(f32x4*)op = v0; *(f32x4*)(op + 4) = v1;
                        if (!isv) {
                            u32x4 o; o.x = pk2(v0[0], v0[1]); o.y = pk2(v0[2], v0[3]); o.z = pk2(v1[0], v1[1]); o.w = pk2(v1[2], v1[3]);
                            *(u32x4*)(mkb + ((size_t)(n * 4 + h) * 256 + key) * 256 + d) = o;
                        } else {
                            bf16_t* vp = mvt + ((size_t)(n * 4 + h) * 256 + d) * 256 + key;
#pragma unroll
                            for (int e = 0; e < 4; ++e) { vp[(size_t)e * 256] = (bf16_t)f2bf(v0[e]); vp[(size_t)(e + 4) * 256] = (bf16_t)f2bf(v1[e]); }
                        }
                    }
            }
        }
        return false;
    }
};

struct SchedP4 {
    int G, c; const char* A; const char* Bt;
    __device__ __forceinline__ bool next(int i, Unit& u) const {
        const int tri = i / 3, L = tri * G + c; if (L >= 288) return false;
        u.br = i - tri * 3; pg8::tile_of(L, 36, 8, u.pm, u.pn); return true;
    }
    __device__ __forceinline__ const char* a_base(const Unit& u) const { return A + (size_t)u.br * ((size_t)9216 * 1024 * 2) + (size_t)u.pm * (256 * 1024 * 2); }
    __device__ __forceinline__ const char* b_base(const Unit& u) const { return Bt + (size_t)u.br * ((size_t)2048 * 1024 * 2) + (size_t)u.pn * (256 * 1024 * 2); }
};
struct EpiP4 {
    const bf16_t* gate; bf16_t* merged;
    __device__ __forceinline__ bool operator()(f32x4 (&acc)[2][2][4][2], const Unit& u, int wr, int wc, int fr, int fq) const {
        const int rloc = wr * 64 + fr, cloc = wc * 32 + 8 * fq;
#pragma unroll
        for (int bj = 0; bj < 2; ++bj) {
            const int col = u.pn * 256 + bj * 128 + cloc;
#pragma unroll
            for (int ai = 0; ai < 2; ++ai)
#pragma unroll
                for (int m = 0; m < 4; ++m) {
                    const size_t row = (size_t)u.pm * 256 + ai * 128 + m * 16 + rloc;
                    const bf16_t* gp = gate + row * LDG + u.br * 2048 + col;
                    const u32x4 g = *(const u32x4*)gp;
                    f32x4 s0 = (f32x4){bflo(g.x), bfhi(g.x), bflo(g.y), bfhi(g.y)}, s1 = (f32x4){bflo(g.z), bfhi(g.z), bflo(g.w), bfhi(g.w)};
                    if (u.br < 2) {
                        const u32x4 h = *(const u32x4*)(gp + 2048);
                        s0[0] *= __builtin_amdgcn_rcpf(bflo(h.x)); s0[1] *= __builtin_amdgcn_rcpf(bfhi(h.x)); s0[2] *= __builtin_amdgcn_rcpf(bflo(h.y)); s0[3] *= __builtin_amdgcn_rcpf(bfhi(h.y));
                        s1[0] *= __builtin_amdgcn_rcpf(bflo(h.z)); s1[1] *= __builtin_amdgcn_rcpf(bfhi(h.z)); s1[2] *= __builtin_amdgcn_rcpf(bflo(h.w)); s1[3] *= __builtin_amdgcn_rcpf(bfhi(h.w));
                    }
                    acc[ai][bj][m][0] *= s0; acc[ai][bj][m][1] *= s1;
                    if (u.br == 2) { const f32x4 v0 = acc[ai][bj][m][0], v1 = acc[ai][bj][m][1];
                        u32x4 o; o.x = pk2(v0[0], v0[1]); o.y = pk2(v0[2], v0[3]); o.z = pk2(v1[0], v1[1]); o.w = pk2(v1[2], v1[3]);
                        *(u32x4*)(merged + row * 2048 + col) = o; }
                }
        }
        return u.br < 2;
    }
};

struct SchedP5 {
    int G, c; const char* A; const char* Bt;
    __device__ __forceinline__ bool next(int i, Unit& u) const {
        const int L = i * G + c; if (L >= 288) return false;
        u.br = 0; pg8::tile_of(L, 36, 8, u.pm, u.pn); return true;
    }
    __device__ __forceinline__ const char* a_base(const Unit& u) const { return A + (size_t)u.pm * (256 * 2048 * 2); }
    __device__ __forceinline__ const char* b_base(const Unit& u) const { return Bt + (size_t)u.pn * (256 * 2048 * 2); }
};
struct EpiP5 {
    const float* xp; const float* xs; float* out;
    __device__ __forceinline__ bool operator()(f32x4 (&acc)[2][2][4][2], const Unit& u, int wr, int wc, int fr, int fq) const {
        const int rloc = wr * 64 + fr, cloc = wc * 32 + 8 * fq;
#pragma unroll
        for (int bj = 0; bj < 2; ++bj) {
            const int col = u.pn * 256 + bj * 128 + cloc;
#pragma unroll
            for (int ai = 0; ai < 2; ++ai)
#pragma unroll
                for (int m = 0; m < 4; ++m) {
                    const size_t row = (size_t)u.pm * 256 + ai * 128 + m * 16 + rloc;
                    const float* xr = (row < (size_t)NTP) ? (xp + row * 2048 + col) : (xs + (row - NTP) * 2048 + col);
                    const f32x4 v0 = acc[ai][bj][m][0] + *(const f32x4*)xr, v1 = acc[ai][bj][m][1] + *(const f32x4*)(xr + 4);
                    float* op = out + row * 2048 + col;
                    *(f32x4*)op = v0; *(f32x4*)(op + 4) = v1;
                }
        }
        return false;
    }
};

struct EpiNull {
    __device__ __forceinline__ bool operator()(f32x4 (&acc)[2][2][4][2], const Unit& u, int wr, int wc, int fr, int fq) const {
        f32x4 t = (f32x4){0.f, 0.f, 0.f, 0.f};
#pragma unroll
        for (int ai = 0; ai < 2; ++ai)
#pragma unroll
            for (int bj = 0; bj < 2; ++bj)
#pragma unroll
                for (int m = 0; m < 4; ++m) t += acc[ai][bj][m][0] + acc[ai][bj][m][1];
        asm volatile("" :: "v"(t[0]), "v"(t[1]), "v"(t[2]), "v"(t[3]));
        return false;
    }
};
__device__ __forceinline__ void transpose_tile(const float* W, int K, int N, bf16_t* WT, int row_off, int kb, int nb, LAS unsigned* T32, int tid) {
    const int nq = tid & 31, kp0 = tid >> 5;
#pragma unroll
    for (int i = 0; i < 4; ++i) {
        const int kpair = kp0 + 16 * i;
        const float* src = W + (size_t)(kb * 128 + 2 * kpair) * N + nb * 128 + 4 * nq;
        const f32x4 r0 = *(const f32x4*)src, r1 = *(const f32x4*)(src + N);
        T32[(4 * nq + 0) * 65 + kpair] = pk2(r0[0], r1[0]); T32[(4 * nq + 1) * 65 + kpair] = pk2(r0[1], r1[1]);
        T32[(4 * nq + 2) * 65 + kpair] = pk2(r0[2], r1[2]); T32[(4 * nq + 3) * 65 + kpair] = pk2(r0[3], r1[3]);
    }
    __syncthreads();
#pragma unroll
    for (int i = 0; i < 4; ++i) {
        const int id = tid + 512 * i, n = id >> 4, c = id & 15;
        u32x4 o; o.x = T32[n * 65 + 4 * c]; o.y = T32[n * 65 + 4 * c + 1]; o.z = T32[n * 65 + 4 * c + 2]; o.w = T32[n * 65 + 4 * c + 3];
        *(u32x4*)(WT + (size_t)(row_off + nb * 128 + n) * K + kb * 128 + 8 * c) = o;
    }
    __syncthreads();
}
__device__ __forceinline__ void rms_row_to_bf16(const float* xrow, const float* g, bf16_t* orow, int lane) {
    f32x4 v[8]; float ss = 0.f;
#pragma unroll
    for (int j = 0; j < 8; ++j) { v[j] = ((const f32x4*)xrow)[lane + 64 * j]; ss += (v[j][0] * v[j][0] + v[j][1] * v[j][1]) + (v[j][2] * v[j][2] + v[j][3] * v[j][3]); }
    ss = wave_sum(ss);
    const float rinv = rsqrtf(ss * (1.f / 2048.f) + EPS);
#pragma unroll
    for (int j = 0; j < 8; ++j) { const f32x4 gg = ((const f32x4*)g)[lane + 64 * j];
        u32x2 o; o.x = pk2(v[j][0] * rinv * gg[0], v[j][1] * rinv * gg[1]); o.y = pk2(v[j][2] * rinv * gg[2], v[j][3] * rinv * gg[3]);
        ((u32x2*)orow)[lane + 64 * j] = o; }
}
__device__ __forceinline__ void p0_prologue(const Params& p, LAS unsigned char* lds) {
    const int tid = threadIdx.x, lane = tid & 63, wave = tid >> 6, G = gridDim.x, c = blockIdx.x;
    LAS unsigned* T32 = (LAS unsigned*)lds;
    bf16_t* WT1 = (bf16_t*)(p.ws + WS_WT1); bf16_t* WT3 = (bf16_t*)(p.ws + WS_WT3); bf16_t* WTO = (bf16_t*)(p.ws + WS_WTO);
    constexpr int T_IN = 1920, T_MKV = 256, T_BR = 128, T_OUT = 256, T_ALL = T_IN + T_MKV + 3 * T_BR + T_OUT;
    for (int it = c; it < T_ALL; it += G) {
        int r = it;
        if (r < T_IN) { transpose_tile(p.w_in, 2048, 15360, WT1, 0, r / 120, r % 120, T32, tid); continue; } r -= T_IN;
        if (r < T_MKV) { transpose_tile(p.w_mem_kv, 2048, 2048, WT1, 15360, r / 16, r % 16, T32, tid); continue; } r -= T_MKV;
        if (r < T_BR) { transpose_tile(p.w_conv_out, 1024, 2048, WT3, 0, r / 16, r % 16, T32, tid); continue; } r -= T_BR;
        if (r < T_BR) { transpose_tile(p.w_hgrn_out, 1024, 2048, WT3 + (size_t)2048 * 1024, 0, r / 16, r % 16, T32, tid); continue; } r -= T_BR;
        if (r < T_BR) { transpose_tile(p.w_attn_out, 1024, 2048, WT3 + (size_t)2 * 2048 * 1024, 0, r / 16, r % 16, T32, tid); continue; } r -= T_BR;
        transpose_tile(p.w_out, 2048, 2048, WTO, 0, r / 16, r % 16, T32, tid);
    }
    bf16_t* HA = (bf16_t*)(p.ws + WS_HA);
    const int gw = c * 8 + wave, NGW = G * 8;
    for (int m = gw; m < 10240; m += NGW) {
        if (m < NTP) rms_row_to_bf16(p.x_prompt + (size_t)m * 2048, p.g_pre, HA + (size_t)m * 2048, lane);
        else if (m < NTOK) rms_row_to_bf16(p.x_sample + (size_t)(m - NTP) * 2048, p.g_pre, HA + (size_t)m * 2048, lane);
        else rms_row_to_bf16(p.mem_prompt + (size_t)(m - NTOK) * 2048, p.g_mem, HA + (size_t)m * 2048, lane);
    }
    if (c == 0) { float* LB = (float*)(p.ws + WS_LB);
        for (int i = tid; i < 1024; i += 512) LB[i] = 1.f / (1.f + __expf(p.lb_logits[1024 + i] - p.lb_logits[i])); }
}

__device__ __forceinline__ void hgrn_prompt_item(const Params& p, int item, LAS unsigned char* lds, int tid) {
    LAS float* qs = (LAS float*)lds;
    LAS float* fs = qs + 4096;
    LAS float* vs = fs + 4096;
    LAS float* part = vs + 512;
    const int s = item >> 3, n = s >> 3, h = s & 7, dvg = item & 7;
    const int vcol = tid & 15, kg = tid >> 4;
    const bf16_t* proj = (const bf16_t*)(p.ws + WS_PROJ9);
    const float* F = (const float*)(p.ws + WS_F);
    float* oraw = (float*)(p.ws + WS_ORAW);
    const size_t row0 = (size_t)n * SEQ;
    const bf16_t* qsrc = proj + (row0 + kg) * LDP + C_HQ + h * 128 + vcol * 8;
    const float* fsrc = F + (row0 + kg) * 1024 + h * 128 + vcol * 8;
    const bf16_t* vsrc = proj + (row0 + kg) * LDP + C_HI + h * 128 + dvg * 16 + vcol;
    float S0 = 0.f, S1 = 0.f, S2 = 0.f, S3 = 0.f;
    u32x4 rq = *(const u32x4*)qsrc; f32x4 rf0 = *(const f32x4*)fsrc, rf1 = *(const f32x4*)(fsrc + 4); bf16_t rv = *vsrc;
    for (int t0 = 0; t0 < SEQ; t0 += 32) {
        { LAS float* qd = qs + kg * 128 + vcol * 8;
          *(LAS f32x4*)qd = (f32x4){bflo(rq.x), bfhi(rq.x), bflo(rq.y), bfhi(rq.y)}; *(LAS f32x4*)(qd + 4) = (f32x4){bflo(rq.z), bfhi(rq.z), bflo(rq.w), bfhi(rq.w)};
          LAS float* fd = fs + kg * 128 + vcol * 8; *(LAS f32x4*)fd = rf0; *(LAS f32x4*)(fd + 4) = rf1;
          vs[kg * 16 + vcol] = bf2f(rv); }
        __syncthreads();
        if (t0 + 32 < SEQ) { const size_t adv = (size_t)(t0 + 32);
            rq = *(const u32x4*)(qsrc + adv * LDP); rf0 = *(const f32x4*)(fsrc + adv * 1024); rf1 = *(const f32x4*)(fsrc + adv * 1024 + 4); rv = *(vsrc + adv * LDP); }
#pragma unroll 4
        for (int tt = 0; tt < 32; ++tt) {
            const f32x4 f4 = *(const LAS f32x4*)(fs + tt * 128 + kg * 4), q4 = *(const LAS f32x4*)(qs + tt * 128 + kg * 4);
            const float vv = vs[tt * 16 + vcol];
            S0 = f4[0] * S0 + (1.f - f4[0]) * vv; S1 = f4[1] * S1 + (1.f - f4[1]) * vv; S2 = f4[2] * S2 + (1.f - f4[2]) * vv; S3 = f4[3] * S3 + (1.f - f4[3]) * vv;
            part[tt * 528 + tid] = (S0 * q4[0] + S1 * q4[1]) + (S2 * q4[2] + S3 * q4[3]);
        }
        __syncthreads();
        { float a = 0.f;
#pragma unroll 8
          for (int k2 = 0; k2 < 32; ++k2) a += part[kg * 528 + k2 * 16 + vcol];
          oraw[(row0 + t0 + kg) * 1024 + h * 128 + dvg * 16 + vcol] = a; }
    }
    float* so = p.out + O_HGRN_P + ((size_t)(n * 8 + h) * 128 + kg * 4) * 128 + dvg * 16 + vcol;
    so[0] = S0; so[128] = S1; so[256] = S2; so[384] = S3;
    __syncthreads();
}

__device__ __forceinline__ void hgrn_sample_item(const Params& p, int item, LAS unsigned char* lds, int tid) {
    LAS float* qs = (LAS float*)lds;
    LAS float* fs = qs + 1024;
    LAS float* vs = fs + 1024;
    LAS float* opart = vs + 1024;
    const int n = item >> 3, h = item & 7, lane = tid & 63, wave = tid >> 6;
    const bf16_t* proj = (const bf16_t*)(p.ws + WS_PROJ9);
    const float* F = (const float*)(p.ws + WS_F);
    const size_t row0 = (size_t)NTP + (size_t)n * 8;
    { const int tt = tid >> 6, k2 = (tid & 63) * 2; const size_t r = row0 + tt;
      const unsigned qw = *(const unsigned*)(proj + r * LDP + C_HQ + h * 128 + k2); const f32x2 ff = *(const f32x2*)(F + r * 1024 + h * 128 + k2);
      const unsigned vw = *(const unsigned*)(proj + r * LDP + C_HI + h * 128 + k2);
      qs[tt * 128 + k2] = bflo(qw); qs[tt * 128 + k2 + 1] = bfhi(qw); fs[tt * 128 + k2] = ff[0]; fs[tt * 128 + k2 + 1] = ff[1];
      vs[tt * 128 + k2] = bflo(vw); vs[tt * 128 + k2 + 1] = bfhi(vw); }
    const int v4 = tid & 31, kg = tid >> 5;
    const size_t sbase = ((size_t)(n * 8 + h) * 128 + kg * 8) * 128 + v4 * 4;
    f32x4 S[8];
#pragma unroll
    for (int i = 0; i < 8; ++i) S[i] = *(const f32x4*)(p.state_hgrn + sbase + (size_t)i * 128);
    __syncthreads();
#pragma unroll
    for (int tt = 0; tt < 8; ++tt) {
        const f32x4 fa = *(const LAS f32x4*)(fs + tt * 128 + kg * 8), fb = *(const LAS f32x4*)(fs + tt * 128 + kg * 8 + 4);
        const f32x4 qa = *(const LAS f32x4*)(qs + tt * 128 + kg * 8), qb = *(const LAS f32x4*)(qs + tt * 128 + kg * 8 + 4);
        const f32x4 vv = *(const LAS f32x4*)(vs + tt * 128 + v4 * 4);
        f32x4 po = (f32x4){0.f, 0.f, 0.f, 0.f};
#pragma unroll
        for (int i = 0; i < 8; ++i) { const float f = (i < 4) ? fa[i & 3] : fb[i & 3], q = (i < 4) ? qa[i & 3] : qb[i & 3];
            S[i] = S[i] * f + vv * (1.f - f); po += S[i] * q; }
#pragma unroll
        for (int e = 0; e < 4; ++e) po[e] += __shfl_xor(po[e], 32);
        if (lane < 32) *(LAS f32x4*)(opart + (tt * 8 + wave) * 128 + v4 * 4) = po;
    }
    float* so = p.out + O_HGRN_S + sbase;
#pragma unroll
    for (int i = 0; i < 8; ++i) *(f32x4*)(so + (size_t)i * 128) = S[i];
    __syncthreads();
    { const int tt = tid >> 6, v = (tid & 63) * 2; float o0 = 0.f, o1 = 0.f;
#pragma unroll
      for (int w = 0; w < 8; ++w) { const f32x2 t = *(const LAS f32x2*)(opart + (tt * 8 + w) * 128 + v); o0 += t[0]; o1 += t[1]; }
      const float ss = wave_sum(o0 * o0 + o1 * o1), rinv = rsqrtf(ss * (1.f / 128.f) + EPS);
      const size_t r = row0 + tt; const f32x2 gg = *(const f32x2*)(p.g_hgrn + h * 128 + v);
      const unsigned gw = *(const unsigned*)(proj + r * LDP + C_HOG + h * 128 + v);
      bf16_t* og = (bf16_t*)(p.ws + WS_ACT3) + (size_t)9216 * 1024 + r * 1024 + h * 128 + v;
      *(unsigned*)og = pk2(o0 * rinv * gg[0] * bflo(gw), o1 * rinv * gg[1] * bfhi(gw)); }
    __syncthreads();
}

__device__ __forceinline__ void hgrn_norm_rows(const Params& p) {
    const int tid = threadIdx.x, lane = tid & 63, gw = blockIdx.x * 8 + (tid >> 6), NGW = gridDim.x * 8;
    const bf16_t* proj = (const bf16_t*)(p.ws + WS_PROJ9); const float* oraw = (const float*)(p.ws + WS_ORAW);
    bf16_t* og = (bf16_t*)(p.ws + WS_ACT3) + (size_t)9216 * 1024;
    for (int r = gw; r < NTP; r += NGW) {
        f32x4 o[4]; float ss = 0.f;
#pragma unroll
        for (int j = 0; j < 4; ++j) { o[j] = *(const f32x4*)(oraw + (size_t)r * 1024 + lane * 16 + j * 4); ss += (o[j][0] * o[j][0] + o[j][1] * o[j][1]) + (o[j][2] * o[j][2] + o[j][3] * o[j][3]); }
        ss += __shfl_xor(ss, 1); ss += __shfl_xor(ss, 2); ss += __shfl_xor(ss, 4);
        const float rinv = rsqrtf(ss * (1.f / 128.f) + EPS);
        const u32x4 ga = *(const u32x4*)(proj + (size_t)r * LDP + C_HOG + lane * 16), gb = *(const u32x4*)(proj + (size_t)r * LDP + C_HOG + lane * 16 + 8);
        f32x4 g[4];
#pragma unroll
        for (int j = 0; j < 4; ++j) g[j] = *(const f32x4*)(p.g_hgrn + lane * 16 + j * 4);
        u32x4 oa, ob;
        oa.x = pk2(o[0][0] * rinv * g[0][0] * bflo(ga.x), o[0][1] * rinv * g[0][1] * bfhi(ga.x)); oa.y = pk2(o[0][2] * rinv * g[0][2] * bflo(ga.y), o[0][3] * rinv * g[0][3] * bfhi(ga.y));
        oa.z = pk2(o[1][0] * rinv * g[1][0] * bflo(ga.z), o[1][1] * rinv * g[1][1] * bfhi(ga.z)); oa.w = pk2(o[1][2] * rinv * g[1][2] * bflo(ga.w), o[1][3] * rinv * g[1][3] * bfhi(ga.w));
        ob.x = pk2(o[2][0] * rinv * g[2][0] * bflo(gb.x), o[2][1] * rinv * g[2][1] * bfhi(gb.x)); ob.y = pk2(o[2][2] * rinv * g[2][2] * bflo(gb.y), o[2][3] * rinv * g[2][3] * bfhi(gb.y));
        ob.z = pk2(o[3][0] * rinv * g[3][0] * bflo(gb.z), o[3][1] * rinv * g[3][1] * bfhi(gb.z)); ob.w = pk2(o[3][2] * rinv * g[3][2] * bflo(gb.w), o[3][3] * rinv * g[3][3] * bfhi(gb.w));
        *(u32x4*)(og + (size_t)r * 1024 + lane * 16) = oa; *(u32x4*)(og + (size_t)r * 1024 + lane * 16 + 8) = ob;
    }
}

template <bool SAMPLE>
__device__ __forceinline__ void conv_item(const Params& p, int item, LAS unsigned char* lds, int tid) {
    constexpr int T = SAMPLE ? 8 : 32;
    constexpr int GP = 4, NG = (T + 32) / GP, G0 = 32 / GP;
    LAS float* dcs = (LAS float*)lds;
    const bf16_t* proj = (const bf16_t*)(p.ws + WS_PROJ9);
    const int n = SAMPLE ? item : (item >> 6), t0 = SAMPLE ? 0 : (item & 63) * 32;
    const size_t rowb = SAMPLE ? ((size_t)NTP + (size_t)n * 8) : ((size_t)n * SEQ);
    const int c0 = 2 * tid;
    float w0[31], w1[31], x0[31], x1[31];
#pragma unroll
    for (int j = 0; j < 31; ++j) { const f32x2 w = *(const f32x2*)(p.conv_w + j * 1024 + c0); w0[j] = w[0]; w1[j] = w[1]; x0[j] = 0.f; x1[j] = 0.f; }
    const f32x2 bias = *(const f32x2*)(p.conv_b + c0);
    unsigned ra[GP], rg[GP];
#define CONV_ISSUE(g) do { \
        if (SAMPLE && (g) < G0) { _Pragma("unroll") for (int i = 0; i < GP; ++i) { const int ti = -2 + GP * (g) + i; \
            const unsigned* tp = (const unsigned*)(p.state_conv + ((size_t)n * 30 + (ti < 0 ? 0 : ti)) * 1024 + c0); ra[i] = tp[0]; rg[i] = tp[1]; } } \
        else { _Pragma("unroll") for (int i = 0; i < GP; ++i) { const int t = t0 - 32 + GP * (g) + i; const bf16_t* rp = proj + (rowb + (t < 0 ? 0 : t)) * LDP + c0; \
            ra[i] = *(const unsigned*)(rp + C_CV); rg[i] = *(const unsigned*)(rp + C_CG); } } } while (0)
    CONV_ISSUE(0);
#pragma unroll 1
    for (int g = 0; g < NG; ++g) {
        float u0[GP], u1[GP];
        if (SAMPLE && g < G0) {
#pragma unroll
            for (int i = 0; i < GP; ++i) { const bool ok = (-2 + GP * g + i) >= 0; u0[i] = ok ? __builtin_bit_cast(float, ra[i]) : 0.f; u1[i] = ok ? __builtin_bit_cast(float, rg[i]) : 0.f; }
        } else {
#pragma unroll
            for (int i = 0; i < GP; ++i) { const bool ok = (t0 - 32 + GP * g + i) >= 0; u0[i] = ok ? bflo(ra[i]) * bflo(rg[i]) : 0.f; u1[i] = ok ? bfhi(ra[i]) * bfhi(rg[i]) : 0.f; }
        }
        if (g + 1 < NG) CONV_ISSUE(g + 1);
#pragma unroll
        for (int i = 0; i < GP; ++i) {
            const int pp = -32 + GP * g + i, t = t0 + pp;
            if (SAMPLE) { if (pp >= -22) *(f32x2*)(p.out + O_CONV_S + ((size_t)n * 30 + (pp + 22)) * 1024 + c0) = (f32x2){u0[i], u1[i]}; }
            else { if (t >= SEQ - 30) *(f32x2*)(p.out + O_CONV_P + ((size_t)n * 30 + (t - (SEQ - 30))) * 1024 + c0) = (f32x2){u0[i], u1[i]}; }
#pragma unroll
            for (int j = 0; j < 30; ++j) { x0[j] = x0[j + 1]; x1[j] = x1[j + 1]; }
            x0[30] = u0[i]; x1[30] = u1[i];
            if (g >= G0) {
                float d0 = bias[0], d1 = bias[1];
#pragma unroll
                for (int j = 0; j < 31; ++j) { d0 += w0[j] * x0[j]; d1 += w1[j] * x1[j]; }
                *(LAS f32x2*)(dcs + (pp) * 1024 + c0) = (f32x2){d0, d1};
            }
        }
    }
#undef CONV_ISSUE
    __syncthreads();
    { const int lane = tid & 63, wave = tid >> 6;
      bf16_t* aact = (bf16_t*)(p.ws + WS_ACT3);
      for (int pp = wave; pp < T; pp += 8) {
          f32x4 v[4]; float s = 0.f;
#pragma unroll
          for (int j = 0; j < 4; ++j) { v[j] = *(const LAS f32x4*)(dcs + pp * 1024 + j * 256 + lane * 4); s += (v[j][0] + v[j][1]) + (v[j][2] + v[j][3]); }
          const float mean = wave_sum(s) * (1.f / 1024.f); float s2 = 0.f;
#pragma unroll
          for (int j = 0; j < 4; ++j) { v[j] = v[j] - mean; s2 += (v[j][0] * v[j][0] + v[j][1] * v[j][1]) + (v[j][2] * v[j][2] + v[j][3] * v[j][3]); }
          const float rstd = rsqrtf(wave_sum(s2) * (1.f / 1024.f) + EPS);
          const size_t r = rowb + t0 + pp;
#pragma unroll
          for (int j = 0; j < 4; ++j) { const int c = j * 256 + lane * 4;
              const f32x4 lg = *(const f32x4*)(p.ln_g + c), lbv = *(const f32x4*)(p.ln_b + c);
              const u32x2 sg = *(const u32x2*)(proj + r * LDP + C_CS + c);
              const float y0 = siluf(v[j][0] * rstd * lg[0] + lbv[0]) * bflo(sg.x), y1 = siluf(v[j][1] * rstd * lg[1] + lbv[1]) * bfhi(sg.x);
              const float y2 = siluf(v[j][2] * rstd * lg[2] + lbv[2]) * bflo(sg.y), y3 = siluf(v[j][3] * rstd * lg[3] + lbv[3]) * bfhi(sg.y);
              u32x2 o; o.x = pk2(y0, y1); o.y = pk2(y2, y3);
              *(u32x2*)(aact + r * 1024 + c) = o; }
      } }
    __syncthreads();
}

__device__ __forceinline__ void attn_prompt_item(const Params& p, int item, int tid) {
    const int lane = tid & 63, wave = tid >> 6, l15 = lane & 15, quad = lane >> 4;
    const int n = item >> 6, h = (item >> 4) & 3, qt = item & 15;
    const bf16_t* proj = (const bf16_t*)(p.ws + WS_PROJ9);
    const bf16_t* kb = (const bf16_t*)(p.ws + WS_MKB) + (size_t)(n * 4 + h) * 65536;
    const bf16_t* vt = (const bf16_t*)(p.ws + WS_MVT) + (size_t)(n * 4 + h) * 65536;
    const size_t qrow = (size_t)n * SEQ + qt * 128 + wave * 16 + l15;
    bf16x8 qf[8];
#pragma unroll
    for (int s = 0; s < 8; ++s) qf[s] = *(const bf16x8*)(proj + qrow * LDP + C_AQ + h * 256 + s * 32 + quad * 8);
    f32x4 sc[16];
#pragma unroll
    for (int T = 0; T < 16; ++T) {
        sc[T] = (f32x4){0.f, 0.f, 0.f, 0.f};
        const bf16_t* kr = kb + (size_t)(T * 16 + l15) * 256 + quad * 8;
#pragma unroll
        for (int s = 0; s < 8; ++s) { const bf16x8 a = *(const bf16x8*)(kr + s * 32); sc[T] = __builtin_amdgcn_mfma_f32_16x16x32_bf16(a, qf[s], sc[T], 0, 0, 0); }
    }
    float mx = -3.0e38f;
#pragma unroll
    for (int T = 0; T < 16; ++T) mx = fmaxf(mx, fmaxf(fmaxf(sc[T][0], sc[T][1]), fmaxf(sc[T][2], sc[T][3])));
    mx = fmaxf(mx, __shfl_xor(mx, 16)); mx = fmaxf(mx, __shfl_xor(mx, 32));
    float sum = 0.f;
#pragma unroll
    for (int T = 0; T < 16; ++T) {
#pragma unroll
        for (int e = 0; e < 4; ++e) { sc[T][e] = __expf(sc[T][e] - mx); sum += sc[T][e]; } }
    sum += __shfl_xor(sum, 16); sum += __shfl_xor(sum, 32);
    const float rs = 1.f / sum;
    bf16x8 pb[8];
#pragma unroll
    for (int s2 = 0; s2 < 8; ++s2) {
        u32x4 w; w.x = pk2(sc[2 * s2][0], sc[2 * s2][1]); w.y = pk2(sc[2 * s2][2], sc[2 * s2][3]); w.z = pk2(sc[2 * s2 + 1][0], sc[2 * s2 + 1][1]); w.w = pk2(sc[2 * s2 + 1][2], sc[2 * s2 + 1][3]);
        pb[s2] = __builtin_bit_cast(bf16x8, w);
    }
    bf16_t* aog = (bf16_t*)(p.ws + WS_ACT3) + (size_t)2 * 9216 * 1024;
#pragma unroll 2
    for (int Tv = 0; Tv < 16; ++Tv) {
        f32x4 oacc = (f32x4){0.f, 0.f, 0.f, 0.f};
        const bf16_t* vr = vt + (size_t)(Tv * 16 + l15) * 256 + quad * 4;
#pragma unroll
        for (int s2 = 0; s2 < 8; ++s2) {
            const u32x2 lo = *(const u32x2*)(vr + s2 * 32), hi = *(const u32x2*)(vr + s2 * 32 + 16);
            u32x4 w; w.x = lo.x; w.y = lo.y; w.z = hi.x; w.w = hi.y;
            oacc = __builtin_amdgcn_mfma_f32_16x16x32_bf16(__builtin_bit_cast(bf16x8, w), pb[s2], oacc, 0, 0, 0);
        }
        const int dv = Tv * 16 + quad * 4;
        const u32x2 sg = *(const u32x2*)(proj + qrow * LDP + C_AS + h * 256 + dv);
        u32x2 o; o.x = pk2(oacc[0] * rs * bflo(sg.x), oacc[1] * rs * bfhi(sg.x)); o.y = pk2(oacc[2] * rs * bflo(sg.y), oacc[3] * rs * bfhi(sg.y));
        *(u32x2*)(aog + qrow * 1024 + h * 256 + dv) = o;
    }
}

__device__ __forceinline__ void attn_sample_item(const Params& p, int item, LAS unsigned char* lds, int tid) {
    LAS float* Ssh = (LAS float*)lds;
    LAS float* Psh = Ssh + 2048;
    LAS float* Opart = Psh + 2048;
    const int lane = tid & 63, wave = tid >> 6, l15 = lane & 15, quad = lane >> 4;
    const int n = item >> 2, h = item & 3;
    const bf16_t* proj = (const bf16_t*)(p.ws + WS_PROJ9);
    const size_t row0 = (size_t)NTP + (size_t)n * 8;
    const float* kc = p.cache_k + ((size_t)n * 256 * 4 + h) * 256;
    const float* vc = p.cache_v + ((size_t)n * 256 * 4 + h) * 256;
    {
        bf16x8 qf[8];
        const size_t qrow = row0 + (lane & 7);
#pragma unroll
        for (int s = 0; s < 8; ++s) qf[s] = *(const bf16x8*)(proj + qrow * LDP + C_AQ + h * 256 + s * 32 + quad * 8);
#pragma unroll
        for (int tl = 0; tl < 2; ++tl) {
            const int T = wave * 2 + tl;
            f32x4 sc = (f32x4){0.f, 0.f, 0.f, 0.f};
            const float* kr = kc + (size_t)(T * 16 + l15) * 1024 + quad * 8;
#pragma unroll
            for (int s = 0; s < 8; ++s) {
                const f32x4 k0 = *(const f32x4*)(kr + s * 32), k1 = *(const f32x4*)(kr + s * 32 + 4);
                u32x4 w; w.x = pk2(k0[0], k0[1]); w.y = pk2(k0[2], k0[3]); w.z = pk2(k1[0], k1[1]); w.w = pk2(k1[2], k1[3]);
                sc = __builtin_amdgcn_mfma_f32_16x16x32_bf16(__builtin_bit_cast(bf16x8, w), qf[s], sc, 0, 0, 0);
            }
            if (l15 < 8) {
#pragma unroll
                for (int e = 0; e < 4; ++e) Ssh[l15 * 256 + T * 16 + quad * 4 + e] = sc[e];
            }
        }
    }
    __syncthreads();
    {
        const f32x4 s4 = *(const LAS f32x4*)(Ssh + wave * 256 + lane * 4);
        const float mx = wave_max(fmaxf(fmaxf(s4[0], s4[1]), fmaxf(s4[2], s4[3])));
        f32x4 e4; e4[0] = __expf(s4[0] - mx); e4[1] = __expf(s4[1] - mx); e4[2] = __expf(s4[2] - mx); e4[3] = __expf(s4[3] - mx);
        const float rs = 1.f / wave_sum((e4[0] + e4[1]) + (e4[2] + e4[3]));
#pragma unroll
        for (int e = 0; e < 4; ++e) Psh[(lane * 4 + e) * 8 + wave] = e4[e] * rs;
    }
    __syncthreads();
    {
        f32x4 acc[8];
#pragma unroll
        for (int q = 0; q < 8; ++q) acc[q] = (f32x4){0.f, 0.f, 0.f, 0.f};
        const float* vr = vc + (size_t)(wave * 32) * 1024 + lane * 4;
#pragma unroll 8
        for (int kk = 0; kk < 32; ++kk) {
            const f32x4 v4 = *(const f32x4*)(vr + (size_t)kk * 1024);
            const f32x4 pa = *(const LAS f32x4*)(Psh + (wave * 32 + kk) * 8), pb = *(const LAS f32x4*)(Psh + (wave * 32 + kk) * 8 + 4);
            acc[0] += v4 * pa[0]; acc[1] += v4 * pa[1]; acc[2] += v4 * pa[2]; acc[3] += v4 * pa[3];
            acc[4] += v4 * pb[0]; acc[5] += v4 * pb[1]; acc[6] += v4 * pb[2]; acc[7] += v4 * pb[3];
        }
#pragma unroll
        for (int q = 0; q < 8; ++q) *(LAS f32x4*)(Opart + (wave * 8 + q) * 256 + lane * 4) = acc[q];
    }
    __syncthreads();
    {
        f32x4 o = (f32x4){0.f, 0.f, 0.f, 0.f};
#pragma unroll
        for (int w = 0; w < 8; ++w) o += *(const LAS f32x4*)(Opart + (w * 8 + wave) * 256 + lane * 4);
        const size_t r = row0 + wave;
        const u32x2 sg = *(const u32x2*)(proj + r * LDP + C_AS + h * 256 + lane * 4);
        u32x2 ov; ov.x = pk2(o[0] * bflo(sg.x), o[1] * bfhi(sg.x)); ov.y = pk2(o[2] * bflo(sg.y), o[3] * bfhi(sg.y));
        bf16_t* aog = (bf16_t*)(p.ws + WS_ACT3) + (size_t)2 * 9216 * 1024;
        *(u32x2*)(aog + r * 1024 + h * 256 + lane * 4) = ov;
    }
    __syncthreads();
}

__device__ __forceinline__ void p2_mixers(const Params& p, LAS unsigned char* lds) {
    const int tid = threadIdx.x, G = gridDim.x, c = blockIdx.x, mask = p.pad;
    if (mask & 1) for (int it = c; it < 256; it += G) hgrn_prompt_item(p, it, lds, tid);
    if (mask & 2) { for (int it = c; it < 256; it += G) conv_item<false>(p, it, lds, tid);
                    for (int it = c; it < 128; it += G) conv_item<true>(p, it, lds, tid); }
    if (mask & 4) for (int it = c; it < 256; it += G) attn_prompt_item(p, it, tid);
    if (mask & 8) for (int it = c; it < 512; it += G) attn_sample_item(p, it, lds, tid);
    if (mask & 16) for (int it = c; it < 1024; it += G) hgrn_sample_item(p, it, lds, tid);
}

__device__ __forceinline__ void p6_final_norm(const Params& p) {
    const int tid = threadIdx.x, lane = tid & 63, gw = blockIdx.x * 8 + (tid >> 6), NGW = gridDim.x * 8;
    for (int r = gw; r < NTOK; r += NGW) {
        float* zr = p.out + (size_t)r * 2048;
        f32x4 v[8]; float ss = 0.f;
#pragma unroll
        for (int j = 0; j < 8; ++j) { v[j] = ((const f32x4*)zr)[lane + 64 * j]; ss += (v[j][0] * v[j][0] + v[j][1] * v[j][1]) + (v[j][2] * v[j][2] + v[j][3] * v[j][3]); }
        ss = wave_sum(ss);
        const float rinv = rsqrtf(ss * (1.f / 2048.f) + EPS);
#pragma unroll
        for (int j = 0; j < 8; ++j) { const f32x4 gg = ((const f32x4*)p.g_final)[lane + 64 * j]; ((f32x4*)zr)[lane + 64 * j] = v[j] * rinv * gg; }
    }
}

__global__ void __launch_bounds__(512, 2) fwd_megakernel(Params p) {
    extern __shared__ __attribute__((aligned(16))) unsigned char shm[];
    LAS unsigned char* lds = (LAS unsigned char*)shm;
    cg::grid_group grid = cg::this_grid();
    const int G = gridDim.x, c = blockIdx.x;
#define SEAM(ph) do { if (p.coop && (ph) + 1 < p.ph_hi) { \
        asm volatile("s_waitcnt vmcnt(0) lgkmcnt(0)" ::: "memory"); __syncthreads(); \
        grid.sync(); \
        if (threadIdx.x < 64) { __builtin_amdgcn_fence(__ATOMIC_ACQUIRE, "agent"); asm volatile("s_waitcnt vmcnt(0)" ::: "memory"); } \
        __syncthreads(); } } while (0)
#define RUNS(ph) (p.ph_lo <= (ph) && (ph) < p.ph_hi)
    if (RUNS(0)) { p0_prologue(p, lds); SEAM(0); }
    if (RUNS(1)) {
        SchedP1 S; S.G = G; S.c = c; S.A = (const char*)(p.ws + WS_HA); S.Bt = (const char*)(p.ws + WS_WT1);
        EpiP1 E; E.proj = (bf16_t*)(p.ws + WS_PROJ9); E.gate = (bf16_t*)(p.ws + WS_GATE); E.F = (float*)(p.ws + WS_F); E.lb = (const float*)(p.ws + WS_LB);
        E.b_gate = p.b_gate; E.out = p.out; E.mkb = (bf16_t*)(p.ws + WS_MKB); E.mvt = (bf16_t*)(p.ws + WS_MVT);
        pg8::gemm_phase(lds, 2048, S, E); SEAM(1);
    }
    if (RUNS(2)) { p2_mixers(p, lds); SEAM(2); }
    if (RUNS(3)) { hgrn_norm_rows(p); SEAM(3); }
    if (RUNS(4)) {
        SchedP4 S; S.G = G; S.c = c; S.A = (const char*)(p.ws + WS_ACT3); S.Bt = (const char*)(p.ws + WS_WT3);
        EpiP4 E; E.gate = (const bf16_t*)(p.ws + WS_GATE); E.merged = (bf16_t*)(p.ws + WS_MERGED);
        pg8::gemm_phase(lds, 1024, S, E); SEAM(4);
    }
    if (RUNS(5)) {
        SchedP5 S; S.G = G; S.c = c; S.A = (const char*)(p.ws + WS_MERGED); S.Bt = (const char*)(p.ws + WS_WTO);
        EpiP5 E; E.xp = p.x_prompt; E.xs = p.x_sample; E.out = p.out;
        pg8::gemm_phase(lds, 2048, S, E); SEAM(5);
    }
    if (RUNS(6)) { p6_final_norm(p); }
#undef RUNS
#undef SEAM
}

extern "C" void kernel_launch(void* const* d_in, const int* in_sizes, int n_in, void* d_out, int out_size, void* d_ws, size_t ws_size, hipStream_t stream) {
    static int grid = 0;
    if (grid == 0) {
        if (n_in != 23 || ws_size < WS_END) { fprintf(stderr, "kernel_launch: expected 23 inputs and >= %zu bytes of workspace, got %d / %zu\n", (size_t)WS_END, n_in, ws_size); grid = -1; return; }
        int dev = 0, cus = 0, per_cu = 0;
        hipGetDevice(&dev); hipDeviceGetAttribute(&cus, hipDeviceAttributeMultiprocessorCount, dev);
        if (hipFuncSetAttribute((const void*)fwd_megakernel, hipFuncAttributeMaxDynamicSharedMemorySize, LDS_BYTES) != hipSuccess) { fprintf(stderr, "kernel_launch: hipFuncSetAttribute failed\n"); grid = -1; return; }
        if (hipOccupancyMaxActiveBlocksPerMultiprocessor(&per_cu, (const void*)fwd_megakernel, 512, LDS_BYTES) != hipSuccess || per_cu < 1) { fprintf(stderr, "kernel_launch: occupancy query failed (%d)\n", per_cu); (void)hipGetLastError(); per_cu = 1; }
        grid = cus * 1;
        if (grid <= 0) grid = 256;
    }
    if (grid < 0) return;
    Params p{};
    const float** pp = (const float**)&p;
    for (int i = 0; i < 23; ++i) pp[i] = (const float*)d_in[i];
    p.out = (float*)d_out; p.ws = (unsigned char*)d_ws; p.pad = 31;
#if N_LAUNCH_MODE == 1
    p.ph_lo = 0; p.ph_hi = N_PHASES; p.coop = 1;
    void* args[] = {&p};
    hipError_t e = hipLaunchCooperativeKernel((const void*)fwd_megakernel, dim3(grid), dim3(512), args, LDS_BYTES, stream);
    if (e != hipSuccess) fprintf(stderr, "cooperative launch failed: %s (grid %d)\n", hipGetErrorString(e), grid);
#else
    for (int ph = 0; ph < N_PHASES; ++ph) {
        p.ph_lo = ph; p.ph_hi = ph + 1; p.coop = 0;
        hipLaunchKernelGGL(fwd_megakernel, dim3(grid), dim3(512), LDS_BYTES, stream, p);
        if ((REP_MASK >> ph) & 1) { if (ph == 2) p.pad = P2_SUBMASK; hipLaunchKernelGGL(fwd_megakernel, dim3(grid), dim3(512), LDS_BYTES, stream, p); p.pad = 31; }
    }
#endif
}
```

```cpp
#include <hip/hip_runtime.h>
#include <hip/hip_cooperative_groups.h>
#include <cstdio>
namespace cg = cooperative_groups;

#define LAS __attribute__((address_space(3)))
typedef unsigned short bf16_t;
typedef short bf16x8 __attribute__((ext_vector_type(8)));
typedef float f32x4 __attribute__((ext_vector_type(4)));
typedef float f32x2 __attribute__((ext_vector_type(2)));
typedef unsigned u32x4 __attribute__((ext_vector_type(4)));
typedef unsigned u32x2 __attribute__((ext_vector_type(2)));

#ifndef REP_MASK
#define REP_MASK 0
#endif
#ifndef P2_SUBMASK
#define P2_SUBMASK 31
#endif
#ifndef N_LAUNCH_MODE
#define N_LAUNCH_MODE 1
#endif

constexpr int DM = 2048, NTP = 8192, NTS = 1024, NTOK = 9216, SEQ = 2048;
constexpr int LDP = 9216;
constexpr int C_CV = 0, C_CG = 1024, C_CS = 2048, C_HQ = 3072, C_HF = 4096, C_HI = 5120, C_HOG = 6144, C_AQ = 7168, C_AS = 8192;
constexpr int LDG = 6144;
constexpr float EPS = 1e-6f;
constexpr size_t O_YP = 0, O_YS = 16777216, O_CONV_P = 18874368, O_HGRN_P = 18997248, O_MK = 19521536, O_MV = 20570112, O_CONV_S = 21618688, O_HGRN_S = 25550848;
constexpr size_t WS_WT1 = 0;
constexpr size_t WS_WT3 = WS_WT1 + (size_t)17408 * 2048 * 2;
constexpr size_t WS_WTO = WS_WT3 + (size_t)3 * 2048 * 1024 * 2;
constexpr size_t WS_HA = WS_WTO + (size_t)2048 * 2048 * 2;
constexpr size_t WS_ORAW = WS_HA;
constexpr size_t WS_PROJ9 = WS_HA + (size_t)10240 * 2048 * 2;
constexpr size_t WS_MF = WS_PROJ9;
constexpr size_t WS_MERGED = WS_MF + (size_t)9216 * 2048 * 4;
constexpr size_t WS_GATE = WS_PROJ9 + (size_t)9216 * 9216 * 2;
constexpr size_t WS_F = WS_GATE + (size_t)9216 * 6144 * 2;
constexpr size_t WS_MKB = WS_F + (size_t)9216 * 1024 * 4;
constexpr size_t WS_MVT = WS_MKB + (size_t)2097152;
constexpr size_t WS_ACT3 = WS_MVT + (size_t)2097152;
constexpr size_t WS_LB = WS_ACT3 + (size_t)3 * 9216 * 1024 * 2;
constexpr size_t WS_END = WS_LB + 4096;
constexpr int LDS_BYTES = 131072;
constexpr int N_PHASES = 7;

struct Params {
    const float *x_prompt, *x_sample, *state_conv, *state_hgrn, *cache_k, *cache_v, *mem_prompt, *g_pre, *w_in, *conv_w, *conv_b, *ln_g, *ln_b,
        *w_conv_out, *lb_logits, *g_hgrn, *w_hgrn_out, *g_mem, *w_mem_kv, *w_attn_out, *b_gate, *w_out, *g_final;
    float* out; unsigned char* ws; int ph_lo, ph_hi, coop, pad;
};

__device__ __forceinline__ unsigned f2bf(float f) { unsigned u = __builtin_bit_cast(unsigned, f); return (u + 0x7fffu + ((u >> 16) & 1u)) >> 16; }
typedef __bf16 bf16x2_t __attribute__((ext_vector_type(2)));
__device__ __forceinline__ unsigned pk2(float lo, float hi) { const f32x2 v = {lo, hi}; const bf16x2_t r = __builtin_convertvector(v, bf16x2_t); return __builtin_bit_cast(unsigned, r); }
__device__ __forceinline__ float bflo(unsigned w) { return __builtin_bit_cast(float, w << 16); }
__device__ __forceinline__ float bfhi(unsigned w) { return __builtin_bit_cast(float, w & 0xffff0000u); }
__device__ __forceinline__ float bf2f(unsigned short b) { return __builtin_bit_cast(float, ((unsigned)b) << 16); }
__device__ __forceinline__ float sigm(float x) { return __builtin_amdgcn_rcpf(1.f + __expf(-x)); }
__device__ __forceinline__ float siluf(float x) { return x * sigm(x); }
__device__ __forceinline__ float wave_sum(float v) {
#pragma unroll
    for (int o = 1; o < 64; o <<= 1) v += __shfl_xor(v, o);
    return v;
}
__device__ __forceinline__ float wave_max(float v) {
#pragma unroll
    for (int o = 1; o < 64; o <<= 1) v = fmaxf(v, __shfl_xor(v, o));
    return v;
}

namespace pg8 {
constexpr int BM = 256, BK = 64, HALF = 128, HTB = HALF * BK * 2, STAGE_BYTES = 8 * HTB, NXCD = 8, WGM = 8;
__host__ __device__ __forceinline__ int lds_byte(int r, int c) { const int st = (r >> 4) * 2 + (c >> 5), rr = r & 15, cc = c & 31, ob = rr * 64 + cc * 2; return st * 1024 + (ob ^ (((ob >> 9) & 1) << 5)); }
__host__ __device__ __forceinline__ void stage_rc(int b, int& R, int& C) { const int st = b / 1024, sb = b % 1024, swz = sb ^ (((sb >> 9) & 1) << 5); R = (st >> 1) * 16 + swz / 64; C = (st & 1) * 32 + (swz % 64) / 2; }
__host__ __device__ __forceinline__ int perm32(int rho) { const int n = rho >> 4, i = rho & 15; return 8 * (i >> 2) + 4 * n + (i & 3); }
struct Unit { int pm, pn, br; };
__device__ __forceinline__ void tile_of(int wgid, int nM, int nN, int& pm, int& pn) {
    const int nwg = nM * nN;
    { const int q = nwg / NXCD, r = nwg % NXCD, xcd = wgid % NXCD, off = wgid / NXCD; wgid = (xcd < r ? xcd * (q + 1) : r * (q + 1) + (xcd - r) * q) + off; }
    const int nig = WGM * nN, gid = wgid / nig, fm = gid * WGM, gsz = (nM - fm) < WGM ? (nM - fm) : WGM;
    pm = fm + ((wgid % nig) % gsz); pn = (wgid % nig) / gsz;
}

template <class Epi, class Sched>
__device__ __forceinline__ void gemm_phase(LAS unsigned char* lds, const int K, const Sched& S, const Epi& E) {
    const int tid = threadIdx.x, wid = __builtin_amdgcn_readfirstlane(tid >> 6), lane = tid & 63, wr = wid >> 2, wc = wid & 3, fr = lane & 15, fq = lane >> 4;
    const int nt = K / BK;
    unsigned voffA[2], voffB[2];
#pragma unroll
    for (int i = 0; i < 2; ++i) { int R, C; stage_rc(tid * 16 + i * 8192, R, C); const int Rb = (R & ~31) + perm32(R & 31);
        voffA[i] = (unsigned)(R * K + C) * 2u; voffB[i] = (unsigned)(Rb * K + C) * 2u; }
    const size_t kstep = (size_t)(BK * 2);
    const size_t hstep = (size_t)HALF * K * 2;
    const unsigned ldsw = (unsigned)wid * 1024u;
    const int aoff = lds_byte(wr * 64 + fr, fq * 8), boff = lds_byte(wc * 32 + fr, fq * 8);
#define PG8_SA(b, h) (((b) * 2 + (h)) * HTB)
#define PG8_SB(b, h) ((4 + (b) * 2 + (h)) * HTB)
#define PG8_STAGE(bufoff, gbase, voff) do { _Pragma("unroll") for (int _i = 0; _i < 2; ++_i) \
        __builtin_amdgcn_global_load_lds((const unsigned*)((const char*)(gbase) + (voff)[_i]), (LAS unsigned*)(lds + (bufoff) + ldsw + _i * 8192), 16, 0, 0); } while (0)
#define PG8_LDA(dst, b, h) do { _Pragma("unroll") for (int m = 0; m < 4; ++m) _Pragma("unroll") for (int k = 0; k < 2; ++k) dst[m][k] = *(const LAS bf16x8*)(lds + PG8_SA(b, h) + aoff + m * 2048 + k * 1024); } while (0)
#define PG8_LDB(dst, b, h) do { _Pragma("unroll") for (int n = 0; n < 2; ++n) _Pragma("unroll") for (int k = 0; k < 2; ++k) dst[n][k] = *(const LAS bf16x8*)(lds + PG8_SB(b, h) + boff + n * 2048 + k * 1024); } while (0)
#define PG8_MMA(ai, bj, At, Bt) do { __builtin_amdgcn_s_setprio(1); _Pragma("unroll") for (int m = 0; m < 4; ++m) _Pragma("unroll") for (int n = 0; n < 2; ++n) _Pragma("unroll") for (int k = 0; k < 2; ++k) \
        acc[ai][bj][m][n] = __builtin_amdgcn_mfma_f32_16x16x32_bf16(Bt[n][k], At[m][k], acc[ai][bj][m][n], 0, 0, 0); __builtin_amdgcn_s_setprio(0); } while (0)
#define PG8_WAIT_V(n) asm volatile("s_waitcnt vmcnt(" #n ")" ::: "memory")
#define PG8_WAIT_L(n) asm volatile("s_waitcnt lgkmcnt(" #n ")" ::: "memory")
#define PG8_BAR __builtin_amdgcn_s_barrier()
#define PG8_SCHED __builtin_amdgcn_sched_barrier(0)
    Unit cur, nxt; int ui = 0;
    if (!S.next(0, cur)) return;
    f32x4 acc[2][2][4][2];
#pragma unroll
    for (int a = 0; a < 2; ++a)
#pragma unroll
        for (int b = 0; b < 2; ++b)
#pragma unroll
            for (int m = 0; m < 4; ++m)
#pragma unroll
                for (int n = 0; n < 2; ++n) acc[a][b][m][n] = (f32x4){0.f, 0.f, 0.f, 0.f};
    bf16x8 At[4][2], B0[2][2], B1[2][2];
    const char* cA = S.a_base(cur); const char* cB = S.b_base(cur);
    PG8_STAGE(PG8_SB(0, 0), cB, voffB); PG8_STAGE(PG8_SA(0, 0), cA, voffA); PG8_STAGE(PG8_SB(0, 1), cB + hstep, voffB); PG8_STAGE(PG8_SA(0, 1), cA + hstep, voffA);
    if (wr == 1) PG8_BAR;
    PG8_WAIT_V(4); PG8_BAR;
    PG8_STAGE(PG8_SB(1, 0), cB + kstep, voffB); PG8_STAGE(PG8_SA(1, 0), cA + kstep, voffA); PG8_STAGE(PG8_SB(1, 1), cB + hstep + kstep, voffB);
    PG8_WAIT_V(6); PG8_BAR;
    for (;;) {
        const bool has_next = S.next(ui + 1, nxt);
        const char* nA = has_next ? S.a_base(nxt) : cA; const char* nB = has_next ? S.b_base(nxt) : cB;
        for (int t = 0; t < nt; t += 2) {
            const bool last = (t == nt - 2);
            const char* a1 = cA + (size_t)(t + 1) * kstep;
            const char* a2 = last ? nA : cA + (size_t)(t + 2) * kstep; const char* b2 = last ? nB : cB + (size_t)(t + 2) * kstep;
            const char* a3 = a2 + kstep; const char* b3 = b2 + kstep;
            PG8_LDB(B0, 0, 0); PG8_SCHED; PG8_LDA(At, 0, 0); PG8_STAGE(PG8_SA(1, 1), a1 + hstep, voffA);
            PG8_WAIT_L(8); PG8_BAR; PG8_WAIT_L(0); PG8_MMA(0, 0, At, B0); PG8_BAR; PG8_SCHED;
            PG8_LDB(B1, 0, 1); PG8_STAGE(PG8_SB(0, 0), b2, voffB);
            PG8_BAR; PG8_WAIT_L(0); PG8_MMA(0, 1, At, B1); PG8_BAR;
            PG8_LDA(At, 0, 1); PG8_STAGE(PG8_SA(0, 0), a2, voffA);
            PG8_BAR; PG8_WAIT_L(0); PG8_MMA(1, 0, At, B0); PG8_BAR; PG8_SCHED;
            PG8_STAGE(PG8_SB(0, 1), b2 + hstep, voffB);
            PG8_WAIT_V(6); PG8_BAR; PG8_MMA(1, 1, At, B1); PG8_BAR;
            PG8_LDB(B0, 1, 0); PG8_SCHED; PG8_LDA(At, 1, 0); PG8_STAGE(PG8_SA(0, 1), a2 + hstep, voffA);
            PG8_WAIT_L(8); PG8_BAR; PG8_WAIT_L(0); PG8_MMA(0, 0, At, B0); PG8_BAR; PG8_SCHED;
            PG8_LDB(B1, 1, 1); PG8_STAGE(PG8_SB(1, 0), b3, voffB);
            PG8_BAR; PG8_WAIT_L(0); PG8_MMA(0, 1, At, B1); PG8_BAR;
            PG8_LDA(At, 1, 1); PG8_STAGE(PG8_SA(1, 0), a3, voffA);
            PG8_BAR; PG8_WAIT_L(0); PG8_MMA(1, 0, At, B0); PG8_BAR; PG8_SCHED;
            PG8_STAGE(PG8_SB(1, 1), b3 + hstep, voffB);
            PG8_WAIT_V(6); PG8_BAR; PG8_MMA(1, 1, At, B1); PG8_BAR;
        }
        const bool keep = E(acc, cur, wr, wc, fr, fq);
        if (!has_next) break;
        if (!keep)
#pragma unroll
        for (int a = 0; a < 2; ++a)
#pragma unroll
            for (int b = 0; b < 2; ++b)
#pragma unroll
                for (int m = 0; m < 4; ++m)
#pragma unroll
                    for (int n = 0; n < 2; ++n) acc[a][b][m][n] = (f32x4){0.f, 0.f, 0.f, 0.f};
        cur = nxt; cA = nA; cB = nB; ++ui;
    }
    PG8_WAIT_V(0);
    if (wr == 0) PG8_BAR;
    PG8_BAR;
#undef PG8_SA
#undef PG8_SB
#undef PG8_STAGE
#undef PG8_LDA
#undef PG8_LDB
#undef PG8_MMA
#undef PG8_WAIT_V
#undef PG8_WAIT_L
#undef PG8_BAR
#undef PG8_SCHED
}
}
using pg8::Unit;

struct SchedP1 {
    int G, c; const char* A; const char* Bt;
    __device__ __forceinline__ bool next(int i, Unit& u) const {
        const int L = i * G + c; if (L >= 2192) return false;
        u.br = 0;
        if (L >= 2160) { const int idx = L - 2160; u.pm = 36 + (idx >> 3); u.pn = 60 + (idx & 7); return true; }
        pg8::tile_of(L, 36, 60, u.pm, u.pn); return true;
    }
    __device__ __forceinline__ const char* a_base(const Unit& u) const { return A + (size_t)u.pm * (256 * 2048 * 2); }
    __device__ __forceinline__ const char* b_base(const Unit& u) const { return Bt + (size_t)u.pn * (256 * 2048 * 2); }
};
struct EpiP1 {
    bf16_t* proj; bf16_t* gate; float* F; const float* lb; const float* b_gate; float* out; bf16_t* mkb; bf16_t* mvt;
    __device__ __forceinline__ bool operator()(f32x4 (&acc)[2][2][4][2], const Unit& u, int wr, int wc, int fr, int fq) const {
        const int rloc = wr * 64 + fr, cloc = wc * 32 + 8 * fq;
        if (u.pn < 36) {
            const int seg = u.pn >> 2;
#pragma unroll
            for (int bj = 0; bj < 2; ++bj) {
                const int col = u.pn * 256 + bj * 128 + cloc;
                f32x4 l0 = (f32x4){0.f, 0.f, 0.f, 0.f}, l1 = l0;
                if (seg == 4) { l0 = *(const f32x4*)(lb + (col - C_HF)); l1 = *(const f32x4*)(lb + (col - C_HF) + 4); }
#pragma unroll
                for (int ai = 0; ai < 2; ++ai)
#pragma unroll
                    for (int m = 0; m < 4; ++m) {
                        const size_t row = (size_t)u.pm * 256 + ai * 128 + m * 16 + rloc;
                        f32x4 v0 = acc[ai][bj][m][0], v1 = acc[ai][bj][m][1];
                        if (seg == 4) {
#pragma unroll
                            for (int e = 0; e < 4; ++e) { v0[e] = l0[e] + (1.f - l0[e]) * sigm(v0[e]); v1[e] = l1[e] + (1.f - l1[e]) * sigm(v1[e]); }
                            float* fp = F + row * 1024 + (col - C_HF);
                            *(f32x4*)fp = v0; *(f32x4*)(fp + 4) = v1;
                        } else {
                            if (seg == 1) {
#pragma unroll
                                for (int e = 0; e < 4; ++e) { v0[e] = sigm(v0[e]); v1[e] = sigm(v1[e]); }
                            } else if (seg == 2 || seg == 6 || seg == 8) {
#pragma unroll
                                for (int e = 0; e < 4; ++e) { v0[e] = siluf(v0[e]); v1[e] = siluf(v1[e]); }
                            } else if (seg == 3) { v0 *= 0.08838834764831845f; v1 *= 0.08838834764831845f; }
                            else if (seg == 7) { v0 *= 0.0625f; v1 *= 0.0625f; }
                            u32x4 o; o.x = pk2(v0[0], v0[1]); o.y = pk2(v0[2], v0[3]); o.z = pk2(v1[0], v1[1]); o.w = pk2(v1[2], v1[3]);
                            *(u32x4*)(proj + row * LDP + col) = o;
                        }
                    }
            }
        } else if (u.pn < 60) {
#pragma unroll
            for (int bj = 0; bj < 2; ++bj) {
                const int col = (u.pn - 36) * 256 + bj * 128 + cloc;
                const f32x4 b0 = *(const f32x4*)(b_gate + col), b1 = *(const f32x4*)(b_gate + col + 4);
#pragma unroll
                for (int ai = 0; ai < 2; ++ai)
#pragma unroll
                    for (int m = 0; m < 4; ++m) {
                        const size_t row = (size_t)u.pm * 256 + ai * 128 + m * 16 + rloc;
                        f32x4 v0 = acc[ai][bj][m][0] + b0, v1 = acc[ai][bj][m][1] + b1;
#pragma unroll
                        for (int e = 0; e < 4; ++e) { v0[e] = fmaxf(sigm(v0[e]), 1e-6f); v1[e] = fmaxf(sigm(v1[e]), 1e-6f); }
                        u32x4 o; o.x = pk2(v0[0], v0[1]); o.y = pk2(v0[2], v0[3]); o.z = pk2(v1[0], v1[1]); o.w = pk2(v1[2], v1[3]);
                        *(u32x4*)(gate + row * LDG + col) = o;
                    }
            }
        } else {
            const int n = u.pm - 36, isv = (u.pn >= 64) ? 1 : 0, h = (u.pn - 60) & 3;
            float* ob = out + (isv ? O_MV : O_MK);
#pragma unroll
            for (int bj = 0; bj < 2; ++bj) {
                const int d = bj * 128 + cloc;
#pragma unroll
                for (int ai = 0; ai < 2; ++ai)
#pragma unroll
                    for (int m = 0; m < 4; ++m) {
                        const int key = ai * 128 + m * 16 + rloc;
                        const f32x4 v0 = acc[ai][bj][m][0], v1 = acc[ai][bj][m][1];
                        float* op = ob + ((size_t)(n * 256 + key) * 4 + h) * 256 + d;
                        *(f32x4*)op = v0; *(f32x4*)(op + 4) = v1;
                        if (!isv) {
                            u32x4 o; o.x = pk2(v0[0], v0[1]); o.y = pk2(v0[2], v0[3]); o.z = pk2(v1[0], v1[1]); o.w = pk2(v1[2], v1[3]);
                            *(u32x4*)(mkb + ((size_t)(n * 4 + h) * 256 + key) * 256 + d) = o;
                        } else {
                            bf16_t* vp = mvt + ((size_t)(n * 4 + h) * 256 + d) * 256 + key;
#pragma unroll
                            for (int e = 0; e < 4; ++e) { vp[(size_t)e * 256] = (bf16_t)f2bf(v0[e]); vp[(size_t)(e + 4) * 256] = (bf16_t)f2bf(v1[e]); }
                        }
                    }
            }
        }
        return false;
    }
};

struct SchedP4 {
    int G, c; const char* A; const char* Bt;
    __device__ __forceinline__ bool next(int i, Unit& u) const {
        const int tri = i / 3, L = tri * G + c; if (L >= 288) return false;
        u.br = i - tri * 3; pg8::tile_of(L, 36, 8, u.pm, u.pn); return true;
    }
    __device__ __forceinline__ const char* a_base(const Unit& u) const { return A + (size_t)u.br * ((size_t)9216 * 1024 * 2) + (size_t)u.pm * (256 * 1024 * 2); }
    __device__ __forceinline__ const char* b_base(const Unit& u) const { return Bt + (size_t)u.br * ((size_t)2048 * 1024 * 2) + (size_t)u.pn * (256 * 1024 * 2); }
};
struct EpiP4 {
    const bf16_t* gate; bf16_t* merged;
    __device__ __forceinline__ bool operator()(f32x4 (&acc)[2][2][4][2], const Unit& u, int wr, int wc, int fr, int fq) const {
        const int rloc = wr * 64 + fr, cloc = wc * 32 + 8 * fq;
#pragma unroll
        for (int bj = 0; bj < 2; ++bj) {
            const int col = u.pn * 256 + bj * 128 + cloc;
#pragma unroll
            for (int ai = 0; ai < 2; ++ai)
#pragma unroll
                for (int m = 0; m < 4; ++m) {
                    const size_t row = (size_t)u.pm * 256 + ai * 128 + m * 16 + rloc;
                    const bf16_t* gp = gate + row * LDG + u.br * 2048 + col;
                    const u32x4 g = *(const u32x4*)gp;
                    f32x4 s0 = (f32x4){bflo(g.x), bfhi(g.x), bflo(g.y), bfhi(g.y)}, s1 = (f32x4){bflo(g.z), bfhi(g.z), bflo(g.w), bfhi(g.w)};
                    if (u.br < 2) {
                        const u32x4 h = *(const u32x4*)(gp + 2048);
                        s0[0] *= __builtin_amdgcn_rcpf(bflo(h.x)); s0[1] *= __builtin_amdgcn_rcpf(bfhi(h.x)); s0[2] *= __builtin_amdgcn_rcpf(bflo(h.y)); s0[3] *= __builtin_amdgcn_rcpf(bfhi(h.y));
                        s1[0] *= __builtin_amdgcn_rcpf(bflo(h.z)); s1[1] *= __builtin_amdgcn_rcpf(bfhi(h.z)); s1[2] *= __builtin_amdgcn_rcpf(bflo(h.w)); s1[3] *= __builtin_amdgcn_rcpf(bfhi(h.w));
                    }
                    acc[ai][bj][m][0] *= s0; acc[ai][bj][m][1] *= s1;
                    if (u.br == 2) { const f32x4 v0 = acc[ai][bj][m][0], v1 = acc[ai][bj][m][1];
                        u32x4 o; o.x = pk2(v0[0], v0[1]); o.y = pk2(v0[2], v0[3]); o.z = pk2(v1[0], v1[1]); o.w = pk2(v1[2], v1[3]);
                        *(u32x4*)(merged + row * 2048 + col) = o; }
                }
        }
        return u.br < 2;
    }
};

struct SchedP5 {
    int G, c; const char* A; const char* Bt;
    __device__ __forceinline__ bool next(int i, Unit& u) const {
        const int L = i * G + c; if (L >= 288) return false;
        u.br = 0; pg8::tile_of(L, 36, 8, u.pm, u.pn); return true;
    }
    __device__ __forceinline__ const char* a_base(const Unit& u) const { return A + (size_t)u.pm * (256 * 2048 * 2); }
    __device__ __forceinline__ const char* b_base(const Unit& u) const { return Bt + (size_t)u.pn * (256 * 2048 * 2); }
};
struct EpiP5 {
    const float* xp; const float* xs; float* out;
    __device__ __forceinline__ bool operator()(f32x4 (&acc)[2][2][4][2], const Unit& u, int wr, int wc, int fr, int fq) const {
        const int rloc = wr * 64 + fr, cloc = wc * 32 + 8 * fq;
#pragma unroll
        for (int bj = 0; bj < 2; ++bj) {
            const int col = u.pn * 256 + bj * 128 + cloc;
#pragma unroll
            for (int ai = 0; ai < 2; ++ai)
#pragma unroll
                for (int m = 0; m < 4; ++m) {
                    const size_t row = (size_t)u.pm * 256 + ai * 128 + m * 16 + rloc;
                    const float* xr = (row < (size_t)NTP) ? (xp + row * 2048 + col) : (xs + (row - NTP) * 2048 + col);
                    const f32x4 v0 = acc[ai][bj][m][0] + *(const f32x4*)xr, v1 = acc[ai][bj][m][1] + *(const f32x4*)(xr + 4);
                    float* op = out + row * 2048 + col;
                    *(f32x4*)op = v0; *(f32x4*)(op + 4) = v1;
                }
        }
        return false;
    }
};

struct EpiNull {
    __device__ __forceinline__ bool operator()(f32x4 (&acc)[2][2][4][2], const Unit& u, int wr, int wc, int fr, int fq) const {
        f32x4 t = (f32x4){0.f, 0.f, 0.f, 0.f};
#pragma unroll
        for (int ai = 0; ai < 2; ++ai)
#pragma unroll
            for (int bj = 0; bj < 2; ++bj)
#pragma unroll
                for (int m = 0; m < 4; ++m) t += acc[ai][bj][m][0] + acc[ai][bj][m][1];
        asm volatile("" :: "v"(t[0]), "v"(t[1]), "v"(t[2]), "v"(t[3]));
        return false;
    }
};
__device__ __forceinline__ void transpose_tile(const float* W, int K, int N, bf16_t* WT, int row_off, int kb, int nb, LAS unsigned* T32, int tid) {
    const int nq = tid & 31, kp0 = tid >> 5;
#pragma unroll
    for (int i = 0; i < 4; ++i) {
        const int kpair = kp0 + 16 * i;
        const float* src = W + (size_t)(kb * 128 + 2 * kpair) * N + nb * 128 + 4 * nq;
        const f32x4 r0 = *(const f32x4*)src, r1 = *(const f32x4*)(src + N);
        T32[(4 * nq + 0) * 65 + kpair] = pk2(r0[0], r1[0]); T32[(4 * nq + 1) * 65 + kpair] = pk2(r0[1], r1[1]);
        T32[(4 * nq + 2) * 65 + kpair] = pk2(r0[2], r1[2]); T32[(4 * nq + 3) * 65 + kpair] = pk2(r0[3], r1[3]);
    }
    __syncthreads();
#pragma unroll
    for (int i = 0; i < 4; ++i) {
        const int id = tid + 512 * i, n = id >> 4, c = id & 15;
        u32x4 o; o.x = T32[n * 65 + 4 * c]; o.y = T32[n * 65 + 4 * c + 1]; o.z = T32[n * 65 + 4 * c + 2]; o.w = T32[n * 65 + 4 * c + 3];
        *(u32x4*)(WT + (size_t)(row_off + nb * 128 + n) * K + kb * 128 + 8 * c) = o;
    }
    __syncthreads();
}
__device__ __forceinline__ void rms_row_to_bf16(const float* xrow, const float* g, bf16_t* orow, int lane) {
    f32x4 v[8]; float ss = 0.f;
#pragma unroll
    for (int j = 0; j < 8; ++j) { v[j] = ((const f32x4*)xrow)[lane + 64 * j]; ss += (v[j][0] * v[j][0] + v[j][1] * v[j][1]) + (v[j][2] * v[j][2] + v[j][3] * v[j][3]); }
    ss = wave_sum(ss);
    const float rinv = rsqrtf(ss * (1.f / 2048.f) + EPS);
#pragma unroll
    for (int j = 0; j < 8; ++j) { const f32x4 gg = ((const f32x4*)g)[lane + 64 * j];
        u32x2 o; o.x = pk2(v[j][0] * rinv * gg[0], v[j][1] * rinv * gg[1]); o.y = pk2(v[j][2] * rinv * gg[2], v[j][3] * rinv * gg[3]);
        ((u32x2*)orow)[lane + 64 * j] = o; }
}
__device__ __forceinline__ void p0_prologue(const Params& p, LAS unsigned char* lds) {
    const int tid = threadIdx.x, lane = tid & 63, wave = tid >> 6, G = gridDim.x, c = blockIdx.x;
    LAS unsigned* T32 = (LAS unsigned*)lds;
    bf16_t* WT1 = (bf16_t*)(p.ws + WS_WT1); bf16_t* WT3 = (bf16_t*)(p.ws + WS_WT3); bf16_t* WTO = (bf16_t*)(p.ws + WS_WTO);
    constexpr int T_IN = 1920, T_MKV = 256, T_BR = 128, T_OUT = 256, T_ALL = T_IN + T_MKV + 3 * T_BR + T_OUT;
    for (int it = c; it < T_ALL; it += G) {
        int r = it;
        if (r < T_IN) { transpose_tile(p.w_in, 2048, 15360, WT1, 0, r / 120, r % 120, T32, tid); continue; } r -= T_IN;
        if (r < T_MKV) { transpose_tile(p.w_mem_kv, 2048, 2048, WT1, 15360, r / 16, r % 16, T32, tid); continue; } r -= T_MKV;
        if (r < T_BR) { transpose_tile(p.w_conv_out, 1024, 2048, WT3, 0, r / 16, r % 16, T32, tid); continue; } r -= T_BR;
        if (r < T_BR) { transpose_tile(p.w_hgrn_out, 1024, 2048, WT3 + (size_t)2048 * 1024, 0, r / 16, r % 16, T32, tid); continue; } r -= T_BR;
        if (r < T_BR) { transpose_tile(p.w_attn_out, 1024, 2048, WT3 + (size_t)2 * 2048 * 1024, 0, r / 16, r % 16, T32, tid); continue; } r -= T_BR;
        transpose_tile(p.w_out, 2048, 2048, WTO, 0, r / 16, r % 16, T32, tid);
    }
    bf16_t* HA = (bf16_t*)(p.ws + WS_HA);
    const int gw = c * 8 + wave, NGW = G * 8;
    for (int m = gw; m < 10240; m += NGW) {
        if (m < NTP) rms_row_to_bf16(p.x_prompt + (size_t)m * 2048, p.g_pre, HA + (size_t)m * 2048, lane);
        else if (m < NTOK) rms_row_to_bf16(p.x_sample + (size_t)(m - NTP) * 2048, p.g_pre, HA + (size_t)m * 2048, lane);
        else rms_row_to_bf16(p.mem_prompt + (size_t)(m - NTOK) * 2048, p.g_mem, HA + (size_t)m * 2048, lane);
    }
    if (c == 0) { float* LB = (float*)(p.ws + WS_LB);
        for (int i = tid; i < 1024; i += 512) LB[i] = 1.f / (1.f + __expf(p.lb_logits[1024 + i] - p.lb_logits[i])); }
}

__device__ __forceinline__ void hgrn_prompt_item(const Params& p, int item, LAS unsigned char* lds, int tid) {
    LAS float* qs = (LAS float*)lds;
    LAS float* fs = qs + 4096;
    LAS float* vs = fs + 4096;
    LAS float* part = vs + 512;
    const int s = item >> 3, n = s >> 3, h = s & 7, dvg = item & 7;
    const int vcol = tid & 15, kg = tid >> 4;
    const bf16_t* proj = (const bf16_t*)(p.ws + WS_PROJ9);
    const float* F = (const float*)(p.ws + WS_F);
    float* oraw = (float*)(p.ws + WS_ORAW);
    const size_t row0 = (size_t)n * SEQ;
    const bf16_t* qsrc = proj + (row0 + kg) * LDP + C_HQ + h * 128 + vcol * 8;
    const float* fsrc = F + (row0 + kg) * 1024 + h * 128 + vcol * 8;
    const bf16_t* vsrc = proj + (row0 + kg) * LDP + C_HI + h * 128 + dvg * 16 + vcol;
    f32x2 S01 = (f32x2){0.f, 0.f}, S23 = (f32x2){0.f, 0.f};
    u32x4 rq = *(const u32x4*)qsrc; f32x4 rf0 = *(const f32x4*)fsrc, rf1 = *(const f32x4*)(fsrc + 4); bf16_t rv = *vsrc;
    for (int t0 = 0; t0 < SEQ; t0 += 32) {
        { LAS float* qd = qs + kg * 128 + vcol * 8;
          *(LAS f32x4*)qd = (f32x4){bflo(rq.x), bfhi(rq.x), bflo(rq.y), bfhi(rq.y)}; *(LAS f32x4*)(qd + 4) = (f32x4){bflo(rq.z), bfhi(rq.z), bflo(rq.w), bfhi(rq.w)};
          LAS float* fd = fs + kg * 128 + vcol * 8; *(LAS f32x4*)fd = rf0; *(LAS f32x4*)(fd + 4) = rf1;
          vs[kg * 16 + vcol] = bf2f(rv); }
        __syncthreads();
        if (t0 + 32 < SEQ) { const size_t adv = (size_t)(t0 + 32);
            rq = *(const u32x4*)(qsrc + adv * LDP); rf0 = *(const f32x4*)(fsrc + adv * 1024); rf1 = *(const f32x4*)(fsrc + adv * 1024 + 4); rv = *(vsrc + adv * LDP); }
        f32x4 cf[4], cq[4]; float cv[4];
#pragma unroll
        for (int i = 0; i < 4; ++i) { cf[i] = *(const LAS f32x4*)(fs + i * 128 + kg * 4); cq[i] = *(const LAS f32x4*)(qs + i * 128 + kg * 4); cv[i] = vs[i * 16 + vcol]; }
#pragma unroll
        for (int g = 0; g < 8; ++g) {
            f32x4 nf[4], nq[4]; float nv[4];
            if (g < 7) {
#pragma unroll
                for (int i = 0; i < 4; ++i) { const int tt = (g + 1) * 4 + i;
                    nf[i] = *(const LAS f32x4*)(fs + tt * 128 + kg * 4); nq[i] = *(const LAS f32x4*)(qs + tt * 128 + kg * 4); nv[i] = vs[tt * 16 + vcol]; }
            }
#pragma unroll
            for (int i = 0; i < 4; ++i) {
                const f32x2 f01 = (f32x2){cf[i][0], cf[i][1]}, f23 = (f32x2){cf[i][2], cf[i][3]}, q01 = (f32x2){cq[i][0], cq[i][1]}, q23 = (f32x2){cq[i][2], cq[i][3]};
                const f32x2 vv = (f32x2){cv[i], cv[i]};
                S01 = f01 * (S01 - vv) + vv; S23 = f23 * (S23 - vv) + vv;
                f32x2 t = S01 * q01; t = S23 * q23 + t;
                part[(g * 4 + i) * 528 + tid] = t[0] + t[1];
            }
            if (g < 7) {
#pragma unroll
                for (int i = 0; i < 4; ++i) { cf[i] = nf[i]; cq[i] = nq[i]; cv[i] = nv[i]; }
            }
        }
        __syncthreads();
        { float a = 0.f;
#pragma unroll 8
          for (int k2 = 0; k2 < 32; ++k2) a += part[kg * 528 + k2 * 16 + vcol];
          oraw[(row0 + t0 + kg) * 1024 + h * 128 + dvg * 16 + vcol] = a; }
    }
    float* so = p.out + O_HGRN_P + ((size_t)(n * 8 + h) * 128 + kg * 4) * 128 + dvg * 16 + vcol;
    so[0] = S01[0]; so[128] = S01[1]; so[256] = S23[0]; so[384] = S23[1];
    __syncthreads();
}

__device__ __forceinline__ void hgrn_sample_item(const Params& p, int item, LAS unsigned char* lds, int tid) {
    LAS float* qs = (LAS float*)lds;
    LAS float* fs = qs + 1024;
    LAS float* vs = fs + 1024;
    LAS float* opart = vs + 1024;
    const int n = item >> 3, h = item & 7, lane = tid & 63, wave = tid >> 6;
    const bf16_t* proj = (const bf16_t*)(p.ws + WS_PROJ9);
    const float* F = (const float*)(p.ws + WS_F);
    const size_t row0 = (size_t)NTP + (size_t)n * 8;
    { const int tt = tid >> 6, k2 = (tid & 63) * 2; const size_t r = row0 + tt;
      const unsigned qw = *(const unsigned*)(proj + r * LDP + C_HQ + h * 128 + k2); const f32x2 ff = *(const f32x2*)(F + r * 1024 + h * 128 + k2);
      const unsigned vw = *(const unsigned*)(proj + r * LDP + C_HI + h * 128 + k2);
      qs[tt * 128 + k2] = bflo(qw); qs[tt * 128 + k2 + 1] = bfhi(qw); fs[tt * 128 + k2] = ff[0]; fs[tt * 128 + k2 + 1] = ff[1];
      vs[tt * 128 + k2] = bflo(vw); vs[tt * 128 + k2 + 1] = bfhi(vw); }
    const int v4 = tid & 31, kg = tid >> 5;
    const size_t sbase = ((size_t)(n * 8 + h) * 128 + kg * 8) * 128 + v4 * 4;
    f32x4 S[8];
#pragma unroll
    for (int i = 0; i < 8; ++i) S[i] = *(const f32x4*)(p.state_hgrn + sbase + (size_t)i * 128);
    __syncthreads();
#pragma unroll
    for (int tt = 0; tt < 8; ++tt) {
        const f32x4 fa = *(const LAS f32x4*)(fs + tt * 128 + kg * 8), fb = *(const LAS f32x4*)(fs + tt * 128 + kg * 8 + 4);
        const f32x4 qa = *(const LAS f32x4*)(qs + tt * 128 + kg * 8), qb = *(const LAS f32x4*)(qs + tt * 128 + kg * 8 + 4);
        const f32x4 vv = *(const LAS f32x4*)(vs + tt * 128 + v4 * 4);
        f32x4 po = (f32x4){0.f, 0.f, 0.f, 0.f};
#pragma unroll
        for (int i = 0; i < 8; ++i) { const float f = (i < 4) ? fa[i & 3] : fb[i & 3], q = (i < 4) ? qa[i & 3] : qb[i & 3];
            S[i] = S[i] * f + vv * (1.f - f); po += S[i] * q; }
#pragma unroll
        for (int e = 0; e < 4; ++e) po[e] += __shfl_xor(po[e], 32);
        if (lane < 32) *(LAS f32x4*)(opart + (tt * 8 + wave) * 128 + v4 * 4) = po;
    }
    float* so = p.out + O_HGRN_S + sbase;
#pragma unroll
    for (int i = 0; i < 8; ++i) *(f32x4*)(so + (size_t)i * 128) = S[i];
    __syncthreads();
    { const int tt = tid >> 6, v = (tid & 63) * 2; float o0 = 0.f, o1 = 0.f;
#pragma unroll
      for (int w = 0; w < 8; ++w) { const f32x2 t = *(const LAS f32x2*)(opart + (tt * 8 + w) * 128 + v); o0 += t[0]; o1 += t[1]; }
      const float ss = wave_sum(o0 * o0 + o1 * o1), rinv = rsqrtf(ss * (1.f / 128.f) + EPS);
      const size_t r = row0 + tt; const f32x2 gg = *(const f32x2*)(p.g_hgrn + h * 128 + v);
      const unsigned gw = *(const unsigned*)(proj + r * LDP + C_HOG + h * 128 + v);
      bf16_t* og = (bf16_t*)(p.ws + WS_ACT3) + (size_t)9216 * 1024 + r * 1024 + h * 128 + v;
      *(unsigned*)og = pk2(o0 * rinv * gg[0] * bflo(gw), o1 * rinv * gg[1] * bfhi(gw)); }
    __syncthreads();
}

__device__ __forceinline__ void hgrn_norm_rows(const Params& p) {
    const int tid = threadIdx.x, lane = tid & 63, gw = blockIdx.x * 8 + (tid >> 6), NGW = gridDim.x * 8;
    const bf16_t* proj = (const bf16_t*)(p.ws + WS_PROJ9); const float* oraw = (const float*)(p.ws + WS_ORAW);
    bf16_t* og = (bf16_t*)(p.ws + WS_ACT3) + (size_t)9216 * 1024;
    for (int r = gw; r < NTP; r += NGW) {
        f32x4 o[4]; float ss = 0.f;
#pragma unroll
        for (int j = 0; j < 4; ++j) { o[j] = *(const f32x4*)(oraw + (size_t)r * 1024 + lane * 16 + j * 4); ss += (o[j][0] * o[j][0] + o[j][1] * o[j][1]) + (o[j][2] * o[j][2] + o[j][3] * o[j][3]); }
        ss += __shfl_xor(ss, 1); ss += __shfl_xor(ss, 2); ss += __shfl_xor(ss, 4);
        const float rinv = rsqrtf(ss * (1.f / 128.f) + EPS);
        const u32x4 ga = *(const u32x4*)(proj + (size_t)r * LDP + C_HOG + lane * 16), gb = *(const u32x4*)(proj + (size_t)r * LDP + C_HOG + lane * 16 + 8);
        f32x4 g[4];
#pragma unroll
        for (int j = 0; j < 4; ++j) g[j] = *(const f32x4*)(p.g_hgrn + lane * 16 + j * 4);
        u32x4 oa, ob;
        oa.x = pk2(o[0][0] * rinv * g[0][0] * bflo(ga.x), o[0][1] * rinv * g[0][1] * bfhi(ga.x)); oa.y = pk2(o[0][2] * rinv * g[0][2] * bflo(ga.y), o[0][3] * rinv * g[0][3] * bfhi(ga.y));
        oa.z = pk2(o[1][0] * rinv * g[1][0] * bflo(ga.z), o[1][1] * rinv * g[1][1] * bfhi(ga.z)); oa.w = pk2(o[1][2] * rinv * g[1][2] * bflo(ga.w), o[1][3] * rinv * g[1][3] * bfhi(ga.w));
        ob.x = pk2(o[2][0] * rinv * g[2][0] * bflo(gb.x), o[2][1] * rinv * g[2][1] * bfhi(gb.x)); ob.y = pk2(o[2][2] * rinv * g[2][2] * bflo(gb.y), o[2][3] * rinv * g[2][3] * bfhi(gb.y));
        ob.z = pk2(o[3][0] * rinv * g[3][0] * bflo(gb.z), o[3][1] * rinv * g[3][1] * bfhi(gb.z)); ob.w = pk2(o[3][2] * rinv * g[3][2] * bflo(gb.w), o[3][3] * rinv * g[3][3] * bfhi(gb.w));
        *(u32x4*)(og + (size_t)r * 1024 + lane * 16) = oa; *(u32x4*)(og + (size_t)r * 1024 + lane * 16 + 8) = ob;
    }
}

template <bool SAMPLE>
__device__ __forceinline__ void conv_item(const Params& p, int item, LAS unsigned char* lds, int tid) {
    constexpr int T = SAMPLE ? 8 : 32;
    constexpr int GP = 4, NG = (T + 32) / GP, G0 = 32 / GP;
    LAS float* dcs = (LAS float*)lds;
    const bf16_t* proj = (const bf16_t*)(p.ws + WS_PROJ9);
    const int n = SAMPLE ? item : (item >> 6), t0 = SAMPLE ? 0 : (item & 63) * 32;
    const size_t rowb = SAMPLE ? ((size_t)NTP + (size_t)n * 8) : ((size_t)n * SEQ);
    const int c0 = 2 * tid;
    float w0[31], w1[31], x0[31], x1[31];
#pragma unroll
    for (int j = 0; j < 31; ++j) { const f32x2 w = *(const f32x2*)(p.conv_w + j * 1024 + c0); w0[j] = w[0]; w1[j] = w[1]; x0[j] = 0.f; x1[j] = 0.f; }
    const f32x2 bias = *(const f32x2*)(p.conv_b + c0);
    unsigned ra[GP], rg[GP];
#define CONV_ISSUE(g) do { \
        if (SAMPLE && (g) < G0) { _Pragma("unroll") for (int i = 0; i < GP; ++i) { const int ti = -2 + GP * (g) + i; \
            const unsigned* tp = (const unsigned*)(p.state_conv + ((size_t)n * 30 + (ti < 0 ? 0 : ti)) * 1024 + c0); ra[i] = tp[0]; rg[i] = tp[1]; } } \
        else { _Pragma("unroll") for (int i = 0; i < GP; ++i) { const int t = t0 - 32 + GP * (g) + i; const bf16_t* rp = proj + (rowb + (t < 0 ? 0 : t)) * LDP + c0; \
            ra[i] = *(const unsigned*)(rp + C_CV); rg[i] = *(const unsigned*)(rp + C_CG); } } } while (0)
    CONV_ISSUE(0);
#pragma unroll 1
    for (int g = 0; g < NG; ++g) {
        float u0[GP], u1[GP];
        if (SAMPLE && g < G0) {
#pragma unroll
            for (int i = 0; i < GP; ++i) { const bool ok = (-2 + GP * g + i) >= 0; u0[i] = ok ? __builtin_bit_cast(float, ra[i]) : 0.f; u1[i] = ok ? __builtin_bit_cast(float, rg[i]) : 0.f; }
        } else {
#pragma unroll
            for (int i = 0; i < GP; ++i) { const bool ok = (t0 - 32 + GP * g + i) >= 0; u0[i] = ok ? bflo(ra[i]) * bflo(rg[i]) : 0.f; u1[i] = ok ? bfhi(ra[i]) * bfhi(rg[i]) : 0.f; }
        }
        if (g + 1 < NG) CONV_ISSUE(g + 1);
#pragma unroll
        for (int i = 0; i < GP; ++i) {
            const int pp = -32 + GP * g + i, t = t0 + pp;
            if (SAMPLE) { if (pp >= -22) *(f32x2*)(p.out + O_CONV_S + ((size_t)n * 30 + (pp + 22)) * 1024 + c0) = (f32x2){u0[i], u1[i]}; }
            else { if (t >= SEQ - 30) *(f32x2*)(p.out + O_CONV_P + ((size_t)n * 30 + (t - (SEQ - 30))) * 1024 + c0) = (f32x2){u0[i], u1[i]}; }
#pragma unroll
            for (int j = 0; j < 30; ++j) { x0[j] = x0[j + 1]; x1[j] = x1[j + 1]; }
            x0[30] = u0[i]; x1[30] = u1[i];
            if (g >= G0) {
                float d0 = bias[0], d1 = bias[1];
#pragma unroll
                for (int j = 0; j < 31; ++j) { d0 += w0[j] * x0[j]; d1 += w1[j] * x1[j]; }
                *(LAS f32x2*)(dcs + (pp) * 1024 + c0) = (f32x2){d0, d1};
            }
        }
    }
#undef CONV_ISSUE
    __syncthreads();
    { const int lane = tid & 63, wave = tid >> 6;
      bf16_t* aact = (bf16_t*)(p.ws + WS_ACT3);
      for (int pp = wave; pp < T; pp += 8) {
          f32x4 v[4]; float s = 0.f;
#pragma unroll
          for (int j = 0; j < 4; ++j) { v[j] = *(const LAS f32x4*)(dcs + pp * 1024 + j * 256 + lane * 4); s += (v[j][0] + v[j][1]) + (v[j][2] + v[j][3]); }
          const float mean = wave_sum(s) * (1.f / 1024.f); float s2 = 0.f;
#pragma unroll
          for (int j = 0; j < 4; ++j) { v[j] = v[j] - mean; s2 += (v[j][0] * v[j][0] + v[j][1] * v[j][1]) + (v[j][2] * v[j][2] + v[j][3] * v[j][3]); }
          const float rstd = rsqrtf(wave_sum(s2) * (1.f / 1024.f) + EPS);
          const size_t r = rowb + t0 + pp;
#pragma unroll
          for (int j = 0; j < 4; ++j) { const int c = j * 256 + lane * 4;
              const f32x4 lg = *(const f32x4*)(p.ln_g + c), lbv = *(const f32x4*)(p.ln_b + c);
              const u32x2 sg = *(const u32x2*)(proj + r * LDP + C_CS + c);
              const float y0 = siluf(v[j][0] * rstd * lg[0] + lbv[0]) * bflo(sg.x), y1 = siluf(v[j][1] * rstd * lg[1] + lbv[1]) * bfhi(sg.x);
              const float y2 = siluf(v[j][2] * rstd * lg[2] + lbv[2]) * bflo(sg.y), y3 = siluf(v[j][3] * rstd * lg[3] + lbv[3]) * bfhi(sg.y);
              u32x2 o; o.x = pk2(y0, y1); o.y = pk2(y2, y3);
              *(u32x2*)(aact + r * 1024 + c) = o; }
      } }
    __syncthreads();
}

__device__ __forceinline__ void attn_prompt_item(const Params& p, int item, int tid) {
    const int lane = tid & 63, wave = tid >> 6, l15 = lane & 15, quad = lane >> 4;
    const int n = item >> 6, h = (item >> 4) & 3, qt = item & 15;
    const bf16_t* proj = (const bf16_t*)(p.ws + WS_PROJ9);
    const bf16_t* kb = (const bf16_t*)(p.ws + WS_MKB) + (size_t)(n * 4 + h) * 65536;
    const bf16_t* vt = (const bf16_t*)(p.ws + WS_MVT) + (size_t)(n * 4 + h) * 65536;
    const size_t qrow = (size_t)n * SEQ + qt * 128 + wave * 16 + l15;
    bf16x8 qf[8];
#pragma unroll
    for (int s = 0; s < 8; ++s) qf[s] = *(const bf16x8*)(proj + qrow * LDP + C_AQ + h * 256 + s * 32 + quad * 8);
    f32x4 sc[16];
#pragma unroll
    for (int T = 0; T < 16; ++T) {
        sc[T] = (f32x4){0.f, 0.f, 0.f, 0.f};
        const bf16_t* kr = kb + (size_t)(T * 16 + l15) * 256 + quad * 8;
#pragma unroll
        for (int s = 0; s < 8; ++s) { const bf16x8 a = *(const bf16x8*)(kr + s * 32); sc[T] = __builtin_amdgcn_mfma_f32_16x16x32_bf16(a, qf[s], sc[T], 0, 0, 0); }
    }
    float mx = -3.0e38f;
#pragma unroll
    for (int T = 0; T < 16; ++T) mx = fmaxf(mx, fmaxf(fmaxf(sc[T][0], sc[T][1]), fmaxf(sc[T][2], sc[T][3])));
    mx = fmaxf(mx, __shfl_xor(mx, 16)); mx = fmaxf(mx, __shfl_xor(mx, 32));
    float sum = 0.f;
#pragma unroll
    for (int T = 0; T < 16; ++T) {
#pragma unroll
        for (int e = 0; e < 4; ++e) { sc[T][e] = __expf(sc[T][e] - mx); sum += sc[T][e]; } }
    sum += __shfl_xor(sum, 16); sum += __shfl_xor(sum, 32);
    const float rs = 1.f / sum;
    bf16x8 pb[8];
#pragma unroll
    for (int s2 = 0; s2 < 8; ++s2) {
        u32x4 w; w.x = pk2(sc[2 * s2][0], sc[2 * s2][1]); w.y = pk2(sc[2 * s2][2], sc[2 * s2][3]); w.z = pk2(sc[2 * s2 + 1][0], sc[2 * s2 + 1][1]); w.w = pk2(sc[2 * s2 + 1][2], sc[2 * s2 + 1][3]);
        pb[s2] = __builtin_bit_cast(bf16x8, w);
    }
    bf16_t* aog = (bf16_t*)(p.ws + WS_ACT3) + (size_t)2 * 9216 * 1024;
    f32x4 oacc[16];
#pragma unroll
    for (int Tv = 0; Tv < 16; ++Tv) {
        oacc[Tv] = (f32x4){0.f, 0.f, 0.f, 0.f};
        const bf16_t* vr = vt + (size_t)(Tv * 16 + l15) * 256 + quad * 4;
#pragma unroll
        for (int s2 = 0; s2 < 8; ++s2) {
            const u32x2 lo = *(const u32x2*)(vr + s2 * 32), hi = *(const u32x2*)(vr + s2 * 32 + 16);
            u32x4 w; w.x = lo.x; w.y = lo.y; w.z = hi.x; w.w = hi.y;
            oacc[Tv] = __builtin_amdgcn_mfma_f32_16x16x32_bf16(__builtin_bit_cast(bf16x8, w), pb[s2], oacc[Tv], 0, 0, 0);
        }
    }
#pragma unroll
    for (int Tv = 0; Tv < 16; ++Tv) {
        const int dv = Tv * 16 + quad * 4;
        const u32x2 sg = *(const u32x2*)(proj + qrow * LDP + C_AS + h * 256 + dv);
        u32x2 o; o.x = pk2(oacc[Tv][0] * rs * bflo(sg.x), oacc[Tv][1] * rs * bfhi(sg.x)); o.y = pk2(oacc[Tv][2] * rs * bflo(sg.y), oacc[Tv][3] * rs * bfhi(sg.y));
        *(u32x2*)(aog + qrow * 1024 + h * 256 + dv) = o;
    }
}

__device__ __forceinline__ void attn_sample_item(const Params& p, int item, LAS unsigned char* lds, int tid) {
    LAS float* Ssh = (LAS float*)lds;
    LAS float* Psh = Ssh + 2048;
    LAS float* Opart = Psh + 2048;
    const int lane = tid & 63, wave = tid >> 6, l15 = lane & 15, quad = lane >> 4;
    const int n = item >> 2, h = item & 3;
    const bf16_t* proj = (const bf16_t*)(p.ws + WS_PROJ9);
    const size_t row0 = (size_t)NTP + (size_t)n * 8;
    const float* kc = p.cache_k + ((size_t)n * 256 * 4 + h) * 256;
    const float* vc = p.cache_v + ((size_t)n * 256 * 4 + h) * 256;
    {
        bf16x8 qf[8];
        const size_t qrow = row0 + (lane & 7);
#pragma unroll
        for (int s = 0; s < 8; ++s) qf[s] = *(const bf16x8*)(proj + qrow * LDP + C_AQ + h * 256 + s * 32 + quad * 8);
#pragma unroll
        for (int tl = 0; tl < 2; ++tl) {
            const int T = wave * 2 + tl;
            f32x4 sc = (f32x4){0.f, 0.f, 0.f, 0.f};
            const float* kr = kc + (size_t)(T * 16 + l15) * 1024 + quad * 8;
#pragma unroll
            for (int s = 0; s < 8; ++s) {
                const f32x4 k0 = *(const f32x4*)(kr + s * 32), k1 = *(const f32x4*)(kr + s * 32 + 4);
                u32x4 w; w.x = pk2(k0[0], k0[1]); w.y = pk2(k0[2], k0[3]); w.z = pk2(k1[0], k1[1]); w.w = pk2(k1[2], k1[3]);
                sc = __builtin_amdgcn_mfma_f32_16x16x32_bf16(__builtin_bit_cast(bf16x8, w), qf[s], sc, 0, 0, 0);
            }
            if (l15 < 8) {
#pragma unroll
                for (int e = 0; e < 4; ++e) Ssh[l15 * 256 + T * 16 + quad * 4 + e] = sc[e];
            }
        }
    }
    __syncthreads();
    {
        const f32x4 s4 = *(const LAS f32x4*)(Ssh + wave * 256 + lane * 4);
        const float mx = wave_max(fmaxf(fmaxf(s4[0], s4[1]), fmaxf(s4[2], s4[3])));
        f32x4 e4; e4[0] = __expf(s4[0] - mx); e4[1] = __expf(s4[1] - mx); e4[2] = __expf(s4[2] - mx); e4[3] = __expf(s4[3] - mx);
        const float rs = 1.f / wave_sum((e4[0] + e4[1]) + (e4[2] + e4[3]));
#pragma unroll
        for (int e = 0; e < 4; ++e) Psh[(lane * 4 + e) * 8 + wave] = e4[e] * rs;
    }
    __syncthreads();
    {
        f32x4 acc[8];
#pragma unroll
        for (int q = 0; q < 8; ++q) acc[q] = (f32x4){0.f, 0.f, 0.f, 0.f};
        const float* vr = vc + (size_t)(wave * 32) * 1024 + lane * 4;
#pragma unroll 8
        for (int kk = 0; kk < 32; ++kk) {
            const f32x4 v4 = *(const f32x4*)(vr + (size_t)kk * 1024);
            const f32x4 pa = *(const LAS f32x4*)(Psh + (wave * 32 + kk) * 8), pb = *(const LAS f32x4*)(Psh + (wave * 32 + kk) * 8 + 4);
            acc[0] += v4 * pa[0]; acc[1] += v4 * pa[1]; acc[2] += v4 * pa[2]; acc[3] += v4 * pa[3];
            acc[4] += v4 * pb[0]; acc[5] += v4 * pb[1]; acc[6] += v4 * pb[2]; acc[7] += v4 * pb[3];
        }
#pragma unroll
        for (int q = 0; q < 8; ++q) *(LAS f32x4*)(Opart + (wave * 8 + q) * 256 + lane * 4) = acc[q];
    }
    __syncthreads();
    {
        f32x4 o = (f32x4){0.f, 0.f, 0.f, 0.f};
#pragma unroll
        for (int w = 0; w < 8; ++w) o += *(const LAS f32x4*)(Opart + (w * 8 + wave) * 256 + lane * 4);
        const size_t r = row0 + wave;
        const u32x2 sg = *(const u32x2*)(proj + r * LDP + C_AS + h * 256 + lane * 4);
        u32x2 ov; ov.x = pk2(o[0] * bflo(sg.x), o[1] * bfhi(sg.x)); ov.y = pk2(o[2] * bflo(sg.y), o[3] * bfhi(sg.y));
        bf16_t* aog = (bf16_t*)(p.ws + WS_ACT3) + (size_t)2 * 9216 * 1024;
        *(u32x2*)(aog + r * 1024 + h * 256 + lane * 4) = ov;
    }
    __syncthreads();
}

__device__ __forceinline__ void p2_mixers(const Params& p, LAS unsigned char* lds) {
    const int tid = threadIdx.x, G = gridDim.x, c = blockIdx.x, mask = p.pad;
    if (mask & 1) for (int it = c; it < 256; it += G) hgrn_prompt_item(p, it, lds, tid);
    if (mask & 2) { for (int it = c; it < 256; it += G) conv_item<false>(p, it, lds, tid);
                    for (int it = c; it < 128; it += G) conv_item<true>(p, it, lds, tid); }
    if (mask & 4) for (int it = c; it < 256; it += G) attn_prompt_item(p, it, tid);
    if (mask & 8) for (int it = c; it < 512; it += G) attn_sample_item(p, it, lds, tid);
    if (mask & 16) for (int it = c; it < 1024; it += G) hgrn_sample_item(p, it, lds, tid);
}

__device__ __forceinline__ void p6_final_norm(const Params& p) {
    const int tid = threadIdx.x, lane = tid & 63, gw = blockIdx.x * 8 + (tid >> 6), NGW = gridDim.x * 8;
    for (int r = gw; r < NTOK; r += NGW) {
        float* zr = p.out + (size_t)r * 2048;
        f32x4 v[8]; float ss = 0.f;
#pragma unroll
        for (int j = 0; j < 8; ++j) { v[j] = ((const f32x4*)zr)[lane + 64 * j]; ss += (v[j][0] * v[j][0] + v[j][1] * v[j][1]) + (v[j][2] * v[j][2] + v[j][3] * v[j][3]); }
        ss = wave_sum(ss);
        const float rinv = rsqrtf(ss * (1.f / 2048.f) + EPS);
#pragma unroll
        for (int j = 0; j < 8; ++j) { const f32x4 gg = ((const f32x4*)p.g_final)[lane + 64 * j]; ((f32x4*)zr)[lane + 64 * j] = v[j] * rinv * gg; }
    }
}

__global__ void __launch_bounds__(512, 2) fwd_megakernel(Params p) {
    extern __shared__ __attribute__((aligned(16))) unsigned char shm[];
    LAS unsigned char* lds = (LAS unsigned char*)shm;
    cg::grid_group grid = cg::this_grid();
    const int G = gridDim.x, c = blockIdx.x;
#define SEAM(ph) do { if (p.coop && (ph) + 1 < p.ph_hi) { \
        asm volatile("s_waitcnt vmcnt(0) lgkmcnt(0)" ::: "memory"); __syncthreads(); \
        grid.sync(); \
        if (threadIdx.x < 64) { __builtin_amdgcn_fence(__ATOMIC_ACQUIRE, "agent"); asm volatile("s_waitcnt vmcnt(0)" ::: "memory"); } \
        __syncthreads(); } } while (0)
#define RUNS(ph) (p.ph_lo <= (ph) && (ph) < p.ph_hi)
    if (RUNS(0)) { p0_prologue(p, lds); SEAM(0); }
    if (RUNS(1)) {
        SchedP1 S; S.G = G; S.c = c; S.A = (const char*)(p.ws + WS_HA); S.Bt = (const char*)(p.ws + WS_WT1);
        EpiP1 E; E.proj = (bf16_t*)(p.ws + WS_PROJ9); E.gate = (bf16_t*)(p.ws + WS_GATE); E.F = (float*)(p.ws + WS_F); E.lb = (const float*)(p.ws + WS_LB);
        E.b_gate = p.b_gate; E.out = p.out; E.mkb = (bf16_t*)(p.ws + WS_MKB); E.mvt = (bf16_t*)(p.ws + WS_MVT);
        pg8::gemm_phase(lds, 2048, S, E); SEAM(1);
    }
    if (RUNS(2)) { p2_mixers(p, lds); SEAM(2); }
    if (RUNS(3)) { hgrn_norm_rows(p); SEAM(3); }
    if (RUNS(4)) {
        SchedP4 S; S.G = G; S.c = c; S.A = (const char*)(p.ws + WS_ACT3); S.Bt = (const char*)(p.ws + WS_WT3);
        EpiP4 E; E.gate = (const bf16_t*)(p.ws + WS_GATE); E.merged = (bf16_t*)(p.ws + WS_MERGED);
        pg8::gemm_phase(lds, 1024, S, E); SEAM(4);
    }
    if (RUNS(5)) {
        SchedP5 S; S.G = G; S.c = c; S.A = (const char*)(p.ws + WS_MERGED); S.Bt = (const char*)(p.ws + WS_WTO);
        EpiP5 E; E.xp = p.x_prompt; E.xs = p.x_sample; E.out = p.out;
        pg8::gemm_phase(lds, 2048, S, E); SEAM(5);
    }
    if (RUNS(6)) { p6_final_norm(p); }
#undef RUNS
#undef SEAM
}

extern "C" void kernel_launch(void* const* d_in, const int* in_sizes, int n_in, void* d_out, int out_size, void* d_ws, size_t ws_size, hipStream_t stream) {
    static int grid = 0;
    if (grid == 0) {
        if (n_in != 23 || ws_size < WS_END) { fprintf(stderr, "kernel_launch: expected 23 inputs and >= %zu bytes of workspace, got %d / %zu\n", (size_t)WS_END, n_in, ws_size); grid = -1; return; }
        int dev = 0, cus = 0, per_cu = 0;
        hipGetDevice(&dev); hipDeviceGetAttribute(&cus, hipDeviceAttributeMultiprocessorCount, dev);
        if (hipFuncSetAttribute((const void*)fwd_megakernel, hipFuncAttributeMaxDynamicSharedMemorySize, LDS_BYTES) != hipSuccess) { fprintf(stderr, "kernel_launch: hipFuncSetAttribute failed\n"); grid = -1; return; }
        if (hipOccupancyMaxActiveBlocksPerMultiprocessor(&per_cu, (const void*)fwd_megakernel, 512, LDS_BYTES) != hipSuccess || per_cu < 1) { fprintf(stderr, "kernel_launch: occupancy query failed (%d)\n", per_cu); (void)hipGetLastError(); per_cu = 1; }
        grid = cus * 1;
        if (grid <= 0) grid = 256;
    }
    if (grid < 0) return;
    Params p{};
    const float** pp = (const float**)&p;
    for (int i = 0; i < 23; ++i) pp[i] = (const float*)d_in[i];
    p.out = (float*)d_out; p.ws = (unsigned char*)d_ws; p.pad = 31;
#if N_LAUNCH_MODE == 1
    p.ph_lo = 0; p.ph_hi = N_PHASES; p.coop = 1;
    void* args[] = {&p};
    hipError_t e = hipLaunchCooperativeKernel((const void*)fwd_megakernel, dim3(grid), dim3(512), args, LDS_BYTES, stream);
    if (e != hipSuccess) fprintf(stderr, "cooperative launch failed: %s (grid %d)\n", hipGetErrorString(e), grid);
#else
    for (int ph = 0; ph < N_PHASES; ++ph) {
        p.ph_lo = ph; p.ph_hi = ph + 1; p.coop = 0;
        hipLaunchKernelGGL(fwd_megakernel, dim3(grid), dim3(512), LDS_BYTES, stream, p);
        if ((REP_MASK >> ph) & 1) { if (ph == 2) p.pad = P2_SUBMASK; hipLaunchKernelGGL(fwd_megakernel, dim3(grid), dim3(512), LDS_BYTES, stream, p); p.pad = 31; }
    }
#endif
}
```

```cpp
#include <hip/hip_runtime.h>
#include <hip/hip_cooperative_groups.h>
#include <cstdio>
namespace cg = cooperative_groups;

#define LAS __attribute__((address_space(3)))
typedef unsigned short bf16_t;
typedef short bf16x8 __attribute__((ext_vector_type(8)));
typedef float f32x4 __attribute__((ext_vector_type(4)));
typedef float f32x2 __attribute__((ext_vector_type(2)));
typedef unsigned u32x4 __attribute__((ext_vector_type(4)));
typedef unsigned u32x2 __attribute__((ext_vector_type(2)));

#ifndef REP_MASK
#define REP_MASK 0
#endif
#ifndef P2_SUBMASK
#define P2_SUBMASK 31
#endif
#ifndef N_LAUNCH_MODE
#define N_LAUNCH_MODE 1
#endif

constexpr int DM = 2048, NTP = 8192, NTS = 1024, NTOK = 9216, SEQ = 2048;
constexpr int LDP = 9216;
constexpr int C_CV = 0, C_CG = 1024, C_CS = 2048, C_HQ = 3072, C_HF = 4096, C_HI = 5120, C_HOG = 6144, C_AQ = 7168, C_AS = 8192;
constexpr int LDG = 6144;
constexpr float EPS = 1e-6f;
constexpr size_t O_YP = 0, O_YS = 16777216, O_CONV_P = 18874368, O_HGRN_P = 18997248, O_MK = 19521536, O_MV = 20570112, O_CONV_S = 21618688, O_HGRN_S = 25550848;
constexpr size_t WS_WT1 = 0;
constexpr size_t WS_WT3 = WS_WT1 + (size_t)17408 * 2048 * 2;
constexpr size_t WS_WTO = WS_WT3 + (size_t)3 * 2048 * 1024 * 2;
constexpr size_t WS_HA = WS_WTO + (size_t)2048 * 2048 * 2;
constexpr size_t WS_ORAW = WS_HA;
constexpr size_t WS_PROJ9 = WS_HA + (size_t)10240 * 2048 * 2;
constexpr size_t WS_MF = WS_PROJ9;
constexpr size_t WS_MERGED = WS_MF + (size_t)9216 * 2048 * 4;
constexpr size_t WS_GATE = WS_PROJ9 + (size_t)9216 * 9216 * 2;
constexpr size_t WS_F = WS_GATE + (size_t)9216 * 6144 * 2;
constexpr size_t WS_MKB = WS_F + (size_t)9216 * 1024 * 4;
constexpr size_t WS_MVT = WS_MKB + (size_t)2097152;
constexpr size_t WS_ACT3 = WS_MVT + (size_t)2097152;
constexpr size_t WS_LB = WS_ACT3 + (size_t)3 * 9216 * 1024 * 2;
constexpr size_t WS_END = WS_LB + 4096;
constexpr int LDS_BYTES = 131072;
constexpr int N_PHASES = 7;

struct Params {
    const float *x_prompt, *x_sample, *state_conv, *state_hgrn, *cache_k, *cache_v, *mem_prompt, *g_pre, *w_in, *conv_w, *conv_b, *ln_g, *ln_b,
        *w_conv_out, *lb_logits, *g_hgrn, *w_hgrn_out, *g_mem, *w_mem_kv, *w_attn_out, *b_gate, *w_out, *g_final;
    float* out; unsigned char* ws; int ph_lo, ph_hi, coop, pad;
};

__device__ __forceinline__ unsigned f2bf(float f) { unsigned u = __builtin_bit_cast(unsigned, f); return (u + 0x7fffu + ((u >> 16) & 1u)) >> 16; }
typedef __bf16 bf16x2_t __attribute__((ext_vector_type(2)));
__device__ __forceinline__ unsigned pk2(float lo, float hi) { const f32x2 v = {lo, hi}; const bf16x2_t r = __builtin_convertvector(v, bf16x2_t); return __builtin_bit_cast(unsigned, r); }
__device__ __forceinline__ float bflo(unsigned w) { return __builtin_bit_cast(float, w << 16); }
__device__ __forceinline__ float bfhi(unsigned w) { return __builtin_bit_cast(float, w & 0xffff0000u); }
__device__ __forceinline__ float bf2f(unsigned short b) { return __builtin_bit_cast(float, ((unsigned)b) << 16); }
__device__ __forceinline__ float sigm(float x) { return __builtin_amdgcn_rcpf(1.f + __expf(-x)); }
__device__ __forceinline__ float siluf(float x) { return x * sigm(x); }
__device__ __forceinline__ float wave_sum(float v) {
#pragma unroll
    for (int o = 1; o < 64; o <<= 1) v += __shfl_xor(v, o);
    return v;
}
__device__ __forceinline__ float wave_max(float v) {
#pragma unroll
    for (int o = 1; o < 64; o <<= 1) v = fmaxf(v, __shfl_xor(v, o));
    return v;
}

namespace pg8 {
constexpr int BM = 256, BK = 64, HALF = 128, HTB = HALF * BK * 2, STAGE_BYTES = 8 * HTB, NXCD = 8, WGM = 8;
__host__ __device__ __forceinline__ int lds_byte(int r, int c) { const int st = (r >> 4) * 2 + (c >> 5), rr = r & 15, cc = c & 31, ob = rr * 64 + cc * 2; return st * 1024 + (ob ^ (((ob >> 9) & 1) << 5)); }
__host__ __device__ __forceinline__ void stage_rc(int b, int& R, int& C) { const int st = b / 1024, sb = b % 1024, swz = sb ^ (((sb >> 9) & 1) << 5); R = (st >> 1) * 16 + swz / 64; C = (st & 1) * 32 + (swz % 64) / 2; }
__host__ __device__ __forceinline__ int perm32(int rho) { const int n = rho >> 4, i = rho & 15; return 8 * (i >> 2) + 4 * n + (i & 3); }
struct Unit { int pm, pn, br; };
__device__ __forceinline__ void tile_of(int wgid, int nM, int nN, int& pm, int& pn) {
    const int nwg = nM * nN;
    { const int q = nwg / NXCD, r = nwg % NXCD, xcd = wgid % NXCD, off = wgid / NXCD; wgid = (xcd < r ? xcd * (q + 1) : r * (q + 1) + (xcd - r) * q) + off; }
    const int nig = WGM * nN, gid = wgid / nig, fm = gid * WGM, gsz = (nM - fm) < WGM ? (nM - fm) : WGM;
    pm = fm + ((wgid % nig) % gsz); pn = (wgid % nig) / gsz;
}

template <class Epi, class Sched>
__device__ __forceinline__ void gemm_phase(LAS unsigned char* lds, const int K, const Sched& S, const Epi& E) {
    const int tid = threadIdx.x, wid = __builtin_amdgcn_readfirstlane(tid >> 6), lane = tid & 63, wr = wid >> 2, wc = wid & 3, fr = lane & 15, fq = lane >> 4;
    const int nt = K / BK;
    unsigned voffA[2], voffB[2];
#pragma unroll
    for (int i = 0; i < 2; ++i) { int R, C; stage_rc(tid * 16 + i * 8192, R, C); const int Rb = (R & ~31) + perm32(R & 31);
        voffA[i] = (unsigned)(R * K + C) * 2u; voffB[i] = (unsigned)(Rb * K + C) * 2u; }
    const size_t kstep = (size_t)(BK * 2);
    const size_t hstep = (size_t)HALF * K * 2;
    const unsigned ldsw = (unsigned)wid * 1024u;
    const int aoff = lds_byte(wr * 64 + fr, fq * 8), boff = lds_byte(wc * 32 + fr, fq * 8);
#define PG8_SA(b, h) (((b) * 2 + (h)) * HTB)
#define PG8_SB(b, h) ((4 + (b) * 2 + (h)) * HTB)
#define PG8_STAGE(bufoff, gbase, voff) do { _Pragma("unroll") for (int _i = 0; _i < 2; ++_i) \
        __builtin_amdgcn_global_load_lds((const unsigned*)((const char*)(gbase) + (voff)[_i]), (LAS unsigned*)(lds + (bufoff) + ldsw + _i * 8192), 16, 0, 0); } while (0)
#define PG8_LDA(dst, b, h) do { _Pragma("unroll") for (int m = 0; m < 4; ++m) _Pragma("unroll") for (int k = 0; k < 2; ++k) dst[m][k] = *(const LAS bf16x8*)(lds + PG8_SA(b, h) + aoff + m * 2048 + k * 1024); } while (0)
#define PG8_LDB(dst, b, h) do { _Pragma("unroll") for (int n = 0; n < 2; ++n) _Pragma("unroll") for (int k = 0; k < 2; ++k) dst[n][k] = *(const LAS bf16x8*)(lds + PG8_SB(b, h) + boff + n * 2048 + k * 1024); } while (0)
#define PG8_MMA(ai, bj, At, Bt) do { __builtin_amdgcn_s_setprio(1); _Pragma("unroll") for (int m = 0; m < 4; ++m) _Pragma("unroll") for (int n = 0; n < 2; ++n) _Pragma("unroll") for (int k = 0; k < 2; ++k) \
        acc[ai][bj][m][n] = __builtin_amdgcn_mfma_f32_16x16x32_bf16(Bt[n][k], At[m][k], acc[ai][bj][m][n], 0, 0, 0); __builtin_amdgcn_s_setprio(0); } while (0)
#define PG8_WAIT_V(n) asm volatile("s_waitcnt vmcnt(" #n ")" ::: "memory")
#define PG8_WAIT_L(n) asm volatile("s_waitcnt lgkmcnt(" #n ")" ::: "memory")
#define PG8_BAR __builtin_amdgcn_s_barrier()
#define PG8_SCHED __builtin_amdgcn_sched_barrier(0)
    Unit cur, nxt; int ui = 0;
    if (!S.next(0, cur)) return;
    f32x4 acc[2][2][4][2];
#pragma unroll
    for (int a = 0; a < 2; ++a)
#pragma unroll
        for (int b = 0; b < 2; ++b)
#pragma unroll
            for (int m = 0; m < 4; ++m)
#pragma unroll
                for (int n = 0; n < 2; ++n) acc[a][b][m][n] = (f32x4){0.f, 0.f, 0.f, 0.f};
    bf16x8 At[4][2], B0[2][2], B1[2][2];
    const char* cA = S.a_base(cur); const char* cB = S.b_base(cur);
    PG8_STAGE(PG8_SB(0, 0), cB, voffB); PG8_STAGE(PG8_SA(0, 0), cA, voffA); PG8_STAGE(PG8_SB(0, 1), cB + hstep, voffB); PG8_STAGE(PG8_SA(0, 1), cA + hstep, voffA);
    if (wr == 1) PG8_BAR;
    PG8_WAIT_V(4); PG8_BAR;
    PG8_STAGE(PG8_SB(1, 0), cB + kstep, voffB); PG8_STAGE(PG8_SA(1, 0), cA + kstep, voffA); PG8_STAGE(PG8_SB(1, 1), cB + hstep + kstep, voffB);
    PG8_WAIT_V(6); PG8_BAR;
    for (;;) {
        const bool has_next = S.next(ui + 1, nxt);
        const char* nA = has_next ? S.a_base(nxt) : cA; const char* nB = has_next ? S.b_base(nxt) : cB;
        for (int t = 0; t < nt; t += 2) {
            const bool last = (t == nt - 2);
            const char* a1 = cA + (size_t)(t + 1) * kstep;
            const char* a2 = last ? nA : cA + (size_t)(t + 2) * kstep; const char* b2 = last ? nB : cB + (size_t)(t + 2) * kstep;
            const char* a3 = a2 + kstep; const char* b3 = b2 + kstep;
            PG8_LDB(B0, 0, 0); PG8_SCHED; PG8_LDA(At, 0, 0); PG8_STAGE(PG8_SA(1, 1), a1 + hstep, voffA);
            PG8_WAIT_L(8); PG8_BAR; PG8_WAIT_L(0); PG8_MMA(0, 0, At, B0); PG8_BAR; PG8_SCHED;
            PG8_LDB(B1, 0, 1); PG8_STAGE(PG8_SB(0, 0), b2, voffB);
            PG8_BAR; PG8_WAIT_L(0); PG8_MMA(0, 1, At, B1); PG8_BAR;
            PG8_LDA(At, 0, 1); PG8_STAGE(PG8_SA(0, 0), a2, voffA);
            PG8_BAR; PG8_WAIT_L(0); PG8_MMA(1, 0, At, B0); PG8_BAR; PG8_SCHED;
            PG8_STAGE(PG8_SB(0, 1), b2 + hstep, voffB);
            PG8_WAIT_V(6); PG8_BAR; PG8_MMA(1, 1, At, B1); PG8_BAR;
            PG8_LDB(B0, 1, 0); PG8_SCHED; PG8_LDA(At, 1, 0); PG8_STAGE(PG8_SA(0, 1), a2 + hstep, voffA);
            PG8_WAIT_L(8); PG8_BAR; PG8_WAIT_L(0); PG8_MMA(0, 0, At, B0); PG8_BAR; PG8_SCHED;
            PG8_LDB(B1, 1, 1); PG8_STAGE(PG8_SB(1, 0), b3, voffB);
            PG8_BAR; PG8_WAIT_L(0); PG8_MMA(0, 1, At, B1); PG8_BAR;
            PG8_LDA(At, 1, 1); PG8_STAGE(PG8_SA(1, 0), a3, voffA);
            PG8_BAR; PG8_WAIT_L(0); PG8_MMA(1, 0, At, B0); PG8_BAR; PG8_SCHED;
            PG8_STAGE(PG8_SB(1, 1), b3 + hstep, voffB);
            PG8_WAIT_V(6); PG8_BAR; PG8_MMA(1, 1, At, B1); PG8_BAR;
        }
        const bool keep = E(acc, cur, wr, wc, fr, fq);
        if (!has_next) break;
        if (!keep)
#pragma unroll
        for (int a = 0; a < 2; ++a)
#pragma unroll
            for (int b = 0; b < 2; ++b)
#pragma unroll
                for (int m = 0; m < 4; ++m)
#pragma unroll
                    for (int n = 0; n < 2; ++n) acc[a][b][m][n] = (f32x4){0.f, 0.f, 0.f, 0.f};
        cur = nxt; cA = nA; cB = nB; ++ui;
    }
    PG8_WAIT_V(0);
    if (wr == 0) PG8_BAR;
    PG8_BAR;
#undef PG8_SA
#undef PG8_SB
#undef PG8_STAGE
#undef PG8_LDA
#undef PG8_LDB
#undef PG8_MMA
#undef PG8_WAIT_V
#undef PG8_WAIT_L
#undef PG8_BAR
#undef PG8_SCHED
}
}
using pg8::Unit;

struct SchedP1 {
    int G, c; const char* A; const char* Bt;
    __device__ __forceinline__ bool next(int i, Unit& u) const {
        const int L = i * G + c; if (L >= 2192) return false;
        u.br = 0;
        if (L >= 2160) { const int idx = L - 2160; u.pm = 36 + (idx >> 3); u.pn = 60 + (idx & 7); return true; }
        pg8::tile_of(L, 36, 60, u.pm, u.pn); return true;
    }
    __device__ __forceinline__ const char* a_base(const Unit& u) const { return A + (size_t)u.pm * (256 * 2048 * 2); }
    __device__ __forceinline__ const char* b_base(const Unit& u) const { return Bt + (size_t)u.pn * (256 * 2048 * 2); }
};
struct EpiP1 {
    bf16_t* proj; bf16_t* gate; float* F; const float* lb; const float* b_gate; float* out; bf16_t* mkb; bf16_t* mvt;
    __device__ __forceinline__ bool operator()(f32x4 (&acc)[2][2][4][2], const Unit& u, int wr, int wc, int fr, int fq) const {
        const int rloc = wr * 64 + fr, cloc = wc * 32 + 8 * fq;
        if (u.pn < 36) {
            const int seg = u.pn >> 2;
#pragma unroll
            for (int bj = 0; bj < 2; ++bj) {
                const int col = u.pn * 256 + bj * 128 + cloc;
                f32x4 l0 = (f32x4){0.f, 0.f, 0.f, 0.f}, l1 = l0;
                if (seg == 4) { l0 = *(const f32x4*)(lb + (col - C_HF)); l1 = *(const f32x4*)(lb + (col - C_HF) + 4); }
#pragma unroll
                for (int ai = 0; ai < 2; ++ai)
#pragma unroll
                    for (int m = 0; m < 4; ++m) {
                        const size_t row = (size_t)u.pm * 256 + ai * 128 + m * 16 + rloc;
                        f32x4 v0 = acc[ai][bj][m][0], v1 = acc[ai][bj][m][1];
                        if (seg == 4) {
#pragma unroll
                            for (int e = 0; e < 4; ++e) { v0[e] = l0[e] + (1.f - l0[e]) * sigm(v0[e]); v1[e] = l1[e] + (1.f - l1[e]) * sigm(v1[e]); }
                            float* fp = F + row * 1024 + (col - C_HF);
                            *(f32x4*)fp = v0; *(f32x4*)(fp + 4) = v1;
                        } else {
                            if (seg == 1) {
#pragma unroll
                                for (int e = 0; e < 4; ++e) { v0[e] = sigm(v0[e]); v1[e] = sigm(v1[e]); }
                            } else if (seg == 2 || seg == 6 || seg == 8) {
#pragma unroll
                                for (int e = 0; e < 4; ++e) { v0[e] = siluf(v0[e]); v1[e] = siluf(v1[e]); }
                            } else if (seg == 3) { v0 *= 0.08838834764831845f; v1 *= 0.08838834764831845f; }
                            else if (seg == 7) { v0 *= 0.0625f; v1 *= 0.0625f; }
                            u32x4 o; o.x = pk2(v0[0], v0[1]); o.y = pk2(v0[2], v0[3]); o.z = pk2(v1[0], v1[1]); o.w = pk2(v1[2], v1[3]);
                            *(u32x4*)(proj + row * LDP + col) = o;
                        }
                    }
            }
        } else if (u.pn < 60) {
#pragma unroll
            for (int bj = 0; bj < 2; ++bj) {
                const int col = (u.pn - 36) * 256 + bj * 128 + cloc;
                const f32x4 b0 = *(const f32x4*)(b_gate + col), b1 = *(const f32x4*)(b_gate + col + 4);
#pragma unroll
                for (int ai = 0; ai < 2; ++ai)
#pragma unroll
                    for (int m = 0; m < 4; ++m) {
                        const size_t row = (size_t)u.pm * 256 + ai * 128 + m * 16 + rloc;
                        f32x4 v0 = acc[ai][bj][m][0] + b0, v1 = acc[ai][bj][m][1] + b1;
#pragma unroll
                        for (int e = 0; e < 4; ++e) { v0[e] = fmaxf(sigm(v0[e]), 1e-6f); v1[e] = fmaxf(sigm(v1[e]), 1e-6f); }
                        u32x4 o; o.x = pk2(v0[0], v0[1]); o.y = pk2(v0[2], v0[3]); o.z = pk2(v1[0], v1[1]); o.w = pk2(v1[2], v1[3]);
                        *(u32x4*)(gate + row * LDG + col) = o;
                    }
            }
        } else {
            const int n = u.pm - 36, isv = (u.pn >= 64) ? 1 : 0, h = (u.pn - 60) & 3;
            float* ob = out + (isv ? O_MV : O_MK);
#pragma unroll
            for (int bj = 0; bj < 2; ++bj) {
                const int d = bj * 128 + cloc;
#pragma unroll
                for (int ai = 0; ai < 2; ++ai)
#pragma unroll
                    for (int m = 0; m < 4; ++m) {
                        const int key = ai * 128 + m * 16 + rloc;
                        const f32x4 v0 = acc[ai][bj][m][0], v1 = acc[ai][bj][m][1];
                        float* op = ob + ((size_t)(n * 256 + key) * 4 + h) * 256 + d;
                        *(f32x4*)op = v0; *(f32x4*)(op + 4) = v1;
                        if (!isv) {
                            u32x4 o; o.x = pk2(v0[0], v0[1]); o.y = pk2(v0[2], v0[3]); o.z = pk2(v1[0], v1[1]); o.w = pk2(v1[2], v1[3]);
                            *(u32x4*)(mkb + ((size_t)(n * 4 + h) * 256 + key) * 256 + d) = o;
                        } else {
                            bf16_t* vp = mvt + ((size_t)(n * 4 + h) * 256 + d) * 256 + key;
#pragma unroll
                            for (int e = 0; e < 4; ++e) { vp[(size_t)e * 256] = (bf16_t)f2bf(v0[e]); vp[(size_t)(e + 4) * 256] = (bf16_t)f2bf(v1[e]); }
                        }
                    }
            }
        }
        return false;
    }
};

struct SchedP4 {
    int G, c; const char* A; const char* Bt;
    __device__ __forceinline__ bool next(int i, Unit& u) const {
        const int tri = i / 3, L = tri * G + c; if (L >= 288) return false;
        u.br = i - tri * 3; pg8::tile_of(L, 36, 8, u.pm, u.pn); return true;
    }
    __device__ __forceinline__ const char* a_base(const Unit& u) const { return A + (size_t)u.br * ((size_t)9216 * 1024 * 2) + (size_t)u.pm * (256 * 1024 * 2); }
    __device__ __forceinline__ const char* b_base(const Unit& u) const { return Bt + (size_t)u.br * ((size_t)2048 * 1024 * 2) + (size_t)u.pn * (256 * 1024 * 2); }
};
struct EpiP4 {
    const bf16_t* gate; bf16_t* merged;
    __device__ __forceinline__ bool operator()(f32x4 (&acc)[2][2][4][2], const Unit& u, int wr, int wc, int fr, int fq) const {
        const int rloc = wr * 64 + fr, cloc = wc * 32 + 8 * fq;
#pragma unroll
        for (int bj = 0; bj < 2; ++bj) {
            const int col = u.pn * 256 + bj * 128 + cloc;
#pragma unroll
            for (int ai = 0; ai < 2; ++ai)
#pragma unroll
                for (int m = 0; m < 4; ++m) {
                    const size_t row = (size_t)u.pm * 256 + ai * 128 + m * 16 + rloc;
                    const bf16_t* gp = gate + row * LDG + u.br * 2048 + col;
                    const u32x4 g = *(const u32x4*)gp;
                    f32x4 s0 = (f32x4){bflo(g.x), bfhi(g.x), bflo(g.y), bfhi(g.y)}, s1 = (f32x4){bflo(g.z), bfhi(g.z), bflo(g.w), bfhi(g.w)};
                    if (u.br < 2) {
                        const u32x4 h = *(const u32x4*)(gp + 2048);
                        s0[0] *= __builtin_amdgcn_rcpf(bflo(h.x)); s0[1] *= __builtin_amdgcn_rcpf(bfhi(h.x)); s0[2] *= __builtin_amdgcn_rcpf(bflo(h.y)); s0[3] *= __builtin_amdgcn_rcpf(bfhi(h.y));
                        s1[0] *= __builtin_amdgcn_rcpf(bflo(h.z)); s1[1] *= __builtin_amdgcn_rcpf(bfhi(h.z)); s1[2] *= __builtin_amdgcn_rcpf(bflo(h.w)); s1[3] *= __builtin_amdgcn_rcpf(bfhi(h.w));
                    }
                    acc[ai][bj][m][0] *= s0; acc[ai][bj][m][1] *= s1;
                    if (u.br == 2) { const f32x4 v0 = acc[ai][bj][m][0], v1 = acc[ai][bj][m][1];
                        u32x4 o; o.x = pk2(v0[0], v0[1]); o.y = pk2(v0[2], v0[3]); o.z = pk2(v1[0], v1[1]); o.w = pk2(v1[2], v1[3]);
                        *(u32x4*)(merged + row * 2048 + col) = o; }
                }
        }
        return u.br < 2;
    }
};

struct SchedP5 {
    int G, c; const char* A; const char* Bt;
    __device__ __forceinline__ bool next(int i, Unit& u) const {
        const int L = i * G + c; if (L >= 288) return false;
        u.br = 0; pg8::tile_of(L, 36, 8, u.pm, u.pn); return true;
    }
    __device__ __forceinline__ const char* a_base(const Unit& u) const { return A + (size_t)u.pm * (256 * 2048 * 2); }
    __device__ __forceinline__ const char* b_base(const Unit& u) const { return Bt + (size_t)u.pn * (256 * 2048 * 2); }
};
struct EpiP5 {
    const float* xp; const float* xs; float* out;
    __device__ __forceinline__ bool operator()(f32x4 (&acc)[2][2][4][2], const Unit& u, int wr, int wc, int fr, int fq) const {
        const int rloc = wr * 64 + fr, cloc = wc * 32 + 8 * fq;
#pragma unroll
        for (int bj = 0; bj < 2; ++bj) {
            const int col = u.pn * 256 + bj * 128 + cloc;
#pragma unroll
            for (int ai = 0; ai < 2; ++ai)
#pragma unroll
                for (int m = 0; m < 4; ++m) {
                    const size_t row = (size_t)u.pm * 256 + ai * 128 + m * 16 + rloc;
                    const float* xr = (row < (size_t)NTP) ? (xp + row * 2048 + col) : (xs + (row - NTP) * 2048 + col);
                    const f32x4 v0 = acc[ai][bj][m][0] + *(const f32x4*)xr, v1 = acc[ai][bj][m][1] + *(const f32x4*)(xr + 4);
                    float* op = out + row * 2048 + col;
                    *(f32x4*)op = v0; *(f32x4*)(op + 4) = v1;
                }
        }
        return false;
    }
};

struct EpiNull {
    __device__ __forceinline__ bool operator()(f32x4 (&acc)[2][2][4][2], const Unit& u, int wr, int wc, int fr, int fq) const {
        f32x4 t = (f32x4){0.f, 0.f, 0.f, 0.f};
#pragma unroll
        for (int ai = 0; ai < 2; ++ai)
#pragma unroll
            for (int bj = 0; bj < 2; ++bj)
#pragma unroll
                for (int m = 0; m < 4; ++m) t += acc[ai][bj][m][0] + acc[ai][bj][m][1];
        asm volatile("" :: "v"(t[0]), "v"(t[1]), "v"(t[2]), "v"(t[3]));
        return false;
    }
};
__device__ __forceinline__ void transpose_tile(const float* W, int K, int N, bf16_t* WT, int row_off, int kb, int nb, LAS unsigned* T32, int tid) {
    const int nq = tid & 31, kp0 = tid >> 5;
#pragma unroll
    for (int i = 0; i < 4; ++i) {
        const int kpair = kp0 + 16 * i;
        const float* src = W + (size_t)(kb * 128 + 2 * kpair) * N + nb * 128 + 4 * nq;
        const f32x4 r0 = *(const f32x4*)src, r1 = *(const f32x4*)(src + N);
        T32[(4 * nq + 0) * 65 + kpair] = pk2(r0[0], r1[0]); T32[(4 * nq + 1) * 65 + kpair] = pk2(r0[1], r1[1]);
        T32[(4 * nq + 2) * 65 + kpair] = pk2(r0[2], r1[2]); T32[(4 * nq + 3) * 65 + kpair] = pk2(r0[3], r1[3]);
    }
    __syncthreads();
#pragma unroll
    for (int i = 0; i < 4; ++i) {
        const int id = tid + 512 * i, n = id >> 4, c = id & 15;
        u32x4 o; o.x = T32[n * 65 + 4 * c]; o.y = T32[n * 65 + 4 * c + 1]; o.z = T32[n * 65 + 4 * c + 2]; o.w = T32[n * 65 + 4 * c + 3];
        *(u32x4*)(WT + (size_t)(row_off + nb * 128 + n) * K + kb * 128 + 8 * c) = o;
    }
    __syncthreads();
}
__device__ __forceinline__ void rms_row_to_bf16(const float* xrow, const float* g, bf16_t* orow, int lane) {
    f32x4 v[8]; float ss = 0.f;
#pragma unroll
    for (int j = 0; j < 8; ++j) { v[j] = ((const f32x4*)xrow)[lane + 64 * j]; ss += (v[j][0] * v[j][0] + v[j][1] * v[j][1]) + (v[j][2] * v[j][2] + v[j][3] * v[j][3]); }
    ss = wave_sum(ss);
    const float rinv = rsqrtf(ss * (1.f / 2048.f) + EPS);
#pragma unroll
    for (int j = 0; j < 8; ++j) { const f32x4 gg = ((const f32x4*)g)[lane + 64 * j];
        u32x2 o; o.x = pk2(v[j][0] * rinv * gg[0], v[j][1] * rinv * gg[1]); o.y = pk2(v[j][2] * rinv * gg[2], v[j][3] * rinv * gg[3]);
        ((u32x2*)orow)[lane + 64 * j] = o; }
}
__device__ __forceinline__ void p0_prologue(const Params& p, LAS unsigned char* lds) {
    const int tid = threadIdx.x, lane = tid & 63, wave = tid >> 6, G = gridDim.x, c = blockIdx.x;
    LAS unsigned* T32 = (LAS unsigned*)lds;
    bf16_t* WT1 = (bf16_t*)(p.ws + WS_WT1); bf16_t* WT3 = (bf16_t*)(p.ws + WS_WT3); bf16_t* WTO = (bf16_t*)(p.ws + WS_WTO);
    constexpr int T_IN = 1920, T_MKV = 256, T_BR = 128, T_OUT = 256, T_ALL = T_IN + T_MKV + 3 * T_BR + T_OUT;
    for (int it = c; it < T_ALL; it += G) {
        int r = it;
        if (r < T_IN) { transpose_tile(p.w_in, 2048, 15360, WT1, 0, r / 120, r % 120, T32, tid); continue; } r -= T_IN;
        if (r < T_MKV) { transpose_tile(p.w_mem_kv, 2048, 2048, WT1, 15360, r / 16, r % 16, T32, tid); continue; } r -= T_MKV;
        if (r < T_BR) { transpose_tile(p.w_conv_out, 1024, 2048, WT3, 0, r / 16, r % 16, T32, tid); continue; } r -= T_BR;
        if (r < T_BR) { transpose_tile(p.w_hgrn_out, 1024, 2048, WT3 + (size_t)2048 * 1024, 0, r / 16, r % 16, T32, tid); continue; } r -= T_BR;
        if (r < T_BR) { transpose_tile(p.w_attn_out, 1024, 2048, WT3 + (size_t)2 * 2048 * 1024, 0, r / 16, r % 16, T32, tid); continue; } r -= T_BR;
        transpose_tile(p.w_out, 2048, 2048, WTO, 0, r / 16, r % 16, T32, tid);
    }
    bf16_t* HA = (bf16_t*)(p.ws + WS_HA);
    const int gw = c * 8 + wave, NGW = G * 8;
    for (int m = gw; m < 10240; m += NGW) {
        if (m < NTP) rms_row_to_bf16(p.x_prompt + (size_t)m * 2048, p.g_pre, HA + (size_t)m * 2048, lane);
        else if (m < NTOK) rms_row_to_bf16(p.x_sample + (size_t)(m - NTP) * 2048, p.g_pre, HA + (size_t)m * 2048, lane);
        else rms_row_to_bf16(p.mem_prompt + (size_t)(m - NTOK) * 2048, p.g_mem, HA + (size_t)m * 2048, lane);
    }
    if (c == 0) { float* LB = (float*)(p.ws + WS_LB);
        for (int i = tid; i < 1024; i += 512) LB[i] = 1.f / (1.f + __expf(p.lb_logits[1024 + i] - p.lb_logits[i])); }
}

__device__ __forceinline__ void hgrn_prompt_item(const Params& p, int item, LAS unsigned char* lds, int tid) {
    LAS float* qs = (LAS float*)lds;
    LAS float* fs = qs + 4096;
    LAS float* vs = fs + 4096;
    LAS float* part = vs + 512;
    const int s = item >> 3, n = s >> 3, h = s & 7, dvg = item & 7;
    const int vcol = tid & 15, kg = tid >> 4;
    const bf16_t* proj = (const bf16_t*)(p.ws + WS_PROJ9);
    const float* F = (const float*)(p.ws + WS_F);
    float* oraw = (float*)(p.ws + WS_ORAW);
    const size_t row0 = (size_t)n * SEQ;
    const bf16_t* qsrc = proj + (row0 + kg) * LDP + C_HQ + h * 128 + vcol * 8;
    const float* fsrc = F + (row0 + kg) * 1024 + h * 128 + vcol * 8;
    const bf16_t* vsrc = proj + (row0 + kg) * LDP + C_HI + h * 128 + dvg * 16 + vcol;
    f32x2 S01 = (f32x2){0.f, 0.f}, S23 = (f32x2){0.f, 0.f};
    u32x4 rq[4]; f32x4 rfa[4], rfb[4]; bf16_t rv[4];
#define HG_FETCH(R, tb) do { const size_t adv = (size_t)(tb); rq[R] = *(const u32x4*)(qsrc + adv * LDP); rfa[R] = *(const f32x4*)(fsrc + adv * 1024); \
        rfb[R] = *(const f32x4*)(fsrc + adv * 1024 + 4); rv[R] = *(vsrc + adv * LDP); } while (0)
#define HG_BATCH(R, tb) do { \
        { LAS float* qd = qs + kg * 128 + vcol * 8; \
          *(LAS f32x4*)qd = (f32x4){bflo(rq[R].x), bfhi(rq[R].x), bflo(rq[R].y), bfhi(rq[R].y)}; *(LAS f32x4*)(qd + 4) = (f32x4){bflo(rq[R].z), bfhi(rq[R].z), bflo(rq[R].w), bfhi(rq[R].w)}; \
          LAS float* fd = fs + kg * 128 + vcol * 8; *(LAS f32x4*)fd = rfa[R]; *(LAS f32x4*)(fd + 4) = rfb[R]; \
          vs[kg * 16 + vcol] = bf2f(rv[R]); } \
        __syncthreads(); \
        if ((tb) + 128 < SEQ) HG_FETCH(R, (tb) + 128); \
        f32x4 cf[4], cq[4]; float cv[4]; \
        _Pragma("unroll") for (int i = 0; i < 4; ++i) { cf[i] = *(const LAS f32x4*)(fs + i * 128 + kg * 4); cq[i] = *(const LAS f32x4*)(qs + i * 128 + kg * 4); cv[i] = vs[i * 16 + vcol]; } \
        _Pragma("unroll") for (int g = 0; g < 8; ++g) { \
            f32x4 nf[4], nq[4]; float nv[4]; \
            if (g < 7) { _Pragma("unroll") for (int i = 0; i < 4; ++i) { const int tt = (g + 1) * 4 + i; \
                nf[i] = *(const LAS f32x4*)(fs + tt * 128 + kg * 4); nq[i] = *(const LAS f32x4*)(qs + tt * 128 + kg * 4); nv[i] = vs[tt * 16 + vcol]; } } \
            _Pragma("unroll") for (int i = 0; i < 4; ++i) { \
                const f32x2 f01 = (f32x2){cf[i][0], cf[i][1]}, f23 = (f32x2){cf[i][2], cf[i][3]}, q01 = (f32x2){cq[i][0], cq[i][1]}, q23 = (f32x2){cq[i][2], cq[i][3]}; \
                const f32x2 vv = (f32x2){cv[i], cv[i]}; \
                S01 = f01 * (S01 - vv) + vv; S23 = f23 * (S23 - vv) + vv; \
                f32x2 t = S01 * q01; t = S23 * q23 + t; \
                part[(g * 4 + i) * 528 + tid] = t[0] + t[1]; } \
            if (g < 7) { _Pragma("unroll") for (int i = 0; i < 4; ++i) { cf[i] = nf[i]; cq[i] = nq[i]; cv[i] = nv[i]; } } } \
        __syncthreads(); \
        { float a = 0.f; \
          _Pragma("unroll 8") for (int k2 = 0; k2 < 32; ++k2) a += part[kg * 528 + k2 * 16 + vcol]; \
          oraw[(row0 + (tb) + kg) * 1024 + h * 128 + dvg * 16 + vcol] = a; } } while (0)
    HG_FETCH(0, 0); HG_FETCH(1, 32); HG_FETCH(2, 64); HG_FETCH(3, 96);
#pragma unroll 1
    for (int t0 = 0; t0 < SEQ; t0 += 128) { HG_BATCH(0, t0); HG_BATCH(1, t0 + 32); HG_BATCH(2, t0 + 64); HG_BATCH(3, t0 + 96); }
#undef HG_FETCH
#undef HG_BATCH
    float* so = p.out + O_HGRN_P + ((size_t)(n * 8 + h) * 128 + kg * 4) * 128 + dvg * 16 + vcol;
    so[0] = S01[0]; so[128] = S01[1]; so[256] = S23[0]; so[384] = S23[1];
    __syncthreads();
}

__device__ __forceinline__ void hgrn_sample_item(const Params& p, int item, LAS unsigned char* lds, int tid) {
    LAS float* qs = (LAS float*)lds;
    LAS float* fs = qs + 1024;
    LAS float* vs = fs + 1024;
    LAS float* opart = vs + 1024;
    const int n = item >> 3, h = item & 7, lane = tid & 63, wave = tid >> 6;
    const bf16_t* proj = (const bf16_t*)(p.ws + WS_PROJ9);
    const float* F = (const float*)(p.ws + WS_F);
    const size_t row0 = (size_t)NTP + (size_t)n * 8;
    { const int tt = tid >> 6, k2 = (tid & 63) * 2; const size_t r = row0 + tt;
      const unsigned qw = *(const unsigned*)(proj + r * LDP + C_HQ + h * 128 + k2); const f32x2 ff = *(const f32x2*)(F + r * 1024 + h * 128 + k2);
      const unsigned vw = *(const unsigned*)(proj + r * LDP + C_HI + h * 128 + k2);
      qs[tt * 128 + k2] = bflo(qw); qs[tt * 128 + k2 + 1] = bfhi(qw); fs[tt * 128 + k2] = ff[0]; fs[tt * 128 + k2 + 1] = ff[1];
      vs[tt * 128 + k2] = bflo(vw); vs[tt * 128 + k2 + 1] = bfhi(vw); }
    const int v4 = tid & 31, kg = tid >> 5;
    const size_t sbase = ((size_t)(n * 8 + h) * 128 + kg * 8) * 128 + v4 * 4;
    f32x4 S[8];
#pragma unroll
    for (int i = 0; i < 8; ++i) S[i] = *(const f32x4*)(p.state_hgrn + sbase + (size_t)i * 128);
    __syncthreads();
#pragma unroll
    for (int tt = 0; tt < 8; ++tt) {
        const f32x4 fa = *(const LAS f32x4*)(fs + tt * 128 + kg * 8), fb = *(const LAS f32x4*)(fs + tt * 128 + kg * 8 + 4);
        const f32x4 qa = *(const LAS f32x4*)(qs + tt * 128 + kg * 8), qb = *(const LAS f32x4*)(qs + tt * 128 + kg * 8 + 4);
        const f32x4 vv = *(const LAS f32x4*)(vs + tt * 128 + v4 * 4);
        f32x4 po = (f32x4){0.f, 0.f, 0.f, 0.f};
#pragma unroll
        for (int i = 0; i < 8; ++i) { const float f = (i < 4) ? fa[i & 3] : fb[i & 3], q = (i < 4) ? qa[i & 3] : qb[i & 3];
            S[i] = S[i] * f + vv * (1.f - f); po += S[i] * q; }
#pragma unroll
        for (int e = 0; e < 4; ++e) po[e] += __shfl_xor(po[e], 32);
        if (lane < 32) *(LAS f32x4*)(opart + (tt * 8 + wave) * 128 + v4 * 4) = po;
    }
    float* so = p.out + O_HGRN_S + sbase;
#pragma unroll
    for (int i = 0; i < 8; ++i) *(f32x4*)(so + (size_t)i * 128) = S[i];
    __syncthreads();
    { const int tt = tid >> 6, v = (tid & 63) * 2; float o0 = 0.f, o1 = 0.f;
#pragma unroll
      for (int w = 0; w < 8; ++w) { const f32x2 t = *(const LAS f32x2*)(opart + (tt * 8 + w) * 128 + v); o0 += t[0]; o1 += t[1]; }
      const float ss = wave_sum(o0 * o0 + o1 * o1), rinv = rsqrtf(ss * (1.f / 128.f) + EPS);
      const size_t r = row0 + tt; const f32x2 gg = *(const f32x2*)(p.g_hgrn + h * 128 + v);
      const unsigned gw = *(const unsigned*)(proj + r * LDP + C_HOG + h * 128 + v);
      bf16_t* og = (bf16_t*)(p.ws + WS_ACT3) + (size_t)9216 * 1024 + r * 1024 + h * 128 + v;
      *(unsigned*)og = pk2(o0 * rinv * gg[0] * bflo(gw), o1 * rinv * gg[1] * bfhi(gw)); }
    __syncthreads();
}

__device__ __forceinline__ void hgrn_norm_rows(const Params& p) {
    const int tid = threadIdx.x, lane = tid & 63, gw = blockIdx.x * 8 + (tid >> 6), NGW = gridDim.x * 8;
    const bf16_t* proj = (const bf16_t*)(p.ws + WS_PROJ9); const float* oraw = (const float*)(p.ws + WS_ORAW);
    bf16_t* og = (bf16_t*)(p.ws + WS_ACT3) + (size_t)9216 * 1024;
    for (int r = gw; r < NTP; r += NGW) {
        f32x4 o[4]; float ss = 0.f;
#pragma unroll
        for (int j = 0; j < 4; ++j) { o[j] = *(const f32x4*)(oraw + (size_t)r * 1024 + lane * 16 + j * 4); ss += (o[j][0] * o[j][0] + o[j][1] * o[j][1]) + (o[j][2] * o[j][2] + o[j][3] * o[j][3]); }
        ss += __shfl_xor(ss, 1); ss += __shfl_xor(ss, 2); ss += __shfl_xor(ss, 4);
        const float rinv = rsqrtf(ss * (1.f / 128.f) + EPS);
        const u32x4 ga = *(const u32x4*)(proj + (size_t)r * LDP + C_HOG + lane * 16), gb = *(const u32x4*)(proj + (size_t)r * LDP + C_HOG + lane * 16 + 8);
        f32x4 g[4];
#pragma unroll
        for (int j = 0; j < 4; ++j) g[j] = *(const f32x4*)(p.g_hgrn + lane * 16 + j * 4);
        u32x4 oa, ob;
        oa.x = pk2(o[0][0] * rinv * g[0][0] * bflo(ga.x), o[0][1] * rinv * g[0][1] * bfhi(ga.x)); oa.y = pk2(o[0][2] * rinv * g[0][2] * bflo(ga.y), o[0][3] * rinv * g[0][3] * bfhi(ga.y));
        oa.z = pk2(o[1][0] * rinv * g[1][0] * bflo(ga.z), o[1][1] * rinv * g[1][1] * bfhi(ga.z)); oa.w = pk2(o[1][2] * rinv * g[1][2] * bflo(ga.w), o[1][3] * rinv * g[1][3] * bfhi(ga.w));
        ob.x = pk2(o[2][0] * rinv * g[2][0] * bflo(gb.x), o[2][1] * rinv * g[2][1] * bfhi(gb.x)); ob.y = pk2(o[2][2] * rinv * g[2][2] * bflo(gb.y), o[2][3] * rinv * g[2][3] * bfhi(gb.y));
        ob.z = pk2(o[3][0] * rinv * g[3][0] * bflo(gb.z), o[3][1] * rinv * g[3][1] * bfhi(gb.z)); ob.w = pk2(o[3][2] * rinv * g[3][2] * bflo(gb.w), o[3][3] * rinv * g[3][3] * bfhi(gb.w));
        *(u32x4*)(og + (size_t)r * 1024 + lane * 16) = oa; *(u32x4*)(og + (size_t)r * 1024 + lane * 16 + 8) = ob;
    }
}

template <bool SAMPLE>
__device__ __forceinline__ void conv_item(const Params& p, int item, LAS unsigned char* lds, int tid) {
    constexpr int T = SAMPLE ? 8 : 32;
    constexpr int GP = 4, NG = (T + 32) / GP, G0 = 32 / GP;
    LAS float* dcs = (LAS float*)lds;
    const bf16_t* proj = (const bf16_t*)(p.ws + WS_PROJ9);
    const int n = SAMPLE ? item : (item >> 6), t0 = SAMPLE ? 0 : (item & 63) * 32;
    const size_t rowb = SAMPLE ? ((size_t)NTP + (size_t)n * 8) : ((size_t)n * SEQ);
    const int c0 = 2 * tid;
    float w0[31], w1[31], x0[31], x1[31];
#pragma unroll
    for (int j = 0; j < 31; ++j) { const f32x2 w = *(const f32x2*)(p.conv_w + j * 1024 + c0); w0[j] = w[0]; w1[j] = w[1]; x0[j] = 0.f; x1[j] = 0.f; }
    const f32x2 bias = *(const f32x2*)(p.conv_b + c0);
    unsigned ra[GP], rg[GP];
#define CONV_ISSUE(g) do { \
        if (SAMPLE && (g) < G0) { _Pragma("unroll") for (int i = 0; i < GP; ++i) { const int ti = -2 + GP * (g) + i; \
            const unsigned* tp = (const unsigned*)(p.state_conv + ((size_t)n * 30 + (ti < 0 ? 0 : ti)) * 1024 + c0); ra[i] = tp[0]; rg[i] = tp[1]; } } \
        else { _Pragma("unroll") for (int i = 0; i < GP; ++i) { const int t = t0 - 32 + GP * (g) + i; const bf16_t* rp = proj + (rowb + (t < 0 ? 0 : t)) * LDP + c0; \
            ra[i] = *(const unsigned*)(rp + C_CV); rg[i] = *(const unsigned*)(rp + C_CG); } } } while (0)
    CONV_ISSUE(0);
#pragma unroll 1
    for (int g = 0; g < NG; ++g) {
        float u0[GP], u1[GP];
        if (SAMPLE && g < G0) {
#pragma unroll
            for (int i = 0; i < GP; ++i) { const bool ok = (-2 + GP * g + i) >= 0; u0[i] = ok ? __builtin_bit_cast(float, ra[i]) : 0.f; u1[i] = ok ? __builtin_bit_cast(float, rg[i]) : 0.f; }
        } else {
#pragma unroll
            for (int i = 0; i < GP; ++i) { const bool ok = (t0 - 32 + GP * g + i) >= 0; u0[i] = ok ? bflo(ra[i]) * bflo(rg[i]) : 0.f; u1[i] = ok ? bfhi(ra[i]) * bfhi(rg[i]) : 0.f; }
        }
        if (g + 1 < NG) CONV_ISSUE(g + 1);
#pragma unroll
        for (int i = 0; i < GP; ++i) {
            const int pp = -32 + GP * g + i, t = t0 + pp;
            if (SAMPLE) { if (pp >= -22) *(f32x2*)(p.out + O_CONV_S + ((size_t)n * 30 + (pp + 22)) * 1024 + c0) = (f32x2){u0[i], u1[i]}; }
            else { if (t >= SEQ - 30) *(f32x2*)(p.out + O_CONV_P + ((size_t)n * 30 + (t - (SEQ - 30))) * 1024 + c0) = (f32x2){u0[i], u1[i]}; }
#pragma unroll
            for (int j = 0; j < 30; ++j) { x0[j] = x0[j + 1]; x1[j] = x1[j + 1]; }
            x0[30] = u0[i]; x1[30] = u1[i];
            if (g >= G0) {
                float d0 = bias[0], d1 = bias[1];
#pragma unroll
                for (int j = 0; j < 31; ++j) { d0 += w0[j] * x0[j]; d1 += w1[j] * x1[j]; }
                *(LAS f32x2*)(dcs + (pp) * 1024 + c0) = (f32x2){d0, d1};
            }
        }
    }
#undef CONV_ISSUE
    __syncthreads();
    { const int lane = tid & 63, wave = tid >> 6;
      bf16_t* aact = (bf16_t*)(p.ws + WS_ACT3);
      for (int pp = wave; pp < T; pp += 8) {
          f32x4 v[4]; float s = 0.f;
#pragma unroll
          for (int j = 0; j < 4; ++j) { v[j] = *(const LAS f32x4*)(dcs + pp * 1024 + j * 256 + lane * 4); s += (v[j][0] + v[j][1]) + (v[j][2] + v[j][3]); }
          const float mean = wave_sum(s) * (1.f / 1024.f); float s2 = 0.f;
#pragma unroll
          for (int j = 0; j < 4; ++j) { v[j] = v[j] - mean; s2 += (v[j][0] * v[j][0] + v[j][1] * v[j][1]) + (v[j][2] * v[j][2] + v[j][3] * v[j][3]); }
          const float rstd = rsqrtf(wave_sum(s2) * (1.f / 1024.f) + EPS);
          const size_t r = rowb + t0 + pp;
#pragma unroll
          for (int j = 0; j < 4; ++j) { const int c = j * 256 + lane * 4;
              const f32x4 lg = *(const f32x4*)(p.ln_g + c), lbv = *(const f32x4*)(p.ln_b + c);
              const u32x2 sg = *(const u32x2*)(proj + r * LDP + C_CS + c);
              const float y0 = siluf(v[j][0] * rstd * lg[0] + lbv[0]) * bflo(sg.x), y1 = siluf(v[j][1] * rstd * lg[1] + lbv[1]) * bfhi(sg.x);
              const float y2 = siluf(v[j][2] * rstd * lg[2] + lbv[2]) * bflo(sg.y), y3 = siluf(v[j][3] * rstd * lg[3] + lbv[3]) * bfhi(sg.y);
              u32x2 o; o.x = pk2(y0, y1); o.y = pk2(y2, y3);
              *(u32x2*)(aact + r * 1024 + c) = o; }
      } }
    __syncthreads();
}

__device__ __forceinline__ void attn_prompt_item(const Params& p, int item, int tid) {
    const int lane = tid & 63, wave = tid >> 6, l15 = lane & 15, quad = lane >> 4;
    const int n = item >> 6, h = (item >> 4) & 3, qt = item & 15;
    const bf16_t* proj = (const bf16_t*)(p.ws + WS_PROJ9);
    const bf16_t* kb = (const bf16_t*)(p.ws + WS_MKB) + (size_t)(n * 4 + h) * 65536;
    const bf16_t* vt = (const bf16_t*)(p.ws + WS_MVT) + (size_t)(n * 4 + h) * 65536;
    const size_t qrow = (size_t)n * SEQ + qt * 128 + wave * 16 + l15;
    bf16x8 qf[8];
#pragma unroll
    for (int s = 0; s < 8; ++s) qf[s] = *(const bf16x8*)(proj + qrow * LDP + C_AQ + h * 256 + s * 32 + quad * 8);
    f32x4 sc[16];
#pragma unroll
    for (int T = 0; T < 16; ++T) {
        sc[T] = (f32x4){0.f, 0.f, 0.f, 0.f};
        const bf16_t* kr = kb + (size_t)(T * 16 + l15) * 256 + quad * 8;
#pragma unroll
        for (int s = 0; s < 8; ++s) { const bf16x8 a = *(const bf16x8*)(kr + s * 32); sc[T] = __builtin_amdgcn_mfma_f32_16x16x32_bf16(a, qf[s], sc[T], 0, 0, 0); }
    }
    float mx = -3.0e38f;
#pragma unroll
    for (int T = 0; T < 16; ++T) mx = fmaxf(mx, fmaxf(fmaxf(sc[T][0], sc[T][1]), fmaxf(sc[T][2], sc[T][3])));
    mx = fmaxf(mx, __shfl_xor(mx, 16)); mx = fmaxf(mx, __shfl_xor(mx, 32));
    float sum = 0.f;
#pragma unroll
    for (int T = 0; T < 16; ++T) {
#pragma unroll
        for (int e = 0; e < 4; ++e) { sc[T][e] = __expf(sc[T][e] - mx); sum += sc[T][e]; } }
    sum += __shfl_xor(sum, 16); sum += __shfl_xor(sum, 32);
    const float rs = 1.f / sum;
    bf16x8 pb[8];
#pragma unroll
    for (int s2 = 0; s2 < 8; ++s2) {
        u32x4 w; w.x = pk2(sc[2 * s2][0], sc[2 * s2][1]); w.y = pk2(sc[2 * s2][2], sc[2 * s2][3]); w.z = pk2(sc[2 * s2 + 1][0], sc[2 * s2 + 1][1]); w.w = pk2(sc[2 * s2 + 1][2], sc[2 * s2 + 1][3]);
        pb[s2] = __builtin_bit_cast(bf16x8, w);
    }
    bf16_t* aog = (bf16_t*)(p.ws + WS_ACT3) + (size_t)2 * 9216 * 1024;
    f32x4 oacc[16];
#pragma unroll
    for (int Tv = 0; Tv < 16; ++Tv) {
        oacc[Tv] = (f32x4){0.f, 0.f, 0.f, 0.f};
        const bf16_t* vr = vt + (size_t)(Tv * 16 + l15) * 256 + quad * 4;
#pragma unroll
        for (int s2 = 0; s2 < 8; ++s2) {
            const u32x2 lo = *(const u32x2*)(vr + s2 * 32), hi = *(const u32x2*)(vr + s2 * 32 + 16);
            u32x4 w; w.x = lo.x; w.y = lo.y; w.z = hi.x; w.w = hi.y;
            oacc[Tv] = __builtin_amdgcn_mfma_f32_16x16x32_bf16(__builtin_bit_cast(bf16x8, w), pb[s2], oacc[Tv], 0, 0, 0);
        }
    }
#pragma unroll
    for (int Tv = 0; Tv < 16; ++Tv) {
        const int dv = Tv * 16 + quad * 4;
        const u32x2 sg = *(const u32x2*)(proj + qrow * LDP + C_AS + h * 256 + dv);
        u32x2 o; o.x = pk2(oacc[Tv][0] * rs * bflo(sg.x), oacc[Tv][1] * rs * bfhi(sg.x)); o.y = pk2(oacc[Tv][2] * rs * bflo(sg.y), oacc[Tv][3] * rs * bfhi(sg.y));
        *(u32x2*)(aog + qrow * 1024 + h * 256 + dv) = o;
    }
}

__device__ __forceinline__ void attn_sample_item(const Params& p, int item, LAS unsigned char* lds, int tid) {
    LAS float* Ssh = (LAS float*)lds;
    LAS float* Psh = Ssh + 2048;
    LAS float* Opart = Psh + 2048;
    const int lane = tid & 63, wave = tid >> 6, l15 = lane & 15, quad = lane >> 4;
    const int n = item >> 2, h = item & 3;
    const bf16_t* proj = (const bf16_t*)(p.ws + WS_PROJ9);
    const size_t row0 = (size_t)NTP + (size_t)n * 8;
    const float* kc = p.cache_k + ((size_t)n * 256 * 4 + h) * 256;
    const float* vc = p.cache_v + ((size_t)n * 256 * 4 + h) * 256;
    {
        bf16x8 qf[8];
        const size_t qrow = row0 + (lane & 7);
#pragma unroll
        for (int s = 0; s < 8; ++s) qf[s] = *(const bf16x8*)(proj + qrow * LDP + C_AQ + h * 256 + s * 32 + quad * 8);
#pragma unroll
        for (int tl = 0; tl < 2; ++tl) {
            const int T = wave * 2 + tl;
            f32x4 sc = (f32x4){0.f, 0.f, 0.f, 0.f};
            const float* kr = kc + (size_t)(T * 16 + l15) * 1024 + quad * 8;
#pragma unroll
            for (int s = 0; s < 8; ++s) {
                const f32x4 k0 = *(const f32x4*)(kr + s * 32), k1 = *(const f32x4*)(kr + s * 32 + 4);
                u32x4 w; w.x = pk2(k0[0], k0[1]); w.y = pk2(k0[2], k0[3]); w.z = pk2(k1[0], k1[1]); w.w = pk2(k1[2], k1[3]);
                sc = __builtin_amdgcn_mfma_f32_16x16x32_bf16(__builtin_bit_cast(bf16x8, w), qf[s], sc, 0, 0, 0);
            }
            if (l15 < 8) {
#pragma unroll
                for (int e = 0; e < 4; ++e) Ssh[l15 * 256 + T * 16 + quad * 4 + e] = sc[e];
            }
        }
    }
    __syncthreads();
    {
        const f32x4 s4 = *(const LAS f32x4*)(Ssh + wave * 256 + lane * 4);
        const float mx = wave_max(fmaxf(fmaxf(s4[0], s4[1]), fmaxf(s4[2], s4[3])));
        f32x4 e4; e4[0] = __expf(s4[0] - mx); e4[1] = __expf(s4[1] - mx); e4[2] = __expf(s4[2] - mx); e4[3] = __expf(s4[3] - mx);
        const float rs = 1.f / wave_sum((e4[0] + e4[1]) + (e4[2] + e4[3]));
#pragma unroll
        for (int e = 0; e < 4; ++e) Psh[(lane * 4 + e) * 8 + wave] = e4[e] * rs;
    }
    __syncthreads();
    {
        f32x4 acc[8];
#pragma unroll
        for (int q = 0; q < 8; ++q) acc[q] = (f32x4){0.f, 0.f, 0.f, 0.f};
        const float* vr = vc + (size_t)(wave * 32) * 1024 + lane * 4;
#pragma unroll 8
        for (int kk = 0; kk < 32; ++kk) {
            const f32x4 v4 = *(const f32x4*)(vr + (size_t)kk * 1024);
            const f32x4 pa = *(const LAS f32x4*)(Psh + (wave * 32 + kk) * 8), pb = *(const LAS f32x4*)(Psh + (wave * 32 + kk) * 8 + 4);
            acc[0] += v4 * pa[0]; acc[1] += v4 * pa[1]; acc[2] += v4 * pa[2]; acc[3] += v4 * pa[3];
            acc[4] += v4 * pb[0]; acc[5] += v4 * pb[1]; acc[6] += v4 * pb[2]; acc[7] += v4 * pb[3];
        }
#pragma unroll
        for (int q = 0; q < 8; ++q) *(LAS f32x4*)(Opart + (wave * 8 + q) * 256 + lane * 4) = acc[q];
    }
    __syncthreads();
    {
        f32x4 o = (f32x4){0.f, 0.f, 0.f, 0.f};
#pragma unroll
        for (int w = 0; w < 8; ++w) o += *(const LAS f32x4*)(Opart + (w * 8 + wave) * 256 + lane * 4);
        const size_t r = row0 + wave;
        const u32x2 sg = *(const u32x2*)(proj + r * LDP + C_AS + h * 256 + lane * 4);
        u32x2 ov; ov.x = pk2(o[0] * bflo(sg.x), o[1] * bfhi(sg.x)); ov.y = pk2(o[2] * bflo(sg.y), o[3] * bfhi(sg.y));
        bf16_t* aog = (bf16_t*)(p.ws + WS_ACT3) + (size_t)2 * 9216 * 1024;
        *(u32x2*)(aog + r * 1024 + h * 256 + lane * 4) = ov;
    }
    __syncthreads();
}

__device__ __forceinline__ void p2_mixers(const Params& p, LAS unsigned char* lds) {
    const int tid = threadIdx.x, G = gridDim.x, c = blockIdx.x, mask = p.pad;
    if (mask & 1) for (int it = c; it < 256; it += G) hgrn_prompt_item(p, it, lds, tid);
    if (mask & 2) { for (int it = c; it < 256; it += G) conv_item<false>(p, it, lds, tid);
                    for (int it = c; it < 128; it += G) conv_item<true>(p, it, lds, tid); }
    if (mask & 4) for (int it = c; it < 256; it += G) attn_prompt_item(p, it, tid);
    if (mask & 8) for (int it = c; it < 512; it += G) attn_sample_item(p, it, lds, tid);
    if (mask & 16) for (int it = c; it < 1024; it += G) hgrn_sample_item(p, it, lds, tid);
}

__device__ __forceinline__ void p6_final_norm(const Params& p) {
    const int tid = threadIdx.x, lane = tid & 63, gw = blockIdx.x * 8 + (tid >> 6), NGW = gridDim.x * 8;
    for (int r = gw; r < NTOK; r += NGW) {
        float* zr = p.out + (size_t)r * 2048;
        f32x4 v[8]; float ss = 0.f;
#pragma unroll
        for (int j = 0; j < 8; ++j) { v[j] = ((const f32x4*)zr)[lane + 64 * j]; ss += (v[j][0] * v[j][0] + v[j][1] * v[j][1]) + (v[j][2] * v[j][2] + v[j][3] * v[j][3]); }
        ss = wave_sum(ss);
        const float rinv = rsqrtf(ss * (1.f / 2048.f) + EPS);
#pragma unroll
        for (int j = 0; j < 8; ++j) { const f32x4 gg = ((const f32x4*)p.g_final)[lane + 64 * j]; ((f32x4*)zr)[lane + 64 * j] = v[j] * rinv * gg; }
    }
}

__global__ void __launch_bounds__(512, 2) fwd_megakernel(Params p) {
    extern __shared__ __attribute__((aligned(16))) unsigned char shm[];
    LAS unsigned char* lds = (LAS unsigned char*)shm;
    cg::grid_group grid = cg::this_grid();
    const int G = gridDim.x, c = blockIdx.x;
#define SEAM(ph) do { if (p.coop && (ph) + 1 < p.ph_hi) { \
        asm volatile("s_waitcnt vmcnt(0) lgkmcnt(0)" ::: "memory"); __syncthreads(); \
        grid.sync(); \
        if (threadIdx.x < 64) { __builtin_amdgcn_fence(__ATOMIC_ACQUIRE, "agent"); asm volatile("s_waitcnt vmcnt(0)" ::: "memory"); } \
        __syncthreads(); } } while (0)
#define RUNS(ph) (p.ph_lo <= (ph) && (ph) < p.ph_hi)
    if (RUNS(0)) { p0_prologue(p, lds); SEAM(0); }
    if (RUNS(1)) {
        SchedP1 S; S.G = G; S.c = c; S.A = (const char*)(p.ws + WS_HA); S.Bt = (const char*)(p.ws + WS_WT1);
        EpiP1 E; E.proj = (bf16_t*)(p.ws + WS_PROJ9); E.gate = (bf16_t*)(p.ws + WS_GATE); E.F = (float*)(p.ws + WS_F); E.lb = (const float*)(p.ws + WS_LB);
        E.b_gate = p.b_gate; E.out = p.out; E.mkb = (bf16_t*)(p.ws + WS_MKB); E.mvt = (bf16_t*)(p.ws + WS_MVT);
        pg8::gemm_phase(lds, 2048, S, E); SEAM(1);
    }
    if (RUNS(2)) { p2_mixers(p, lds); SEAM(2); }
    if (RUNS(3)) { hgrn_norm_rows(p); SEAM(3); }
    if (RUNS(4)) {
        SchedP4 S; S.G = G; S.c = c; S.A = (const char*)(p.ws + WS_ACT3); S.Bt = (const char*)(p.ws + WS_WT3);
        EpiP4 E; E.gate = (const bf16_t*)(p.ws + WS_GATE); E.merged = (bf16_t*)(p.ws + WS_MERGED);
        pg8::gemm_phase(lds, 1024, S, E); SEAM(4);
    }
    if (RUNS(5)) {
        SchedP5 S; S.G = G; S.c = c; S.A = (const char*)(p.ws + WS_MERGED); S.Bt = (const char*)(p.ws + WS_WTO);
        EpiP5 E; E.xp = p.x_prompt; E.xs = p.x_sample; E.out = p.out;
        pg8::gemm_phase(lds, 2048, S, E); SEAM(5);
    }
    if (RUNS(6)) { p6_final_norm(p); }
#undef RUNS
#undef SEAM
}

extern "C" void kernel_launch(void* const* d_in, const int* in_sizes, int n_in, void* d_out, int out_size, void* d_ws, size_t ws_size, hipStream_t stream) {
    static int grid = 0;
    if (grid == 0) {
        if (n_in != 23 || ws_size < WS_END) { fprintf(stderr, "kernel_launch: expected 23 inputs and >= %zu bytes of workspace, got %d / %zu\n", (size_t)WS_END, n_in, ws_size); grid = -1; return; }
        int dev = 0, cus = 0, per_cu = 0;
        hipGetDevice(&dev); hipDeviceGetAttribute(&cus, hipDeviceAttributeMultiprocessorCount, dev);
        if (hipFuncSetAttribute((const void*)fwd_megakernel, hipFuncAttributeMaxDynamicSharedMemorySize, LDS_BYTES) != hipSuccess) { fprintf(stderr, "kernel_launch: hipFuncSetAttribute failed\n"); grid = -1; return; }
        if (hipOccupancyMaxActiveBlocksPerMultiprocessor(&per_cu, (const void*)fwd_megakernel, 512, LDS_BYTES) != hipSuccess || per_cu < 1) { fprintf(stderr, "kernel_launch: occupancy query failed (%d)\n", per_cu); (void)hipGetLastError(); per_cu = 1; }
        grid = cus * 1;
        if (grid <= 0) grid = 256;
    }
    if (grid < 0) return;
    Params p{};
    const float** pp = (const float**)&p;
    for (int i = 0; i < 23; ++i) pp[i] = (const float*)d_in[i];
    p.out = (float*)d_out; p.ws = (unsigned char*)d_ws; p.pad = 31;
#if N_LAUNCH_MODE == 1
    p.ph_lo = 0; p.ph_hi = N_PHASES; p.coop = 1;
    void* args[] = {&p};
    hipError_t e = hipLaunchCooperativeKernel((const void*)fwd_megakernel, dim3(grid), dim3(512), args, LDS_BYTES, stream);
    if (e != hipSuccess) fprintf(stderr, "cooperative launch failed: %s (grid %d)\n", hipGetErrorString(e), grid);
#else
    for (int ph = 0; ph < N_PHASES; ++ph) {
        p.ph_lo = ph; p.ph_hi = ph + 1; p.coop = 0;
        hipLaunchKernelGGL(fwd_megakernel, dim3(grid), dim3(512), LDS_BYTES, stream, p);
        if ((REP_MASK >> ph) & 1) { if (ph == 2) p.pad = P2_SUBMASK; hipLaunchKernelGGL(fwd_megakernel, dim3(grid), dim3(512), LDS_BYTES, stream, p); p.pad = 31; }
    }
#endif
}
```

```cpp
#include <hip/hip_runtime.h>
#include <hip/hip_cooperative_groups.h>
#include <cstdio>
namespace cg = cooperative_groups;

#define LAS __attribute__((address_space(3)))
typedef unsigned short bf16_t;
typedef short bf16x8 __attribute__((ext_vector_type(8)));
typedef float f32x4 __attribute__((ext_vector_type(4)));
typedef float f32x2 __attribute__((ext_vector_type(2)));
typedef unsigned u32x4 __attribute__((ext_vector_type(4)));
typedef unsigned u32x2 __attribute__((ext_vector_type(2)));

#ifndef REP_MASK
#define REP_MASK 0
#endif
#ifndef P2_SUBMASK
#define P2_SUBMASK 31
#endif
#ifndef N_LAUNCH_MODE
#define N_LAUNCH_MODE 1
#endif

constexpr int DM = 2048, NTP = 8192, NTS = 1024, NTOK = 9216, SEQ = 2048;
constexpr int LDP = 9216;
constexpr int C_CV = 0, C_CG = 1024, C_CS = 2048, C_HQ = 3072, C_HF = 4096, C_HI = 5120, C_HOG = 6144, C_AQ = 7168, C_AS = 8192;
constexpr int LDG = 6144;
constexpr float EPS = 1e-6f;
constexpr size_t O_YP = 0, O_YS = 16777216, O_CONV_P = 18874368, O_HGRN_P = 18997248, O_MK = 19521536, O_MV = 20570112, O_CONV_S = 21618688, O_HGRN_S = 25550848;
constexpr size_t WS_WT1 = 0;
constexpr size_t WS_WT3 = WS_WT1 + (size_t)17408 * 2048 * 2;
constexpr size_t WS_WTO = WS_WT3 + (size_t)3 * 2048 * 1024 * 2;
constexpr size_t WS_HA = WS_WTO + (size_t)2048 * 2048 * 2;
constexpr size_t WS_ORAW = WS_HA;
constexpr size_t WS_PROJ9 = WS_HA + (size_t)10240 * 2048 * 2;
constexpr size_t WS_MF = WS_PROJ9;
constexpr size_t WS_MERGED = WS_MF + (size_t)9216 * 2048 * 4;
constexpr size_t WS_GATE = WS_PROJ9 + (size_t)9216 * 9216 * 2;
constexpr size_t WS_F = WS_GATE + (size_t)9216 * 6144 * 2;
constexpr size_t WS_MKB = WS_F + (size_t)9216 * 1024 * 4;
constexpr size_t WS_MVT = WS_MKB + (size_t)2097152;
constexpr size_t WS_ACT3 = WS_MVT + (size_t)2097152;
constexpr size_t WS_LB = WS_ACT3 + (size_t)3 * 9216 * 1024 * 2;
constexpr size_t WS_END = WS_LB + 4096;
constexpr int LDS_BYTES = 131072;
constexpr int N_PHASES = 7;

struct Params {
    const float *x_prompt, *x_sample, *state_conv, *state_hgrn, *cache_k, *cache_v, *mem_prompt, *g_pre, *w_in, *conv_w, *conv_b, *ln_g, *ln_b,
        *w_conv_out, *lb_logits, *g_hgrn, *w_hgrn_out, *g_mem, *w_mem_kv, *w_attn_out, *b_gate, *w_out, *g_final;
    float* out; unsigned char* ws; int ph_lo, ph_hi, coop, pad;
};

__device__ __forceinline__ unsigned f2bf(float f) { unsigned u = __builtin_bit_cast(unsigned, f); return (u + 0x7fffu + ((u >> 16) & 1u)) >> 16; }
typedef __bf16 bf16x2_t __attribute__((ext_vector_type(2)));
__device__ __forceinline__ unsigned pk2(float lo, float hi) { const f32x2 v = {lo, hi}; const bf16x2_t r = __builtin_convertvector(v, bf16x2_t); return __builtin_bit_cast(unsigned, r); }
__device__ __forceinline__ float bflo(unsigned w) { return __builtin_bit_cast(float, w << 16); }
__device__ __forceinline__ float bfhi(unsigned w) { return __builtin_bit_cast(float, w & 0xffff0000u); }
__device__ __forceinline__ float bf2f(unsigned short b) { return __builtin_bit_cast(float, ((unsigned)b) << 16); }
__device__ __forceinline__ float sigm(float x) { return __builtin_amdgcn_rcpf(1.f + __expf(-x)); }
__device__ __forceinline__ float siluf(float x) { return x * sigm(x); }
__device__ __forceinline__ float wave_sum(float v) {
#pragma unroll
    for (int o = 1; o < 64; o <<= 1) v += __shfl_xor(v, o);
    return v;
}
__device__ __forceinline__ float wave_max(float v) {
#pragma unroll
    for (int o = 1; o < 64; o <<= 1) v = fmaxf(v, __shfl_xor(v, o));
    return v;
}

namespace pg8 {
constexpr int BM = 256, BK = 64, HALF = 128, HTB = HALF * BK * 2, STAGE_BYTES = 8 * HTB, NXCD = 8, WGM = 8;
__host__ __device__ __forceinline__ int lds_byte(int r, int c) { const int st = (r >> 4) * 2 + (c >> 5), rr = r & 15, cc = c & 31, ob = rr * 64 + cc * 2; return st * 1024 + (ob ^ (((ob >> 9) & 1) << 5)); }
__host__ __device__ __forceinline__ void stage_rc(int b, int& R, int& C) { const int st = b / 1024, sb = b % 1024, swz = sb ^ (((sb >> 9) & 1) << 5); R = (st >> 1) * 16 + swz / 64; C = (st & 1) * 32 + (swz % 64) / 2; }
__host__ __device__ __forceinline__ int perm32(int rho) { const int n = rho >> 4, i = rho & 15; return 8 * (i >> 2) + 4 * n + (i & 3); }
struct Unit { int pm, pn, br; };
__device__ __forceinline__ void tile_of(int wgid, int nM, int nN, int& pm, int& pn) {
    const int nwg = nM * nN;
    { const int q = nwg / NXCD, r = nwg % NXCD, xcd = wgid % NXCD, off = wgid / NXCD; wgid = (xcd < r ? xcd * (q + 1) : r * (q + 1) + (xcd - r) * q) + off; }
    const int nig = WGM * nN, gid = wgid / nig, fm = gid * WGM, gsz = (nM - fm) < WGM ? (nM - fm) : WGM;
    pm = fm + ((wgid % nig) % gsz); pn = (wgid % nig) / gsz;
}

template <class Epi, class Sched>
__device__ __forceinline__ void gemm_phase(LAS unsigned char* lds, const int K, const Sched& S, const Epi& E) {
    const int tid = threadIdx.x, wid = __builtin_amdgcn_readfirstlane(tid >> 6), lane = tid & 63, wr = wid >> 2, wc = wid & 3, fr = lane & 15, fq = lane >> 4;
    const int nt = K / BK;
    unsigned voffA[2], voffB[2];
#pragma unroll
    for (int i = 0; i < 2; ++i) { int R, C; stage_rc(tid * 16 + i * 8192, R, C); const int Rb = (R & ~31) + perm32(R & 31);
        voffA[i] = (unsigned)(R * K + C) * 2u; voffB[i] = (unsigned)(Rb * K + C) * 2u; }
    const size_t kstep = (size_t)(BK * 2);
    const size_t hstep = (size_t)HALF * K * 2;
    const unsigned ldsw = (unsigned)wid * 1024u;
    const int aoff = lds_byte(wr * 64 + fr, fq * 8), boff = lds_byte(wc * 32 + fr, fq * 8);
#define PG8_SA(b, h) (((b) * 2 + (h)) * HTB)
#define PG8_SB(b, h) ((4 + (b) * 2 + (h)) * HTB)
#define PG8_STAGE(bufoff, gbase, voff) do { _Pragma("unroll") for (int _i = 0; _i < 2; ++_i) \
        __builtin_amdgcn_global_load_lds((const unsigned*)((const char*)(gbase) + (voff)[_i]), (LAS unsigned*)(lds + (bufoff) + ldsw + _i * 8192), 16, 0, 0); } while (0)
#define PG8_LDA(dst, b, h) do { _Pragma("unroll") for (int m = 0; m < 4; ++m) _Pragma("unroll") for (int k = 0; k < 2; ++k) dst[m][k] = *(const LAS bf16x8*)(lds + PG8_SA(b, h) + aoff + m * 2048 + k * 1024); } while (0)
#define PG8_LDB(dst, b, h) do { _Pragma("unroll") for (int n = 0; n < 2; ++n) _Pragma("unroll") for (int k = 0; k < 2; ++k) dst[n][k] = *(const LAS bf16x8*)(lds + PG8_SB(b, h) + boff + n * 2048 + k * 1024); } while (0)
#define PG8_MMA(ai, bj, At, Bt) do { __builtin_amdgcn_s_setprio(1); _Pragma("unroll") for (int m = 0; m < 4; ++m) _Pragma("unroll") for (int n = 0; n < 2; ++n) _Pragma("unroll") for (int k = 0; k < 2; ++k) \
        acc[ai][bj][m][n] = __builtin_amdgcn_mfma_f32_16x16x32_bf16(Bt[n][k], At[m][k], acc[ai][bj][m][n], 0, 0, 0); __builtin_amdgcn_s_setprio(0); } while (0)
#define PG8_WAIT_V(n) asm volatile("s_waitcnt vmcnt(" #n ")" ::: "memory")
#define PG8_WAIT_L(n) asm volatile("s_waitcnt lgkmcnt(" #n ")" ::: "memory")
#define PG8_BAR __builtin_amdgcn_s_barrier()
#define PG8_SCHED __builtin_amdgcn_sched_barrier(0)
    Unit cur, nxt; int ui = 0;
    if (!S.next(0, cur)) return;
    f32x4 acc[2][2][4][2];
#pragma unroll
    for (int a = 0; a < 2; ++a)
#pragma unroll
        for (int b = 0; b < 2; ++b)
#pragma unroll
            for (int m = 0; m < 4; ++m)
#pragma unroll
                for (int n = 0; n < 2; ++n) acc[a][b][m][n] = (f32x4){0.f, 0.f, 0.f, 0.f};
    bf16x8 At[4][2], B0[2][2], B1[2][2];
    const char* cA = S.a_base(cur); const char* cB = S.b_base(cur);
    PG8_STAGE(PG8_SB(0, 0), cB, voffB); PG8_STAGE(PG8_SA(0, 0), cA, voffA); PG8_STAGE(PG8_SB(0, 1), cB + hstep, voffB); PG8_STAGE(PG8_SA(0, 1), cA + hstep, voffA);
    if (wr == 1) PG8_BAR;
    PG8_WAIT_V(4); PG8_BAR;
    PG8_STAGE(PG8_SB(1, 0), cB + kstep, voffB); PG8_STAGE(PG8_SA(1, 0), cA + kstep, voffA); PG8_STAGE(PG8_SB(1, 1), cB + hstep + kstep, voffB);
    PG8_WAIT_V(6); PG8_BAR;
    for (;;) {
        const bool has_next = S.next(ui + 1, nxt);
        const char* nA = has_next ? S.a_base(nxt) : cA; const char* nB = has_next ? S.b_base(nxt) : cB;
        for (int t = 0; t < nt; t += 2) {
            const bool last = (t == nt - 2);
            const char* a1 = cA + (size_t)(t + 1) * kstep;
            const char* a2 = last ? nA : cA + (size_t)(t + 2) * kstep; const char* b2 = last ? nB : cB + (size_t)(t + 2) * kstep;
            const char* a3 = a2 + kstep; const char* b3 = b2 + kstep;
            PG8_LDB(B0, 0, 0); PG8_SCHED; PG8_LDA(At, 0, 0); PG8_STAGE(PG8_SA(1, 1), a1 + hstep, voffA);
            PG8_WAIT_L(8); PG8_BAR; PG8_WAIT_L(0); PG8_MMA(0, 0, At, B0); PG8_BAR; PG8_SCHED;
            PG8_LDB(B1, 0, 1); PG8_STAGE(PG8_SB(0, 0), b2, voffB);
            PG8_BAR; PG8_WAIT_L(0); PG8_MMA(0, 1, At, B1); PG8_BAR;
            PG8_LDA(At, 0, 1); PG8_STAGE(PG8_SA(0, 0), a2, voffA);
            PG8_BAR; PG8_WAIT_L(0); PG8_MMA(1, 0, At, B0); PG8_BAR; PG8_SCHED;
            PG8_STAGE(PG8_SB(0, 1), b2 + hstep, voffB);
            PG8_WAIT_V(6); PG8_BAR; PG8_MMA(1, 1, At, B1); PG8_BAR;
            PG8_LDB(B0, 1, 0); PG8_SCHED; PG8_LDA(At, 1, 0); PG8_STAGE(PG8_SA(0, 1), a2 + hstep, voffA);
            PG8_WAIT_L(8); PG8_BAR; PG8_WAIT_L(0); PG8_MMA(0, 0, At, B0); PG8_BAR; PG8_SCHED;
            PG8_LDB(B1, 1, 1); PG8_STAGE(PG8_SB(1, 0), b3, voffB);
            PG8_BAR; PG8_WAIT_L(0); PG8_MMA(0, 1, At, B1); PG8_BAR;
            PG8_LDA(At, 1, 1); PG8_STAGE(PG8_SA(1, 0), a3, voffA);
            PG8_BAR; PG8_WAIT_L(0); PG8_MMA(1, 0, At, B0); PG8_BAR; PG8_SCHED;
            PG8_STAGE(PG8_SB(1, 1), b3 + hstep, voffB);
            PG8_WAIT_V(6); PG8_BAR; PG8_MMA(1, 1, At, B1); PG8_BAR;
        }
        const bool keep = E(acc, cur, wr, wc, fr, fq);
        if (!has_next) break;
        if (!keep)
#pragma unroll
        for (int a = 0; a < 2; ++a)
#pragma unroll
            for (int b = 0; b < 2; ++b)
#pragma unroll
                for (int m = 0; m < 4; ++m)
#pragma unroll
                    for (int n = 0; n < 2; ++n) acc[a][b][m][n] = (f32x4){0.f, 0.f, 0.f, 0.f};
        cur = nxt; cA = nA; cB = nB; ++ui;
    }
    PG8_WAIT_V(0);
    if (wr == 0) PG8_BAR;
    PG8_BAR;
#undef PG8_SA
#undef PG8_SB
#undef PG8_STAGE
#undef PG8_LDA
#undef PG8_LDB
#undef PG8_MMA
#undef PG8_WAIT_V
#undef PG8_WAIT_L
#undef PG8_BAR
#undef PG8_SCHED
}
}
using pg8::Unit;

struct SchedP1 {
    int G, c; const char* A; const char* Bt;
    __device__ __forceinline__ bool next(int i, Unit& u) const {
        const int L = i * G + c; if (L >= 2192) return false;
        u.br = 0;
        if (L >= 2160) { const int idx = L - 2160; u.pm = 36 + (idx >> 3); u.pn = 60 + (idx & 7); return true; }
        pg8::tile_of(L, 36, 60, u.pm, u.pn); return true;
    }
    __device__ __forceinline__ const char* a_base(const Unit& u) const { return A + (size_t)u.pm * (256 * 2048 * 2); }
    __device__ __forceinline__ const char* b_base(const Unit& u) const { return Bt + (size_t)u.pn * (256 * 2048 * 2); }
};
struct EpiP1 {
    bf16_t* proj; bf16_t* gate; float* F; const float* lb; const float* b_gate; float* out; bf16_t* mkb; bf16_t* mvt;
    __device__ __forceinline__ bool operator()(f32x4 (&acc)[2][2][4][2], const Unit& u, int wr, int wc, int fr, int fq) const {
        const int rloc = wr * 64 + fr, cloc = wc * 32 + 8 * fq;
        if (u.pn < 36) {
            const int seg = u.pn >> 2;
#pragma unroll
            for (int bj = 0; bj < 2; ++bj) {
                const int col = u.pn * 256 + bj * 128 + cloc;
                f32x4 l0 = (f32x4){0.f, 0.f, 0.f, 0.f}, l1 = l0;
                if (seg == 4) { l0 = *(const f32x4*)(lb + (col - C_HF)); l1 = *(const f32x4*)(lb + (col - C_HF) + 4); }
#pragma unroll
                for (int ai = 0; ai < 2; ++ai)
#pragma unroll
                    for (int m = 0; m < 4; ++m) {
                        const size_t row = (size_t)u.pm * 256 + ai * 128 + m * 16 + rloc;
                        f32x4 v0 = acc[ai][bj][m][0], v1 = acc[ai][bj][m][1];
                        if (seg == 4) {
#pragma unroll
                            for (int e = 0; e < 4; ++e) { v0[e] = l0[e] + (1.f - l0[e]) * sigm(v0[e]); v1[e] = l1[e] + (1.f - l1[e]) * sigm(v1[e]); }
                            float* fp = F + row * 1024 + (col - C_HF);
                            *(f32x4*)fp = v0; *(f32x4*)(fp + 4) = v1;
                        } else {
                            if (seg == 1) {
#pragma unroll
                                for (int e = 0; e < 4; ++e) { v0[e] = sigm(v0[e]); v1[e] = sigm(v1[e]); }
                            } else if (seg == 2 || seg == 6 || seg == 8) {
#pragma unroll
                                for (int e = 0; e < 4; ++e) { v0[e] = siluf(v0[e]); v1[e] = siluf(v1[e]); }
                            } else if (seg == 3) { v0 *= 0.08838834764831845f; v1 *= 0.08838834764831845f; }
                            else if (seg == 7) { v0 *= 0.0625f; v1 *= 0.0625f; }
                            u32x4 o; o.x = pk2(v0[0], v0[1]); o.y = pk2(v0[2], v0[3]); o.z = pk2(v1[0], v1[1]); o.w = pk2(v1[2], v1[3]);
                            *(u32x4*)(proj + row * LDP + col) = o;
                        }
                    }
            }
        } else if (u.pn < 60) {
#pragma unroll
            for (int bj = 0; bj < 2; ++bj) {
                const int col = (u.pn - 36) * 256 + bj * 128 + cloc;
                const f32x4 b0 = *(const f32x4*)(b_gate + col), b1 = *(const f32x4*)(b_gate + col + 4);
#pragma unroll
                for (int ai = 0; ai < 2; ++ai)
#pragma unroll
                    for (int m = 0; m < 4; ++m) {
                        const size_t row = (size_t)u.pm * 256 + ai * 128 + m * 16 + rloc;
                        f32x4 v0 = acc[ai][bj][m][0] + b0, v1 = acc[ai][bj][m][1] + b1;
#pragma unroll
                        for (int e = 0; e < 4; ++e) { v0[e] = fmaxf(sigm(v0[e]), 1e-6f); v1[e] = fmaxf(sigm(v1[e]), 1e-6f); }
                        u32x4 o; o.x = pk2(v0[0], v0[1]); o.y = pk2(v0[2], v0[3]); o.z = pk2(v1[0], v1[1]); o.w = pk2(v1[2], v1[3]);
                        *(u32x4*)(gate + row * LDG + col) = o;
                    }
            }
        } else {
            const int n = u.pm - 36, isv = (u.pn >= 64) ? 1 : 0, h = (u.pn - 60) & 3;
            float* ob = out + (isv ? O_MV : O_MK);
#pragma unroll
            for (int bj = 0; bj < 2; ++bj) {
                const int d = bj * 128 + cloc;
#pragma unroll
                for (int ai = 0; ai < 2; ++ai)
#pragma unroll
                    for (int m = 0; m < 4; ++m) {
                        const int key = ai * 128 + m * 16 + rloc;
                        const f32x4 v0 = acc[ai][bj][m][0], v1 = acc[ai][bj][m][1];
                        float* op = ob + ((size_t)(n * 256 + key) * 4 + h) * 256 + d;
                        *(f32x4*)op = v0; *(f32x4*)(op + 4) = v1;
                        if (!isv) {
                            u32x4 o; o.x = pk2(v0[0], v0[1]); o.y = pk2(v0[2], v0[3]); o.z = pk2(v1[0], v1[1]); o.w = pk2(v1[2], v1[3]);
                            *(u32x4*)(mkb + ((size_t)(n * 4 + h) * 256 + key) * 256 + d) = o;
                        } else {
                            bf16_t* vp = mvt + ((size_t)(n * 4 + h) * 256 + d) * 256 + key;
#pragma unroll
                            for (int e = 0; e < 4; ++e) { vp[(size_t)e * 256] = (bf16_t)f2bf(v0[e]); vp[(size_t)(e + 4) * 256] = (bf16_t)f2bf(v1[e]); }
                        }
                    }
            }
        }
        return false;
    }
};

struct SchedP4 {
    int G, c; const char* A; const char* Bt;
    __device__ __forceinline__ bool next(int i, Unit& u) const {
        const int tri = i / 3, L = tri * G + c; if (L >= 288) return false;
        u.br = i - tri * 3; pg8::tile_of(L, 36, 8, u.pm, u.pn); return true;
    }
    __device__ __forceinline__ const char* a_base(const Unit& u) const { return A + (size_t)u.br * ((size_t)9216 * 1024 * 2) + (size_t)u.pm * (256 * 1024 * 2); }
    __device__ __forceinline__ const char* b_base(const Unit& u) const { return Bt + (size_t)u.br * ((size_t)2048 * 1024 * 2) + (size_t)u.pn * (256 * 1024 * 2); }
};
struct EpiP4 {
    const bf16_t* gate; bf16_t* merged;
    __device__ __forceinline__ bool operator()(f32x4 (&acc)[2][2][4][2], const Unit& u, int wr, int wc, int fr, int fq) const {
        const int rloc = wr * 64 + fr, cloc = wc * 32 + 8 * fq;
#pragma unroll
        for (int bj = 0; bj < 2; ++bj) {
            const int col = u.pn * 256 + bj * 128 + cloc;
#pragma unroll
            for (int ai = 0; ai < 2; ++ai)
#pragma unroll
                for (int m = 0; m < 4; ++m) {
                    const size_t row = (size_t)u.pm * 256 + ai * 128 + m * 16 + rloc;
                    const bf16_t* gp = gate + row * LDG + u.br * 2048 + col;
                    const u32x4 g = *(const u32x4*)gp;
                    f32x4 s0 = (f32x4){bflo(g.x), bfhi(g.x), bflo(g.y), bfhi(g.y)}, s1 = (f32x4){bflo(g.z), bfhi(g.z), bflo(g.w), bfhi(g.w)};
                    if (u.br < 2) {
                        const u32x4 h = *(const u32x4*)(gp + 2048);
                        s0[0] *= __builtin_amdgcn_rcpf(bflo(h.x)); s0[1] *= __builtin_amdgcn_rcpf(bfhi(h.x)); s0[2] *= __builtin_amdgcn_rcpf(bflo(h.y)); s0[3] *= __builtin_amdgcn_rcpf(bfhi(h.y));
                        s1[0] *= __builtin_amdgcn_rcpf(bflo(h.z)); s1[1] *= __builtin_amdgcn_rcpf(bfhi(h.z)); s1[2] *= __builtin_amdgcn_rcpf(bflo(h.w)); s1[3] *= __builtin_amdgcn_rcpf(bfhi(h.w));
                    }
                    acc[ai][bj][m][0] *= s0; acc[ai][bj][m][1] *= s1;
                    if (u.br == 2) { const f32x4 v0 = acc[ai][bj][m][0], v1 = acc[ai][bj][m][1];
                        u32x4 o; o.x = pk2(v0[0], v0[1]); o.y = pk2(v0[2], v0[3]); o.z = pk2(v1[0], v1[1]); o.w = pk2(v1[2], v1[3]);
                        *(u32x4*)(merged + row * 2048 + col) = o; }
                }
        }
        return u.br < 2;
    }
};

struct SchedP5 {
    int G, c; const char* A; const char* Bt;
    __device__ __forceinline__ bool next(int i, Unit& u) const {
        const int L = i * G + c; if (L >= 288) return false;
        u.br = 0; pg8::tile_of(L, 36, 8, u.pm, u.pn); return true;
    }
    __device__ __forceinline__ const char* a_base(const Unit& u) const { return A + (size_t)u.pm * (256 * 2048 * 2); }
    __device__ __forceinline__ const char* b_base(const Unit& u) const { return Bt + (size_t)u.pn * (256 * 2048 * 2); }
};
struct EpiP5 {
    const float* xp; const float* xs; float* out;
    __device__ __forceinline__ bool operator()(f32x4 (&acc)[2][2][4][2], const Unit& u, int wr, int wc, int fr, int fq) const {
        const int rloc = wr * 64 + fr, cloc = wc * 32 + 8 * fq;
#pragma unroll
        for (int bj = 0; bj < 2; ++bj) {
            const int col = u.pn * 256 + bj * 128 + cloc;
#pragma unroll
            for (int ai = 0; ai < 2; ++ai)
#pragma unroll
                for (int m = 0; m < 4; ++m) {
                    const size_t row = (size_t)u.pm * 256 + ai * 128 + m * 16 + rloc;
                    const float* xr = (row < (size_t)NTP) ? (xp + row * 2048 + col) : (xs + (row - NTP) * 2048 + col);
                    const f32x4 v0 = acc[ai][bj][m][0] + *(const f32x4*)xr, v1 = acc[ai][bj][m][1] + *(const f32x4*)(xr + 4);
                    float* op = out + row * 2048 + col;
                    *(f32x4*)op = v0; *(f32x4*)(op + 4) = v1;
                }
        }
        return false;
    }
};

struct EpiNull {
    __device__ __forceinline__ bool operator()(f32x4 (&acc)[2][2][4][2], const Unit& u, int wr, int wc, int fr, int fq) const {
        f32x4 t = (f32x4){0.f, 0.f, 0.f, 0.f};
#pragma unroll
        for (int ai = 0; ai < 2; ++ai)
#pragma unroll
            for (int bj = 0; bj < 2; ++bj)
#pragma unroll
                for (int m = 0; m < 4; ++m) t += acc[ai][bj][m][0] + acc[ai][bj][m][1];
        asm volatile("" :: "v"(t[0]), "v"(t[1]), "v"(t[2]), "v"(t[3]));
        return false;
    }
};
__device__ __forceinline__ void transpose_tile(const float* W, int K, int N, bf16_t* WT, int row_off, int kb, int nb, LAS unsigned* T32, int tid) {
    const int nq = tid & 31, kp0 = tid >> 5;
#pragma unroll
    for (int i = 0; i < 4; ++i) {
        const int kpair = kp0 + 16 * i;
        const float* src = W + (size_t)(kb * 128 + 2 * kpair) * N + nb * 128 + 4 * nq;
        const f32x4 r0 = *(const f32x4*)src, r1 = *(const f32x4*)(src + N);
        T32[(4 * nq + 0) * 65 + kpair] = pk2(r0[0], r1[0]); T32[(4 * nq + 1) * 65 + kpair] = pk2(r0[1], r1[1]);
        T32[(4 * nq + 2) * 65 + kpair] = pk2(r0[2], r1[2]); T32[(4 * nq + 3) * 65 + kpair] = pk2(r0[3], r1[3]);
    }
    __syncthreads();
#pragma unroll
    for (int i = 0; i < 4; ++i) {
        const int id = tid + 512 * i, n = id >> 4, c = id & 15;
        u32x4 o; o.x = T32[n * 65 + 4 * c]; o.y = T32[n * 65 + 4 * c + 1]; o.z = T32[n * 65 + 4 * c + 2]; o.w = T32[n * 65 + 4 * c + 3];
        *(u32x4*)(WT + (size_t)(row_off + nb * 128 + n) * K + kb * 128 + 8 * c) = o;
    }
    __syncthreads();
}
__device__ __forceinline__ void rms_row_to_bf16(const float* xrow, const float* g, bf16_t* orow, int lane) {
    f32x4 v[8]; float ss = 0.f;
#pragma unroll
    for (int j = 0; j < 8; ++j) { v[j] = ((const f32x4*)xrow)[lane + 64 * j]; ss += (v[j][0] * v[j][0] + v[j][1] * v[j][1]) + (v[j][2] * v[j][2] + v[j][3] * v[j][3]); }
    ss = wave_sum(ss);
    const float rinv = rsqrtf(ss * (1.f / 2048.f) + EPS);
#pragma unroll
    for (int j = 0; j < 8; ++j) { const f32x4 gg = ((const f32x4*)g)[lane + 64 * j];
        u32x2 o; o.x = pk2(v[j][0] * rinv * gg[0], v[j][1] * rinv * gg[1]); o.y = pk2(v[j][2] * rinv * gg[2], v[j][3] * rinv * gg[3]);
        ((u32x2*)orow)[lane + 64 * j] = o; }
}
__device__ __forceinline__ void p0_prologue(const Params& p, LAS unsigned char* lds) {
    const int tid = threadIdx.x, lane = tid & 63, wave = tid >> 6, G = gridDim.x, c = blockIdx.x;
    LAS unsigned* T32 = (LAS unsigned*)lds;
    bf16_t* WT1 = (bf16_t*)(p.ws + WS_WT1); bf16_t* WT3 = (bf16_t*)(p.ws + WS_WT3); bf16_t* WTO = (bf16_t*)(p.ws + WS_WTO);
    constexpr int T_IN = 1920, T_MKV = 256, T_BR = 128, T_OUT = 256, T_ALL = T_IN + T_MKV + 3 * T_BR + T_OUT;
    for (int it = c; it < T_ALL; it += G) {
        int r = it;
        if (r < T_IN) { transpose_tile(p.w_in, 2048, 15360, WT1, 0, r / 120, r % 120, T32, tid); continue; } r -= T_IN;
        if (r < T_MKV) { transpose_tile(p.w_mem_kv, 2048, 2048, WT1, 15360, r / 16, r % 16, T32, tid); continue; } r -= T_MKV;
        if (r < T_BR) { transpose_tile(p.w_conv_out, 1024, 2048, WT3, 0, r / 16, r % 16, T32, tid); continue; } r -= T_BR;
        if (r < T_BR) { transpose_tile(p.w_hgrn_out, 1024, 2048, WT3 + (size_t)2048 * 1024, 0, r / 16, r % 16, T32, tid); continue; } r -= T_BR;
        if (r < T_BR) { transpose_tile(p.w_attn_out, 1024, 2048, WT3 + (size_t)2 * 2048 * 1024, 0, r / 16, r % 16, T32, tid); continue; } r -= T_BR;
        transpose_tile(p.w_out, 2048, 2048, WTO, 0, r / 16, r % 16, T32, tid);
    }
    bf16_t* HA = (bf16_t*)(p.ws + WS_HA);
    const int gw = c * 8 + wave, NGW = G * 8;
    for (int m = gw; m < 10240; m += NGW) {
        if (m < NTP) rms_row_to_bf16(p.x_prompt + (size_t)m * 2048, p.g_pre, HA + (size_t)m * 2048, lane);
        else if (m < NTOK) rms_row_to_bf16(p.x_sample + (size_t)(m - NTP) * 2048, p.g_pre, HA + (size_t)m * 2048, lane);
        else rms_row_to_bf16(p.mem_prompt + (size_t)(m - NTOK) * 2048, p.g_mem, HA + (size_t)m * 2048, lane);
    }
    if (c == 0) { float* LB = (float*)(p.ws + WS_LB);
        for (int i = tid; i < 1024; i += 512) LB[i] = 1.f / (1.f + __expf(p.lb_logits[1024 + i] - p.lb_logits[i])); }
}

__device__ __forceinline__ void hgrn_prompt_item(const Params& p, int item, LAS unsigned char* lds, int tid) {
    LAS float* qs = (LAS float*)lds;
    LAS float* fs = qs + 4096;
    LAS float* vs = fs + 4096;
    LAS float* part = vs + 512;
    const int s = item >> 3, n = s >> 3, h = s & 7, dvg = item & 7;
    const int vcol = tid & 15, kg = tid >> 4;
    const bf16_t* proj = (const bf16_t*)(p.ws + WS_PROJ9);
    const float* F = (const float*)(p.ws + WS_F);
    float* oraw = (float*)(p.ws + WS_ORAW);
    const size_t row0 = (size_t)n * SEQ;
    const bf16_t* qsrc = proj + (row0 + kg) * LDP + C_HQ + h * 128 + vcol * 8;
    const float* fsrc = F + (row0 + kg) * 1024 + h * 128 + vcol * 8;
    const bf16_t* vsrc = proj + (row0 + kg) * LDP + C_HI + h * 128 + dvg * 16 + vcol;
    f32x2 S01 = (f32x2){0.f, 0.f}, S23 = (f32x2){0.f, 0.f};
    u32x4 rq[4]; f32x4 rfa[4], rfb[4]; bf16_t rv[4];
#define HG_FETCH(R, tb) do { const size_t adv = (size_t)(tb); rq[R] = *(const u32x4*)(qsrc + adv * LDP); rfa[R] = *(const f32x4*)(fsrc + adv * 1024); \
        rfb[R] = *(const f32x4*)(fsrc + adv * 1024 + 4); rv[R] = *(vsrc + adv * LDP); } while (0)
#define HG_BATCH(R, tb) do { \
        { LAS float* qd = qs + kg * 128 + vcol * 8; \
          *(LAS f32x4*)qd = (f32x4){bflo(rq[R].x), bfhi(rq[R].x), bflo(rq[R].y), bfhi(rq[R].y)}; *(LAS f32x4*)(qd + 4) = (f32x4){bflo(rq[R].z), bfhi(rq[R].z), bflo(rq[R].w), bfhi(rq[R].w)}; \
          LAS float* fd = fs + kg * 128 + vcol * 8; *(LAS f32x4*)fd = rfa[R]; *(LAS f32x4*)(fd + 4) = rfb[R]; \
          vs[kg * 16 + vcol] = bf2f(rv[R]); } \
        __syncthreads(); \
        if ((tb) + 128 < SEQ) HG_FETCH(R, (tb) + 128); \
        f32x4 cf[4], cq[4]; float cv[4]; \
        _Pragma("unroll") for (int i = 0; i < 4; ++i) { cf[i] = *(const LAS f32x4*)(fs + i * 128 + kg * 4); cq[i] = *(const LAS f32x4*)(qs + i * 128 + kg * 4); cv[i] = vs[i * 16 + vcol]; } \
        _Pragma("unroll") for (int g = 0; g < 8; ++g) { \
            f32x4 nf[4], nq[4]; float nv[4]; \
            if (g < 7) { _Pragma("unroll") for (int i = 0; i < 4; ++i) { const int tt = (g + 1) * 4 + i; \
                nf[i] = *(const LAS f32x4*)(fs + tt * 128 + kg * 4); nq[i] = *(const LAS f32x4*)(qs + tt * 128 + kg * 4); nv[i] = vs[tt * 16 + vcol]; } } \
            _Pragma("unroll") for (int i = 0; i < 4; ++i) { \
                const f32x2 f01 = (f32x2){cf[i][0], cf[i][1]}, f23 = (f32x2){cf[i][2], cf[i][3]}, q01 = (f32x2){cq[i][0], cq[i][1]}, q23 = (f32x2){cq[i][2], cq[i][3]}; \
                const f32x2 vv = (f32x2){cv[i], cv[i]}; \
                S01 = f01 * (S01 - vv) + vv; S23 = f23 * (S23 - vv) + vv; \
                f32x2 t = S01 * q01; t = S23 * q23 + t; \
                part[(g * 4 + i) * 528 + tid] = t[0] + t[1]; } \
            if (g < 7) { _Pragma("unroll") for (int i = 0; i < 4; ++i) { cf[i] = nf[i]; cq[i] = nq[i]; cv[i] = nv[i]; } } } \
        __syncthreads(); \
        { float a = 0.f; \
          _Pragma("unroll 8") for (int k2 = 0; k2 < 32; ++k2) a += part[kg * 528 + k2 * 16 + vcol]; \
          oraw[(row0 + (tb) + kg) * 1024 + h * 128 + dvg * 16 + vcol] = a; } } while (0)
    HG_FETCH(0, 0); HG_FETCH(1, 32); HG_FETCH(2, 64); HG_FETCH(3, 96);
#pragma unroll 1
    for (int t0 = 0; t0 < SEQ; t0 += 128) { HG_BATCH(0, t0); HG_BATCH(1, t0 + 32); HG_BATCH(2, t0 + 64); HG_BATCH(3, t0 + 96); }
#undef HG_FETCH
#undef HG_BATCH
    float* so = p.out + O_HGRN_P + ((size_t)(n * 8 + h) * 128 + kg * 4) * 128 + dvg * 16 + vcol;
    so[0] = S01[0]; so[128] = S01[1]; so[256] = S23[0]; so[384] = S23[1];
    __syncthreads();
}

__device__ __forceinline__ void hgrn_sample_item(const Params& p, int item, LAS unsigned char* lds, int tid) {
    LAS float* qs = (LAS float*)lds;
    LAS float* fs = qs + 1024;
    LAS float* vs = fs + 1024;
    LAS float* opart = vs + 1024;
    const int n = item >> 3, h = item & 7, lane = tid & 63, wave = tid >> 6;
    const bf16_t* proj = (const bf16_t*)(p.ws + WS_PROJ9);
    const float* F = (const float*)(p.ws + WS_F);
    const size_t row0 = (size_t)NTP + (size_t)n * 8;
    { const int tt = tid >> 6, k2 = (tid & 63) * 2; const size_t r = row0 + tt;
      const unsigned qw = *(const unsigned*)(proj + r * LDP + C_HQ + h * 128 + k2); const f32x2 ff = *(const f32x2*)(F + r * 1024 + h * 128 + k2);
      const unsigned vw = *(const unsigned*)(proj + r * LDP + C_HI + h * 128 + k2);
      qs[tt * 128 + k2] = bflo(qw); qs[tt * 128 + k2 + 1] = bfhi(qw); fs[tt * 128 + k2] = ff[0]; fs[tt * 128 + k2 + 1] = ff[1];
      vs[tt * 128 + k2] = bflo(vw); vs[tt * 128 + k2 + 1] = bfhi(vw); }
    const int v4 = tid & 31, kg = tid >> 5;
    const size_t sbase = ((size_t)(n * 8 + h) * 128 + kg * 8) * 128 + v4 * 4;
    f32x4 S[8];
#pragma unroll
    for (int i = 0; i < 8; ++i) S[i] = *(const f32x4*)(p.state_hgrn + sbase + (size_t)i * 128);
    __syncthreads();
#pragma unroll
    for (int tt = 0; tt < 8; ++tt) {
        const f32x4 fa = *(const LAS f32x4*)(fs + tt * 128 + kg * 8), fb = *(const LAS f32x4*)(fs + tt * 128 + kg * 8 + 4);
        const f32x4 qa = *(const LAS f32x4*)(qs + tt * 128 + kg * 8), qb = *(const LAS f32x4*)(qs + tt * 128 + kg * 8 + 4);
        const f32x4 vv = *(const LAS f32x4*)(vs + tt * 128 + v4 * 4);
        f32x4 po = (f32x4){0.f, 0.f, 0.f, 0.f};
#pragma unroll
        for (int i = 0; i < 8; ++i) { const float f = (i < 4) ? fa[i & 3] : fb[i & 3], q = (i < 4) ? qa[i & 3] : qb[i & 3];
            S[i] = S[i] * f + vv * (1.f - f); po += S[i] * q; }
#pragma unroll
        for (int e = 0; e < 4; ++e) po[e] += __shfl_xor(po[e], 32);
        if (lane < 32) *(LAS f32x4*)(opart + (tt * 8 + wave) * 128 + v4 * 4) = po;
    }
    float* so = p.out + O_HGRN_S + sbase;
#pragma unroll
    for (int i = 0; i < 8; ++i) *(f32x4*)(so + (size_t)i * 128) = S[i];
    __syncthreads();
    { const int tt = tid >> 6, v = (tid & 63) * 2; float o0 = 0.f, o1 = 0.f;
#pragma unroll
      for (int w = 0; w < 8; ++w) { const f32x2 t = *(const LAS f32x2*)(opart + (tt * 8 + w) * 128 + v); o0 += t[0]; o1 += t[1]; }
      const float ss = wave_sum(o0 * o0 + o1 * o1), rinv = rsqrtf(ss * (1.f / 128.f) + EPS);
      const size_t r = row0 + tt; const f32x2 gg = *(const f32x2*)(p.g_hgrn + h * 128 + v);
      const unsigned gw = *(const unsigned*)(proj + r * LDP + C_HOG + h * 128 + v);
      bf16_t* og = (bf16_t*)(p.ws + WS_ACT3) + (size_t)9216 * 1024 + r * 1024 + h * 128 + v;
      *(unsigned*)og = pk2(o0 * rinv * gg[0] * bflo(gw), o1 * rinv * gg[1] * bfhi(gw)); }
    __syncthreads();
}

__device__ __forceinline__ void hgrn_norm_rows(const Params& p) {
    const int tid = threadIdx.x, lane = tid & 63, gw = blockIdx.x * 8 + (tid >> 6), NGW = gridDim.x * 8;
    const bf16_t* proj = (const bf16_t*)(p.ws + WS_PROJ9); const float* oraw = (const float*)(p.ws + WS_ORAW);
    bf16_t* og = (bf16_t*)(p.ws + WS_ACT3) + (size_t)9216 * 1024;
    for (int r = gw; r < NTP; r += NGW) {
        f32x4 o[4]; float ss = 0.f;
#pragma unroll
        for (int j = 0; j < 4; ++j) { o[j] = *(const f32x4*)(oraw + (size_t)r * 1024 + lane * 16 + j * 4); ss += (o[j][0] * o[j][0] + o[j][1] * o[j][1]) + (o[j][2] * o[j][2] + o[j][3] * o[j][3]); }
        ss += __shfl_xor(ss, 1); ss += __shfl_xor(ss, 2); ss += __shfl_xor(ss, 4);
        const float rinv = rsqrtf(ss * (1.f / 128.f) + EPS);
        const u32x4 ga = *(const u32x4*)(proj + (size_t)r * LDP + C_HOG + lane * 16), gb = *(const u32x4*)(proj + (size_t)r * LDP + C_HOG + lane * 16 + 8);
        f32x4 g[4];
#pragma unroll
        for (int j = 0; j < 4; ++j) g[j] = *(const f32x4*)(p.g_hgrn + lane * 16 + j * 4);
        u32x4 oa, ob;
        oa.x = pk2(o[0][0] * rinv * g[0][0] * bflo(ga.x), o[0][1] * rinv * g[0][1] * bfhi(ga.x)); oa.y = pk2(o[0][2] * rinv * g[0][2] * bflo(ga.y), o[0][3] * rinv * g[0][3] * bfhi(ga.y));
        oa.z = pk2(o[1][0] * rinv * g[1][0] * bflo(ga.z), o[1][1] * rinv * g[1][1] * bfhi(ga.z)); oa.w = pk2(o[1][2] * rinv * g[1][2] * bflo(ga.w), o[1][3] * rinv * g[1][3] * bfhi(ga.w));
        ob.x = pk2(o[2][0] * rinv * g[2][0] * bflo(gb.x), o[2][1] * rinv * g[2][1] * bfhi(gb.x)); ob.y = pk2(o[2][2] * rinv * g[2][2] * bflo(gb.y), o[2][3] * rinv * g[2][3] * bfhi(gb.y));
        ob.z = pk2(o[3][0] * rinv * g[3][0] * bflo(gb.z), o[3][1] * rinv * g[3][1] * bfhi(gb.z)); ob.w = pk2(o[3][2] * rinv * g[3][2] * bflo(gb.w), o[3][3] * rinv * g[3][3] * bfhi(gb.w));
        *(u32x4*)(og + (size_t)r * 1024 + lane * 16) = oa; *(u32x4*)(og + (size_t)r * 1024 + lane * 16 + 8) = ob;
    }
}

template <bool SAMPLE>
__device__ __forceinline__ void conv_item(const Params& p, int item, LAS unsigned char* lds, int tid) {
    constexpr int T = SAMPLE ? 8 : 32;
    constexpr int GP = 4, NG = (T + 32) / GP, G0 = 32 / GP;
    LAS float* dcs = (LAS float*)lds;
    const bf16_t* proj = (const bf16_t*)(p.ws + WS_PROJ9);
    const int n = SAMPLE ? item : (item >> 6), t0 = SAMPLE ? 0 : (item & 63) * 32;
    const size_t rowb = SAMPLE ? ((size_t)NTP + (size_t)n * 8) : ((size_t)n * SEQ);
    const int c0 = 2 * tid;
    float w0[31], w1[31], x0[31], x1[31];
#pragma unroll
    for (int j = 0; j < 31; ++j) { const f32x2 w = *(const f32x2*)(p.conv_w + j * 1024 + c0); w0[j] = w[0]; w1[j] = w[1]; x0[j] = 0.f; x1[j] = 0.f; }
    const f32x2 bias = *(const f32x2*)(p.conv_b + c0);
    unsigned ra[GP], rg[GP];
#define CONV_ISSUE(g) do { \
        if (SAMPLE && (g) < G0) { _Pragma("unroll") for (int i = 0; i < GP; ++i) { const int ti = -2 + GP * (g) + i; \
            const unsigned* tp = (const unsigned*)(p.state_conv + ((size_t)n * 30 + (ti < 0 ? 0 : ti)) * 1024 + c0); ra[i] = tp[0]; rg[i] = tp[1]; } } \
        else { _Pragma("unroll") for (int i = 0; i < GP; ++i) { const int t = t0 - 32 + GP * (g) + i; const bf16_t* rp = proj + (rowb + (t < 0 ? 0 : t)) * LDP + c0; \
            ra[i] = *(const unsigned*)(rp + C_CV); rg[i] = *(const unsigned*)(rp + C_CG); } } } while (0)
    CONV_ISSUE(0);
#pragma unroll 1
    for (int g = 0; g < NG; ++g) {
        float u0[GP], u1[GP];
        if (SAMPLE && g < G0) {
#pragma unroll
            for (int i = 0; i < GP; ++i) { const bool ok = (-2 + GP * g + i) >= 0; u0[i] = ok ? __builtin_bit_cast(float, ra[i]) : 0.f; u1[i] = ok ? __builtin_bit_cast(float, rg[i]) : 0.f; }
        } else {
#pragma unroll
            for (int i = 0; i < GP; ++i) { const bool ok = (t0 - 32 + GP * g + i) >= 0; u0[i] = ok ? bflo(ra[i]) * bflo(rg[i]) : 0.f; u1[i] = ok ? bfhi(ra[i]) * bfhi(rg[i]) : 0.f; }
        }
        if (g + 1 < NG) CONV_ISSUE(g + 1);
#pragma unroll
        for (int i = 0; i < GP; ++i) {
            const int pp = -32 + GP * g + i, t = t0 + pp;
            if (SAMPLE) { if (pp >= -22) *(f32x2*)(p.out + O_CONV_S + ((size_t)n * 30 + (pp + 22)) * 1024 + c0) = (f32x2){u0[i], u1[i]}; }
            else { if (t >= SEQ - 30) *(f32x2*)(p.out + O_CONV_P + ((size_t)n * 30 + (t - (SEQ - 30))) * 1024 + c0) = (f32x2){u0[i], u1[i]}; }
#pragma unroll
            for (int j = 0; j < 30; ++j) { x0[j] = x0[j + 1]; x1[j] = x1[j + 1]; }
            x0[30] = u0[i]; x1[30] = u1[i];
            if (g >= G0) {
                float d0 = bias[0], d1 = bias[1];
#pragma unroll
                for (int j = 0; j < 31; ++j) { d0 += w0[j] * x0[j]; d1 += w1[j] * x1[j]; }
                *(LAS f32x2*)(dcs + (pp) * 1024 + c0) = (f32x2){d0, d1};
            }
        }
    }
#undef CONV_ISSUE
    __syncthreads();
    { const int lane = tid & 63, wave = tid >> 6;
      bf16_t* aact = (bf16_t*)(p.ws + WS_ACT3);
      for (int pp = wave; pp < T; pp += 8) {
          f32x4 v[4]; float s = 0.f;
#pragma unroll
          for (int j = 0; j < 4; ++j) { v[j] = *(const LAS f32x4*)(dcs + pp * 1024 + j * 256 + lane * 4); s += (v[j][0] + v[j][1]) + (v[j][2] + v[j][3]); }
          const float mean = wave_sum(s) * (1.f / 1024.f); float s2 = 0.f;
#pragma unroll
          for (int j = 0; j < 4; ++j) { v[j] = v[j] - mean; s2 += (v[j][0] * v[j][0] + v[j][1] * v[j][1]) + (v[j][2] * v[j][2] + v[j][3] * v[j][3]); }
          const float rstd = rsqrtf(wave_sum(s2) * (1.f / 1024.f) + EPS);
          const size_t r = rowb + t0 + pp;
#pragma unroll
          for (int j = 0; j < 4; ++j) { const int c = j * 256 + lane * 4;
              const f32x4 lg = *(const f32x4*)(p.ln_g + c), lbv = *(const f32x4*)(p.ln_b + c);
              const u32x2 sg = *(const u32x2*)(proj + r * LDP + C_CS + c);
              const float y0 = siluf(v[j][0] * rstd * lg[0] + lbv[0]) * bflo(sg.x), y1 = siluf(v[j][1] * rstd * lg[1] + lbv[1]) * bfhi(sg.x);
              const float y2 = siluf(v[j][2] * rstd * lg[2] + lbv[2]) * bflo(sg.y), y3 = siluf(v[j][3] * rstd * lg[3] + lbv[3]) * bfhi(sg.y);
              u32x2 o; o.x = pk2(y0, y1); o.y = pk2(y2, y3);
              *(u32x2*)(aact + r * 1024 + c) = o; }
      } }
    __syncthreads();
}

__device__ __forceinline__ void attn_prompt_item(const Params& p, int item, LAS unsigned char* lds, int tid) {
    const int lane = tid & 63, wave = tid >> 6, l15 = lane & 15, quad = lane >> 4;
    const int n = item >> 6, h = (item >> 4) & 3, qt = item & 15;
    const bf16_t* proj = (const bf16_t*)(p.ws + WS_PROJ9);
    const bf16_t* kb = (const bf16_t*)(p.ws + WS_MKB) + (size_t)(n * 4 + h) * 65536;
    const bf16_t* vt = (const bf16_t*)(p.ws + WS_MVT) + (size_t)(n * 4 + h) * 65536;
    const size_t qrow = (size_t)n * SEQ + qt * 128 + wave * 16 + l15;
    u32x4 st[16];
#pragma unroll
    for (int i = 0; i < 16; ++i) st[i] = *(const u32x4*)(kb + (size_t)(tid + 512 * i) * 8);
    bf16x8 qf[8];
#pragma unroll
    for (int s = 0; s < 8; ++s) qf[s] = *(const bf16x8*)(proj + qrow * LDP + C_AQ + h * 256 + s * 32 + quad * 8);
#pragma unroll
    for (int i = 0; i < 16; ++i) { const int id = tid + 512 * i, r = id >> 5, c = id & 31; *(LAS u32x4*)(lds + r * 512 + ((c ^ (r & 15)) * 16)) = st[i]; }
    __syncthreads();
    f32x4 sc[16];
#pragma unroll
    for (int T = 0; T < 16; ++T) {
        sc[T] = (f32x4){0.f, 0.f, 0.f, 0.f};
        const LAS unsigned char* kr = lds + (T * 16 + l15) * 512;
#pragma unroll
        for (int s = 0; s < 8; ++s) { const bf16x8 a = *(const LAS bf16x8*)(kr + (((s * 4 + quad) ^ l15) * 16)); sc[T] = __builtin_amdgcn_mfma_f32_16x16x32_bf16(a, qf[s], sc[T], 0, 0, 0); }
    }
#pragma unroll
    for (int i = 0; i < 16; ++i) st[i] = *(const u32x4*)(vt + (size_t)(tid + 512 * i) * 8);
    __syncthreads();
    float mx = -3.0e38f;
#pragma unroll
    for (int T = 0; T < 16; ++T) mx = fmaxf(mx, fmaxf(fmaxf(sc[T][0], sc[T][1]), fmaxf(sc[T][2], sc[T][3])));
    mx = fmaxf(mx, __shfl_xor(mx, 16)); mx = fmaxf(mx, __shfl_xor(mx, 32));
    float sum = 0.f;
#pragma unroll
    for (int T = 0; T < 16; ++T) {
#pragma unroll
        for (int e = 0; e < 4; ++e) { sc[T][e] = __expf(sc[T][e] - mx); sum += sc[T][e]; } }
    sum += __shfl_xor(sum, 16); sum += __shfl_xor(sum, 32);
    const float rs = 1.f / sum;
    bf16x8 pb[8];
#pragma unroll
    for (int s2 = 0; s2 < 8; ++s2) {
        u32x4 w; w.x = pk2(sc[2 * s2][0], sc[2 * s2][1]); w.y = pk2(sc[2 * s2][2], sc[2 * s2][3]); w.z = pk2(sc[2 * s2 + 1][0], sc[2 * s2 + 1][1]); w.w = pk2(sc[2 * s2 + 1][2], sc[2 * s2 + 1][3]);
        pb[s2] = __builtin_bit_cast(bf16x8, w);
    }
#pragma unroll
    for (int i = 0; i < 16; ++i) { const int id = tid + 512 * i, r = id >> 5, c = id & 31; *(LAS u32x4*)(lds + r * 512 + ((c ^ (r & 15)) * 16)) = st[i]; }
    __syncthreads();
    bf16_t* aog = (bf16_t*)(p.ws + WS_ACT3) + (size_t)2 * 9216 * 1024;
    f32x4 oacc[16];
#pragma unroll
    for (int Tv = 0; Tv < 16; ++Tv) {
        oacc[Tv] = (f32x4){0.f, 0.f, 0.f, 0.f};
        const LAS unsigned char* vr = lds + (Tv * 16 + l15) * 512 + (quad & 1) * 8;
#pragma unroll
        for (int s2 = 0; s2 < 8; ++s2) {
            const int ch = 4 * s2 + (quad >> 1);
            const u32x2 lo = *(const LAS u32x2*)(vr + ((ch ^ l15) * 16)), hi = *(const LAS u32x2*)(vr + (((ch + 2) ^ l15) * 16));
            u32x4 w; w.x = lo.x; w.y = lo.y; w.z = hi.x; w.w = hi.y;
            oacc[Tv] = __builtin_amdgcn_mfma_f32_16x16x32_bf16(__builtin_bit_cast(bf16x8, w), pb[s2], oacc[Tv], 0, 0, 0);
        }
    }
#pragma unroll
    for (int Tv = 0; Tv < 16; ++Tv) {
        const int dv = Tv * 16 + quad * 4;
        const u32x2 sg = *(const u32x2*)(proj + qrow * LDP + C_AS + h * 256 + dv);
        u32x2 o; o.x = pk2(oacc[Tv][0] * rs * bflo(sg.x), oacc[Tv][1] * rs * bfhi(sg.x)); o.y = pk2(oacc[Tv][2] * rs * bflo(sg.y), oacc[Tv][3] * rs * bfhi(sg.y));
        *(u32x2*)(aog + qrow * 1024 + h * 256 + dv) = o;
    }
    __syncthreads();
}

__device__ __forceinline__ void attn_sample_item(const Params& p, int item, LAS unsigned char* lds, int tid) {
    LAS float* Ssh = (LAS float*)lds;
    LAS float* Psh = Ssh + 2048;
    LAS float* Opart = Psh + 2048;
    const int lane = tid & 63, wave = tid >> 6, l15 = lane & 15, quad = lane >> 4;
    const int n = item >> 2, h = item & 3;
    const bf16_t* proj = (const bf16_t*)(p.ws + WS_PROJ9);
    const size_t row0 = (size_t)NTP + (size_t)n * 8;
    const float* kc = p.cache_k + ((size_t)n * 256 * 4 + h) * 256;
    const float* vc = p.cache_v + ((size_t)n * 256 * 4 + h) * 256;
    {
        bf16x8 qf[8];
        const size_t qrow = row0 + (lane & 7);
#pragma unroll
        for (int s = 0; s < 8; ++s) qf[s] = *(const bf16x8*)(proj + qrow * LDP + C_AQ + h * 256 + s * 32 + quad * 8);
#pragma unroll
        for (int tl = 0; tl < 2; ++tl) {
            const int T = wave * 2 + tl;
            f32x4 sc = (f32x4){0.f, 0.f, 0.f, 0.f};
            const float* kr = kc + (size_t)(T * 16 + l15) * 1024 + quad * 8;
#pragma unroll
            for (int s = 0; s < 8; ++s) {
                const f32x4 k0 = *(const f32x4*)(kr + s * 32), k1 = *(const f32x4*)(kr + s * 32 + 4);
                u32x4 w; w.x = pk2(k0[0], k0[1]); w.y = pk2(k0[2], k0[3]); w.z = pk2(k1[0], k1[1]); w.w = pk2(k1[2], k1[3]);
                sc = __builtin_amdgcn_mfma_f32_16x16x32_bf16(__builtin_bit_cast(bf16x8, w), qf[s], sc, 0, 0, 0);
            }
            if (l15 < 8) {
#pragma unroll
                for (int e = 0; e < 4; ++e) Ssh[l15 * 256 + T * 16 + quad * 4 + e] = sc[e];
            }
        }
    }
    __syncthreads();
    {
        const f32x4 s4 = *(const LAS f32x4*)(Ssh + wave * 256 + lane * 4);
        const float mx = wave_max(fmaxf(fmaxf(s4[0], s4[1]), fmaxf(s4[2], s4[3])));
        f32x4 e4; e4[0] = __expf(s4[0] - mx); e4[1] = __expf(s4[1] - mx); e4[2] = __expf(s4[2] - mx); e4[3] = __expf(s4[3] - mx);
        const float rs = 1.f / wave_sum((e4[0] + e4[1]) + (e4[2] + e4[3]));
#pragma unroll
        for (int e = 0; e < 4; ++e) Psh[(lane * 4 + e) * 8 + wave] = e4[e] * rs;
    }
    __syncthreads();
    {
        f32x4 acc[8];
#pragma unroll
        for (int q = 0; q < 8; ++q) acc[q] = (f32x4){0.f, 0.f, 0.f, 0.f};
        const float* vr = vc + (size_t)(wave * 32) * 1024 + lane * 4;
#pragma unroll 8
        for (int kk = 0; kk < 32; ++kk) {
            const f32x4 v4 = *(const f32x4*)(vr + (size_t)kk * 1024);
            const f32x4 pa = *(const LAS f32x4*)(Psh + (wave * 32 + kk) * 8), pb = *(const LAS f32x4*)(Psh + (wave * 32 + kk) * 8 + 4);
            acc[0] += v4 * pa[0]; acc[1] += v4 * pa[1]; acc[2] += v4 * pa[2]; acc[3] += v4 * pa[3];
            acc[4] += v4 * pb[0]; acc[5] += v4 * pb[1]; acc[6] += v4 * pb[2]; acc[7] += v4 * pb[3];
        }
#pragma unroll
        for (int q = 0; q < 8; ++q) *(LAS f32x4*)(Opart + (wave * 8 + q) * 256 + lane * 4) = acc[q];
    }
    __syncthreads();
    {
        f32x4 o = (f32x4){0.f, 0.f, 0.f, 0.f};
#pragma unroll
        for (int w = 0; w < 8; ++w) o += *(const LAS f32x4*)(Opart + (w * 8 + wave) * 256 + lane * 4);
        const size_t r = row0 + wave;
        const u32x2 sg = *(const u32x2*)(proj + r * LDP + C_AS + h * 256 + lane * 4);
        u32x2 ov; ov.x = pk2(o[0] * bflo(sg.x), o[1] * bfhi(sg.x)); ov.y = pk2(o[2] * bflo(sg.y), o[3] * bfhi(sg.y));
        bf16_t* aog = (bf16_t*)(p.ws + WS_ACT3) + (size_t)2 * 9216 * 1024;
        *(u32x2*)(aog + r * 1024 + h * 256 + lane * 4) = ov;
    }
    __syncthreads();
}

__device__ __forceinline__ void p2_mixers(const Params& p, LAS unsigned char* lds) {
    const int tid = threadIdx.x, G = gridDim.x, c = blockIdx.x, mask = p.pad;
    if (mask & 1) for (int it = c; it < 256; it += G) hgrn_prompt_item(p, it, lds, tid);
    if (mask & 2) { for (int it = c; it < 256; it += G) conv_item<false>(p, it, lds, tid);
                    for (int it = c; it < 128; it += G) conv_item<true>(p, it, lds, tid); }
    if (mask & 4) for (int it = c; it < 256; it += G) attn_prompt_item(p, it, lds, tid);
    if (mask & 8) for (int it = c; it < 512; it += G) attn_sample_item(p, it, lds, tid);
    if (mask & 16) for (int it = c; it < 1024; it += G) hgrn_sample_item(p, it, lds, tid);
}

__device__ __forceinline__ void p6_final_norm(const Params& p) {
    const int tid = threadIdx.x, lane = tid & 63, gw = blockIdx.x * 8 + (tid >> 6), NGW = gridDim.x * 8;
    for (int r = gw; r < NTOK; r += NGW) {
        float* zr = p.out + (size_t)r * 2048;
        f32x4 v[8]; float ss = 0.f;
#pragma unroll
        for (int j = 0; j < 8; ++j) { v[j] = ((const f32x4*)zr)[lane + 64 * j]; ss += (v[j][0] * v[j][0] + v[j][1] * v[j][1]) + (v[j][2] * v[j][2] + v[j][3] * v[j][3]); }
        ss = wave_sum(ss);
        const float rinv = rsqrtf(ss * (1.f / 2048.f) + EPS);
#pragma unroll
        for (int j = 0; j < 8; ++j) { const f32x4 gg = ((const f32x4*)p.g_final)[lane + 64 * j]; ((f32x4*)zr)[lane + 64 * j] = v[j] * rinv * gg; }
    }
}

__global__ void __launch_bounds__(512, 2) fwd_megakernel(Params p) {
    extern __shared__ __attribute__((aligned(16))) unsigned char shm[];
    LAS unsigned char* lds = (LAS unsigned char*)shm;
    cg::grid_group grid = cg::this_grid();
    const int G = gridDim.x, c = blockIdx.x;
#define SEAM(ph) do { if (p.coop && (ph) + 1 < p.ph_hi) { \
        asm volatile("s_waitcnt vmcnt(0) lgkmcnt(0)" ::: "memory"); __syncthreads(); \
        grid.sync(); \
        if (threadIdx.x < 64) { __builtin_amdgcn_fence(__ATOMIC_ACQUIRE, "agent"); asm volatile("s_waitcnt vmcnt(0)" ::: "memory"); } \
        __syncthreads(); } } while (0)
#define RUNS(ph) (p.ph_lo <= (ph) && (ph) < p.ph_hi)
    if (RUNS(0)) { p0_prologue(p, lds); SEAM(0); }
    if (RUNS(1)) {
        SchedP1 S; S.G = G; S.c = c; S.A = (const char*)(p.ws + WS_HA); S.Bt = (const char*)(p.ws + WS_WT1);
        EpiP1 E; E.proj = (bf16_t*)(p.ws + WS_PROJ9); E.gate = (bf16_t*)(p.ws + WS_GATE); E.F = (float*)(p.ws + WS_F); E.lb = (const float*)(p.ws + WS_LB);
        E.b_gate = p.b_gate; E.out = p.out; E.mkb = (bf16_t*)(p.ws + WS_MKB); E.mvt = (bf16_t*)(p.ws + WS_MVT);
        pg8::gemm_phase(lds, 2048, S, E); SEAM(1);
    }
    if (RUNS(2)) { p2_mixers(p, lds); SEAM(2); }
    if (RUNS(3)) { hgrn_norm_rows(p); SEAM(3); }
    if (RUNS(4)) {
        SchedP4 S; S.G = G; S.c = c; S.A = (const char*)(p.ws + WS_ACT3); S.Bt = (const char*)(p.ws + WS_WT3);
        EpiP4 E; E.gate = (const bf16_t*)(p.ws + WS_GATE); E.merged = (bf16_t*)(p.ws + WS_MERGED);
        pg8::gemm_phase(lds, 1024, S, E); SEAM(4);
    }
    if (RUNS(5)) {
        SchedP5 S; S.G = G; S.c = c; S.A = (const char*)(p.ws + WS_MERGED); S.Bt = (const char*)(p.ws + WS_WTO);
        EpiP5 E; E.xp = p.x_prompt; E.xs = p.x_sample; E.out = p.out;
        pg8::gemm_phase(lds, 2048, S, E); SEAM(5);
    }
    if (RUNS(6)) { p6_final_norm(p); }
#undef RUNS
#undef SEAM
}

extern "C" void kernel_launch(void* const* d_in, const int* in_sizes, int n_in, void* d_out, int out_size, void* d_ws, size_t ws_size, hipStream_t stream) {
    static int grid = 0;
    if (grid == 0) {
        if (n_in != 23 || ws_size < WS_END) { fprintf(stderr, "kernel_launch: expected 23 inputs and >= %zu bytes of workspace, got %d / %zu\n", (size_t)WS_END, n_in, ws_size); grid = -1; return; }
        int dev = 0, cus = 0, per_cu = 0;
        hipGetDevice(&dev); hipDeviceGetAttribute(&cus, hipDeviceAttributeMultiprocessorCount, dev);
        if (hipFuncSetAttribute((const void*)fwd_megakernel, hipFuncAttributeMaxDynamicSharedMemorySize, LDS_BYTES) != hipSuccess) { fprintf(stderr, "kernel_launch: hipFuncSetAttribute failed\n"); grid = -1; return; }
        if (hipOccupancyMaxActiveBlocksPerMultiprocessor(&per_cu, (const void*)fwd_megakernel, 512, LDS_BYTES) != hipSuccess || per_cu < 1) { fprintf(stderr, "kernel_launch: occupancy query failed (%d)\n", per_cu); (void)hipGetLastError(); per_cu = 1; }
        grid = cus * 1;
        if (grid <= 0) grid = 256;
    }
    if (grid < 0) return;
    Params p{};
    const float** pp = (const float**)&p;
    for (int i = 0; i < 23; ++i) pp[i] = (const float*)d_in[i];
    p.out = (float*)d_out; p.ws = (unsigned char*)d_ws; p.pad = 31;
#if N_LAUNCH_MODE == 1
    p.ph_lo = 0; p.ph_hi = N_PHASES; p.coop = 1;
    void* args[] = {&p};
    hipError_t e = hipLaunchCooperativeKernel((const void*)fwd_megakernel, dim3(grid), dim3(512), args, LDS_BYTES, stream);
    if (e != hipSuccess) fprintf(stderr, "cooperative launch failed: %s (grid %d)\n", hipGetErrorString(e), grid);
#else
    for (int ph = 0; ph < N_PHASES; ++ph) {
        p.ph_lo = ph; p.ph_hi = ph + 1; p.coop = 0;
        hipLaunchKernelGGL(fwd_megakernel, dim3(grid), dim3(512), LDS_BYTES, stream, p);
        if ((REP_MASK >> ph) & 1) { if (ph == 2) p.pad = P2_SUBMASK; hipLaunchKernelGGL(fwd_megakernel, dim3(grid), dim3(512), LDS_BYTES, stream, p); p.pad = 31; }
    }
#endif
}
```

```cpp
#include <hip/hip_runtime.h>
#include <hip/hip_cooperative_groups.h>
#include <cstdio>
namespace cg = cooperative_groups;

#define LAS __attribute__((address_space(3)))
typedef unsigned short bf16_t;
typedef short bf16x8 __attribute__((ext_vector_type(8)));
typedef float f32x4 __attribute__((ext_vector_type(4)));
typedef float f32x2 __attribute__((ext_vector_type(2)));
typedef unsigned u32x4 __attribute__((ext_vector_type(4)));
typedef unsigned u32x2 __attribute__((ext_vector_type(2)));

#ifndef REP_MASK
#define REP_MASK 0
#endif
#ifndef P2_SUBMASK
#define P2_SUBMASK 31
#endif
#ifndef N_LAUNCH_MODE
#define N_LAUNCH_MODE 1
#endif

constexpr int DM = 2048, NTP = 8192, NTS = 1024, NTOK = 9216, SEQ = 2048;
constexpr int LDP = 9216;
constexpr int C_CV = 0, C_CG = 1024, C_CS = 2048, C_HQ = 3072, C_HF = 4096, C_HI = 5120, C_HOG = 6144, C_AQ = 7168, C_AS = 8192;
constexpr int LDG = 6144;
constexpr float EPS = 1e-6f;
constexpr size_t O_YP = 0, O_YS = 16777216, O_CONV_P = 18874368, O_HGRN_P = 18997248, O_MK = 19521536, O_MV = 20570112, O_CONV_S = 21618688, O_HGRN_S = 25550848;
constexpr size_t WS_WT1 = 0;
constexpr size_t WS_WT3 = WS_WT1 + (size_t)17408 * 2048 * 2;
constexpr size_t WS_WTO = WS_WT3 + (size_t)3 * 2048 * 1024 * 2;
constexpr size_t WS_HA = WS_WTO + (size_t)2048 * 2048 * 2;
constexpr size_t WS_ORAW = WS_HA;
constexpr size_t WS_PROJ9 = WS_HA + (size_t)10240 * 2048 * 2;
constexpr size_t WS_MF = WS_PROJ9;
constexpr size_t WS_MERGED = WS_MF + (size_t)9216 * 2048 * 4;
constexpr size_t WS_GATE = WS_PROJ9 + (size_t)9216 * 9216 * 2;
constexpr size_t WS_F = WS_GATE + (size_t)9216 * 6144 * 2;
constexpr size_t WS_MKB = WS_F + (size_t)9216 * 1024 * 4;
constexpr size_t WS_MVT = WS_MKB + (size_t)2097152;
constexpr size_t WS_ACT3 = WS_MVT + (size_t)2097152;
constexpr size_t WS_LB = WS_ACT3 + (size_t)3 * 9216 * 1024 * 2;
constexpr size_t WS_END = WS_LB + 4096;
constexpr int LDS_BYTES = 131072;
constexpr int N_PHASES = 7;

struct Params {
    const float *x_prompt, *x_sample, *state_conv, *state_hgrn, *cache_k, *cache_v, *mem_prompt, *g_pre, *w_in, *conv_w, *conv_b, *ln_g, *ln_b,
        *w_conv_out, *lb_logits, *g_hgrn, *w_hgrn_out, *g_mem, *w_mem_kv, *w_attn_out, *b_gate, *w_out, *g_final;
    float* out; unsigned char* ws; int ph_lo, ph_hi, coop, pad;
};

__device__ __forceinline__ unsigned f2bf(float f) { unsigned u = __builtin_bit_cast(unsigned, f); return (u + 0x7fffu + ((u >> 16) & 1u)) >> 16; }
typedef __bf16 bf16x2_t __attribute__((ext_vector_type(2)));
__device__ __forceinline__ unsigned pk2(float lo, float hi) { const f32x2 v = {lo, hi}; const bf16x2_t r = __builtin_convertvector(v, bf16x2_t); return __builtin_bit_cast(unsigned, r); }
__device__ __forceinline__ float bflo(unsigned w) { return __builtin_bit_cast(float, w << 16); }
__device__ __forceinline__ float bfhi(unsigned w) { return __builtin_bit_cast(float, w & 0xffff0000u); }
__device__ __forceinline__ float bf2f(unsigned short b) { return __builtin_bit_cast(float, ((unsigned)b) << 16); }
__device__ __forceinline__ float sigm(float x) { return __builtin_amdgcn_rcpf(1.f + __expf(-x)); }
__device__ __forceinline__ float siluf(float x) { return x * sigm(x); }
__device__ __forceinline__ size_t tl(size_t row, int col, int K) { return (row >> 8) * ((size_t)256 * K) + (size_t)(col >> 6) * (256 * 64) + (row & 255) * 64 + (col & 63); }
__device__ __forceinline__ float wave_sum(float v) {
#pragma unroll
    for (int o = 1; o < 64; o <<= 1) v += __shfl_xor(v, o);
    return v;
}
__device__ __forceinline__ float wave_max(float v) {
#pragma unroll
    for (int o = 1; o < 64; o <<= 1) v = fmaxf(v, __shfl_xor(v, o));
    return v;
}

namespace pg8 {
constexpr int BM = 256, BK = 64, HALF = 128, HTB = HALF * BK * 2, STAGE_BYTES = 8 * HTB, NXCD = 8, WGM = 8;
__host__ __device__ __forceinline__ int lds_byte(int r, int c) { const int st = (r >> 4) * 2 + (c >> 5), rr = r & 15, cc = c & 31, ob = rr * 64 + cc * 2; return st * 1024 + (ob ^ (((ob >> 9) & 1) << 5)); }
__host__ __device__ __forceinline__ void stage_rc(int b, int& R, int& C) { const int st = b / 1024, sb = b % 1024, swz = sb ^ (((sb >> 9) & 1) << 5); R = (st >> 1) * 16 + swz / 64; C = (st & 1) * 32 + (swz % 64) / 2; }
__host__ __device__ __forceinline__ int perm32(int rho) { const int n = rho >> 4, i = rho & 15; return 8 * (i >> 2) + 4 * n + (i & 3); }
struct Unit { int pm, pn, br; };
__device__ __forceinline__ void tile_of(int wgid, int nM, int nN, int& pm, int& pn) {
    const int nwg = nM * nN;
    { const int q = nwg / NXCD, r = nwg % NXCD, xcd = wgid % NXCD, off = wgid / NXCD; wgid = (xcd < r ? xcd * (q + 1) : r * (q + 1) + (xcd - r) * q) + off; }
    const int nig = WGM * nN, gid = wgid / nig, fm = gid * WGM, gsz = (nM - fm) < WGM ? (nM - fm) : WGM;
    pm = fm + ((wgid % nig) % gsz); pn = (wgid % nig) / gsz;
}

template <class Epi, class Sched>
__device__ __forceinline__ void gemm_phase(LAS unsigned char* lds, const int K, const Sched& S, const Epi& E) {
    const int tid = threadIdx.x, wid = __builtin_amdgcn_readfirstlane(tid >> 6), lane = tid & 63, wr = wid >> 2, wc = wid & 3, fr = lane & 15, fq = lane >> 4;
    const int nt = K / BK;
    unsigned voffA[2], voffB[2];
#pragma unroll
    for (int i = 0; i < 2; ++i) { int R, C; stage_rc(tid * 16 + i * 8192, R, C); const int Rb = (R & ~31) + perm32(R & 31);
        voffA[i] = (unsigned)(R * BK + C) * 2u; voffB[i] = (unsigned)(Rb * BK + C) * 2u; }
    const size_t kstep = (size_t)(BM * BK * 2);
    const size_t hstep = (size_t)HALF * BK * 2;
    const unsigned ldsw = (unsigned)wid * 1024u;
    const int aoff = lds_byte(wr * 64 + fr, fq * 8), boff = lds_byte(wc * 32 + fr, fq * 8);
#define PG8_SA(b, h) (((b) * 2 + (h)) * HTB)
#define PG8_SB(b, h) ((4 + (b) * 2 + (h)) * HTB)
#define PG8_STAGE(bufoff, gbase, voff) do { _Pragma("unroll") for (int _i = 0; _i < 2; ++_i) \
        __builtin_amdgcn_global_load_lds((const unsigned*)((const char*)(gbase) + (voff)[_i]), (LAS unsigned*)(lds + (bufoff) + ldsw + _i * 8192), 16, 0, 0); } while (0)
#define PG8_LDA(dst, b, h) do { _Pragma("unroll") for (int m = 0; m < 4; ++m) _Pragma("unroll") for (int k = 0; k < 2; ++k) dst[m][k] = *(const LAS bf16x8*)(lds + PG8_SA(b, h) + aoff + m * 2048 + k * 1024); } while (0)
#define PG8_LDB(dst, b, h) do { _Pragma("unroll") for (int n = 0; n < 2; ++n) _Pragma("unroll") for (int k = 0; k < 2; ++k) dst[n][k] = *(const LAS bf16x8*)(lds + PG8_SB(b, h) + boff + n * 2048 + k * 1024); } while (0)
#define PG8_MMA(ai, bj, At, Bt) do { __builtin_amdgcn_s_setprio(1); _Pragma("unroll") for (int m = 0; m < 4; ++m) _Pragma("unroll") for (int n = 0; n < 2; ++n) _Pragma("unroll") for (int k = 0; k < 2; ++k) \
        acc[ai][bj][m][n] = __builtin_amdgcn_mfma_f32_16x16x32_bf16(Bt[n][k], At[m][k], acc[ai][bj][m][n], 0, 0, 0); __builtin_amdgcn_s_setprio(0); } while (0)
#define PG8_WAIT_V(n) asm volatile("s_waitcnt vmcnt(" #n ")" ::: "memory")
#define PG8_WAIT_L(n) asm volatile("s_waitcnt lgkmcnt(" #n ")" ::: "memory")
#define PG8_BAR __builtin_amdgcn_s_barrier()
#define PG8_SCHED __builtin_amdgcn_sched_barrier(0)
    Unit cur, nxt; int ui = 0;
    if (!S.next(0, cur)) return;
    f32x4 acc[2][2][4][2];
#pragma unroll
    for (int a = 0; a < 2; ++a)
#pragma unroll
        for (int b = 0; b < 2; ++b)
#pragma unroll
            for (int m = 0; m < 4; ++m)
#pragma unroll
                for (int n = 0; n < 2; ++n) acc[a][b][m][n] = (f32x4){0.f, 0.f, 0.f, 0.f};
    bf16x8 At[4][2], B0[2][2], B1[2][2];
    const char* cA = S.a_base(cur); const char* cB = S.b_base(cur);
    PG8_STAGE(PG8_SB(0, 0), cB, voffB); PG8_STAGE(PG8_SA(0, 0), cA, voffA); PG8_STAGE(PG8_SB(0, 1), cB + hstep, voffB); PG8_STAGE(PG8_SA(0, 1), cA + hstep, voffA);
    if (wr == 1) PG8_BAR;
    PG8_WAIT_V(4); PG8_BAR;
    PG8_STAGE(PG8_SB(1, 0), cB + kstep, voffB); PG8_STAGE(PG8_SA(1, 0), cA + kstep, voffA); PG8_STAGE(PG8_SB(1, 1), cB + hstep + kstep, voffB);
    PG8_WAIT_V(6); PG8_BAR;
    for (;;) {
        const bool has_next = S.next(ui + 1, nxt);
        const char* nA = has_next ? S.a_base(nxt) : cA; const char* nB = has_next ? S.b_base(nxt) : cB;
        for (int t = 0; t < nt; t += 2) {
            const bool last = (t == nt - 2);
            const char* a1 = cA + (size_t)(t + 1) * kstep;
            const char* a2 = last ? nA : cA + (size_t)(t + 2) * kstep; const char* b2 = last ? nB : cB + (size_t)(t + 2) * kstep;
            const char* a3 = a2 + kstep; const char* b3 = b2 + kstep;
            PG8_LDB(B0, 0, 0); PG8_SCHED; PG8_LDA(At, 0, 0); PG8_STAGE(PG8_SA(1, 1), a1 + hstep, voffA);
            PG8_WAIT_L(8); PG8_BAR; PG8_WAIT_L(0); PG8_MMA(0, 0, At, B0); PG8_BAR; PG8_SCHED;
            PG8_LDB(B1, 0, 1); PG8_STAGE(PG8_SB(0, 0), b2, voffB);
            PG8_BAR; PG8_WAIT_L(0); PG8_MMA(0, 1, At, B1); PG8_BAR;
            PG8_LDA(At, 0, 1); PG8_STAGE(PG8_SA(0, 0), a2, voffA);
            PG8_BAR; PG8_WAIT_L(0); PG8_MMA(1, 0, At, B0); PG8_BAR; PG8_SCHED;
            PG8_STAGE(PG8_SB(0, 1), b2 + hstep, voffB);
            PG8_WAIT_V(6); PG8_BAR; PG8_MMA(1, 1, At, B1); PG8_BAR;
            PG8_LDB(B0, 1, 0); PG8_SCHED; PG8_LDA(At, 1, 0); PG8_STAGE(PG8_SA(0, 1), a2 + hstep, voffA);
            PG8_WAIT_L(8); PG8_BAR; PG8_WAIT_L(0); PG8_MMA(0, 0, At, B0); PG8_BAR; PG8_SCHED;
            PG8_LDB(B1, 1, 1); PG8_STAGE(PG8_SB(1, 0), b3, voffB);
            PG8_BAR; PG8_WAIT_L(0); PG8_MMA(0, 1, At, B1); PG8_BAR;
            PG8_LDA(At, 1, 1); PG8_STAGE(PG8_SA(1, 0), a3, voffA);
            PG8_BAR; PG8_WAIT_L(0); PG8_MMA(1, 0, At, B0); PG8_BAR; PG8_SCHED;
            PG8_STAGE(PG8_SB(1, 1), b3 + hstep, voffB);
            PG8_WAIT_V(6); PG8_BAR; PG8_MMA(1, 1, At, B1); PG8_BAR;
        }
        const bool keep = E(acc, cur, wr, wc, fr, fq);
        if (!has_next) break;
        if (!keep)
#pragma unroll
        for (int a = 0; a < 2; ++a)
#pragma unroll
            for (int b = 0; b < 2; ++b)
#pragma unroll
                for (int m = 0; m < 4; ++m)
#pragma unroll
                    for (int n = 0; n < 2; ++n) acc[a][b][m][n] = (f32x4){0.f, 0.f, 0.f, 0.f};
        cur = nxt; cA = nA; cB = nB; ++ui;
    }
    PG8_WAIT_V(0);
    if (wr == 0) PG8_BAR;
    PG8_BAR;
#undef PG8_SA
#undef PG8_SB
#undef PG8_STAGE
#undef PG8_LDA
#undef PG8_LDB
#undef PG8_MMA
#undef PG8_WAIT_V
#undef PG8_WAIT_L
#undef PG8_BAR
#undef PG8_SCHED
}
}
using pg8::Unit;

struct SchedP1 {
    int G, c; const char* A; const char* Bt;
    __device__ __forceinline__ bool next(int i, Unit& u) const {
        const int L = i * G + c; if (L >= 2192) return false;
        u.br = 0;
        if (L >= 2160) { const int idx = L - 2160; u.pm = 36 + (idx >> 3); u.pn = 60 + (idx & 7); return true; }
        pg8::tile_of(L, 36, 60, u.pm, u.pn); return true;
    }
    __device__ __forceinline__ const char* a_base(const Unit& u) const { return A + (size_t)u.pm * (256 * 2048 * 2); }
    __device__ __forceinline__ const char* b_base(const Unit& u) const { return Bt + (size_t)u.pn * (256 * 2048 * 2); }
};
struct EpiP1 {
    bf16_t* proj; bf16_t* gate; float* F; const float* lb; const float* b_gate; float* out; bf16_t* mkb; bf16_t* mvt;
    __device__ __forceinline__ bool operator()(f32x4 (&acc)[2][2][4][2], const Unit& u, int wr, int wc, int fr, int fq) const {
        const int rloc = wr * 64 + fr, cloc = wc * 32 + 8 * fq;
        if (u.pn < 36) {
            const int seg = u.pn >> 2;
#pragma unroll
            for (int bj = 0; bj < 2; ++bj) {
                const int col = u.pn * 256 + bj * 128 + cloc;
                f32x4 l0 = (f32x4){0.f, 0.f, 0.f, 0.f}, l1 = l0;
                if (seg == 4) { l0 = *(const f32x4*)(lb + (col - C_HF)); l1 = *(const f32x4*)(lb + (col - C_HF) + 4); }
#pragma unroll
                for (int ai = 0; ai < 2; ++ai)
#pragma unroll
                    for (int m = 0; m < 4; ++m) {
                        const size_t row = (size_t)u.pm * 256 + ai * 128 + m * 16 + rloc;
                        f32x4 v0 = acc[ai][bj][m][0], v1 = acc[ai][bj][m][1];
                        if (seg == 4) {
#pragma unroll
                            for (int e = 0; e < 4; ++e) { v0[e] = l0[e] + (1.f - l0[e]) * sigm(v0[e]); v1[e] = l1[e] + (1.f - l1[e]) * sigm(v1[e]); }
                            float* fp = F + row * 1024 + (col - C_HF);
                            *(f32x4*)fp = v0; *(f32x4*)(fp + 4) = v1;
                        } else {
                            if (seg == 1) {
#pragma unroll
                                for (int e = 0; e < 4; ++e) { v0[e] = sigm(v0[e]); v1[e] = sigm(v1[e]); }
                            } else if (seg == 2 || seg == 6 || seg == 8) {
#pragma unroll
                                for (int e = 0; e < 4; ++e) { v0[e] = siluf(v0[e]); v1[e] = siluf(v1[e]); }
                            } else if (seg == 3) { v0 *= 0.08838834764831845f; v1 *= 0.08838834764831845f; }
                            else if (seg == 7) { v0 *= 0.0625f; v1 *= 0.0625f; }
                            u32x4 o; o.x = pk2(v0[0], v0[1]); o.y = pk2(v0[2], v0[3]); o.z = pk2(v1[0], v1[1]); o.w = pk2(v1[2], v1[3]);
                            *(u32x4*)(proj + row * LDP + col) = o;
                        }
                    }
            }
        } else if (u.pn < 60) {
#pragma unroll
            for (int bj = 0; bj < 2; ++bj) {
                const int col = (u.pn - 36) * 256 + bj * 128 + cloc;
                const f32x4 b0 = *(const f32x4*)(b_gate + col), b1 = *(const f32x4*)(b_gate + col + 4);
#pragma unroll
                for (int ai = 0; ai < 2; ++ai)
#pragma unroll
                    for (int m = 0; m < 4; ++m) {
                        const size_t row = (size_t)u.pm * 256 + ai * 128 + m * 16 + rloc;
                        f32x4 v0 = acc[ai][bj][m][0] + b0, v1 = acc[ai][bj][m][1] + b1;
#pragma unroll
                        for (int e = 0; e < 4; ++e) { v0[e] = fmaxf(sigm(v0[e]), 1e-6f); v1[e] = fmaxf(sigm(v1[e]), 1e-6f); }
                        u32x4 o; o.x = pk2(v0[0], v0[1]); o.y = pk2(v0[2], v0[3]); o.z = pk2(v1[0], v1[1]); o.w = pk2(v1[2], v1[3]);
                        *(u32x4*)(gate + row * LDG + col) = o;
                    }
            }
        } else {
            const int n = u.pm - 36, isv = (u.pn >= 64) ? 1 : 0, h = (u.pn - 60) & 3;
            float* ob = out + (isv ? O_MV : O_MK);
#pragma unroll
            for (int bj = 0; bj < 2; ++bj) {
                const int d = bj * 128 + cloc;
#pragma unroll
                for (int ai = 0; ai < 2; ++ai)
#pragma unroll
                    for (int m = 0; m < 4; ++m) {
                        const int key = ai * 128 + m * 16 + rloc;
                        const f32x4 v0 = acc[ai][bj][m][0], v1 = acc[ai][bj][m][1];
                        float* op = ob + ((size_t)(n * 256 + key) * 4 + h) * 256 + d;
                        *(f32x4*)op = v0; *(f32x4*)(op + 4) = v1;
                        if (!isv) {
                            u32x4 o; o.x = pk2(v0[0], v0[1]); o.y = pk2(v0[2], v0[3]); o.z = pk2(v1[0], v1[1]); o.w = pk2(v1[2], v1[3]);
                            *(u32x4*)(mkb + ((size_t)(n * 4 + h) * 256 + key) * 256 + d) = o;
                        } else {
                            bf16_t* vp = mvt + ((size_t)(n * 4 + h) * 256 + d) * 256 + key;
#pragma unroll
                            for (int e = 0; e < 4; ++e) { vp[(size_t)e * 256] = (bf16_t)f2bf(v0[e]); vp[(size_t)(e + 4) * 256] = (bf16_t)f2bf(v1[e]); }
                        }
                    }
            }
        }
        return false;
    }
};

struct SchedP4 {
    int G, c; const char* A; const char* Bt;
    __device__ __forceinline__ bool next(int i, Unit& u) const {
        const int tri = i / 3, L = tri * G + c; if (L >= 288) return false;
        u.br = i - tri * 3; pg8::tile_of(L, 36, 8, u.pm, u.pn); return true;
    }
    __device__ __forceinline__ const char* a_base(const Unit& u) const { return A + (size_t)u.br * ((size_t)9216 * 1024 * 2) + (size_t)u.pm * (256 * 1024 * 2); }
    __device__ __forceinline__ const char* b_base(const Unit& u) const { return Bt + (size_t)u.br * ((size_t)2048 * 1024 * 2) + (size_t)u.pn * (256 * 1024 * 2); }
};
struct EpiP4 {
    const bf16_t* gate; bf16_t* merged;
    __device__ __forceinline__ bool operator()(f32x4 (&acc)[2][2][4][2], const Unit& u, int wr, int wc, int fr, int fq) const {
        const int rloc = wr * 64 + fr, cloc = wc * 32 + 8 * fq;
        bf16_t* mbase = merged + tl((size_t)u.pm * 256 + rloc, u.pn * 256 + cloc, 2048);
#pragma unroll
        for (int bj = 0; bj < 2; ++bj) {
            const int col = u.pn * 256 + bj * 128 + cloc;
#pragma unroll
            for (int ai = 0; ai < 2; ++ai)
#pragma unroll
                for (int m = 0; m < 4; ++m) {
                    const size_t row = (size_t)u.pm * 256 + ai * 128 + m * 16 + rloc;
                    const bf16_t* gp = gate + row * LDG + u.br * 2048 + col;
                    const u32x4 g = *(const u32x4*)gp;
                    f32x4 s0 = (f32x4){bflo(g.x), bfhi(g.x), bflo(g.y), bfhi(g.y)}, s1 = (f32x4){bflo(g.z), bfhi(g.z), bflo(g.w), bfhi(g.w)};
                    if (u.br < 2) {
                        const u32x4 h = *(const u32x4*)(gp + 2048);
                        s0[0] *= __builtin_amdgcn_rcpf(bflo(h.x)); s0[1] *= __builtin_amdgcn_rcpf(bfhi(h.x)); s0[2] *= __builtin_amdgcn_rcpf(bflo(h.y)); s0[3] *= __builtin_amdgcn_rcpf(bfhi(h.y));
                        s1[0] *= __builtin_amdgcn_rcpf(bflo(h.z)); s1[1] *= __builtin_amdgcn_rcpf(bfhi(h.z)); s1[2] *= __builtin_amdgcn_rcpf(bflo(h.w)); s1[3] *= __builtin_amdgcn_rcpf(bfhi(h.w));
                    }
                    acc[ai][bj][m][0] *= s0; acc[ai][bj][m][1] *= s1;
                    if (u.br == 2) { const f32x4 v0 = acc[ai][bj][m][0], v1 = acc[ai][bj][m][1];
                        u32x4 o; o.x = pk2(v0[0], v0[1]); o.y = pk2(v0[2], v0[3]); o.z = pk2(v1[0], v1[1]); o.w = pk2(v1[2], v1[3]);
                        *(u32x4*)(mbase + bj * 32768 + (ai * 128 + m * 16) * 64) = o; }
                }
        }
        return u.br < 2;
    }
};

struct SchedP5 {
    int G, c; const char* A; const char* Bt;
    __device__ __forceinline__ bool next(int i, Unit& u) const {
        const int L = i * G + c; if (L >= 288) return false;
        u.br = 0; pg8::tile_of(L, 36, 8, u.pm, u.pn); return true;
    }
    __device__ __forceinline__ const char* a_base(const Unit& u) const { return A + (size_t)u.pm * (256 * 2048 * 2); }
    __device__ __forceinline__ const char* b_base(const Unit& u) const { return Bt + (size_t)u.pn * (256 * 2048 * 2); }
};
struct EpiP5 {
    const float* xp; const float* xs; float* out;
    __device__ __forceinline__ bool operator()(f32x4 (&acc)[2][2][4][2], const Unit& u, int wr, int wc, int fr, int fq) const {
        const int rloc = wr * 64 + fr, cloc = wc * 32 + 8 * fq;
#pragma unroll
        for (int bj = 0; bj < 2; ++bj) {
            const int col = u.pn * 256 + bj * 128 + cloc;
#pragma unroll
            for (int ai = 0; ai < 2; ++ai)
#pragma unroll
                for (int m = 0; m < 4; ++m) {
                    const size_t row = (size_t)u.pm * 256 + ai * 128 + m * 16 + rloc;
                    const float* xr = (row < (size_t)NTP) ? (xp + row * 2048 + col) : (xs + (row - NTP) * 2048 + col);
                    const f32x4 v0 = acc[ai][bj][m][0] + *(const f32x4*)xr, v1 = acc[ai][bj][m][1] + *(const f32x4*)(xr + 4);
                    float* op = out + row * 2048 + col;
                    *(f32x4*)op = v0; *(f32x4*)(op + 4) = v1;
                }
        }
        return false;
    }
};

struct EpiNull {
    __device__ __forceinline__ bool operator()(f32x4 (&acc)[2][2][4][2], const Unit& u, int wr, int wc, int fr, int fq) const {
        f32x4 t = (f32x4){0.f, 0.f, 0.f, 0.f};
#pragma unroll
        for (int ai = 0; ai < 2; ++ai)
#pragma unroll
            for (int bj = 0; bj < 2; ++bj)
#pragma unroll
                for (int m = 0; m < 4; ++m) t += acc[ai][bj][m][0] + acc[ai][bj][m][1];
        asm volatile("" :: "v"(t[0]), "v"(t[1]), "v"(t[2]), "v"(t[3]));
        return false;
    }
};
__device__ __forceinline__ void transpose_tile(const float* W, int K, int N, bf16_t* WT, int row_off, int kb, int nb, LAS unsigned* T32, int tid) {
    const int nq = tid & 31, kp0 = tid >> 5;
#pragma unroll
    for (int i = 0; i < 4; ++i) {
        const int kpair = kp0 + 16 * i;
        const float* src = W + (size_t)(kb * 128 + 2 * kpair) * N + nb * 128 + 4 * nq;
        const f32x4 r0 = *(const f32x4*)src, r1 = *(const f32x4*)(src + N);
        T32[(4 * nq + 0) * 65 + kpair] = pk2(r0[0], r1[0]); T32[(4 * nq + 1) * 65 + kpair] = pk2(r0[1], r1[1]);
        T32[(4 * nq + 2) * 65 + kpair] = pk2(r0[2], r1[2]); T32[(4 * nq + 3) * 65 + kpair] = pk2(r0[3], r1[3]);
    }
    __syncthreads();
#pragma unroll
    for (int i = 0; i < 4; ++i) {
        const int id = tid + 512 * i, n = id >> 4, c = id & 15;
        u32x4 o; o.x = T32[n * 65 + 4 * c]; o.y = T32[n * 65 + 4 * c + 1]; o.z = T32[n * 65 + 4 * c + 2]; o.w = T32[n * 65 + 4 * c + 3];
        *(u32x4*)(WT + tl((size_t)(row_off + nb * 128 + n), kb * 128 + 8 * c, K)) = o;
    }
    __syncthreads();
}
__device__ __forceinline__ void rms_row_to_bf16(const float* xrow, const float* g, bf16_t* HA, int m, int lane) {
    f32x4 v[8]; float ss = 0.f;
#pragma unroll
    for (int j = 0; j < 8; ++j) { v[j] = ((const f32x4*)xrow)[lane + 64 * j]; ss += (v[j][0] * v[j][0] + v[j][1] * v[j][1]) + (v[j][2] * v[j][2] + v[j][3] * v[j][3]); }
    ss = wave_sum(ss);
    const float rinv = rsqrtf(ss * (1.f / 2048.f) + EPS);
#pragma unroll
    for (int j = 0; j < 8; ++j) { const f32x4 gg = ((const f32x4*)g)[lane + 64 * j];
        u32x2 o; o.x = pk2(v[j][0] * rinv * gg[0], v[j][1] * rinv * gg[1]); o.y = pk2(v[j][2] * rinv * gg[2], v[j][3] * rinv * gg[3]);
        *(u32x2*)(HA + tl((size_t)m, 4 * (lane + 64 * j), 2048)) = o; }
}
__device__ __forceinline__ void p0_prologue(const Params& p, LAS unsigned char* lds) {
    const int tid = threadIdx.x, lane = tid & 63, wave = tid >> 6, G = gridDim.x, c = blockIdx.x;
    LAS unsigned* T32 = (LAS unsigned*)lds;
    bf16_t* WT1 = (bf16_t*)(p.ws + WS_WT1); bf16_t* WT3 = (bf16_t*)(p.ws + WS_WT3); bf16_t* WTO = (bf16_t*)(p.ws + WS_WTO);
    constexpr int T_IN = 1920, T_MKV = 256, T_BR = 128, T_OUT = 256, T_ALL = T_IN + T_MKV + 3 * T_BR + T_OUT;
    for (int it = c; it < T_ALL; it += G) {
        int r = it;
        if (r < T_IN) { transpose_tile(p.w_in, 2048, 15360, WT1, 0, r / 120, r % 120, T32, tid); continue; } r -= T_IN;
        if (r < T_MKV) { transpose_tile(p.w_mem_kv, 2048, 2048, WT1, 15360, r / 16, r % 16, T32, tid); continue; } r -= T_MKV;
        if (r < T_BR) { transpose_tile(p.w_conv_out, 1024, 2048, WT3, 0, r / 16, r % 16, T32, tid); continue; } r -= T_BR;
        if (r < T_BR) { transpose_tile(p.w_hgrn_out, 1024, 2048, WT3 + (size_t)2048 * 1024, 0, r / 16, r % 16, T32, tid); continue; } r -= T_BR;
        if (r < T_BR) { transpose_tile(p.w_attn_out, 1024, 2048, WT3 + (size_t)2 * 2048 * 1024, 0, r / 16, r % 16, T32, tid); continue; } r -= T_BR;
        transpose_tile(p.w_out, 2048, 2048, WTO, 0, r / 16, r % 16, T32, tid);
    }
    bf16_t* HA = (bf16_t*)(p.ws + WS_HA);
    const int gw = c * 8 + wave, NGW = G * 8;
    for (int m = gw; m < 10240; m += NGW) {
        if (m < NTP) rms_row_to_bf16(p.x_prompt + (size_t)m * 2048, p.g_pre, HA, m, lane);
        else if (m < NTOK) rms_row_to_bf16(p.x_sample + (size_t)(m - NTP) * 2048, p.g_pre, HA, m, lane);
        else rms_row_to_bf16(p.mem_prompt + (size_t)(m - NTOK) * 2048, p.g_mem, HA, m, lane);
    }
    if (c == 0) { float* LB = (float*)(p.ws + WS_LB);
        for (int i = tid; i < 1024; i += 512) LB[i] = 1.f / (1.f + __expf(p.lb_logits[1024 + i] - p.lb_logits[i])); }
}

__device__ __forceinline__ void hgrn_prompt_item(const Params& p, int item, LAS unsigned char* lds, int tid) {
    LAS float* qs = (LAS float*)lds;
    LAS float* fs = qs + 4096;
    LAS float* vs = fs + 4096;
    LAS float* part = vs + 512;
    const int s = item >> 3, n = s >> 3, h = s & 7, dvg = item & 7;
    const int vcol = tid & 15, kg = tid >> 4;
    const bf16_t* proj = (const bf16_t*)(p.ws + WS_PROJ9);
    const float* F = (const float*)(p.ws + WS_F);
    float* oraw = (float*)(p.ws + WS_ORAW);
    const size_t row0 = (size_t)n * SEQ;
    const bf16_t* qsrc = proj + (row0 + kg) * LDP + C_HQ + h * 128 + vcol * 8;
    const float* fsrc = F + (row0 + kg) * 1024 + h * 128 + vcol * 8;
    const bf16_t* vsrc = proj + (row0 + kg) * LDP + C_HI + h * 128 + dvg * 16 + vcol;
    f32x2 S01 = (f32x2){0.f, 0.f}, S23 = (f32x2){0.f, 0.f};
    u32x4 rq[4]; f32x4 rfa[4], rfb[4]; bf16_t rv[4];
#define HG_FETCH(R, tb) do { const size_t adv = (size_t)(tb); rq[R] = *(const u32x4*)(qsrc + adv * LDP); rfa[R] = *(const f32x4*)(fsrc + adv * 1024); \
        rfb[R] = *(const f32x4*)(fsrc + adv * 1024 + 4); rv[R] = *(vsrc + adv * LDP); } while (0)
#define HG_BATCH(R, tb) do { \
        { LAS float* qd = qs + kg * 128 + vcol * 8; \
          *(LAS f32x4*)qd = (f32x4){bflo(rq[R].x), bfhi(rq[R].x), bflo(rq[R].y), bfhi(rq[R].y)}; *(LAS f32x4*)(qd + 4) = (f32x4){bflo(rq[R].z), bfhi(rq[R].z), bflo(rq[R].w), bfhi(rq[R].w)}; \
          LAS float* fd = fs + kg * 128 + vcol * 8; *(LAS f32x4*)fd = rfa[R]; *(LAS f32x4*)(fd + 4) = rfb[R]; \
          vs[kg * 16 + vcol] = bf2f(rv[R]); } \
        __syncthreads(); \
        if ((tb) + 128 < SEQ) HG_FETCH(R, (tb) + 128); \
        f32x4 cf[4], cq[4]; float cv[4]; \
        _Pragma("unroll") for (int i = 0; i < 4; ++i) { cf[i] = *(const LAS f32x4*)(fs + i * 128 + kg * 4); cq[i] = *(const LAS f32x4*)(qs + i * 128 + kg * 4); cv[i] = vs[i * 16 + vcol]; } \
        _Pragma("unroll") for (int g = 0; g < 8; ++g) { \
            f32x4 nf[4], nq[4]; float nv[4]; \
            if (g < 7) { _Pragma("unroll") for (int i = 0; i < 4; ++i) { const int tt = (g + 1) * 4 + i; \
                nf[i] = *(const LAS f32x4*)(fs + tt * 128 + kg * 4); nq[i] = *(const LAS f32x4*)(qs + tt * 128 + kg * 4); nv[i] = vs[tt * 16 + vcol]; } } \
            _Pragma("unroll") for (int i = 0; i < 4; ++i) { \
                const f32x2 f01 = (f32x2){cf[i][0], cf[i][1]}, f23 = (f32x2){cf[i][2], cf[i][3]}, q01 = (f32x2){cq[i][0], cq[i][1]}, q23 = (f32x2){cq[i][2], cq[i][3]}; \
                const f32x2 vv = (f32x2){cv[i], cv[i]}; \
                S01 = f01 * (S01 - vv) + vv; S23 = f23 * (S23 - vv) + vv; \
                f32x2 t = S01 * q01; t = S23 * q23 + t; \
                part[(g * 4 + i) * 528 + tid] = t[0] + t[1]; } \
            if (g < 7) { _Pragma("unroll") for (int i = 0; i < 4; ++i) { cf[i] = nf[i]; cq[i] = nq[i]; cv[i] = nv[i]; } } } \
        __syncthreads(); \
        { float a = 0.f; \
          _Pragma("unroll 8") for (int k2 = 0; k2 < 32; ++k2) a += part[kg * 528 + k2 * 16 + vcol]; \
          oraw[(row0 + (tb) + kg) * 1024 + h * 128 + dvg * 16 + vcol] = a; } } while (0)
    HG_FETCH(0, 0); HG_FETCH(1, 32); HG_FETCH(2, 64); HG_FETCH(3, 96);
#pragma unroll 1
    for (int t0 = 0; t0 < SEQ; t0 += 128) { HG_BATCH(0, t0); HG_BATCH(1, t0 + 32); HG_BATCH(2, t0 + 64); HG_BATCH(3, t0 + 96); }
#undef HG_FETCH
#undef HG_BATCH
    float* so = p.out + O_HGRN_P + ((size_t)(n * 8 + h) * 128 + kg * 4) * 128 + dvg * 16 + vcol;
    so[0] = S01[0]; so[128] = S01[1]; so[256] = S23[0]; so[384] = S23[1];
    __syncthreads();
}

__device__ __forceinline__ void hgrn_sample_item(const Params& p, int item, LAS unsigned char* lds, int tid) {
    LAS float* qs = (LAS float*)lds;
    LAS float* fs = qs + 1024;
    LAS float* vs = fs + 1024;
    LAS float* opart = vs + 1024;
    const int n = item >> 3, h = item & 7, lane = tid & 63, wave = tid >> 6;
    const bf16_t* proj = (const bf16_t*)(p.ws + WS_PROJ9);
    const float* F = (const float*)(p.ws + WS_F);
    const size_t row0 = (size_t)NTP + (size_t)n * 8;
    { const int tt = tid >> 6, k2 = (tid & 63) * 2; const size_t r = row0 + tt;
      const unsigned qw = *(const unsigned*)(proj + r * LDP + C_HQ + h * 128 + k2); const f32x2 ff = *(const f32x2*)(F + r * 1024 + h * 128 + k2);
      const unsigned vw = *(const unsigned*)(proj + r * LDP + C_HI + h * 128 + k2);
      qs[tt * 128 + k2] = bflo(qw); qs[tt * 128 + k2 + 1] = bfhi(qw); fs[tt * 128 + k2] = ff[0]; fs[tt * 128 + k2 + 1] = ff[1];
      vs[tt * 128 + k2] = bflo(vw); vs[tt * 128 + k2 + 1] = bfhi(vw); }
    const int v4 = tid & 31, kg = tid >> 5;
    const size_t sbase = ((size_t)(n * 8 + h) * 128 + kg * 8) * 128 + v4 * 4;
    f32x4 S[8];
#pragma unroll
    for (int i = 0; i < 8; ++i) S[i] = *(const f32x4*)(p.state_hgrn + sbase + (size_t)i * 128);
    __syncthreads();
#pragma unroll
    for (int tt = 0; tt < 8; ++tt) {
        const f32x4 fa = *(const LAS f32x4*)(fs + tt * 128 + kg * 8), fb = *(const LAS f32x4*)(fs + tt * 128 + kg * 8 + 4);
        const f32x4 qa = *(const LAS f32x4*)(qs + tt * 128 + kg * 8), qb = *(const LAS f32x4*)(qs + tt * 128 + kg * 8 + 4);
        const f32x4 vv = *(const LAS f32x4*)(vs + tt * 128 + v4 * 4);
        f32x4 po = (f32x4){0.f, 0.f, 0.f, 0.f};
#pragma unroll
        for (int i = 0; i < 8; ++i) { const float f = (i < 4) ? fa[i & 3] : fb[i & 3], q = (i < 4) ? qa[i & 3] : qb[i & 3];
            S[i] = S[i] * f + vv * (1.f - f); po += S[i] * q; }
#pragma unroll
        for (int e = 0; e < 4; ++e) po[e] += __shfl_xor(po[e], 32);
        if (lane < 32) *(LAS f32x4*)(opart + (tt * 8 + wave) * 128 + v4 * 4) = po;
    }
    float* so = p.out + O_HGRN_S + sbase;
#pragma unroll
    for (int i = 0; i < 8; ++i) *(f32x4*)(so + (size_t)i * 128) = S[i];
    __syncthreads();
    { const int tt = tid >> 6, v = (tid & 63) * 2; float o0 = 0.f, o1 = 0.f;
#pragma unroll
      for (int w = 0; w < 8; ++w) { const f32x2 t = *(const LAS f32x2*)(opart + (tt * 8 + w) * 128 + v); o0 += t[0]; o1 += t[1]; }
      const float ss = wave_sum(o0 * o0 + o1 * o1), rinv = rsqrtf(ss * (1.f / 128.f) + EPS);
      const size_t r = row0 + tt; const f32x2 gg = *(const f32x2*)(p.g_hgrn + h * 128 + v);
      const unsigned gw = *(const unsigned*)(proj + r * LDP + C_HOG + h * 128 + v);
      bf16_t* og = (bf16_t*)(p.ws + WS_ACT3) + (size_t)9216 * 1024 + tl(r, h * 128 + v, 1024);
      *(unsigned*)og = pk2(o0 * rinv * gg[0] * bflo(gw), o1 * rinv * gg[1] * bfhi(gw)); }
    __syncthreads();
}

__device__ __forceinline__ void hgrn_norm_rows(const Params& p) {
    const int tid = threadIdx.x, lane = tid & 63, gw = blockIdx.x * 8 + (tid >> 6), NGW = gridDim.x * 8;
    const bf16_t* proj = (const bf16_t*)(p.ws + WS_PROJ9); const float* oraw = (const float*)(p.ws + WS_ORAW);
    bf16_t* og = (bf16_t*)(p.ws + WS_ACT3) + (size_t)9216 * 1024;
    for (int r = gw; r < NTP; r += NGW) {
        f32x4 o[4]; float ss = 0.f;
#pragma unroll
        for (int j = 0; j < 4; ++j) { o[j] = *(const f32x4*)(oraw + (size_t)r * 1024 + lane * 16 + j * 4); ss += (o[j][0] * o[j][0] + o[j][1] * o[j][1]) + (o[j][2] * o[j][2] + o[j][3] * o[j][3]); }
        ss += __shfl_xor(ss, 1); ss += __shfl_xor(ss, 2); ss += __shfl_xor(ss, 4);
        const float rinv = rsqrtf(ss * (1.f / 128.f) + EPS);
        const u32x4 ga = *(const u32x4*)(proj + (size_t)r * LDP + C_HOG + lane * 16), gb = *(const u32x4*)(proj + (size_t)r * LDP + C_HOG + lane * 16 + 8);
        f32x4 g[4];
#pragma unroll
        for (int j = 0; j < 4; ++j) g[j] = *(const f32x4*)(p.g_hgrn + lane * 16 + j * 4);
        u32x4 oa, ob;
        oa.x = pk2(o[0][0] * rinv * g[0][0] * bflo(ga.x), o[0][1] * rinv * g[0][1] * bfhi(ga.x)); oa.y = pk2(o[0][2] * rinv * g[0][2] * bflo(ga.y), o[0][3] * rinv * g[0][3] * bfhi(ga.y));
        oa.z = pk2(o[1][0] * rinv * g[1][0] * bflo(ga.z), o[1][1] * rinv * g[1][1] * bfhi(ga.z)); oa.w = pk2(o[1][2] * rinv * g[1][2] * bflo(ga.w), o[1][3] * rinv * g[1][3] * bfhi(ga.w));
        ob.x = pk2(o[2][0] * rinv * g[2][0] * bflo(gb.x), o[2][1] * rinv * g[2][1] * bfhi(gb.x)); ob.y = pk2(o[2][2] * rinv * g[2][2] * bflo(gb.y), o[2][3] * rinv * g[2][3] * bfhi(gb.y));
        ob.z = pk2(o[3][0] * rinv * g[3][0] * bflo(gb.z), o[3][1] * rinv * g[3][1] * bfhi(gb.z)); ob.w = pk2(o[3][2] * rinv * g[3][2] * bflo(gb.w), o[3][3] * rinv * g[3][3] * bfhi(gb.w));
        *(u32x4*)(og + tl((size_t)r, lane * 16, 1024)) = oa; *(u32x4*)(og + tl((size_t)r, lane * 16 + 8, 1024)) = ob;
    }
}

template <bool SAMPLE>
__device__ __forceinline__ void conv_item(const Params& p, int item, LAS unsigned char* lds, int tid) {
    constexpr int T = SAMPLE ? 8 : 32;
    constexpr int GP = 4, NG = (T + 32) / GP, G0 = 32 / GP;
    LAS float* dcs = (LAS float*)lds;
    const bf16_t* proj = (const bf16_t*)(p.ws + WS_PROJ9);
    const int n = SAMPLE ? item : (item >> 6), t0 = SAMPLE ? 0 : (item & 63) * 32;
    const size_t rowb = SAMPLE ? ((size_t)NTP + (size_t)n * 8) : ((size_t)n * SEQ);
    const int c0 = 2 * tid;
    float w0[31], w1[31], x0[31], x1[31];
#pragma unroll
    for (int j = 0; j < 31; ++j) { const f32x2 w = *(const f32x2*)(p.conv_w + j * 1024 + c0); w0[j] = w[0]; w1[j] = w[1]; x0[j] = 0.f; x1[j] = 0.f; }
    const f32x2 bias = *(const f32x2*)(p.conv_b + c0);
    unsigned ra[GP], rg[GP];
#define CONV_ISSUE(g) do { \
        if (SAMPLE && (g) < G0) { _Pragma("unroll") for (int i = 0; i < GP; ++i) { const int ti = -2 + GP * (g) + i; \
            const unsigned* tp = (const unsigned*)(p.state_conv + ((size_t)n * 30 + (ti < 0 ? 0 : ti)) * 1024 + c0); ra[i] = tp[0]; rg[i] = tp[1]; } } \
        else { _Pragma("unroll") for (int i = 0; i < GP; ++i) { const int t = t0 - 32 + GP * (g) + i; const bf16_t* rp = proj + (rowb + (t < 0 ? 0 : t)) * LDP + c0; \
            ra[i] = *(const unsigned*)(rp + C_CV); rg[i] = *(const unsigned*)(rp + C_CG); } } } while (0)
    CONV_ISSUE(0);
#pragma unroll 1
    for (int g = 0; g < NG; ++g) {
        float u0[GP], u1[GP];
        if (SAMPLE && g < G0) {
#pragma unroll
            for (int i = 0; i < GP; ++i) { const bool ok = (-2 + GP * g + i) >= 0; u0[i] = ok ? __builtin_bit_cast(float, ra[i]) : 0.f; u1[i] = ok ? __builtin_bit_cast(float, rg[i]) : 0.f; }
        } else {
#pragma unroll
            for (int i = 0; i < GP; ++i) { const bool ok = (t0 - 32 + GP * g + i) >= 0; u0[i] = ok ? bflo(ra[i]) * bflo(rg[i]) : 0.f; u1[i] = ok ? bfhi(ra[i]) * bfhi(rg[i]) : 0.f; }
        }
        if (g + 1 < NG) CONV_ISSUE(g + 1);
#pragma unroll
        for (int i = 0; i < GP; ++i) {
            const int pp = -32 + GP * g + i, t = t0 + pp;
            if (SAMPLE) { if (pp >= -22) *(f32x2*)(p.out + O_CONV_S + ((size_t)n * 30 + (pp + 22)) * 1024 + c0) = (f32x2){u0[i], u1[i]}; }
            else { if (t >= SEQ - 30) *(f32x2*)(p.out + O_CONV_P + ((size_t)n * 30 + (t - (SEQ - 30))) * 1024 + c0) = (f32x2){u0[i], u1[i]}; }
#pragma unroll
            for (int j = 0; j < 30; ++j) { x0[j] = x0[j + 1]; x1[j] = x1[j + 1]; }
            x0[30] = u0[i]; x1[30] = u1[i];
            if (g >= G0) {
                float d0 = bias[0], d1 = bias[1];
#pragma unroll
                for (int j = 0; j < 31; ++j) { d0 += w0[j] * x0[j]; d1 += w1[j] * x1[j]; }
                *(LAS f32x2*)(dcs + (pp) * 1024 + c0) = (f32x2){d0, d1};
            }
        }
    }
#undef CONV_ISSUE
    __syncthreads();
    { const int lane = tid & 63, wave = tid >> 6;
      bf16_t* aact = (bf16_t*)(p.ws + WS_ACT3);
      for (int pp = wave; pp < T; pp += 8) {
          f32x4 v[4]; float s = 0.f;
#pragma unroll
          for (int j = 0; j < 4; ++j) { v[j] = *(const LAS f32x4*)(dcs + pp * 1024 + j * 256 + lane * 4); s += (v[j][0] + v[j][1]) + (v[j][2] + v[j][3]); }
          const float mean = wave_sum(s) * (1.f / 1024.f); float s2 = 0.f;
#pragma unroll
          for (int j = 0; j < 4; ++j) { v[j] = v[j] - mean; s2 += (v[j][0] * v[j][0] + v[j][1] * v[j][1]) + (v[j][2] * v[j][2] + v[j][3] * v[j][3]); }
          const float rstd = rsqrtf(wave_sum(s2) * (1.f / 1024.f) + EPS);
          const size_t r = rowb + t0 + pp;
          bf16_t* arow = aact + tl(r, lane * 4, 1024);
#pragma unroll
          for (int j = 0; j < 4; ++j) { const int c = j * 256 + lane * 4;
              const f32x4 lg = *(const f32x4*)(p.ln_g + c), lbv = *(const f32x4*)(p.ln_b + c);
              const u32x2 sg = *(const u32x2*)(proj + r * LDP + C_CS + c);
              const float y0 = siluf(v[j][0] * rstd * lg[0] + lbv[0]) * bflo(sg.x), y1 = siluf(v[j][1] * rstd * lg[1] + lbv[1]) * bfhi(sg.x);
              const float y2 = siluf(v[j][2] * rstd * lg[2] + lbv[2]) * bflo(sg.y), y3 = siluf(v[j][3] * rstd * lg[3] + lbv[3]) * bfhi(sg.y);
              u32x2 o; o.x = pk2(y0, y1); o.y = pk2(y2, y3);
              *(u32x2*)(arow + j * 65536) = o; }
      } }
    __syncthreads();
}

__device__ __forceinline__ void attn_prompt_item(const Params& p, int item, LAS unsigned char* lds, int tid) {
    const int lane = tid & 63, wave = tid >> 6, l15 = lane & 15, quad = lane >> 4;
    const int n = item >> 6, h = (item >> 4) & 3, qt = item & 15;
    const bf16_t* proj = (const bf16_t*)(p.ws + WS_PROJ9);
    const bf16_t* kb = (const bf16_t*)(p.ws + WS_MKB) + (size_t)(n * 4 + h) * 65536;
    const bf16_t* vt = (const bf16_t*)(p.ws + WS_MVT) + (size_t)(n * 4 + h) * 65536;
    const size_t qrow = (size_t)n * SEQ + qt * 128 + wave * 16 + l15;
    u32x4 st[16];
#pragma unroll
    for (int i = 0; i < 16; ++i) st[i] = *(const u32x4*)(kb + (size_t)(tid + 512 * i) * 8);
    bf16x8 qf[8];
#pragma unroll
    for (int s = 0; s < 8; ++s) qf[s] = *(const bf16x8*)(proj + qrow * LDP + C_AQ + h * 256 + s * 32 + quad * 8);
#pragma unroll
    for (int i = 0; i < 16; ++i) { const int id = tid + 512 * i, r = id >> 5, c = id & 31; *(LAS u32x4*)(lds + r * 512 + ((c ^ (r & 15)) * 16)) = st[i]; }
    __syncthreads();
    f32x4 sc[16];
#pragma unroll
    for (int T = 0; T < 16; ++T) {
        sc[T] = (f32x4){0.f, 0.f, 0.f, 0.f};
        const LAS unsigned char* kr = lds + (T * 16 + l15) * 512;
#pragma unroll
        for (int s = 0; s < 8; ++s) { const bf16x8 a = *(const LAS bf16x8*)(kr + (((s * 4 + quad) ^ l15) * 16)); sc[T] = __builtin_amdgcn_mfma_f32_16x16x32_bf16(a, qf[s], sc[T], 0, 0, 0); }
    }
#pragma unroll
    for (int i = 0; i < 16; ++i) st[i] = *(const u32x4*)(vt + (size_t)(tid + 512 * i) * 8);
    __syncthreads();
    float mx = -3.0e38f;
#pragma unroll
    for (int T = 0; T < 16; ++T) mx = fmaxf(mx, fmaxf(fmaxf(sc[T][0], sc[T][1]), fmaxf(sc[T][2], sc[T][3])));
    mx = fmaxf(mx, __shfl_xor(mx, 16)); mx = fmaxf(mx, __shfl_xor(mx, 32));
    float sum = 0.f;
#pragma unroll
    for (int T = 0; T < 16; ++T) {
#pragma unroll
        for (int e = 0; e < 4; ++e) { sc[T][e] = __expf(sc[T][e] - mx); sum += sc[T][e]; } }
    sum += __shfl_xor(sum, 16); sum += __shfl_xor(sum, 32);
    const float rs = 1.f / sum;
    bf16x8 pb[8];
#pragma unroll
    for (int s2 = 0; s2 < 8; ++s2) {
        u32x4 w; w.x = pk2(sc[2 * s2][0], sc[2 * s2][1]); w.y = pk2(sc[2 * s2][2], sc[2 * s2][3]); w.z = pk2(sc[2 * s2 + 1][0], sc[2 * s2 + 1][1]); w.w = pk2(sc[2 * s2 + 1][2], sc[2 * s2 + 1][3]);
        pb[s2] = __builtin_bit_cast(bf16x8, w);
    }
#pragma unroll
    for (int i = 0; i < 16; ++i) { const int id = tid + 512 * i, r = id >> 5, c = id & 31; *(LAS u32x4*)(lds + r * 512 + ((c ^ (r & 15)) * 16)) = st[i]; }
    __syncthreads();
    bf16_t* aog_row = (bf16_t*)(p.ws + WS_ACT3) + (size_t)2 * 9216 * 1024 + tl(qrow, h * 256 + quad * 4, 1024);
    f32x4 oacc[16];
#pragma unroll
    for (int Tv = 0; Tv < 16; ++Tv) {
        oacc[Tv] = (f32x4){0.f, 0.f, 0.f, 0.f};
        const LAS unsigned char* vr = lds + (Tv * 16 + l15) * 512 + (quad & 1) * 8;
#pragma unroll
        for (int s2 = 0; s2 < 8; ++s2) {
            const int ch = 4 * s2 + (quad >> 1);
            const u32x2 lo = *(const LAS u32x2*)(vr + ((ch ^ l15) * 16)), hi = *(const LAS u32x2*)(vr + (((ch + 2) ^ l15) * 16));
            u32x4 w; w.x = lo.x; w.y = lo.y; w.z = hi.x; w.w = hi.y;
            oacc[Tv] = __builtin_amdgcn_mfma_f32_16x16x32_bf16(__builtin_bit_cast(bf16x8, w), pb[s2], oacc[Tv], 0, 0, 0);
        }
    }
#pragma unroll
    for (int Tv = 0; Tv < 16; ++Tv) {
        const int dv = Tv * 16 + quad * 4;
        const u32x2 sg = *(const u32x2*)(proj + qrow * LDP + C_AS + h * 256 + dv);
        u32x2 o; o.x = pk2(oacc[Tv][0] * rs * bflo(sg.x), oacc[Tv][1] * rs * bfhi(sg.x)); o.y = pk2(oacc[Tv][2] * rs * bflo(sg.y), oacc[Tv][3] * rs * bfhi(sg.y));
        *(u32x2*)(aog_row + (Tv >> 2) * 16384 + (Tv & 3) * 16) = o;
    }
    __syncthreads();
}

__device__ __forceinline__ void attn_sample_item(const Params& p, int item, LAS unsigned char* lds, int tid) {
    LAS float* Ssh = (LAS float*)lds;
    LAS float* Psh = Ssh + 2048;
    LAS float* Opart = Psh + 2048;
    const int lane = tid & 63, wave = tid >> 6, l15 = lane & 15, quad = lane >> 4;
    const int n = item >> 2, h = item & 3;
    const bf16_t* proj = (const bf16_t*)(p.ws + WS_PROJ9);
    const size_t row0 = (size_t)NTP + (size_t)n * 8;
    const float* kc = p.cache_k + ((size_t)n * 256 * 4 + h) * 256;
    const float* vc = p.cache_v + ((size_t)n * 256 * 4 + h) * 256;
    {
        bf16x8 qf[8];
        const size_t qrow = row0 + (lane & 7);
#pragma unroll
        for (int s = 0; s < 8; ++s) qf[s] = *(const bf16x8*)(proj + qrow * LDP + C_AQ + h * 256 + s * 32 + quad * 8);
#pragma unroll
        for (int tl = 0; tl < 2; ++tl) {
            const int T = wave * 2 + tl;
            f32x4 sc = (f32x4){0.f, 0.f, 0.f, 0.f};
            const float* kr = kc + (size_t)(T * 16 + l15) * 1024 + quad * 8;
#pragma unroll
            for (int s = 0; s < 8; ++s) {
                const f32x4 k0 = *(const f32x4*)(kr + s * 32), k1 = *(const f32x4*)(kr + s * 32 + 4);
                u32x4 w; w.x = pk2(k0[0], k0[1]); w.y = pk2(k0[2], k0[3]); w.z = pk2(k1[0], k1[1]); w.w = pk2(k1[2], k1[3]);
                sc = __builtin_amdgcn_mfma_f32_16x16x32_bf16(__builtin_bit_cast(bf16x8, w), qf[s], sc, 0, 0, 0);
            }
            if (l15 < 8) {
#pragma unroll
                for (int e = 0; e < 4; ++e) Ssh[l15 * 256 + T * 16 + quad * 4 + e] = sc[e];
            }
        }
    }
    __syncthreads();
    {
        const f32x4 s4 = *(const LAS f32x4*)(Ssh + wave * 256 + lane * 4);
        const float mx = wave_max(fmaxf(fmaxf(s4[0], s4[1]), fmaxf(s4[2], s4[3])));
        f32x4 e4; e4[0] = __expf(s4[0] - mx); e4[1] = __expf(s4[1] - mx); e4[2] = __expf(s4[2] - mx); e4[3] = __expf(s4[3] - mx);
        const float rs = 1.f / wave_sum((e4[0] + e4[1]) + (e4[2] + e4[3]));
#pragma unroll
        for (int e = 0; e < 4; ++e) Psh[(lane * 4 + e) * 8 + wave] = e4[e] * rs;
    }
    __syncthreads();
    {
        f32x4 acc[8];
#pragma unroll
        for (int q = 0; q < 8; ++q) acc[q] = (f32x4){0.f, 0.f, 0.f, 0.f};
        const float* vr = vc + (size_t)(wave * 32) * 1024 + lane * 4;
#pragma unroll 8
        for (int kk = 0; kk < 32; ++kk) {
            const f32x4 v4 = *(const f32x4*)(vr + (size_t)kk * 1024);
            const f32x4 pa = *(const LAS f32x4*)(Psh + (wave * 32 + kk) * 8), pb = *(const LAS f32x4*)(Psh + (wave * 32 + kk) * 8 + 4);
            acc[0] += v4 * pa[0]; acc[1] += v4 * pa[1]; acc[2] += v4 * pa[2]; acc[3] += v4 * pa[3];
            acc[4] += v4 * pb[0]; acc[5] += v4 * pb[1]; acc[6] += v4 * pb[2]; acc[7] += v4 * pb[3];
        }
#pragma unroll
        for (int q = 0; q < 8; ++q) *(LAS f32x4*)(Opart + (wave * 8 + q) * 256 + lane * 4) = acc[q];
    }
    __syncthreads();
    {
        f32x4 o = (f32x4){0.f, 0.f, 0.f, 0.f};
#pragma unroll
        for (int w = 0; w < 8; ++w) o += *(const LAS f32x4*)(Opart + (w * 8 + wave) * 256 + lane * 4);
        const size_t r = row0 + wave;
        const u32x2 sg = *(const u32x2*)(proj + r * LDP + C_AS + h * 256 + lane * 4);
        u32x2 ov; ov.x = pk2(o[0] * bflo(sg.x), o[1] * bfhi(sg.x)); ov.y = pk2(o[2] * bflo(sg.y), o[3] * bfhi(sg.y));
        bf16_t* aog = (bf16_t*)(p.ws + WS_ACT3) + (size_t)2 * 9216 * 1024;
        *(u32x2*)(aog + tl(r, h * 256 + lane * 4, 1024)) = ov;
    }
    __syncthreads();
}

__device__ __forceinline__ void p2_mixers(const Params& p, LAS unsigned char* lds) {
    const int tid = threadIdx.x, G = gridDim.x, c = blockIdx.x, mask = p.pad;
    if (mask & 1) for (int it = c; it < 256; it += G) hgrn_prompt_item(p, it, lds, tid);
    if (mask & 2) { for (int it = c; it < 256; it += G) conv_item<false>(p, it, lds, tid);
                    for (int it = c; it < 128; it += G) conv_item<true>(p, it, lds, tid); }
    if (mask & 4) for (int it = c; it < 256; it += G) attn_prompt_item(p, it, lds, tid);
    if (mask & 8) for (int it = c; it < 512; it += G) attn_sample_item(p, it, lds, tid);
    if (mask & 16) for (int it = c; it < 1024; it += G) hgrn_sample_item(p, it, lds, tid);
}

__device__ __forceinline__ void p6_final_norm(const Params& p) {
    const int tid = threadIdx.x, lane = tid & 63, gw = blockIdx.x * 8 + (tid >> 6), NGW = gridDim.x * 8;
    for (int r = gw; r < NTOK; r += NGW) {
        float* zr = p.out + (size_t)r * 2048;
        f32x4 v[8]; float ss = 0.f;
#pragma unroll
        for (int j = 0; j < 8; ++j) { v[j] = ((const f32x4*)zr)[lane + 64 * j]; ss += (v[j][0] * v[j][0] + v[j][1] * v[j][1]) + (v[j][2] * v[j][2] + v[j][3] * v[j][3]); }
        ss = wave_sum(ss);
        const float rinv = rsqrtf(ss * (1.f / 2048.f) + EPS);
#pragma unroll
        for (int j = 0; j < 8; ++j) { const f32x4 gg = ((const f32x4*)p.g_final)[lane + 64 * j]; ((f32x4*)zr)[lane + 64 * j] = v[j] * rinv * gg; }
    }
}

__global__ void __launch_bounds__(512, 2) fwd_megakernel(Params p) {
    extern __shared__ __attribute__((aligned(16))) unsigned char shm[];
    LAS unsigned char* lds = (LAS unsigned char*)shm;
    cg::grid_group grid = cg::this_grid();
    const int G = gridDim.x, c = blockIdx.x;
#define SEAM(ph) do { if (p.coop && (ph) + 1 < p.ph_hi) { \
        asm volatile("s_waitcnt vmcnt(0) lgkmcnt(0)" ::: "memory"); __syncthreads(); \
        grid.sync(); \
        if (threadIdx.x < 64) { __builtin_amdgcn_fence(__ATOMIC_ACQUIRE, "agent"); asm volatile("s_waitcnt vmcnt(0)" ::: "memory"); } \
        __syncthreads(); } } while (0)
#define RUNS(ph) (p.ph_lo <= (ph) && (ph) < p.ph_hi)
    if (RUNS(0)) { p0_prologue(p, lds); SEAM(0); }
    if (RUNS(1)) {
        SchedP1 S; S.G = G; S.c = c; S.A = (const char*)(p.ws + WS_HA); S.Bt = (const char*)(p.ws + WS_WT1);
        EpiP1 E; E.proj = (bf16_t*)(p.ws + WS_PROJ9); E.gate = (bf16_t*)(p.ws + WS_GATE); E.F = (float*)(p.ws + WS_F); E.lb = (const float*)(p.ws + WS_LB);
        E.b_gate = p.b_gate; E.out = p.out; E.mkb = (bf16_t*)(p.ws + WS_MKB); E.mvt = (bf16_t*)(p.ws + WS_MVT);
        pg8::gemm_phase(lds, 2048, S, E); SEAM(1);
    }
    if (RUNS(2)) { p2_mixers(p, lds); SEAM(2); }
    if (RUNS(3)) { hgrn_norm_rows(p); SEAM(3); }
    if (RUNS(4)) {
        SchedP4 S; S.G = G; S.c = c; S.A = (const char*)(p.ws + WS_ACT3); S.Bt = (const char*)(p.ws + WS_WT3);
        EpiP4 E; E.gate = (const bf16_t*)(p.ws + WS_GATE); E.merged = (bf16_t*)(p.ws + WS_MERGED);
        pg8::gemm_phase(lds, 1024, S, E); SEAM(4);
    }
    if (RUNS(5)) {
        SchedP5 S; S.G = G; S.c = c; S.A = (const char*)(p.ws + WS_MERGED); S.Bt = (const char*)(p.ws + WS_WTO);
        EpiP5 E; E.xp = p.x_prompt; E.xs = p.x_sample; E.out = p.out;
        pg8::gemm_phase(lds, 2048, S, E); SEAM(5);
    }
    if (RUNS(6)) { p6_final_norm(p); }
#undef RUNS
#undef SEAM
}

extern "C" void kernel_launch(void* const* d_in, const int* in_sizes, int n_in, void* d_out, int out_size, void* d_ws, size_t ws_size, hipStream_t stream) {
    static int grid = 0;
    if (grid == 0) {
        if (n_in != 23 || ws_size < WS_END) { fprintf(stderr, "kernel_launch: expected 23 inputs and >= %zu bytes of workspace, got %d / %zu\n", (size_t)WS_END, n_in, ws_size); grid = -1; return; }
        int dev = 0, cus = 0, per_cu = 0;
        hipGetDevice(&dev); hipDeviceGetAttribute(&cus, hipDeviceAttributeMultiprocessorCount, dev);
        if (hipFuncSetAttribute((const void*)fwd_megakernel, hipFuncAttributeMaxDynamicSharedMemorySize, LDS_BYTES) != hipSuccess) { fprintf(stderr, "kernel_launch: hipFuncSetAttribute failed\n"); grid = -1; return; }
        if (hipOccupancyMaxActiveBlocksPerMultiprocessor(&per_cu, (const void*)fwd_megakernel, 512, LDS_BYTES) != hipSuccess || per_cu < 1) { fprintf(stderr, "kernel_launch: occupancy query failed (%d)\n", per_cu); (void)hipGetLastError(); per_cu = 1; }
        grid = cus * 1;
        if (grid <= 0) grid = 256;
    }
    if (grid < 0) return;
    Params p{};
    const float** pp = (const float**)&p;
    for (int i = 0; i < 23; ++i) pp[i] = (const float*)d_in[i];
    p.out = (float*)d_out; p.ws = (unsigned char*)d_ws; p.pad = 31;
#if N_LAUNCH_MODE == 1
    p.ph_lo = 0; p.ph_hi = N_PHASES; p.coop = 1;
    void* args[] = {&p};
    hipError_t e = hipLaunchCooperativeKernel((const void*)fwd_megakernel, dim3(grid), dim3(512), args, LDS_BYTES, stream);
    if (e != hipSuccess) fprintf(stderr, "cooperative launch failed: %s (grid %d)\n", hipGetErrorString(e), grid);
#else
    for (int ph = 0; ph < N_PHASES; ++ph) {
        p.ph_lo = ph; p.ph_hi = ph + 1; p.coop = 0;
        hipLaunchKernelGGL(fwd_megakernel, dim3(grid), dim3(512), LDS_BYTES, stream, p);
        if ((REP_MASK >> ph) & 1) { if (ph == 2) p.pad = P2_SUBMASK; hipLaunchKernelGGL(fwd_megakernel, dim3(grid), dim3(512), LDS_BYTES, stream, p); p.pad = 31; }
    }
#endif
}
```

```cpp
#include <hip/hip_runtime.h>
#include <hip/hip_cooperative_groups.h>
#include <cstdio>
namespace cg = cooperative_groups;

#define LAS __attribute__((address_space(3)))
typedef unsigned short bf16_t;
typedef short bf16x8 __attribute__((ext_vector_type(8)));
typedef float f32x4 __attribute__((ext_vector_type(4)));
typedef float f32x2 __attribute__((ext_vector_type(2)));
typedef unsigned u32x4 __attribute__((ext_vector_type(4)));
typedef unsigned u32x2 __attribute__((ext_vector_type(2)));

#ifndef REP_MASK
#define REP_MASK 0
#endif
#ifndef P2_SUBMASK
#define P2_SUBMASK 31
#endif
#ifndef N_LAUNCH_MODE
#define N_LAUNCH_MODE 1
#endif

constexpr int DM = 2048, NTP = 8192, NTS = 1024, NTOK = 9216, SEQ = 2048;
constexpr int LDP = 9216;
constexpr int C_CV = 0, C_CG = 1024, C_CS = 2048, C_HQ = 3072, C_HF = 4096, C_HI = 5120, C_HOG = 6144, C_AQ = 7168, C_AS = 8192;
constexpr int LDG = 6144;
constexpr float EPS = 1e-6f;
constexpr size_t O_YP = 0, O_YS = 16777216, O_CONV_P = 18874368, O_HGRN_P = 18997248, O_MK = 19521536, O_MV = 20570112, O_CONV_S = 21618688, O_HGRN_S = 25550848;
constexpr size_t WS_WT1 = 0;
constexpr size_t WS_WT3 = WS_WT1 + (size_t)17408 * 2048 * 2;
constexpr size_t WS_WTO = WS_WT3 + (size_t)3 * 2048 * 1024 * 2;
constexpr size_t WS_HA = WS_WTO + (size_t)2048 * 2048 * 2;
constexpr size_t WS_ORAW = WS_HA;
constexpr size_t WS_PROJ9 = WS_HA + (size_t)10240 * 2048 * 2;
constexpr size_t WS_MF = WS_PROJ9;
constexpr size_t WS_MERGED = WS_MF + (size_t)9216 * 2048 * 4;
constexpr size_t WS_GATE = WS_PROJ9 + (size_t)9216 * 9216 * 2;
constexpr size_t WS_F = WS_GATE + (size_t)9216 * 6144 * 2;
constexpr size_t WS_MKB = WS_F + (size_t)9216 * 1024 * 4;
constexpr size_t WS_MVT = WS_MKB + (size_t)2097152;
constexpr size_t WS_ACT3 = WS_MVT + (size_t)2097152;
constexpr size_t WS_LB = WS_ACT3 + (size_t)3 * 9216 * 1024 * 2;
constexpr size_t WS_END = WS_LB + 4096;
constexpr int LDS_BYTES = 131072;
constexpr int N_PHASES = 7;

struct Params {
    const float *x_prompt, *x_sample, *state_conv, *state_hgrn, *cache_k, *cache_v, *mem_prompt, *g_pre, *w_in, *conv_w, *conv_b, *ln_g, *ln_b,
        *w_conv_out, *lb_logits, *g_hgrn, *w_hgrn_out, *g_mem, *w_mem_kv, *w_attn_out, *b_gate, *w_out, *g_final;
    float* out; unsigned char* ws; int ph_lo, ph_hi, coop, pad;
};

__device__ __forceinline__ unsigned f2bf(float f) { unsigned u = __builtin_bit_cast(unsigned, f); return (u + 0x7fffu + ((u >> 16) & 1u)) >> 16; }
typedef __bf16 bf16x2_t __attribute__((ext_vector_type(2)));
__device__ __forceinline__ unsigned pk2(float lo, float hi) { const f32x2 v = {lo, hi}; const bf16x2_t r = __builtin_convertvector(v, bf16x2_t); return __builtin_bit_cast(unsigned, r); }
__device__ __forceinline__ float bflo(unsigned w) { return __builtin_bit_cast(float, w << 16); }
__device__ __forceinline__ float bfhi(unsigned w) { return __builtin_bit_cast(float, w & 0xffff0000u); }
__device__ __forceinline__ float bf2f(unsigned short b) { return __builtin_bit_cast(float, ((unsigned)b) << 16); }
__device__ __forceinline__ float sigm(float x) { return __builtin_amdgcn_rcpf(1.f + __expf(-x)); }
__device__ __forceinline__ float siluf(float x) { return x * sigm(x); }
__device__ __forceinline__ size_t tl(size_t row, int col, int K) { return (row >> 8) * ((size_t)256 * K) + (size_t)(col >> 6) * (256 * 64) + (row & 255) * 64 + (col & 63); }
__device__ __forceinline__ float wave_sum(float v) {
#pragma unroll
    for (int o = 1; o < 64; o <<= 1) v += __shfl_xor(v, o);
    return v;
}
__device__ __forceinline__ float wave_max(float v) {
#pragma unroll
    for (int o = 1; o < 64; o <<= 1) v = fmaxf(v, __shfl_xor(v, o));
    return v;
}

namespace pg8 {
constexpr int BM = 256, BK = 64, HALF = 128, HTB = HALF * BK * 2, STAGE_BYTES = 8 * HTB, NXCD = 8, WGM = 8;
__host__ __device__ __forceinline__ int lds_byte(int r, int c) { const int st = (r >> 4) * 2 + (c >> 5), rr = r & 15, cc = c & 31, ob = rr * 64 + cc * 2; return st * 1024 + (ob ^ (((ob >> 9) & 1) << 5)); }
__host__ __device__ __forceinline__ void stage_rc(int b, int& R, int& C) { const int st = b / 1024, sb = b % 1024, swz = sb ^ (((sb >> 9) & 1) << 5); R = (st >> 1) * 16 + swz / 64; C = (st & 1) * 32 + (swz % 64) / 2; }
__host__ __device__ __forceinline__ int perm32(int rho) { const int n = rho >> 4, i = rho & 15; return 8 * (i >> 2) + 4 * n + (i & 3); }
struct Unit { int pm, pn, br; };
__device__ __forceinline__ void tile_of(int wgid, int nM, int nN, int& pm, int& pn) {
    const int nwg = nM * nN;
    { const int q = nwg / NXCD, r = nwg % NXCD, xcd = wgid % NXCD, off = wgid / NXCD; wgid = (xcd < r ? xcd * (q + 1) : r * (q + 1) + (xcd - r) * q) + off; }
    const int nig = WGM * nN, gid = wgid / nig, fm = gid * WGM, gsz = (nM - fm) < WGM ? (nM - fm) : WGM;
    pm = fm + ((wgid % nig) % gsz); pn = (wgid % nig) / gsz;
}

template <class Epi, class Sched>
__device__ __forceinline__ void gemm_phase(LAS unsigned char* lds, const int K, const Sched& S, const Epi& E) {
    const int tid = threadIdx.x, wid = __builtin_amdgcn_readfirstlane(tid >> 6), lane = tid & 63, wr = wid >> 2, wc = wid & 3, fr = lane & 15, fq = lane >> 4;
    const int nt = K / BK;
    unsigned voffA[2], voffB[2];
#pragma unroll
    for (int i = 0; i < 2; ++i) { int R, C; stage_rc(tid * 16 + i * 8192, R, C); const int Rb = (R & ~31) + perm32(R & 31);
        voffA[i] = (unsigned)(R * BK + C) * 2u; voffB[i] = (unsigned)(Rb * BK + C) * 2u; }
    const size_t kstep = (size_t)(BM * BK * 2);
    const size_t hstep = (size_t)HALF * BK * 2;
    const unsigned ldsw = (unsigned)wid * 1024u;
    const int aoff = lds_byte(wr * 64 + fr, fq * 8), boff = lds_byte(wc * 32 + fr, fq * 8);
#define PG8_SA(b, h) (((b) * 2 + (h)) * HTB)
#define PG8_SB(b, h) ((4 + (b) * 2 + (h)) * HTB)
#define PG8_STAGE(bufoff, gbase, voff) do { _Pragma("unroll") for (int _i = 0; _i < 2; ++_i) \
        __builtin_amdgcn_global_load_lds((const unsigned*)((const char*)(gbase) + (voff)[_i]), (LAS unsigned*)(lds + (bufoff) + ldsw + _i * 8192), 16, 0, 0); } while (0)
#define PG8_LDA(dst, b, h) do { _Pragma("unroll") for (int m = 0; m < 4; ++m) _Pragma("unroll") for (int k = 0; k < 2; ++k) dst[m][k] = *(const LAS bf16x8*)(lds + PG8_SA(b, h) + aoff + m * 2048 + k * 1024); } while (0)
#define PG8_LDB(dst, b, h) do { _Pragma("unroll") for (int n = 0; n < 2; ++n) _Pragma("unroll") for (int k = 0; k < 2; ++k) dst[n][k] = *(const LAS bf16x8*)(lds + PG8_SB(b, h) + boff + n * 2048 + k * 1024); } while (0)
#define PG8_MMA(ai, bj, At, Bt) do { __builtin_amdgcn_s_setprio(1); _Pragma("unroll") for (int m = 0; m < 4; ++m) _Pragma("unroll") for (int n = 0; n < 2; ++n) _Pragma("unroll") for (int k = 0; k < 2; ++k) \
        acc[ai][bj][m][n] = __builtin_amdgcn_mfma_f32_16x16x32_bf16(Bt[n][k], At[m][k], acc[ai][bj][m][n], 0, 0, 0); __builtin_amdgcn_s_setprio(0); } while (0)
#define PG8_WAIT_V(n) asm volatile("s_waitcnt vmcnt(" #n ")" ::: "memory")
#define PG8_WAIT_L(n) asm volatile("s_waitcnt lgkmcnt(" #n ")" ::: "memory")
#define PG8_BAR __builtin_amdgcn_s_barrier()
#define PG8_SCHED __builtin_amdgcn_sched_barrier(0)
    Unit cur, nxt; int ui = 0;
    if (!S.next(0, cur)) return;
    f32x4 acc[2][2][4][2];
#pragma unroll
    for (int a = 0; a < 2; ++a)
#pragma unroll
        for (int b = 0; b < 2; ++b)
#pragma unroll
            for (int m = 0; m < 4; ++m)
#pragma unroll
                for (int n = 0; n < 2; ++n) acc[a][b][m][n] = (f32x4){0.f, 0.f, 0.f, 0.f};
    bf16x8 At[4][2], B0[2][2], B1[2][2];
    const char* cA = S.a_base(cur); const char* cB = S.b_base(cur);
    PG8_STAGE(PG8_SB(0, 0), cB, voffB); PG8_STAGE(PG8_SA(0, 0), cA, voffA); PG8_STAGE(PG8_SB(0, 1), cB + hstep, voffB); PG8_STAGE(PG8_SA(0, 1), cA + hstep, voffA);
    if (wr == 1) PG8_BAR;
    PG8_WAIT_V(4); PG8_BAR;
    PG8_STAGE(PG8_SB(1, 0), cB + kstep, voffB); PG8_STAGE(PG8_SA(1, 0), cA + kstep, voffA); PG8_STAGE(PG8_SB(1, 1), cB + hstep + kstep, voffB);
    PG8_WAIT_V(6); PG8_BAR;
    for (;;) {
        const bool has_next = S.next(ui + 1, nxt);
        const char* nA = has_next ? S.a_base(nxt) : cA; const char* nB = has_next ? S.b_base(nxt) : cB;
        for (int t = 0; t < nt; t += 2) {
            const bool last = (t == nt - 2);
            const char* a1 = cA + (size_t)(t + 1) * kstep;
            const char* a2 = last ? nA : cA + (size_t)(t + 2) * kstep; const char* b2 = last ? nB : cB + (size_t)(t + 2) * kstep;
            const char* a3 = a2 + kstep; const char* b3 = b2 + kstep;
            PG8_LDB(B0, 0, 0); PG8_SCHED; PG8_LDA(At, 0, 0); PG8_STAGE(PG8_SA(1, 1), a1 + hstep, voffA);
            PG8_WAIT_L(8); PG8_BAR; PG8_WAIT_L(0); PG8_MMA(0, 0, At, B0); PG8_BAR; PG8_SCHED;
            PG8_LDB(B1, 0, 1); PG8_STAGE(PG8_SB(0, 0), b2, voffB);
            PG8_BAR; PG8_WAIT_L(0); PG8_MMA(0, 1, At, B1); PG8_BAR;
            PG8_LDA(At, 0, 1); PG8_STAGE(PG8_SA(0, 0), a2, voffA);
            PG8_BAR; PG8_WAIT_L(0); PG8_MMA(1, 0, At, B0); PG8_BAR; PG8_SCHED;
            PG8_STAGE(PG8_SB(0, 1), b2 + hstep, voffB);
            PG8_WAIT_V(6); PG8_BAR; PG8_MMA(1, 1, At, B1); PG8_BAR;
            PG8_LDB(B0, 1, 0); PG8_SCHED; PG8_LDA(At, 1, 0); PG8_STAGE(PG8_SA(0, 1), a2 + hstep, voffA);
            PG8_WAIT_L(8); PG8_BAR; PG8_WAIT_L(0); PG8_MMA(0, 0, At, B0); PG8_BAR; PG8_SCHED;
            PG8_LDB(B1, 1, 1); PG8_STAGE(PG8_SB(1, 0), b3, voffB);
            PG8_BAR; PG8_WAIT_L(0); PG8_MMA(0, 1, At, B1); PG8_BAR;
            PG8_LDA(At, 1, 1); PG8_STAGE(PG8_SA(1, 0), a3, voffA);
            PG8_BAR; PG8_WAIT_L(0); PG8_MMA(1, 0, At, B0); PG8_BAR; PG8_SCHED;
            PG8_STAGE(PG8_SB(1, 1), b3 + hstep, voffB);
            PG8_WAIT_V(6); PG8_BAR; PG8_MMA(1, 1, At, B1); PG8_BAR;
        }
        const bool keep = E(acc, cur, wr, wc, fr, fq);
        if (!has_next) break;
        if (!keep)
#pragma unroll
        for (int a = 0; a < 2; ++a)
#pragma unroll
            for (int b = 0; b < 2; ++b)
#pragma unroll
                for (int m = 0; m < 4; ++m)
#pragma unroll
                    for (int n = 0; n < 2; ++n) acc[a][b][m][n] = (f32x4){0.f, 0.f, 0.f, 0.f};
        cur = nxt; cA = nA; cB = nB; ++ui;
    }
    PG8_WAIT_V(0);
    if (wr == 0) PG8_BAR;
    PG8_BAR;
#undef PG8_SA
#undef PG8_SB
#undef PG8_STAGE
#undef PG8_LDA
#undef PG8_LDB
#undef PG8_MMA
#undef PG8_WAIT_V
#undef PG8_WAIT_L
#undef PG8_BAR
#undef PG8_SCHED
}
}
using pg8::Unit;

struct SchedP1 {
    int G, c; const char* A; const char* Bt;
    __device__ __forceinline__ bool next(int i, Unit& u) const {
        const int L = i * G + c; if (L >= 2192) return false;
        u.br = 0;
        if (L >= 2160) { const int idx = L - 2160; u.pm = 36 + (idx >> 3); u.pn = 60 + (idx & 7); return true; }
        pg8::tile_of(L, 36, 60, u.pm, u.pn); return true;
    }
    __device__ __forceinline__ const char* a_base(const Unit& u) const { return A + (size_t)u.pm * (256 * 2048 * 2); }
    __device__ __forceinline__ const char* b_base(const Unit& u) const { return Bt + (size_t)u.pn * (256 * 2048 * 2); }
};
struct EpiP1 {
    bf16_t* proj; bf16_t* gate; float* F; const float* lb; const float* b_gate; float* out; bf16_t* mkb; bf16_t* mvt;
    __device__ __forceinline__ bool operator()(f32x4 (&acc)[2][2][4][2], const Unit& u, int wr, int wc, int fr, int fq) const {
        const int rloc = wr * 64 + fr, cloc = wc * 32 + 8 * fq;
        if (u.pn < 36) {
            const int seg = u.pn >> 2;
#pragma unroll
            for (int bj = 0; bj < 2; ++bj) {
                const int col = u.pn * 256 + bj * 128 + cloc;
                f32x4 l0 = (f32x4){0.f, 0.f, 0.f, 0.f}, l1 = l0;
                if (seg == 4) { l0 = *(const f32x4*)(lb + (col - C_HF)); l1 = *(const f32x4*)(lb + (col - C_HF) + 4); }
#pragma unroll
                for (int ai = 0; ai < 2; ++ai)
#pragma unroll
                    for (int m = 0; m < 4; ++m) {
                        const size_t row = (size_t)u.pm * 256 + ai * 128 + m * 16 + rloc;
                        f32x4 v0 = acc[ai][bj][m][0], v1 = acc[ai][bj][m][1];
                        if (seg == 4) {
#pragma unroll
                            for (int e = 0; e < 4; ++e) { v0[e] = l0[e] + (1.f - l0[e]) * sigm(v0[e]); v1[e] = l1[e] + (1.f - l1[e]) * sigm(v1[e]); }
                            float* fp = F + row * 1024 + (col - C_HF);
                            *(f32x4*)fp = v0; *(f32x4*)(fp + 4) = v1;
                        } else {
                            if (seg == 1) {
#pragma unroll
                                for (int e = 0; e < 4; ++e) { v0[e] = sigm(v0[e]); v1[e] = sigm(v1[e]); }
                            } else if (seg == 2 || seg == 6 || seg == 8) {
#pragma unroll
                                for (int e = 0; e < 4; ++e) { v0[e] = siluf(v0[e]); v1[e] = siluf(v1[e]); }
                            } else if (seg == 3) { v0 *= 0.08838834764831845f; v1 *= 0.08838834764831845f; }
                            else if (seg == 7) { v0 *= 0.0625f; v1 *= 0.0625f; }
                            u32x4 o; o.x = pk2(v0[0], v0[1]); o.y = pk2(v0[2], v0[3]); o.z = pk2(v1[0], v1[1]); o.w = pk2(v1[2], v1[3]);
                            *(u32x4*)(proj + row * LDP + col) = o;
                        }
                    }
            }
        } else if (u.pn < 60) {
#pragma unroll
            for (int bj = 0; bj < 2; ++bj) {
                const int col = (u.pn - 36) * 256 + bj * 128 + cloc;
                const f32x4 b0 = *(const f32x4*)(b_gate + col), b1 = *(const f32x4*)(b_gate + col + 4);
#pragma unroll
                for (int ai = 0; ai < 2; ++ai)
#pragma unroll
                    for (int m = 0; m < 4; ++m) {
                        const size_t row = (size_t)u.pm * 256 + ai * 128 + m * 16 + rloc;
                        f32x4 v0 = acc[ai][bj][m][0] + b0, v1 = acc[ai][bj][m][1] + b1;
#pragma unroll
                        for (int e = 0; e < 4; ++e) { v0[e] = fmaxf(sigm(v0[e]), 1e-6f); v1[e] = fmaxf(sigm(v1[e]), 1e-6f); }
                        u32x4 o; o.x = pk2(v0[0], v0[1]); o.y = pk2(v0[2], v0[3]); o.z = pk2(v1[0], v1[1]); o.w = pk2(v1[2], v1[3]);
                        *(u32x4*)(gate + row * LDG + col) = o;
                    }
            }
        } else {
            const int n = u.pm - 36, isv = (u.pn >= 64) ? 1 : 0, h = (u.pn - 60) & 3;
            float* ob = out + (isv ? O_MV : O_MK);
#pragma unroll
            for (int bj = 0; bj < 2; ++bj) {
                const int d = bj * 128 + cloc;
#pragma unroll
                for (int ai = 0; ai < 2; ++ai)
#pragma unroll
                    for (int m = 0; m < 4; ++m) {
                        const int key = ai * 128 + m * 16 + rloc;
                        const f32x4 v0 = acc[ai][bj][m][0], v1 = acc[ai][bj][m][1];
                        float* op = ob + ((size_t)(n * 256 + key) * 4 + h) * 256 + d;
                        *(f32x4*)op = v0; *(f32x4*)(op + 4) = v1;
                        if (!isv) {
                            u32x4 o; o.x = pk2(v0[0], v0[1]); o.y = pk2(v0[2], v0[3]); o.z = pk2(v1[0], v1[1]); o.w = pk2(v1[2], v1[3]);
                            *(u32x4*)(mkb + ((size_t)(n * 4 + h) * 256 + key) * 256 + d) = o;
                        } else {
                            bf16_t* vp = mvt + ((size_t)(n * 4 + h) * 256 + d) * 256 + key;
#pragma unroll
                            for (int e = 0; e < 4; ++e) { vp[(size_t)e * 256] = (bf16_t)f2bf(v0[e]); vp[(size_t)(e + 4) * 256] = (bf16_t)f2bf(v1[e]); }
                        }
                    }
            }
        }
        return false;
    }
};

struct SchedP4 {
    int G, c; const char* A; const char* Bt;
    __device__ __forceinline__ bool next(int i, Unit& u) const {
        const int tri = i / 3, L = tri * G + c; if (L >= 288) return false;
        u.br = i - tri * 3; pg8::tile_of(L, 36, 8, u.pm, u.pn); return true;
    }
    __device__ __forceinline__ const char* a_base(const Unit& u) const { return A + (size_t)u.br * ((size_t)9216 * 1024 * 2) + (size_t)u.pm * (256 * 1024 * 2); }
    __device__ __forceinline__ const char* b_base(const Unit& u) const { return Bt + (size_t)u.br * ((size_t)2048 * 1024 * 2) + (size_t)u.pn * (256 * 1024 * 2); }
};
struct EpiP4 {
    const bf16_t* gate; bf16_t* merged;
    __device__ __forceinline__ bool operator()(f32x4 (&acc)[2][2][4][2], const Unit& u, int wr, int wc, int fr, int fq) const {
        const int rloc = wr * 64 + fr, cloc = wc * 32 + 8 * fq;
        bf16_t* mbase = merged + tl((size_t)u.pm * 256 + rloc, u.pn * 256 + cloc, 2048);
#pragma unroll
        for (int bj = 0; bj < 2; ++bj) {
            const int col = u.pn * 256 + bj * 128 + cloc;
#pragma unroll
            for (int ai = 0; ai < 2; ++ai)
#pragma unroll
                for (int m = 0; m < 4; ++m) {
                    const size_t row = (size_t)u.pm * 256 + ai * 128 + m * 16 + rloc;
                    const bf16_t* gp = gate + row * LDG + u.br * 2048 + col;
                    const u32x4 g = *(const u32x4*)gp;
                    f32x4 s0 = (f32x4){bflo(g.x), bfhi(g.x), bflo(g.y), bfhi(g.y)}, s1 = (f32x4){bflo(g.z), bfhi(g.z), bflo(g.w), bfhi(g.w)};
                    if (u.br < 2) {
                        const u32x4 h = *(const u32x4*)(gp + 2048);
                        s0[0] *= __builtin_amdgcn_rcpf(bflo(h.x)); s0[1] *= __builtin_amdgcn_rcpf(bfhi(h.x)); s0[2] *= __builtin_amdgcn_rcpf(bflo(h.y)); s0[3] *= __builtin_amdgcn_rcpf(bfhi(h.y));
                        s1[0] *= __builtin_amdgcn_rcpf(bflo(h.z)); s1[1] *= __builtin_amdgcn_rcpf(bfhi(h.z)); s1[2] *= __builtin_amdgcn_rcpf(bflo(h.w)); s1[3] *= __builtin_amdgcn_rcpf(bfhi(h.w));
                    }
                    acc[ai][bj][m][0] *= s0; acc[ai][bj][m][1] *= s1;
                    if (u.br == 2) { const f32x4 v0 = acc[ai][bj][m][0], v1 = acc[ai][bj][m][1];
                        u32x4 o; o.x = pk2(v0[0], v0[1]); o.y = pk2(v0[2], v0[3]); o.z = pk2(v1[0], v1[1]); o.w = pk2(v1[2], v1[3]);
                        *(u32x4*)(mbase + bj * 32768 + (ai * 128 + m * 16) * 64) = o; }
                }
        }
        return u.br < 2;
    }
};

struct SchedP5 {
    int G, c; const char* A; const char* Bt;
    __device__ __forceinline__ bool next(int i, Unit& u) const {
        const int L = i * G + c; if (L >= 288) return false;
        u.br = 0; pg8::tile_of(L, 36, 8, u.pm, u.pn); return true;
    }
    __device__ __forceinline__ const char* a_base(const Unit& u) const { return A + (size_t)u.pm * (256 * 2048 * 2); }
    __device__ __forceinline__ const char* b_base(const Unit& u) const { return Bt + (size_t)u.pn * (256 * 2048 * 2); }
};
struct EpiP5 {
    const float* xp; const float* xs; float* out;
    __device__ __forceinline__ bool operator()(f32x4 (&acc)[2][2][4][2], const Unit& u, int wr, int wc, int fr, int fq) const {
        const int rloc = wr * 64 + fr, cloc = wc * 32 + 8 * fq;
#pragma unroll
        for (int bj = 0; bj < 2; ++bj) {
            const int col = u.pn * 256 + bj * 128 + cloc;
#pragma unroll
            for (int ai = 0; ai < 2; ++ai)
#pragma unroll
                for (int m = 0; m < 4; ++m) {
                    const size_t row = (size_t)u.pm * 256 + ai * 128 + m * 16 + rloc;
                    const float* xr = (row < (size_t)NTP) ? (xp + row * 2048 + col) : (xs + (row - NTP) * 2048 + col);
                    const f32x4 v0 = acc[ai][bj][m][0] + *(const f32x4*)xr, v1 = acc[ai][bj][m][1] + *(const f32x4*)(xr + 4);
                    float* op = out + row * 2048 + col;
                    *(f32x4*)op = v0; *(f32x4*)(op + 4) = v1;
                }
        }
        return false;
    }
};

struct EpiNull {
    __device__ __forceinline__ bool operator()(f32x4 (&acc)[2][2][4][2], const Unit& u, int wr, int wc, int fr, int fq) const {
        f32x4 t = (f32x4){0.f, 0.f, 0.f, 0.f};
#pragma unroll
        for (int ai = 0; ai < 2; ++ai)
#pragma unroll
            for (int bj = 0; bj < 2; ++bj)
#pragma unroll
                for (int m = 0; m < 4; ++m) t += acc[ai][bj][m][0] + acc[ai][bj][m][1];
        asm volatile("" :: "v"(t[0]), "v"(t[1]), "v"(t[2]), "v"(t[3]));
        return false;
    }
};
#define P0_DESC(it_, W_, WT_, K_, N_, ro_, kb_, nb_) do { int r_ = (it_); \
    if (r_ < 1920) { W_ = p.w_in; WT_ = WT1; K_ = 2048; N_ = 15360; ro_ = 0; kb_ = r_ / 120; nb_ = r_ % 120; } \
    else if (r_ < 2176) { r_ -= 1920; W_ = p.w_mem_kv; WT_ = WT1; K_ = 2048; N_ = 2048; ro_ = 15360; kb_ = r_ >> 4; nb_ = r_ & 15; } \
    else if (r_ < 2304) { r_ -= 2176; W_ = p.w_conv_out; WT_ = WT3; K_ = 1024; N_ = 2048; ro_ = 0; kb_ = r_ >> 4; nb_ = r_ & 15; } \
    else if (r_ < 2432) { r_ -= 2304; W_ = p.w_hgrn_out; WT_ = WT3 + (size_t)2048 * 1024; K_ = 1024; N_ = 2048; ro_ = 0; kb_ = r_ >> 4; nb_ = r_ & 15; } \
    else if (r_ < 2560) { r_ -= 2432; W_ = p.w_attn_out; WT_ = WT3 + (size_t)2 * 2048 * 1024; K_ = 1024; N_ = 2048; ro_ = 0; kb_ = r_ >> 4; nb_ = r_ & 15; } \
    else { r_ -= 2560; W_ = p.w_out; WT_ = WTO; K_ = 2048; N_ = 2048; ro_ = 0; kb_ = r_ >> 4; nb_ = r_ & 15; } } while (0)
__device__ __forceinline__ void p0_prologue(const Params& p, LAS unsigned char* lds) {
    const int tid = threadIdx.x, lane = tid & 63, wave = tid >> 6, G = gridDim.x, c = blockIdx.x;
    LAS unsigned* T32 = (LAS unsigned*)lds;
    constexpr int T_ALL = 1920 + 256 + 3 * 128 + 256;
    const int nq = tid & 31, kp0 = tid >> 5;
    f32x4 r0[4], r1[4];
#define P0_LOAD(W_, N_, kb_, nb_) do { _Pragma("unroll") for (int i = 0; i < 4; ++i) { const int kpair = kp0 + 16 * i; \
        const float* src = (W_) + (size_t)((kb_) * 128 + 2 * kpair) * (N_) + (nb_) * 128 + 4 * nq; r0[i] = *(const f32x4*)src; r1[i] = *(const f32x4*)(src + (N_)); } } while (0)
    bf16_t* WT1 = (bf16_t*)(p.ws + WS_WT1); bf16_t* WT3 = (bf16_t*)(p.ws + WS_WT3); bf16_t* WTO = (bf16_t*)(p.ws + WS_WTO);
    int it = c;
    const float* dW = p.w_in; bf16_t* dWT = WT1; int dK = 2048, dN = 15360, dro = 0, dkb = 0, dnb = 0;
    if (it < T_ALL) { P0_DESC(it, dW, dWT, dK, dN, dro, dkb, dnb); P0_LOAD(dW, dN, dkb, dnb); }
    while (it < T_ALL) {
#pragma unroll
        for (int i = 0; i < 4; ++i) { const int kpair = kp0 + 16 * i;
            T32[(4 * nq + 0) * 65 + kpair] = pk2(r0[i][0], r1[i][0]); T32[(4 * nq + 1) * 65 + kpair] = pk2(r0[i][1], r1[i][1]);
            T32[(4 * nq + 2) * 65 + kpair] = pk2(r0[i][2], r1[i][2]); T32[(4 * nq + 3) * 65 + kpair] = pk2(r0[i][3], r1[i][3]); }
        __syncthreads();
        const int itn = it + G;
        const float* nW = dW; bf16_t* nWT = dWT; int nK = dK, nN = dN, nro = dro, nkb = dkb, nnb = dnb;
        if (itn < T_ALL) { P0_DESC(itn, nW, nWT, nK, nN, nro, nkb, nnb); P0_LOAD(nW, nN, nkb, nnb); }
#pragma unroll
        for (int i = 0; i < 4; ++i) {
            const int id = tid + 512 * i, n = id >> 4, cc = id & 15;
            u32x4 o; o.x = T32[n * 65 + 4 * cc]; o.y = T32[n * 65 + 4 * cc + 1]; o.z = T32[n * 65 + 4 * cc + 2]; o.w = T32[n * 65 + 4 * cc + 3];
            *(u32x4*)(dWT + tl((size_t)(dro + dnb * 128 + n), dkb * 128 + 8 * cc, dK)) = o;
        }
        __syncthreads();
        it = itn; dW = nW; dWT = nWT; dK = nK; dN = nN; dro = nro; dkb = nkb; dnb = nnb;
    }
#undef P0_LOAD
#undef P0_DESC
    bf16_t* HA = (bf16_t*)(p.ws + WS_HA);
    const int gw = c * 8 + wave, NGW = G * 8;
#define P0_ROWPTR(m) ((m) < NTP ? p.x_prompt + (size_t)(m) * 2048 : ((m) < NTOK ? p.x_sample + (size_t)((m) - NTP) * 2048 : p.mem_prompt + (size_t)((m) - NTOK) * 2048))
    f32x4 v[8];
    int m = gw;
    if (m < 10240) { const float* xr = P0_ROWPTR(m);
#pragma unroll
        for (int j = 0; j < 8; ++j) v[j] = ((const f32x4*)xr)[lane + 64 * j]; }
    while (m < 10240) {
        const int mn = m + NGW; f32x4 vn[8];
        if (mn < 10240) { const float* xr = P0_ROWPTR(mn);
#pragma unroll
            for (int j = 0; j < 8; ++j) vn[j] = ((const f32x4*)xr)[lane + 64 * j]; }
        float ss = 0.f;
#pragma unroll
        for (int j = 0; j < 8; ++j) ss += (v[j][0] * v[j][0] + v[j][1] * v[j][1]) + (v[j][2] * v[j][2] + v[j][3] * v[j][3]);
        ss = wave_sum(ss);
        const float rinv = rsqrtf(ss * (1.f / 2048.f) + EPS);
        const float* g = (m < NTOK) ? p.g_pre : p.g_mem;
#pragma unroll
        for (int j = 0; j < 8; ++j) { const f32x4 gg = ((const f32x4*)g)[lane + 64 * j];
            u32x2 o; o.x = pk2(v[j][0] * rinv * gg[0], v[j][1] * rinv * gg[1]); o.y = pk2(v[j][2] * rinv * gg[2], v[j][3] * rinv * gg[3]);
            *(u32x2*)(HA + tl((size_t)m, 4 * (lane + 64 * j), 2048)) = o; }
        if (mn < 10240) {
#pragma unroll
            for (int j = 0; j < 8; ++j) v[j] = vn[j]; }
        m = mn;
    }
#undef P0_ROWPTR
    if (c == 0) { float* LB = (float*)(p.ws + WS_LB);
        for (int i = tid; i < 1024; i += 512) LB[i] = 1.f / (1.f + __expf(p.lb_logits[1024 + i] - p.lb_logits[i])); }
}

__device__ __forceinline__ void hgrn_prompt_item(const Params& p, int item, LAS unsigned char* lds, int tid) {
    LAS float* qs = (LAS float*)lds;
    LAS float* fs = qs + 4096;
    LAS float* vs = fs + 4096;
    LAS float* part = vs + 512;
    const int s = item >> 3, n = s >> 3, h = s & 7, dvg = item & 7;
    const int vcol = tid & 15, kg = tid >> 4;
    const bf16_t* proj = (const bf16_t*)(p.ws + WS_PROJ9);
    const float* F = (const float*)(p.ws + WS_F);
    float* oraw = (float*)(p.ws + WS_ORAW);
    const size_t row0 = (size_t)n * SEQ;
    const bf16_t* qsrc = proj + (row0 + kg) * LDP + C_HQ + h * 128 + vcol * 8;
    const float* fsrc = F + (row0 + kg) * 1024 + h * 128 + vcol * 8;
    const bf16_t* vsrc = proj + (row0 + kg) * LDP + C_HI + h * 128 + dvg * 16 + vcol;
    f32x2 S01 = (f32x2){0.f, 0.f}, S23 = (f32x2){0.f, 0.f};
    u32x4 rq[4]; f32x4 rfa[4], rfb[4]; bf16_t rv[4];
#define HG_FETCH(R, tb) do { const size_t adv = (size_t)(tb); rq[R] = *(const u32x4*)(qsrc + adv * LDP); rfa[R] = *(const f32x4*)(fsrc + adv * 1024); \
        rfb[R] = *(const f32x4*)(fsrc + adv * 1024 + 4); rv[R] = *(vsrc + adv * LDP); } while (0)
#define HG_BATCH(R, tb) do { \
        { LAS float* qd = qs + kg * 128 + vcol * 8; \
          *(LAS f32x4*)qd = (f32x4){bflo(rq[R].x), bfhi(rq[R].x), bflo(rq[R].y), bfhi(rq[R].y)}; *(LAS f32x4*)(qd + 4) = (f32x4){bflo(rq[R].z), bfhi(rq[R].z), bflo(rq[R].w), bfhi(rq[R].w)}; \
          LAS float* fd = fs + kg * 128 + vcol * 8; *(LAS f32x4*)fd = rfa[R]; *(LAS f32x4*)(fd + 4) = rfb[R]; \
          vs[kg * 16 + vcol] = bf2f(rv[R]); } \
        __syncthreads(); \
        if ((tb) + 128 < SEQ) HG_FETCH(R, (tb) + 128); \
        f32x4 cf[4], cq[4]; float cv[4]; \
        _Pragma("unroll") for (int i = 0; i < 4; ++i) { cf[i] = *(const LAS f32x4*)(fs + i * 128 + kg * 4); cq[i] = *(const LAS f32x4*)(qs + i * 128 + kg * 4); cv[i] = vs[i * 16 + vcol]; } \
        _Pragma("unroll") for (int g = 0; g < 8; ++g) { \
            f32x4 nf[4], nq[4]; float nv[4]; \
            if (g < 7) { _Pragma("unroll") for (int i = 0; i < 4; ++i) { const int tt = (g + 1) * 4 + i; \
                nf[i] = *(const LAS f32x4*)(fs + tt * 128 + kg * 4); nq[i] = *(const LAS f32x4*)(qs + tt * 128 + kg * 4); nv[i] = vs[tt * 16 + vcol]; } } \
            _Pragma("unroll") for (int i = 0; i < 4; ++i) { \
                const f32x2 f01 = (f32x2){cf[i][0], cf[i][1]}, f23 = (f32x2){cf[i][2], cf[i][3]}, q01 = (f32x2){cq[i][0], cq[i][1]}, q23 = (f32x2){cq[i][2], cq[i][3]}; \
                const f32x2 vv = (f32x2){cv[i], cv[i]}; \
                S01 = f01 * (S01 - vv) + vv; S23 = f23 * (S23 - vv) + vv; \
                f32x2 t = S01 * q01; t = S23 * q23 + t; \
                part[(g * 4 + i) * 528 + tid] = t[0] + t[1]; } \
            if (g < 7) { _Pragma("unroll") for (int i = 0; i < 4; ++i) { cf[i] = nf[i]; cq[i] = nq[i]; cv[i] = nv[i]; } } } \
        __syncthreads(); \
        { float a = 0.f; \
          _Pragma("unroll 8") for (int k2 = 0; k2 < 32; ++k2) a += part[kg * 528 + k2 * 16 + vcol]; \
          oraw[(row0 + (tb) + kg) * 1024 + h * 128 + dvg * 16 + vcol] = a; } } while (0)
    HG_FETCH(0, 0); HG_FETCH(1, 32); HG_FETCH(2, 64); HG_FETCH(3, 96);
#pragma unroll 1
    for (int t0 = 0; t0 < SEQ; t0 += 128) { HG_BATCH(0, t0); HG_BATCH(1, t0 + 32); HG_BATCH(2, t0 + 64); HG_BATCH(3, t0 + 96); }
#undef HG_FETCH
#undef HG_BATCH
    float* so = p.out + O_HGRN_P + ((size_t)(n * 8 + h) * 128 + kg * 4) * 128 + dvg * 16 + vcol;
    so[0] = S01[0]; so[128] = S01[1]; so[256] = S23[0]; so[384] = S23[1];
    __syncthreads();
}

__device__ __forceinline__ void hgrn_sample_item(const Params& p, int item, LAS unsigned char* lds, int tid) {
    LAS float* qs = (LAS float*)lds;
    LAS float* fs = qs + 1024;
    LAS float* vs = fs + 1024;
    LAS float* opart = vs + 1024;
    const int n = item >> 3, h = item & 7, lane = tid & 63, wave = tid >> 6;
    const bf16_t* proj = (const bf16_t*)(p.ws + WS_PROJ9);
    const float* F = (const float*)(p.ws + WS_F);
    const size_t row0 = (size_t)NTP + (size_t)n * 8;
    { const int tt = tid >> 6, k2 = (tid & 63) * 2; const size_t r = row0 + tt;
      const unsigned qw = *(const unsigned*)(proj + r * LDP + C_HQ + h * 128 + k2); const f32x2 ff = *(const f32x2*)(F + r * 1024 + h * 128 + k2);
      const unsigned vw = *(const unsigned*)(proj + r * LDP + C_HI + h * 128 + k2);
      qs[tt * 128 + k2] = bflo(qw); qs[tt * 128 + k2 + 1] = bfhi(qw); fs[tt * 128 + k2] = ff[0]; fs[tt * 128 + k2 + 1] = ff[1];
      vs[tt * 128 + k2] = bflo(vw); vs[tt * 128 + k2 + 1] = bfhi(vw); }
    const int v4 = tid & 31, kg = tid >> 5;
    const size_t sbase = ((size_t)(n * 8 + h) * 128 + kg * 8) * 128 + v4 * 4;
    f32x4 S[8];
#pragma unroll
    for (int i = 0; i < 8; ++i) S[i] = *(const f32x4*)(p.state_hgrn + sbase + (size_t)i * 128);
    __syncthreads();
#pragma unroll
    for (int tt = 0; tt < 8; ++tt) {
        const f32x4 fa = *(const LAS f32x4*)(fs + tt * 128 + kg * 8), fb = *(const LAS f32x4*)(fs + tt * 128 + kg * 8 + 4);
        const f32x4 qa = *(const LAS f32x4*)(qs + tt * 128 + kg * 8), qb = *(const LAS f32x4*)(qs + tt * 128 + kg * 8 + 4);
        const f32x4 vv = *(const LAS f32x4*)(vs + tt * 128 + v4 * 4);
        f32x4 po = (f32x4){0.f, 0.f, 0.f, 0.f};
#pragma unroll
        for (int i = 0; i < 8; ++i) { const float f = (i < 4) ? fa[i & 3] : fb[i & 3], q = (i < 4) ? qa[i & 3] : qb[i & 3];
            S[i] = S[i] * f + vv * (1.f - f); po += S[i] * q; }
#pragma unroll
        for (int e = 0; e < 4; ++e) po[e] += __shfl_xor(po[e], 32);
        if (lane < 32) *(LAS f32x4*)(opart + (tt * 8 + wave) * 128 + v4 * 4) = po;
    }
    float* so = p.out + O_HGRN_S + sbase;
#pragma unroll
    for (int i = 0; i < 8; ++i) *(f32x4*)(so + (size_t)i * 128) = S[i];
    __syncthreads();
    { const int tt = tid >> 6, v = (tid & 63) * 2; float o0 = 0.f, o1 = 0.f;
#pragma unroll
      for (int w = 0; w < 8; ++w) { const f32x2 t = *(const LAS f32x2*)(opart + (tt * 8 + w) * 128 + v); o0 += t[0]; o1 += t[1]; }
      const float ss = wave_sum(o0 * o0 + o1 * o1), rinv = rsqrtf(ss * (1.f / 128.f) + EPS);
      const size_t r = row0 + tt; const f32x2 gg = *(const f32x2*)(p.g_hgrn + h * 128 + v);
      const unsigned gw = *(const unsigned*)(proj + r * LDP + C_HOG + h * 128 + v);
      bf16_t* og = (bf16_t*)(p.ws + WS_ACT3) + (size_t)9216 * 1024 + tl(r, h * 128 + v, 1024);
      *(unsigned*)og = pk2(o0 * rinv * gg[0] * bflo(gw), o1 * rinv * gg[1] * bfhi(gw)); }
    __syncthreads();
}

__device__ __forceinline__ void hgrn_norm_rows(const Params& p) {
    const int tid = threadIdx.x, lane = tid & 63, gw = blockIdx.x * 8 + (tid >> 6), NGW = gridDim.x * 8;
    const bf16_t* proj = (const bf16_t*)(p.ws + WS_PROJ9); const float* oraw = (const float*)(p.ws + WS_ORAW);
    bf16_t* og = (bf16_t*)(p.ws + WS_ACT3) + (size_t)9216 * 1024;
    for (int r = gw; r < NTP; r += NGW) {
        f32x4 o[4]; float ss = 0.f;
#pragma unroll
        for (int j = 0; j < 4; ++j) { o[j] = *(const f32x4*)(oraw + (size_t)r * 1024 + lane * 16 + j * 4); ss += (o[j][0] * o[j][0] + o[j][1] * o[j][1]) + (o[j][2] * o[j][2] + o[j][3] * o[j][3]); }
        ss += __shfl_xor(ss, 1); ss += __shfl_xor(ss, 2); ss += __shfl_xor(ss, 4);
        const float rinv = rsqrtf(ss * (1.f / 128.f) + EPS);
        const u32x4 ga = *(const u32x4*)(proj + (size_t)r * LDP + C_HOG + lane * 16), gb = *(const u32x4*)(proj + (size_t)r * LDP + C_HOG + lane * 16 + 8);
        f32x4 g[4];
#pragma unroll
        for (int j = 0; j < 4; ++j) g[j] = *(const f32x4*)(p.g_hgrn + lane * 16 + j * 4);
        u32x4 oa, ob;
        oa.x = pk2(o[0][0] * rinv * g[0][0] * bflo(ga.x), o[0][1] * rinv * g[0][1] * bfhi(ga.x)); oa.y = pk2(o[0][2] * rinv * g[0][2] * bflo(ga.y), o[0][3] * rinv * g[0][3] * bfhi(ga.y));
        oa.z = pk2(o[1][0] * rinv * g[1][0] * bflo(ga.z), o[1][1] * rinv * g[1][1] * bfhi(ga.z)); oa.w = pk2(o[1][2] * rinv * g[1][2] * bflo(ga.w), o[1][3] * rinv * g[1][3] * bfhi(ga.w));
        ob.x = pk2(o[2][0] * rinv * g[2][0] * bflo(gb.x), o[2][1] * rinv * g[2][1] * bfhi(gb.x)); ob.y = pk2(o[2][2] * rinv * g[2][2] * bflo(gb.y), o[2][3] * rinv * g[2][3] * bfhi(gb.y));
        ob.z = pk2(o[3][0] * rinv * g[3][0] * bflo(gb.z), o[3][1] * rinv * g[3][1] * bfhi(gb.z)); ob.w = pk2(o[3][2] * rinv * g[3][2] * bflo(gb.w), o[3][3] * rinv * g[3][3] * bfhi(gb.w));
        *(u32x4*)(og + tl((size_t)r, lane * 16, 1024)) = oa; *(u32x4*)(og + tl((size_t)r, lane * 16 + 8, 1024)) = ob;
    }
}

template <bool SAMPLE>
__device__ __forceinline__ void conv_item(const Params& p, int item, LAS unsigned char* lds, int tid) {
    constexpr int T = SAMPLE ? 8 : 32;
    constexpr int GP = 4, NG = (T + 32) / GP, G0 = 32 / GP;
    LAS float* dcs = (LAS float*)lds;
    const bf16_t* proj = (const bf16_t*)(p.ws + WS_PROJ9);
    const int n = SAMPLE ? item : (item >> 6), t0 = SAMPLE ? 0 : (item & 63) * 32;
    const size_t rowb = SAMPLE ? ((size_t)NTP + (size_t)n * 8) : ((size_t)n * SEQ);
    const int c0 = 2 * tid;
    float w0[31], w1[31], x0[31], x1[31];
#pragma unroll
    for (int j = 0; j < 31; ++j) { const f32x2 w = *(const f32x2*)(p.conv_w + j * 1024 + c0); w0[j] = w[0]; w1[j] = w[1]; x0[j] = 0.f; x1[j] = 0.f; }
    const f32x2 bias = *(const f32x2*)(p.conv_b + c0);
    unsigned ra[GP], rg[GP];
#define CONV_ISSUE(g) do { \
        if (SAMPLE && (g) < G0) { _Pragma("unroll") for (int i = 0; i < GP; ++i) { const int ti = -2 + GP * (g) + i; \
            const unsigned* tp = (const unsigned*)(p.state_conv + ((size_t)n * 30 + (ti < 0 ? 0 : ti)) * 1024 + c0); ra[i] = tp[0]; rg[i] = tp[1]; } } \
        else { _Pragma("unroll") for (int i = 0; i < GP; ++i) { const int t = t0 - 32 + GP * (g) + i; const bf16_t* rp = proj + (rowb + (t < 0 ? 0 : t)) * LDP + c0; \
            ra[i] = *(const unsigned*)(rp + C_CV); rg[i] = *(const unsigned*)(rp + C_CG); } } } while (0)
    CONV_ISSUE(0);
#pragma unroll 1
    for (int g = 0; g < NG; ++g) {
        float u0[GP], u1[GP];
        if (SAMPLE && g < G0) {
#pragma unroll
            for (int i = 0; i < GP; ++i) { const bool ok = (-2 + GP * g + i) >= 0; u0[i] = ok ? __builtin_bit_cast(float, ra[i]) : 0.f; u1[i] = ok ? __builtin_bit_cast(float, rg[i]) : 0.f; }
        } else {
#pragma unroll
            for (int i = 0; i < GP; ++i) { const bool ok = (t0 - 32 + GP * g + i) >= 0; u0[i] = ok ? bflo(ra[i]) * bflo(rg[i]) : 0.f; u1[i] = ok ? bfhi(ra[i]) * bfhi(rg[i]) : 0.f; }
        }
        if (g + 1 < NG) CONV_ISSUE(g + 1);
#pragma unroll
        for (int i = 0; i < GP; ++i) {
            const int pp = -32 + GP * g + i, t = t0 + pp;
            if (SAMPLE) { if (pp >= -22) *(f32x2*)(p.out + O_CONV_S + ((size_t)n * 30 + (pp + 22)) * 1024 + c0) = (f32x2){u0[i], u1[i]}; }
            else { if (t >= SEQ - 30) *(f32x2*)(p.out + O_CONV_P + ((size_t)n * 30 + (t - (SEQ - 30))) * 1024 + c0) = (f32x2){u0[i], u1[i]}; }
#pragma unroll
            for (int j = 0; j < 30; ++j) { x0[j] = x0[j + 1]; x1[j] = x1[j + 1]; }
            x0[30] = u0[i]; x1[30] = u1[i];
            if (g >= G0) {
                float d0 = bias[0], d1 = bias[1];
#pragma unroll
                for (int j = 0; j < 31; ++j) { d0 += w0[j] * x0[j]; d1 += w1[j] * x1[j]; }
                *(LAS f32x2*)(dcs + (pp) * 1024 + c0) = (f32x2){d0, d1};
            }
        }
    }
#undef CONV_ISSUE
    __syncthreads();
    { const int lane = tid & 63, wave = tid >> 6;
      bf16_t* aact = (bf16_t*)(p.ws + WS_ACT3);
      for (int pp = wave; pp < T; pp += 8) {
          f32x4 v[4]; float s = 0.f;
#pragma unroll
          for (int j = 0; j < 4; ++j) { v[j] = *(const LAS f32x4*)(dcs + pp * 1024 + j * 256 + lane * 4); s += (v[j][0] + v[j][1]) + (v[j][2] + v[j][3]); }
          const float mean = wave_sum(s) * (1.f / 1024.f); float s2 = 0.f;
#pragma unroll
          for (int j = 0; j < 4; ++j) { v[j] = v[j] - mean; s2 += (v[j][0] * v[j][0] + v[j][1] * v[j][1]) + (v[j][2] * v[j][2] + v[j][3] * v[j][3]); }
          const float rstd = rsqrtf(wave_sum(s2) * (1.f / 1024.f) + EPS);
          const size_t r = rowb + t0 + pp;
          bf16_t* arow = aact + tl(r, lane * 4, 1024);
#pragma unroll
          for (int j = 0; j < 4; ++j) { const int c = j * 256 + lane * 4;
              const f32x4 lg = *(const f32x4*)(p.ln_g + c), lbv = *(const f32x4*)(p.ln_b + c);
              const u32x2 sg = *(const u32x2*)(proj + r * LDP + C_CS + c);
              const float y0 = siluf(v[j][0] * rstd * lg[0] + lbv[0]) * bflo(sg.x), y1 = siluf(v[j][1] * rstd * lg[1] + lbv[1]) * bfhi(sg.x);
              const float y2 = siluf(v[j][2] * rstd * lg[2] + lbv[2]) * bflo(sg.y), y3 = siluf(v[j][3] * rstd * lg[3] + lbv[3]) * bfhi(sg.y);
              u32x2 o; o.x = pk2(y0, y1); o.y = pk2(y2, y3);
              *(u32x2*)(arow + j * 65536) = o; }
      } }
    __syncthreads();
}

__device__ __forceinline__ void attn_prompt_item(const Params& p, int item, LAS unsigned char* lds, int tid) {
    const int lane = tid & 63, wave = tid >> 6, l15 = lane & 15, quad = lane >> 4;
    const int n = item >> 6, h = (item >> 4) & 3, qt = item & 15;
    const bf16_t* proj = (const bf16_t*)(p.ws + WS_PROJ9);
    const bf16_t* kb = (const bf16_t*)(p.ws + WS_MKB) + (size_t)(n * 4 + h) * 65536;
    const bf16_t* vt = (const bf16_t*)(p.ws + WS_MVT) + (size_t)(n * 4 + h) * 65536;
    const size_t qrow = (size_t)n * SEQ + qt * 128 + wave * 16 + l15;
    u32x4 st[16];
#pragma unroll
    for (int i = 0; i < 16; ++i) st[i] = *(const u32x4*)(kb + (size_t)(tid + 512 * i) * 8);
    bf16x8 qf[8];
#pragma unroll
    for (int s = 0; s < 8; ++s) qf[s] = *(const bf16x8*)(proj + qrow * LDP + C_AQ + h * 256 + s * 32 + quad * 8);
#pragma unroll
    for (int i = 0; i < 16; ++i) { const int id = tid + 512 * i, r = id >> 5, c = id & 31; *(LAS u32x4*)(lds + r * 512 + ((c ^ (r & 15)) * 16)) = st[i]; }
    __syncthreads();
    f32x4 sc[16];
#pragma unroll
    for (int T = 0; T < 16; ++T) {
        sc[T] = (f32x4){0.f, 0.f, 0.f, 0.f};
        const LAS unsigned char* kr = lds + (T * 16 + l15) * 512;
#pragma unroll
        for (int s = 0; s < 8; ++s) { const bf16x8 a = *(const LAS bf16x8*)(kr + (((s * 4 + quad) ^ l15) * 16)); sc[T] = __builtin_amdgcn_mfma_f32_16x16x32_bf16(a, qf[s], sc[T], 0, 0, 0); }
    }
#pragma unroll
    for (int i = 0; i < 16; ++i) st[i] = *(const u32x4*)(vt + (size_t)(tid + 512 * i) * 8);
    __syncthreads();
    float mx = -3.0e38f;
#pragma unroll
    for (int T = 0; T < 16; ++T) mx = fmaxf(mx, fmaxf(fmaxf(sc[T][0], sc[T][1]), fmaxf(sc[T][2], sc[T][3])));
    mx = fmaxf(mx, __shfl_xor(mx, 16)); mx = fmaxf(mx, __shfl_xor(mx, 32));
    float sum = 0.f;
#pragma unroll
    for (int T = 0; T < 16; ++T) {
#pragma unroll
        for (int e = 0; e < 4; ++e) { sc[T][e] = __expf(sc[T][e] - mx); sum += sc[T][e]; } }
    sum += __shfl_xor(sum, 16); sum += __shfl_xor(sum, 32);
    const float rs = 1.f / sum;
    bf16x8 pb[8];
#pragma unroll
    for (int s2 = 0; s2 < 8; ++s2) {
        u32x4 w; w.x = pk2(sc[2 * s2][0], sc[2 * s2][1]); w.y = pk2(sc[2 * s2][2], sc[2 * s2][3]); w.z = pk2(sc[2 * s2 + 1][0], sc[2 * s2 + 1][1]); w.w = pk2(sc[2 * s2 + 1][2], sc[2 * s2 + 1][3]);
        pb[s2] = __builtin_bit_cast(bf16x8, w);
    }
#pragma unroll
    for (int i = 0; i < 16; ++i) { const int id = tid + 512 * i, r = id >> 5, c = id & 31; *(LAS u32x4*)(lds + r * 512 + ((c ^ (r & 15)) * 16)) = st[i]; }
    __syncthreads();
    bf16_t* aog_row = (bf16_t*)(p.ws + WS_ACT3) + (size_t)2 * 9216 * 1024 + tl(qrow, h * 256 + quad * 4, 1024);
    f32x4 oacc[16];
#pragma unroll
    for (int Tv = 0; Tv < 16; ++Tv) {
        oacc[Tv] = (f32x4){0.f, 0.f, 0.f, 0.f};
        const LAS unsigned char* vr = lds + (Tv * 16 + l15) * 512 + (quad & 1) * 8;
#pragma unroll
        for (int s2 = 0; s2 < 8; ++s2) {
            const int ch = 4 * s2 + (quad >> 1);
            const u32x2 lo = *(const LAS u32x2*)(vr + ((ch ^ l15) * 16)), hi = *(const LAS u32x2*)(vr + (((ch + 2) ^ l15) * 16));
            u32x4 w; w.x = lo.x; w.y = lo.y; w.z = hi.x; w.w = hi.y;
            oacc[Tv] = __builtin_amdgcn_mfma_f32_16x16x32_bf16(__builtin_bit_cast(bf16x8, w), pb[s2], oacc[Tv], 0, 0, 0);
        }
    }
#pragma unroll
    for (int Tv = 0; Tv < 16; ++Tv) {
        const int dv = Tv * 16 + quad * 4;
        const u32x2 sg = *(const u32x2*)(proj + qrow * LDP + C_AS + h * 256 + dv);
        u32x2 o; o.x = pk2(oacc[Tv][0] * rs * bflo(sg.x), oacc[Tv][1] * rs * bfhi(sg.x)); o.y = pk2(oacc[Tv][2] * rs * bflo(sg.y), oacc[Tv][3] * rs * bfhi(sg.y));
        *(u32x2*)(aog_row + (Tv >> 2) * 16384 + (Tv & 3) * 16) = o;
    }
    __syncthreads();
}

__device__ __forceinline__ void attn_sample_item(const Params& p, int item, LAS unsigned char* lds, int tid) {
    LAS float* Ssh = (LAS float*)lds;
    LAS float* Psh = Ssh + 2048;
    LAS float* Opart = Psh + 2048;
    const int lane = tid & 63, wave = tid >> 6, l15 = lane & 15, quad = lane >> 4;
    const int n = item >> 2, h = item & 3;
    const bf16_t* proj = (const bf16_t*)(p.ws + WS_PROJ9);
    const size_t row0 = (size_t)NTP + (size_t)n * 8;
    const float* kc = p.cache_k + ((size_t)n * 256 * 4 + h) * 256;
    const float* vc = p.cache_v + ((size_t)n * 256 * 4 + h) * 256;
    {
        bf16x8 qf[8];
        const size_t qrow = row0 + (lane & 7);
#pragma unroll
        for (int s = 0; s < 8; ++s) qf[s] = *(const bf16x8*)(proj + qrow * LDP + C_AQ + h * 256 + s * 32 + quad * 8);
#pragma unroll
        for (int tl = 0; tl < 2; ++tl) {
            const int T = wave * 2 + tl;
            f32x4 sc = (f32x4){0.f, 0.f, 0.f, 0.f};
            const float* kr = kc + (size_t)(T * 16 + l15) * 1024 + quad * 8;
#pragma unroll
            for (int s = 0; s < 8; ++s) {
                const f32x4 k0 = *(const f32x4*)(kr + s * 32), k1 = *(const f32x4*)(kr + s * 32 + 4);
                u32x4 w; w.x = pk2(k0[0], k0[1]); w.y = pk2(k0[2], k0[3]); w.z = pk2(k1[0], k1[1]); w.w = pk2(k1[2], k1[3]);
                sc = __builtin_amdgcn_mfma_f32_16x16x32_bf16(__builtin_bit_cast(bf16x8, w), qf[s], sc, 0, 0, 0);
            }
            if (l15 < 8) {
#pragma unroll
                for (int e = 0; e < 4; ++e) Ssh[l15 * 256 + T * 16 + quad * 4 + e] = sc[e];
            }
        }
    }
    __syncthreads();
    {
        const f32x4 s4 = *(const LAS f32x4*)(Ssh + wave * 256 + lane * 4);
        const float mx = wave_max(fmaxf(fmaxf(s4[0], s4[1]), fmaxf(s4[2], s4[3])));
        f32x4 e4; e4[0] = __expf(s4[0] - mx); e4[1] = __expf(s4[1] - mx); e4[2] = __expf(s4[2] - mx); e4[3] = __expf(s4[3] - mx);
        const float rs = 1.f / wave_sum((e4[0] + e4[1]) + (e4[2] + e4[3]));
#pragma unroll
        for (int e = 0; e < 4; ++e) Psh[(lane * 4 + e) * 8 + wave] = e4[e] * rs;
    }
    __syncthreads();
    {
        f32x4 acc[8];
#pragma unroll
        for (int q = 0; q < 8; ++q) acc[q] = (f32x4){0.f, 0.f, 0.f, 0.f};
        const float* vr = vc + (size_t)(wave * 32) * 1024 + lane * 4;
#pragma unroll 8
        for (int kk = 0; kk < 32; ++kk) {
            const f32x4 v4 = *(const f32x4*)(vr + (size_t)kk * 1024);
            const f32x4 pa = *(const LAS f32x4*)(Psh + (wave * 32 + kk) * 8), pb = *(const LAS f32x4*)(Psh + (wave * 32 + kk) * 8 + 4);
            acc[0] += v4 * pa[0]; acc[1] += v4 * pa[1]; acc[2] += v4 * pa[2]; acc[3] += v4 * pa[3];
            acc[4] += v4 * pb[0]; acc[5] += v4 * pb[1]; acc[6] += v4 * pb[2]; acc[7] += v4 * pb[3];
        }
#pragma unroll
        for (int q = 0; q < 8; ++q) *(LAS f32x4*)(Opart + (wave * 8 + q) * 256 + lane * 4) = acc[q];
    }
    __syncthreads();
    {
        f32x4 o = (f32x4){0.f, 0.f, 0.f, 0.f};
#pragma unroll
        for (int w = 0; w < 8; ++w) o += *(const LAS f32x4*)(Opart + (w * 8 + wave) * 256 + lane * 4);
        const size_t r = row0 + wave;
        const u32x2 sg = *(const u32x2*)(proj + r * LDP + C_AS + h * 256 + lane * 4);
        u32x2 ov; ov.x = pk2(o[0] * bflo(sg.x), o[1] * bfhi(sg.x)); ov.y = pk2(o[2] * bflo(sg.y), o[3] * bfhi(sg.y));
        bf16_t* aog = (bf16_t*)(p.ws + WS_ACT3) + (size_t)2 * 9216 * 1024;
        *(u32x2*)(aog + tl(r, h * 256 + lane * 4, 1024)) = ov;
    }
    __syncthreads();
}

__device__ __forceinline__ void p2_mixers(const Params& p, LAS unsigned char* lds) {
    const int tid = threadIdx.x, G = gridDim.x, c = blockIdx.x, mask = p.pad;
    if (mask & 1) for (int it = c; it < 256; it += G) hgrn_prompt_item(p, it, lds, tid);
    if (mask & 2) { for (int it = c; it < 256; it += G) conv_item<false>(p, it, lds, tid);
                    for (int it = c; it < 128; it += G) conv_item<true>(p, it, lds, tid); }
    if (mask & 4) for (int it = c; it < 256; it += G) attn_prompt_item(p, it, lds, tid);
    if (mask & 8) for (int it = c; it < 512; it += G) attn_sample_item(p, it, lds, tid);
    if (mask & 16) for (int it = c; it < 1024; it += G) hgrn_sample_item(p, it, lds, tid);
}

__device__ __forceinline__ void p6_final_norm(const Params& p) {
    const int tid = threadIdx.x, lane = tid & 63, gw = blockIdx.x * 8 + (tid >> 6), NGW = gridDim.x * 8;
    for (int r = gw; r < NTOK; r += NGW) {
        float* zr = p.out + (size_t)r * 2048;
        f32x4 v[8]; float ss = 0.f;
#pragma unroll
        for (int j = 0; j < 8; ++j) { v[j] = ((const f32x4*)zr)[lane + 64 * j]; ss += (v[j][0] * v[j][0] + v[j][1] * v[j][1]) + (v[j][2] * v[j][2] + v[j][3] * v[j][3]); }
        ss = wave_sum(ss);
        const float rinv = rsqrtf(ss * (1.f / 2048.f) + EPS);
#pragma unroll
        for (int j = 0; j < 8; ++j) { const f32x4 gg = ((const f32x4*)p.g_final)[lane + 64 * j]; ((f32x4*)zr)[lane + 64 * j] = v[j] * rinv * gg; }
    }
}

__global__ void __launch_bounds__(512, 2) fwd_megakernel(Params p) {
    extern __shared__ __attribute__((aligned(16))) unsigned char shm[];
    LAS unsigned char* lds = (LAS unsigned char*)shm;
    cg::grid_group grid = cg::this_grid();
    const int G = gridDim.x, c = blockIdx.x;
#define SEAM(ph) do { if (p.coop && (ph) + 1 < p.ph_hi) { \
        asm volatile("s_waitcnt vmcnt(0) lgkmcnt(0)" ::: "memory"); __syncthreads(); \
        grid.sync(); \
        if (threadIdx.x < 64) { __builtin_amdgcn_fence(__ATOMIC_ACQUIRE, "agent"); asm volatile("s_waitcnt vmcnt(0)" ::: "memory"); } \
        __syncthreads(); } } while (0)
#define RUNS(ph) (p.ph_lo <= (ph) && (ph) < p.ph_hi)
    if (RUNS(0)) { p0_prologue(p, lds); SEAM(0); }
    if (RUNS(1)) {
        SchedP1 S; S.G = G; S.c = c; S.A = (const char*)(p.ws + WS_HA); S.Bt = (const char*)(p.ws + WS_WT1);
        EpiP1 E; E.proj = (bf16_t*)(p.ws + WS_PROJ9); E.gate = (bf16_t*)(p.ws + WS_GATE); E.F = (float*)(p.ws + WS_F); E.lb = (const float*)(p.ws + WS_LB);
        E.b_gate = p.b_gate; E.out = p.out; E.mkb = (bf16_t*)(p.ws + WS_MKB); E.mvt = (bf16_t*)(p.ws + WS_MVT);
        pg8::gemm_phase(lds, 2048, S, E); SEAM(1);
    }
    if (RUNS(2)) { p2_mixers(p, lds); SEAM(2); }
    if (RUNS(3)) { hgrn_norm_rows(p); SEAM(3); }
    if (RUNS(4)) {
        SchedP4 S; S.G = G; S.c = c; S.A = (const char*)(p.ws + WS_ACT3); S.Bt = (const char*)(p.ws + WS_WT3);
        EpiP4 E; E.gate = (const bf16_t*)(p.ws + WS_GATE); E.merged = (bf16_t*)(p.ws + WS_MERGED);
        pg8::gemm_phase(lds, 1024, S, E); SEAM(4);
    }
    if (RUNS(5)) {
        SchedP5 S; S.G = G; S.c = c; S.A = (const char*)(p.ws + WS_MERGED); S.Bt = (const char*)(p.ws + WS_WTO);
        EpiP5 E; E.xp = p.x_prompt; E.xs = p.x_sample; E.out = p.out;
        pg8::gemm_phase(lds, 2048, S, E); SEAM(5);
    }
    if (RUNS(6)) { p6_final_norm(p); }
#undef RUNS
#undef SEAM
}

extern "C" void kernel_launch(void* const* d_in, const int* in_sizes, int n_in, void* d_out, int out_size, void* d_ws, size_t ws_size, hipStream_t stream) {
    static int grid = 0;
    if (grid == 0) {
        if (n_in != 23 || ws_size < WS_END) { fprintf(stderr, "kernel_launch: expected 23 inputs and >= %zu bytes of workspace, got %d / %zu\n", (size_t)WS_END, n_in, ws_size); grid = -1; return; }
        int dev = 0, cus = 0, per_cu = 0;
        hipGetDevice(&dev); hipDeviceGetAttribute(&cus, hipDeviceAttributeMultiprocessorCount, dev);
        if (hipFuncSetAttribute((const void*)fwd_megakernel, hipFuncAttributeMaxDynamicSharedMemorySize, LDS_BYTES) != hipSuccess) { fprintf(stderr, "kernel_launch: hipFuncSetAttribute failed\n"); grid = -1; return; }
        if (hipOccupancyMaxActiveBlocksPerMultiprocessor(&per_cu, (const void*)fwd_megakernel, 512, LDS_BYTES) != hipSuccess || per_cu < 1) { fprintf(stderr, "kernel_launch: occupancy query failed (%d)\n", per_cu); (void)hipGetLastError(); per_cu = 1; }
        grid = cus * 1;
        if (grid <= 0) grid = 256;
    }
    if (grid < 0) return;
    Params p{};
    const float** pp = (const float**)&p;
    for (int i = 0; i < 23; ++i) pp[i] = (const float*)d_in[i];
    p.out = (float*)d_out; p.ws = (unsigned char*)d_ws; p.pad = 31;
#if N_LAUNCH_MODE == 1
    p.ph_lo = 0; p.ph_hi = N_PHASES; p.coop = 1;
    void* args[] = {&p};
    hipError_t e = hipLaunchCooperativeKernel((const void*)fwd_megakernel, dim3(grid), dim3(512), args, LDS_BYTES, stream);
    if (e != hipSuccess) fprintf(stderr, "cooperative launch failed: %s (grid %d)\n", hipGetErrorString(e), grid);
#else
    for (int ph = 0; ph < N_PHASES; ++ph) {
        p.ph_lo = ph; p.ph_hi = ph + 1; p.coop = 0;
        hipLaunchKernelGGL(fwd_megakernel, dim3(grid), dim3(512), LDS_BYTES, stream, p);
        if ((REP_MASK >> ph) & 1) { if (ph == 2) p.pad = P2_SUBMASK; hipLaunchKernelGGL(fwd_megakernel, dim3(grid), dim3(512), LDS_BYTES, stream, p); p.pad = 31; }
    }
#endif
}
```

```cpp
#include <hip/hip_runtime.h>
#include <hip/hip_cooperative_groups.h>
#include <cstdio>
namespace cg = cooperative_groups;

#define LAS __attribute__((address_space(3)))
typedef unsigned short bf16_t;
typedef short bf16x8 __attribute__((ext_vector_type(8)));
typedef float f32x4 __attribute__((ext_vector_type(4)));
typedef float f32x2 __attribute__((ext_vector_type(2)));
typedef unsigned u32x4 __attribute__((ext_vector_type(4)));
typedef unsigned u32x2 __attribute__((ext_vector_type(2)));

#ifndef REP_MASK
#define REP_MASK 0
#endif
#ifndef P2_SUBMASK
#define P2_SUBMASK 31
#endif
#ifndef N_LAUNCH_MODE
#define N_LAUNCH_MODE 1
#endif

constexpr int DM = 2048, NTP = 8192, NTS = 1024, NTOK = 9216, SEQ = 2048;
constexpr int LDP = 9216;
constexpr int C_CV = 0, C_CG = 1024, C_CS = 2048, C_HQ = 3072, C_HF = 4096, C_HI = 5120, C_HOG = 6144, C_AQ = 7168, C_AS = 8192;
constexpr int LDG = 6144;
constexpr float EPS = 1e-6f;
constexpr size_t O_YP = 0, O_YS = 16777216, O_CONV_P = 18874368, O_HGRN_P = 18997248, O_MK = 19521536, O_MV = 20570112, O_CONV_S = 21618688, O_HGRN_S = 25550848;
constexpr size_t WS_WT1 = 0;
constexpr size_t WS_WT3 = WS_WT1 + (size_t)17408 * 2048 * 2;
constexpr size_t WS_WTO = WS_WT3 + (size_t)3 * 2048 * 1024 * 2;
constexpr size_t WS_HA = WS_WTO + (size_t)2048 * 2048 * 2;
constexpr size_t WS_ORAW = WS_HA;
constexpr size_t WS_PROJ9 = WS_HA + (size_t)10240 * 2048 * 2;
constexpr size_t WS_MF = WS_PROJ9;
constexpr size_t WS_MERGED = WS_MF + (size_t)9216 * 2048 * 4;
constexpr size_t WS_GATE = WS_PROJ9 + (size_t)9216 * 9216 * 2;
constexpr size_t WS_F = WS_GATE + (size_t)9216 * 6144 * 2;
constexpr size_t WS_MKB = WS_F + (size_t)9216 * 1024 * 4;
constexpr size_t WS_MVT = WS_MKB + (size_t)2097152;
constexpr size_t WS_ACT3 = WS_MVT + (size_t)2097152;
constexpr size_t WS_LB = WS_ACT3 + (size_t)3 * 9216 * 1024 * 2;
constexpr size_t WS_END = WS_LB + 4096;
constexpr int LDS_BYTES = 131072;
constexpr int N_PHASES = 7;

struct Params {
    const float *x_prompt, *x_sample, *state_conv, *state_hgrn, *cache_k, *cache_v, *mem_prompt, *g_pre, *w_in, *conv_w, *conv_b, *ln_g, *ln_b,
        *w_conv_out, *lb_logits, *g_hgrn, *w_hgrn_out, *g_mem, *w_mem_kv, *w_attn_out, *b_gate, *w_out, *g_final;
    float* out; unsigned char* ws; int ph_lo, ph_hi, coop, pad;
};

__device__ __forceinline__ unsigned f2bf(float f) { unsigned u = __builtin_bit_cast(unsigned, f); return (u + 0x7fffu + ((u >> 16) & 1u)) >> 16; }
typedef __bf16 bf16x2_t __attribute__((ext_vector_type(2)));
__device__ __forceinline__ unsigned pk2(float lo, float hi) { const f32x2 v = {lo, hi}; const bf16x2_t r = __builtin_convertvector(v, bf16x2_t); return __builtin_bit_cast(unsigned, r); }
__device__ __forceinline__ float bflo(unsigned w) { return __builtin_bit_cast(float, w << 16); }
__device__ __forceinline__ float bfhi(unsigned w) { return __builtin_bit_cast(float, w & 0xffff0000u); }
__device__ __forceinline__ float bf2f(unsigned short b) { return __builtin_bit_cast(float, ((unsigned)b) << 16); }
__device__ __forceinline__ float sigm(float x) { return __builtin_amdgcn_rcpf(1.f + __expf(-x)); }
__device__ __forceinline__ float siluf(float x) { return x * sigm(x); }
__device__ __forceinline__ size_t tl(size_t row, int col, int K) { return (row >> 8) * ((size_t)256 * K) + (size_t)(col >> 6) * (256 * 64) + (row & 255) * 64 + (col & 63); }
__device__ __forceinline__ float wave_sum(float v) {
#pragma unroll
    for (int o = 1; o < 64; o <<= 1) v += __shfl_xor(v, o);
    return v;
}
__device__ __forceinline__ float wave_max(float v) {
#pragma unroll
    for (int o = 1; o < 64; o <<= 1) v = fmaxf(v, __shfl_xor(v, o));
    return v;
}

namespace pg8 {
constexpr int BM = 256, BK = 64, HALF = 128, HTB = HALF * BK * 2, STAGE_BYTES = 8 * HTB, NXCD = 8, WGM = 8;
__host__ __device__ __forceinline__ int lds_byte(int r, int c) { const int st = (r >> 4) * 2 + (c >> 5), rr = r & 15, cc = c & 31, ob = rr * 64 + cc * 2; return st * 1024 + (ob ^ (((ob >> 9) & 1) << 5)); }
__host__ __device__ __forceinline__ void stage_rc(int b, int& R, int& C) { const int st = b / 1024, sb = b % 1024, swz = sb ^ (((sb >> 9) & 1) << 5); R = (st >> 1) * 16 + swz / 64; C = (st & 1) * 32 + (swz % 64) / 2; }
__host__ __device__ __forceinline__ int perm32(int rho) { const int n = rho >> 4, i = rho & 15; return 8 * (i >> 2) + 4 * n + (i & 3); }
struct Unit { int pm, pn, br; };
__device__ __forceinline__ void tile_of(int wgid, int nM, int nN, int& pm, int& pn) {
    const int nwg = nM * nN;
    { const int q = nwg / NXCD, r = nwg % NXCD, xcd = wgid % NXCD, off = wgid / NXCD; wgid = (xcd < r ? xcd * (q + 1) : r * (q + 1) + (xcd - r) * q) + off; }
    const int nig = WGM * nN, gid = wgid / nig, fm = gid * WGM, gsz = (nM - fm) < WGM ? (nM - fm) : WGM;
    pm = fm + ((wgid % nig) % gsz); pn = (wgid % nig) / gsz;
}

template <class Epi, class Sched>
__device__ __forceinline__ void gemm_phase(LAS unsigned char* lds, const int K, const Sched& S, const Epi& E) {
    const int tid = threadIdx.x, wid = __builtin_amdgcn_readfirstlane(tid >> 6), lane = tid & 63, wr = wid >> 2, wc = wid & 3, fr = lane & 15, fq = lane >> 4;
    const int nt = K / BK;
    unsigned voffA[2], voffB[2];
#pragma unroll
    for (int i = 0; i < 2; ++i) { int R, C; stage_rc(tid * 16 + i * 8192, R, C); const int Rb = (R & ~31) + perm32(R & 31);
        voffA[i] = (unsigned)(R * BK + C) * 2u; voffB[i] = (unsigned)(Rb * BK + C) * 2u; }
    const size_t kstep = (size_t)(BM * BK * 2);
    const size_t hstep = (size_t)HALF * BK * 2;
    const unsigned ldsw = (unsigned)wid * 1024u;
    const int aoff = lds_byte(wr * 64 + fr, fq * 8), boff = lds_byte(wc * 32 + fr, fq * 8);
#define PG8_SA(b, h) (((b) * 2 + (h)) * HTB)
#define PG8_SB(b, h) ((4 + (b) * 2 + (h)) * HTB)
#define PG8_STAGE(bufoff, gbase, voff) do { _Pragma("unroll") for (int _i = 0; _i < 2; ++_i) \
        __builtin_amdgcn_global_load_lds((const unsigned*)((const char*)(gbase) + (voff)[_i]), (LAS unsigned*)(lds + (bufoff) + ldsw + _i * 8192), 16, 0, 0); } while (0)
#define PG8_LDA(dst, b, h) do { _Pragma("unroll") for (int m = 0; m < 4; ++m) _Pragma("unroll") for (int k = 0; k < 2; ++k) dst[m][k] = *(const LAS bf16x8*)(lds + PG8_SA(b, h) + aoff + m * 2048 + k * 1024); } while (0)
#define PG8_LDB(dst, b, h) do { _Pragma("unroll") for (int n = 0; n < 2; ++n) _Pragma("unroll") for (int k = 0; k < 2; ++k) dst[n][k] = *(const LAS bf16x8*)(lds + PG8_SB(b, h) + boff + n * 2048 + k * 1024); } while (0)
#define PG8_MMA(ai, bj, At, Bt) do { __builtin_amdgcn_s_setprio(1); _Pragma("unroll") for (int m = 0; m < 4; ++m) _Pragma("unroll") for (int n = 0; n < 2; ++n) _Pragma("unroll") for (int k = 0; k < 2; ++k) \
        acc[ai][bj][m][n] = __builtin_amdgcn_mfma_f32_16x16x32_bf16(Bt[n][k], At[m][k], acc[ai][bj][m][n], 0, 0, 0); __builtin_amdgcn_s_setprio(0); } while (0)
#define PG8_WAIT_V(n) asm volatile("s_waitcnt vmcnt(" #n ")" ::: "memory")
#define PG8_WAIT_L(n) asm volatile("s_waitcnt lgkmcnt(" #n ")" ::: "memory")
#define PG8_BAR __builtin_amdgcn_s_barrier()
#define PG8_SCHED __builtin_amdgcn_sched_barrier(0)
    Unit cur, nxt; int ui = 0;
    if (!S.next(0, cur)) return;
    f32x4 acc[2][2][4][2];
#pragma unroll
    for (int a = 0; a < 2; ++a)
#pragma unroll
        for (int b = 0; b < 2; ++b)
#pragma unroll
            for (int m = 0; m < 4; ++m)
#pragma unroll
                for (int n = 0; n < 2; ++n) acc[a][b][m][n] = (f32x4){0.f, 0.f, 0.f, 0.f};
    bf16x8 At[4][2], B0[2][2], B1[2][2];
    const char* cA = S.a_base(cur); const char* cB = S.b_base(cur);
    PG8_STAGE(PG8_SB(0, 0), cB, voffB); PG8_STAGE(PG8_SA(0, 0), cA, voffA); PG8_STAGE(PG8_SB(0, 1), cB + hstep, voffB); PG8_STAGE(PG8_SA(0, 1), cA + hstep, voffA);
    if (wr == 1) PG8_BAR;
    PG8_WAIT_V(4); PG8_BAR;
    PG8_STAGE(PG8_SB(1, 0), cB + kstep, voffB); PG8_STAGE(PG8_SA(1, 0), cA + kstep, voffA); PG8_STAGE(PG8_SB(1, 1), cB + hstep + kstep, voffB);
    PG8_WAIT_V(6); PG8_BAR;
    for (;;) {
        const bool has_next = S.next(ui + 1, nxt);
        const char* nA = has_next ? S.a_base(nxt) : cA; const char* nB = has_next ? S.b_base(nxt) : cB;
        for (int t = 0; t < nt; t += 2) {
            const bool last = (t == nt - 2);
            const char* a1 = cA + (size_t)(t + 1) * kstep;
            const char* a2 = last ? nA : cA + (size_t)(t + 2) * kstep; const char* b2 = last ? nB : cB + (size_t)(t + 2) * kstep;
            const char* a3 = a2 + kstep; const char* b3 = b2 + kstep;
            PG8_LDB(B0, 0, 0); PG8_SCHED; PG8_LDA(At, 0, 0); PG8_STAGE(PG8_SA(1, 1), a1 + hstep, voffA);
            PG8_WAIT_L(8); PG8_BAR; PG8_WAIT_L(0); PG8_MMA(0, 0, At, B0); PG8_BAR; PG8_SCHED;
            PG8_LDB(B1, 0, 1); PG8_STAGE(PG8_SB(0, 0), b2, voffB);
            PG8_BAR; PG8_WAIT_L(0); PG8_MMA(0, 1, At, B1); PG8_BAR;
            PG8_LDA(At, 0, 1); PG8_STAGE(PG8_SA(0, 0), a2, voffA);
            PG8_BAR; PG8_WAIT_L(0); PG8_MMA(1, 0, At, B0); PG8_BAR; PG8_SCHED;
            PG8_STAGE(PG8_SB(0, 1), b2 + hstep, voffB);
            PG8_WAIT_V(6); PG8_BAR; PG8_MMA(1, 1, At, B1); PG8_BAR;
            PG8_LDB(B0, 1, 0); PG8_SCHED; PG8_LDA(At, 1, 0); PG8_STAGE(PG8_SA(0, 1), a2 + hstep, voffA);
            PG8_WAIT_L(8); PG8_BAR; PG8_WAIT_L(0); PG8_MMA(0, 0, At, B0); PG8_BAR; PG8_SCHED;
            PG8_LDB(B1, 1, 1); PG8_STAGE(PG8_SB(1, 0), b3, voffB);
            PG8_BAR; PG8_WAIT_L(0); PG8_MMA(0, 1, At, B1); PG8_BAR;
            PG8_LDA(At, 1, 1); PG8_STAGE(PG8_SA(1, 0), a3, voffA);
            PG8_BAR; PG8_WAIT_L(0); PG8_MMA(1, 0, At, B0); PG8_BAR; PG8_SCHED;
            PG8_STAGE(PG8_SB(1, 1), b3 + hstep, voffB);
            PG8_WAIT_V(6); PG8_BAR; PG8_MMA(1, 1, At, B1); PG8_BAR;
        }
        const bool keep = E(acc, cur, wr, wc, fr, fq);
        if (!has_next) break;
        if (!keep)
#pragma unroll
        for (int a = 0; a < 2; ++a)
#pragma unroll
            for (int b = 0; b < 2; ++b)
#pragma unroll
                for (int m = 0; m < 4; ++m)
#pragma unroll
                    for (int n = 0; n < 2; ++n) acc[a][b][m][n] = (f32x4){0.f, 0.f, 0.f, 0.f};
        cur = nxt; cA = nA; cB = nB; ++ui;
    }
    PG8_WAIT_V(0);
    if (wr == 0) PG8_BAR;
    PG8_BAR;
#undef PG8_SA
#undef PG8_SB
#undef PG8_STAGE
#undef PG8_LDA
#undef PG8_LDB
#undef PG8_MMA
#undef PG8_WAIT_V
#undef PG8_WAIT_L
#undef PG8_BAR
#undef PG8_SCHED
}
}
using pg8::Unit;

struct SchedP1 {
    int G, c; const char* A; const char* Bt;
    __device__ __forceinline__ bool next(int i, Unit& u) const {
        const int L = i * G + c; if (L >= 2192) return false;
        u.br = 0;
        if (L >= 2160) { const int idx = L - 2160; u.pm = 36 + (idx >> 3); u.pn = 60 + (idx & 7); return true; }
        pg8::tile_of(L, 36, 60, u.pm, u.pn); return true;
    }
    __device__ __forceinline__ const char* a_base(const Unit& u) const { return A + (size_t)u.pm * (256 * 2048 * 2); }
    __device__ __forceinline__ const char* b_base(const Unit& u) const { return Bt + (size_t)u.pn * (256 * 2048 * 2); }
};
struct EpiP1 {
    bf16_t* proj; bf16_t* gate; float* F; const float* lb; const float* b_gate; float* out; bf16_t* mkb; bf16_t* mvt;
    __device__ __forceinline__ bool operator()(f32x4 (&acc)[2][2][4][2], const Unit& u, int wr, int wc, int fr, int fq) const {
        const int rloc = wr * 64 + fr, cloc = wc * 32 + 8 * fq;
        if (u.pn < 36) {
            const int seg = u.pn >> 2;
#pragma unroll
            for (int bj = 0; bj < 2; ++bj) {
                const int col = u.pn * 256 + bj * 128 + cloc;
                f32x4 l0 = (f32x4){0.f, 0.f, 0.f, 0.f}, l1 = l0;
                if (seg == 4) { l0 = *(const f32x4*)(lb + (col - C_HF)); l1 = *(const f32x4*)(lb + (col - C_HF) + 4); }
#pragma unroll
                for (int ai = 0; ai < 2; ++ai)
#pragma unroll
                    for (int m = 0; m < 4; ++m) {
                        const size_t row = (size_t)u.pm * 256 + ai * 128 + m * 16 + rloc;
                        f32x4 v0 = acc[ai][bj][m][0], v1 = acc[ai][bj][m][1];
                        if (seg == 4) {
#pragma unroll
                            for (int e = 0; e < 4; ++e) { v0[e] = l0[e] + (1.f - l0[e]) * sigm(v0[e]); v1[e] = l1[e] + (1.f - l1[e]) * sigm(v1[e]); }
                            float* fp = F + row * 1024 + (col - C_HF);
                            *(f32x4*)fp = v0; *(f32x4*)(fp + 4) = v1;
                        } else {
                            if (seg == 1) {
#pragma unroll
                                for (int e = 0; e < 4; ++e) { v0[e] = sigm(v0[e]); v1[e] = sigm(v1[e]); }
                            } else if (seg == 2 || seg == 6 || seg == 8) {
#pragma unroll
                                for (int e = 0; e < 4; ++e) { v0[e] = siluf(v0[e]); v1[e] = siluf(v1[e]); }
                            } else if (seg == 3) { v0 *= 0.08838834764831845f; v1 *= 0.08838834764831845f; }
                            else if (seg == 7) { v0 *= 0.0625f; v1 *= 0.0625f; }
                            u32x4 o; o.x = pk2(v0[0], v0[1]); o.y = pk2(v0[2], v0[3]); o.z = pk2(v1[0], v1[1]); o.w = pk2(v1[2], v1[3]);
                            *(u32x4*)(proj + row * LDP + col) = o;
                        }
                    }
            }
        } else if (u.pn < 60) {
            const int etid = (wr * 4 + wc) * 64 + fq * 16 + fr;
#pragma unroll
            for (int bj = 0; bj < 2; ++bj) {
                const int col = (u.pn - 36) * 256 + bj * 128 + cloc;
                const f32x4 b0 = *(const f32x4*)(b_gate + col), b1 = *(const f32x4*)(b_gate + col + 4);
#pragma unroll
                for (int ai = 0; ai < 2; ++ai)
#pragma unroll
                    for (int m = 0; m < 4; ++m) {
                        const size_t row = (size_t)u.pm * 256 + ai * 128 + m * 16 + rloc;
                        f32x4 v0 = acc[ai][bj][m][0] + b0, v1 = acc[ai][bj][m][1] + b1;
#pragma unroll
                        for (int e = 0; e < 4; ++e) { v0[e] = fmaxf(sigm(v0[e]), 1e-6f); v1[e] = fmaxf(sigm(v1[e]), 1e-6f); }
                        u32x4 o; o.x = pk2(v0[0], v0[1]); o.y = pk2(v0[2], v0[3]); o.z = pk2(v1[0], v1[1]); o.w = pk2(v1[2], v1[3]);
                        *(u32x4*)(gate + ((((size_t)u.pm * 24 + (u.pn - 36)) * 16 + (ai * 8 + m * 2 + bj)) * 512 + etid) * 8) = o;
                    }
            }
        } else {
            const int n = u.pm - 36, isv = (u.pn >= 64) ? 1 : 0, h = (u.pn - 60) & 3;
            float* ob = out + (isv ? O_MV : O_MK);
#pragma unroll
            for (int bj = 0; bj < 2; ++bj) {
                const int d = bj * 128 + cloc;
#pragma unroll
                for (int ai = 0; ai < 2; ++ai)
#pragma unroll
                    for (int m = 0; m < 4; ++m) {
                        const int key = ai * 128 + m * 16 + rloc;
                        const f32x4 v0 = acc[ai][bj][m][0], v1 = acc[ai][bj][m][1];
                        float* op = ob + ((size_t)(n * 256 + key) * 4 + h) * 256 + d;
                        *(f32x4*)op = v0; *(f32x4*)(op + 4) = v1;
                        if (!isv) {
                            u32x4 o; o.x = pk2(v0[0], v0[1]); o.y = pk2(v0[2], v0[3]); o.z = pk2(v1[0], v1[1]); o.w = pk2(v1[2], v1[3]);
                            *(u32x4*)(mkb + ((size_t)(n * 4 + h) * 256 + key) * 256 + d) = o;
                        } else {
                            bf16_t* vp = mvt + ((size_t)(n * 4 + h) * 256 + d) * 256 + key;
#pragma unroll
                            for (int e = 0; e < 4; ++e) { vp[(size_t)e * 256] = (bf16_t)f2bf(v0[e]); vp[(size_t)(e + 4) * 256] = (bf16_t)f2bf(v1[e]); }
                        }
                    }
            }
        }
        return false;
    }
};

struct SchedP4 {
    int G, c; const char* A; const char* Bt;
    __device__ __forceinline__ bool next(int i, Unit& u) const {
        const int tri = i / 3, L = tri * G + c; if (L >= 288) return false;
        u.br = i - tri * 3; pg8::tile_of(L, 36, 8, u.pm, u.pn); return true;
    }
    __device__ __forceinline__ const char* a_base(const Unit& u) const { return A + (size_t)u.br * ((size_t)9216 * 1024 * 2) + (size_t)u.pm * (256 * 1024 * 2); }
    __device__ __forceinline__ const char* b_base(const Unit& u) const { return Bt + (size_t)u.br * ((size_t)2048 * 1024 * 2) + (size_t)u.pn * (256 * 1024 * 2); }
};
struct EpiP4 {
    const bf16_t* gate; bf16_t* merged;
    __device__ __forceinline__ bool operator()(f32x4 (&acc)[2][2][4][2], const Unit& u, int wr, int wc, int fr, int fq) const {
        const int rloc = wr * 64 + fr, cloc = wc * 32 + 8 * fq;
        const int etid = (wr * 4 + wc) * 64 + fq * 16 + fr;
        bf16_t* mbase = merged + tl((size_t)u.pm * 256 + rloc, u.pn * 256 + cloc, 2048);
#pragma unroll
        for (int bj = 0; bj < 2; ++bj) {
            const int col = u.pn * 256 + bj * 128 + cloc;
#pragma unroll
            for (int ai = 0; ai < 2; ++ai)
#pragma unroll
                for (int m = 0; m < 4; ++m) {
                    const size_t row = (size_t)u.pm * 256 + ai * 128 + m * 16 + rloc;
                    const bf16_t* gp = gate + ((((size_t)u.pm * 24 + (u.br * 8 + u.pn)) * 16 + (ai * 8 + m * 2 + bj)) * 512 + etid) * 8;
                    const u32x4 g = *(const u32x4*)gp;
                    f32x4 s0 = (f32x4){bflo(g.x), bfhi(g.x), bflo(g.y), bfhi(g.y)}, s1 = (f32x4){bflo(g.z), bfhi(g.z), bflo(g.w), bfhi(g.w)};
                    if (u.br < 2) {
                        const u32x4 h = *(const u32x4*)(gp + (size_t)8 * 16 * 512 * 8);
                        s0[0] *= __builtin_amdgcn_rcpf(bflo(h.x)); s0[1] *= __builtin_amdgcn_rcpf(bfhi(h.x)); s0[2] *= __builtin_amdgcn_rcpf(bflo(h.y)); s0[3] *= __builtin_amdgcn_rcpf(bfhi(h.y));
                        s1[0] *= __builtin_amdgcn_rcpf(bflo(h.z)); s1[1] *= __builtin_amdgcn_rcpf(bfhi(h.z)); s1[2] *= __builtin_amdgcn_rcpf(bflo(h.w)); s1[3] *= __builtin_amdgcn_rcpf(bfhi(h.w));
                    }
                    acc[ai][bj][m][0] *= s0; acc[ai][bj][m][1] *= s1;
                    if (u.br == 2) { const f32x4 v0 = acc[ai][bj][m][0], v1 = acc[ai][bj][m][1];
                        u32x4 o; o.x = pk2(v0[0], v0[1]); o.y = pk2(v0[2], v0[3]); o.z = pk2(v1[0], v1[1]); o.w = pk2(v1[2], v1[3]);
                        *(u32x4*)(mbase + bj * 32768 + (ai * 128 + m * 16) * 64) = o; }
                }
        }
        return u.br < 2;
    }
};

struct SchedP5 {
    int G, c; const char* A; const char* Bt;
    __device__ __forceinline__ bool next(int i, Unit& u) const {
        const int L = i * G + c; if (L >= 288) return false;
        u.br = 0; pg8::tile_of(L, 36, 8, u.pm, u.pn); return true;
    }
    __device__ __forceinline__ const char* a_base(const Unit& u) const { return A + (size_t)u.pm * (256 * 2048 * 2); }
    __device__ __forceinline__ const char* b_base(const Unit& u) const { return Bt + (size_t)u.pn * (256 * 2048 * 2); }
};
struct EpiP5 {
    const float* xp; const float* xs; float* out;
    __device__ __forceinline__ bool operator()(f32x4 (&acc)[2][2][4][2], const Unit& u, int wr, int wc, int fr, int fq) const {
        const int rloc = wr * 64 + fr, cloc = wc * 32 + 8 * fq;
#pragma unroll
        for (int bj = 0; bj < 2; ++bj) {
            const int col = u.pn * 256 + bj * 128 + cloc;
#pragma unroll
            for (int ai = 0; ai < 2; ++ai)
#pragma unroll
                for (int m = 0; m < 4; ++m) {
                    const size_t row = (size_t)u.pm * 256 + ai * 128 + m * 16 + rloc;
                    const float* xr = (row < (size_t)NTP) ? (xp + row * 2048 + col) : (xs + (row - NTP) * 2048 + col);
                    const f32x4 v0 = acc[ai][bj][m][0] + *(const f32x4*)xr, v1 = acc[ai][bj][m][1] + *(const f32x4*)(xr + 4);
                    float* op = out + row * 2048 + col;
                    *(f32x4*)op = v0; *(f32x4*)(op + 4) = v1;
                }
        }
        return false;
    }
};

struct EpiNull {
    __device__ __forceinline__ bool operator()(f32x4 (&acc)[2][2][4][2], const Unit& u, int wr, int wc, int fr, int fq) const {
        f32x4 t = (f32x4){0.f, 0.f, 0.f, 0.f};
#pragma unroll
        for (int ai = 0; ai < 2; ++ai)
#pragma unroll
            for (int bj = 0; bj < 2; ++bj)
#pragma unroll
                for (int m = 0; m < 4; ++m) t += acc[ai][bj][m][0] + acc[ai][bj][m][1];
        asm volatile("" :: "v"(t[0]), "v"(t[1]), "v"(t[2]), "v"(t[3]));
        return false;
    }
};
#define P0_DESC(it_, W_, WT_, K_, N_, ro_, kb_, nb_) do { int r_ = (it_); \
    if (r_ < 1920) { W_ = p.w_in; WT_ = WT1; K_ = 2048; N_ = 15360; ro_ = 0; kb_ = r_ / 120; nb_ = r_ % 120; } \
    else if (r_ < 2176) { r_ -= 1920; W_ = p.w_mem_kv; WT_ = WT1; K_ = 2048; N_ = 2048; ro_ = 15360; kb_ = r_ >> 4; nb_ = r_ & 15; } \
    else if (r_ < 2304) { r_ -= 2176; W_ = p.w_conv_out; WT_ = WT3; K_ = 1024; N_ = 2048; ro_ = 0; kb_ = r_ >> 4; nb_ = r_ & 15; } \
    else if (r_ < 2432) { r_ -= 2304; W_ = p.w_hgrn_out; WT_ = WT3 + (size_t)2048 * 1024; K_ = 1024; N_ = 2048; ro_ = 0; kb_ = r_ >> 4; nb_ = r_ & 15; } \
    else if (r_ < 2560) { r_ -= 2432; W_ = p.w_attn_out; WT_ = WT3 + (size_t)2 * 2048 * 1024; K_ = 1024; N_ = 2048; ro_ = 0; kb_ = r_ >> 4; nb_ = r_ & 15; } \
    else { r_ -= 2560; W_ = p.w_out; WT_ = WTO; K_ = 2048; N_ = 2048; ro_ = 0; kb_ = r_ >> 4; nb_ = r_ & 15; } } while (0)
__device__ __forceinline__ void p0_prologue(const Params& p, LAS unsigned char* lds) {
    const int tid = threadIdx.x, lane = tid & 63, wave = tid >> 6, G = gridDim.x, c = blockIdx.x;
    LAS unsigned* T32 = (LAS unsigned*)lds;
    constexpr int T_ALL = 1920 + 256 + 3 * 128 + 256;
    const int nq = tid & 31, kp0 = tid >> 5;
    f32x4 r0[4], r1[4];
#define P0_LOAD(W_, N_, kb_, nb_) do { _Pragma("unroll") for (int i = 0; i < 4; ++i) { const int kpair = kp0 + 16 * i; \
        const float* src = (W_) + (size_t)((kb_) * 128 + 2 * kpair) * (N_) + (nb_) * 128 + 4 * nq; r0[i] = *(const f32x4*)src; r1[i] = *(const f32x4*)(src + (N_)); } } while (0)
    bf16_t* WT1 = (bf16_t*)(p.ws + WS_WT1); bf16_t* WT3 = (bf16_t*)(p.ws + WS_WT3); bf16_t* WTO = (bf16_t*)(p.ws + WS_WTO);
    int it = c;
    const float* dW = p.w_in; bf16_t* dWT = WT1; int dK = 2048, dN = 15360, dro = 0, dkb = 0, dnb = 0;
    if (it < T_ALL) { P0_DESC(it, dW, dWT, dK, dN, dro, dkb, dnb); P0_LOAD(dW, dN, dkb, dnb); }
    while (it < T_ALL) {
#pragma unroll
        for (int i = 0; i < 4; ++i) { const int kpair = kp0 + 16 * i;
            T32[(4 * nq + 0) * 65 + kpair] = pk2(r0[i][0], r1[i][0]); T32[(4 * nq + 1) * 65 + kpair] = pk2(r0[i][1], r1[i][1]);
            T32[(4 * nq + 2) * 65 + kpair] = pk2(r0[i][2], r1[i][2]); T32[(4 * nq + 3) * 65 + kpair] = pk2(r0[i][3], r1[i][3]); }
        __syncthreads();
        const int itn = it + G;
        const float* nW = dW; bf16_t* nWT = dWT; int nK = dK, nN = dN, nro = dro, nkb = dkb, nnb = dnb;
        if (itn < T_ALL) { P0_DESC(itn, nW, nWT, nK, nN, nro, nkb, nnb); P0_LOAD(nW, nN, nkb, nnb); }
#pragma unroll
        for (int i = 0; i < 4; ++i) {
            const int id = tid + 512 * i, n = id >> 4, cc = id & 15;
            u32x4 o; o.x = T32[n * 65 + 4 * cc]; o.y = T32[n * 65 + 4 * cc + 1]; o.z = T32[n * 65 + 4 * cc + 2]; o.w = T32[n * 65 + 4 * cc + 3];
            *(u32x4*)(dWT + tl((size_t)(dro + dnb * 128 + n), dkb * 128 + 8 * cc, dK)) = o;
        }
        __syncthreads();
        it = itn; dW = nW; dWT = nWT; dK = nK; dN = nN; dro = nro; dkb = nkb; dnb = nnb;
    }
#undef P0_LOAD
#undef P0_DESC
    bf16_t* HA = (bf16_t*)(p.ws + WS_HA);
    const int gw = c * 8 + wave, NGW = G * 8;
#define P0_ROWPTR(m) ((m) < NTP ? p.x_prompt + (size_t)(m) * 2048 : ((m) < NTOK ? p.x_sample + (size_t)((m) - NTP) * 2048 : p.mem_prompt + (size_t)((m) - NTOK) * 2048))
    f32x4 v[8];
    int m = gw;
    if (m < 10240) { const float* xr = P0_ROWPTR(m);
#pragma unroll
        for (int j = 0; j < 8; ++j) v[j] = ((const f32x4*)xr)[lane + 64 * j]; }
    while (m < 10240) {
        const int mn = m + NGW; f32x4 vn[8];
        if (mn < 10240) { const float* xr = P0_ROWPTR(mn);
#pragma unroll
            for (int j = 0; j < 8; ++j) vn[j] = ((const f32x4*)xr)[lane + 64 * j]; }
        float ss = 0.f;
#pragma unroll
        for (int j = 0; j < 8; ++j) ss += (v[j][0] * v[j][0] + v[j][1] * v[j][1]) + (v[j][2] * v[j][2] + v[j][3] * v[j][3]);
        ss = wave_sum(ss);
        const float rinv = rsqrtf(ss * (1.f / 2048.f) + EPS);
        const float* g = (m < NTOK) ? p.g_pre : p.g_mem;
#pragma unroll
        for (int j = 0; j < 8; ++j) { const f32x4 gg = ((const f32x4*)g)[lane + 64 * j];
            u32x2 o; o.x = pk2(v[j][0] * rinv * gg[0], v[j][1] * rinv * gg[1]); o.y = pk2(v[j][2] * rinv * gg[2], v[j][3] * rinv * gg[3]);
            *(u32x2*)(HA + tl((size_t)m, 4 * (lane + 64 * j), 2048)) = o; }
        if (mn < 10240) {
#pragma unroll
            for (int j = 0; j < 8; ++j) v[j] = vn[j]; }
        m = mn;
    }
#undef P0_ROWPTR
    if (c == 0) { float* LB = (float*)(p.ws + WS_LB);
        for (int i = tid; i < 1024; i += 512) LB[i] = 1.f / (1.f + __expf(p.lb_logits[1024 + i] - p.lb_logits[i])); }
}

__device__ __forceinline__ void hgrn_prompt_item(const Params& p, int item, LAS unsigned char* lds, int tid) {
    LAS float* qs = (LAS float*)lds;
    LAS float* fs = qs + 4096;
    LAS float* vs = fs + 4096;
    LAS float* part = vs + 512;
    const int s = item >> 3, n = s >> 3, h = s & 7, dvg = item & 7;
    const int vcol = tid & 15, kg = tid >> 4;
    const bf16_t* proj = (const bf16_t*)(p.ws + WS_PROJ9);
    const float* F = (const float*)(p.ws + WS_F);
    float* oraw = (float*)(p.ws + WS_ORAW);
    const size_t row0 = (size_t)n * SEQ;
    const bf16_t* qsrc = proj + (row0 + kg) * LDP + C_HQ + h * 128 + vcol * 8;
    const float* fsrc = F + (row0 + kg) * 1024 + h * 128 + vcol * 8;
    const bf16_t* vsrc = proj + (row0 + kg) * LDP + C_HI + h * 128 + dvg * 16 + vcol;
    f32x2 S01 = (f32x2){0.f, 0.f}, S23 = (f32x2){0.f, 0.f};
    u32x4 rq[4]; f32x4 rfa[4], rfb[4]; bf16_t rv[4];
#define HG_FETCH(R, tb) do { const size_t adv = (size_t)(tb); rq[R] = *(const u32x4*)(qsrc + adv * LDP); rfa[R] = *(const f32x4*)(fsrc + adv * 1024); \
        rfb[R] = *(const f32x4*)(fsrc + adv * 1024 + 4); rv[R] = *(vsrc + adv * LDP); } while (0)
#define HG_BATCH(R, tb) do { \
        { LAS float* qd = qs + kg * 128 + vcol * 8; \
          *(LAS f32x4*)qd = (f32x4){bflo(rq[R].x), bfhi(rq[R].x), bflo(rq[R].y), bfhi(rq[R].y)}; *(LAS f32x4*)(qd + 4) = (f32x4){bflo(rq[R].z), bfhi(rq[R].z), bflo(rq[R].w), bfhi(rq[R].w)}; \
          LAS float* fd = fs + kg * 128 + vcol * 8; *(LAS f32x4*)fd = rfa[R]; *(LAS f32x4*)(fd + 4) = rfb[R]; \
          vs[kg * 16 + vcol] = bf2f(rv[R]); } \
        __syncthreads(); \
        if ((tb) + 128 < SEQ) HG_FETCH(R, (tb) + 128); \
        f32x4 cf[4], cq[4]; float cv[4]; \
        _Pragma("unroll") for (int i = 0; i < 4; ++i) { cf[i] = *(const LAS f32x4*)(fs + i * 128 + kg * 4); cq[i] = *(const LAS f32x4*)(qs + i * 128 + kg * 4); cv[i] = vs[i * 16 + vcol]; } \
        _Pragma("unroll") for (int g = 0; g < 8; ++g) { \
            f32x4 nf[4], nq[4]; float nv[4]; \
            if (g < 7) { _Pragma("unroll") for (int i = 0; i < 4; ++i) { const int tt = (g + 1) * 4 + i; \
                nf[i] = *(const LAS f32x4*)(fs + tt * 128 + kg * 4); nq[i] = *(const LAS f32x4*)(qs + tt * 128 + kg * 4); nv[i] = vs[tt * 16 + vcol]; } } \
            _Pragma("unroll") for (int i = 0; i < 4; ++i) { \
                const f32x2 f01 = (f32x2){cf[i][0], cf[i][1]}, f23 = (f32x2){cf[i][2], cf[i][3]}, q01 = (f32x2){cq[i][0], cq[i][1]}, q23 = (f32x2){cq[i][2], cq[i][3]}; \
                const f32x2 vv = (f32x2){cv[i], cv[i]}; \
                S01 = f01 * (S01 - vv) + vv; S23 = f23 * (S23 - vv) + vv; \
                f32x2 t = S01 * q01; t = S23 * q23 + t; \
                part[(g * 4 + i) * 528 + tid] = t[0] + t[1]; } \
            if (g < 7) { _Pragma("unroll") for (int i = 0; i < 4; ++i) { cf[i] = nf[i]; cq[i] = nq[i]; cv[i] = nv[i]; } } } \
        __syncthreads(); \
        { float a = 0.f; \
          _Pragma("unroll 8") for (int k2 = 0; k2 < 32; ++k2) a += part[kg * 528 + k2 * 16 + vcol]; \
          oraw[(row0 + (tb) + kg) * 1024 + h * 128 + dvg * 16 + vcol] = a; } } while (0)
    HG_FETCH(0, 0); HG_FETCH(1, 32); HG_FETCH(2, 64); HG_FETCH(3, 96);
#pragma unroll 1
    for (int t0 = 0; t0 < SEQ; t0 += 128) { HG_BATCH(0, t0); HG_BATCH(1, t0 + 32); HG_BATCH(2, t0 + 64); HG_BATCH(3, t0 + 96); }
#undef HG_FETCH
#undef HG_BATCH
    float* so = p.out + O_HGRN_P + ((size_t)(n * 8 + h) * 128 + kg * 4) * 128 + dvg * 16 + vcol;
    so[0] = S01[0]; so[128] = S01[1]; so[256] = S23[0]; so[384] = S23[1];
    __syncthreads();
}

__device__ __forceinline__ void hgrn_sample_item(const Params& p, int item, LAS unsigned char* lds, int tid) {
    LAS float* qs = (LAS float*)lds;
    LAS float* fs = qs + 1024;
    LAS float* vs = fs + 1024;
    LAS float* opart = vs + 1024;
    const int n = item >> 3, h = item & 7, lane = tid & 63, wave = tid >> 6;
    const bf16_t* proj = (const bf16_t*)(p.ws + WS_PROJ9);
    const float* F = (const float*)(p.ws + WS_F);
    const size_t row0 = (size_t)NTP + (size_t)n * 8;
    { const int tt = tid >> 6, k2 = (tid & 63) * 2; const size_t r = row0 + tt;
      const unsigned qw = *(const unsigned*)(proj + r * LDP + C_HQ + h * 128 + k2); const f32x2 ff = *(const f32x2*)(F + r * 1024 + h * 128 + k2);
      const unsigned vw = *(const unsigned*)(proj + r * LDP + C_HI + h * 128 + k2);
      qs[tt * 128 + k2] = bflo(qw); qs[tt * 128 + k2 + 1] = bfhi(qw); fs[tt * 128 + k2] = ff[0]; fs[tt * 128 + k2 + 1] = ff[1];
      vs[tt * 128 + k2] = bflo(vw); vs[tt * 128 + k2 + 1] = bfhi(vw); }
    const int v4 = tid & 31, kg = tid >> 5;
    const size_t sbase = ((size_t)(n * 8 + h) * 128 + kg * 8) * 128 + v4 * 4;
    f32x4 S[8];
#pragma unroll
    for (int i = 0; i < 8; ++i) S[i] = *(const f32x4*)(p.state_hgrn + sbase + (size_t)i * 128);
    __syncthreads();
#pragma unroll
    for (int tt = 0; tt < 8; ++tt) {
        const f32x4 fa = *(const LAS f32x4*)(fs + tt * 128 + kg * 8), fb = *(const LAS f32x4*)(fs + tt * 128 + kg * 8 + 4);
        const f32x4 qa = *(const LAS f32x4*)(qs + tt * 128 + kg * 8), qb = *(const LAS f32x4*)(qs + tt * 128 + kg * 8 + 4);
        const f32x4 vv = *(const LAS f32x4*)(vs + tt * 128 + v4 * 4);
        f32x4 po = (f32x4){0.f, 0.f, 0.f, 0.f};
#pragma unroll
        for (int i = 0; i < 8; ++i) { const float f = (i < 4) ? fa[i & 3] : fb[i & 3], q = (i < 4) ? qa[i & 3] : qb[i & 3];
            S[i] = S[i] * f + vv * (1.f - f); po += S[i] * q; }
#pragma unroll
        for (int e = 0; e < 4; ++e) po[e] += __shfl_xor(po[e], 32);
        if (lane < 32) *(LAS f32x4*)(opart + (tt * 8 + wave) * 128 + v4 * 4) = po;
    }
    float* so = p.out + O_HGRN_S + sbase;
#pragma unroll
    for (int i = 0; i < 8; ++i) *(f32x4*)(so + (size_t)i * 128) = S[i];
    __syncthreads();
    { const int tt = tid >> 6, v = (tid & 63) * 2; float o0 = 0.f, o1 = 0.f;
#pragma unroll
      for (int w = 0; w < 8; ++w) { const f32x2 t = *(const LAS f32x2*)(opart + (tt * 8 + w) * 128 + v); o0 += t[0]; o1 += t[1]; }
      const float ss = wave_sum(o0 * o0 + o1 * o1), rinv = rsqrtf(ss * (1.f / 128.f) + EPS);
      const size_t r = row0 + tt; const f32x2 gg = *(const f32x2*)(p.g_hgrn + h * 128 + v);
      const unsigned gw = *(const unsigned*)(proj + r * LDP + C_HOG + h * 128 + v);
      bf16_t* og = (bf16_t*)(p.ws + WS_ACT3) + (size_t)9216 * 1024 + tl(r, h * 128 + v, 1024);
      *(unsigned*)og = pk2(o0 * rinv * gg[0] * bflo(gw), o1 * rinv * gg[1] * bfhi(gw)); }
    __syncthreads();
}

__device__ __forceinline__ void hgrn_norm_rows(const Params& p) {
    const int tid = threadIdx.x, lane = tid & 63, gw = blockIdx.x * 8 + (tid >> 6), NGW = gridDim.x * 8;
    const bf16_t* proj = (const bf16_t*)(p.ws + WS_PROJ9); const float* oraw = (const float*)(p.ws + WS_ORAW);
    bf16_t* og = (bf16_t*)(p.ws + WS_ACT3) + (size_t)9216 * 1024;
    for (int r = gw; r < NTP; r += NGW) {
        f32x4 o[4]; float ss = 0.f;
#pragma unroll
        for (int j = 0; j < 4; ++j) { o[j] = *(const f32x4*)(oraw + (size_t)r * 1024 + lane * 16 + j * 4); ss += (o[j][0] * o[j][0] + o[j][1] * o[j][1]) + (o[j][2] * o[j][2] + o[j][3] * o[j][3]); }
        ss += __shfl_xor(ss, 1); ss += __shfl_xor(ss, 2); ss += __shfl_xor(ss, 4);
        const float rinv = rsqrtf(ss * (1.f / 128.f) + EPS);
        const u32x4 ga = *(const u32x4*)(proj + (size_t)r * LDP + C_HOG + lane * 16), gb = *(const u32x4*)(proj + (size_t)r * LDP + C_HOG + lane * 16 + 8);
        f32x4 g[4];
#pragma unroll
        for (int j = 0; j < 4; ++j) g[j] = *(const f32x4*)(p.g_hgrn + lane * 16 + j * 4);
        u32x4 oa, ob;
        oa.x = pk2(o[0][0] * rinv * g[0][0] * bflo(ga.x), o[0][1] * rinv * g[0][1] * bfhi(ga.x)); oa.y = pk2(o[0][2] * rinv * g[0][2] * bflo(ga.y), o[0][3] * rinv * g[0][3] * bfhi(ga.y));
        oa.z = pk2(o[1][0] * rinv * g[1][0] * bflo(ga.z), o[1][1] * rinv * g[1][1] * bfhi(ga.z)); oa.w = pk2(o[1][2] * rinv * g[1][2] * bflo(ga.w), o[1][3] * rinv * g[1][3] * bfhi(ga.w));
        ob.x = pk2(o[2][0] * rinv * g[2][0] * bflo(gb.x), o[2][1] * rinv * g[2][1] * bfhi(gb.x)); ob.y = pk2(o[2][2] * rinv * g[2][2] * bflo(gb.y), o[2][3] * rinv * g[2][3] * bfhi(gb.y));
        ob.z = pk2(o[3][0] * rinv * g[3][0] * bflo(gb.z), o[3][1] * rinv * g[3][1] * bfhi(gb.z)); ob.w = pk2(o[3][2] * rinv * g[3][2] * bflo(gb.w), o[3][3] * rinv * g[3][3] * bfhi(gb.w));
        *(u32x4*)(og + tl((size_t)r, lane * 16, 1024)) = oa; *(u32x4*)(og + tl((size_t)r, lane * 16 + 8, 1024)) = ob;
    }
}

template <bool SAMPLE>
__device__ __forceinline__ void conv_item(const Params& p, int item, LAS unsigned char* lds, int tid) {
    constexpr int T = SAMPLE ? 8 : 32;
    constexpr int GP = 4, NG = (T + 32) / GP, G0 = 32 / GP;
    LAS float* dcs = (LAS float*)lds;
    const bf16_t* proj = (const bf16_t*)(p.ws + WS_PROJ9);
    const int n = SAMPLE ? item : (item >> 6), t0 = SAMPLE ? 0 : (item & 63) * 32;
    const size_t rowb = SAMPLE ? ((size_t)NTP + (size_t)n * 8) : ((size_t)n * SEQ);
    const int c0 = 2 * tid;
    float w0[31], w1[31], x0[31], x1[31];
#pragma unroll
    for (int j = 0; j < 31; ++j) { const f32x2 w = *(const f32x2*)(p.conv_w + j * 1024 + c0); w0[j] = w[0]; w1[j] = w[1]; x0[j] = 0.f; x1[j] = 0.f; }
    const f32x2 bias = *(const f32x2*)(p.conv_b + c0);
    unsigned ra[GP], rg[GP];
#define CONV_ISSUE(g) do { \
        if (SAMPLE && (g) < G0) { _Pragma("unroll") for (int i = 0; i < GP; ++i) { const int ti = -2 + GP * (g) + i; \
            const unsigned* tp = (const unsigned*)(p.state_conv + ((size_t)n * 30 + (ti < 0 ? 0 : ti)) * 1024 + c0); ra[i] = tp[0]; rg[i] = tp[1]; } } \
        else { _Pragma("unroll") for (int i = 0; i < GP; ++i) { const int t = t0 - 32 + GP * (g) + i; const bf16_t* rp = proj + (rowb + (t < 0 ? 0 : t)) * LDP + c0; \
            ra[i] = *(const unsigned*)(rp + C_CV); rg[i] = *(const unsigned*)(rp + C_CG); } } } while (0)
    CONV_ISSUE(0);
#pragma unroll 1
    for (int g = 0; g < NG; ++g) {
        float u0[GP], u1[GP];
        if (SAMPLE && g < G0) {
#pragma unroll
            for (int i = 0; i < GP; ++i) { const bool ok = (-2 + GP * g + i) >= 0; u0[i] = ok ? __builtin_bit_cast(float, ra[i]) : 0.f; u1[i] = ok ? __builtin_bit_cast(float, rg[i]) : 0.f; }
        } else {
#pragma unroll
            for (int i = 0; i < GP; ++i) { const bool ok = (t0 - 32 + GP * g + i) >= 0; u0[i] = ok ? bflo(ra[i]) * bflo(rg[i]) : 0.f; u1[i] = ok ? bfhi(ra[i]) * bfhi(rg[i]) : 0.f; }
        }
        if (g + 1 < NG) CONV_ISSUE(g + 1);
#pragma unroll
        for (int i = 0; i < GP; ++i) {
            const int pp = -32 + GP * g + i, t = t0 + pp;
            if (SAMPLE) { if (pp >= -22) *(f32x2*)(p.out + O_CONV_S + ((size_t)n * 30 + (pp + 22)) * 1024 + c0) = (f32x2){u0[i], u1[i]}; }
            else { if (t >= SEQ - 30) *(f32x2*)(p.out + O_CONV_P + ((size_t)n * 30 + (t - (SEQ - 30))) * 1024 + c0) = (f32x2){u0[i], u1[i]}; }
#pragma unroll
            for (int j = 0; j < 30; ++j) { x0[j] = x0[j + 1]; x1[j] = x1[j + 1]; }
            x0[30] = u0[i]; x1[30] = u1[i];
            if (g >= G0) {
                float d0 = bias[0], d1 = bias[1];
#pragma unroll
                for (int j = 0; j < 31; ++j) { d0 += w0[j] * x0[j]; d1 += w1[j] * x1[j]; }
                *(LAS f32x2*)(dcs + (pp) * 1024 + c0) = (f32x2){d0, d1};
            }
        }
    }
#undef CONV_ISSUE
    __syncthreads();
    { const int lane = tid & 63, wave = tid >> 6;
      bf16_t* aact = (bf16_t*)(p.ws + WS_ACT3);
      for (int pp = wave; pp < T; pp += 8) {
          f32x4 v[4]; float s = 0.f;
#pragma unroll
          for (int j = 0; j < 4; ++j) { v[j] = *(const LAS f32x4*)(dcs + pp * 1024 + j * 256 + lane * 4); s += (v[j][0] + v[j][1]) + (v[j][2] + v[j][3]); }
          const float mean = wave_sum(s) * (1.f / 1024.f); float s2 = 0.f;
#pragma unroll
          for (int j = 0; j < 4; ++j) { v[j] = v[j] - mean; s2 += (v[j][0] * v[j][0] + v[j][1] * v[j][1]) + (v[j][2] * v[j][2] + v[j][3] * v[j][3]); }
          const float rstd = rsqrtf(wave_sum(s2) * (1.f / 1024.f) + EPS);
          const size_t r = rowb + t0 + pp;
          bf16_t* arow = aact + tl(r, lane * 4, 1024);
#pragma unroll
          for (int j = 0; j < 4; ++j) { const int c = j * 256 + lane * 4;
              const f32x4 lg = *(const f32x4*)(p.ln_g + c), lbv = *(const f32x4*)(p.ln_b + c);
              const u32x2 sg = *(const u32x2*)(proj + r * LDP + C_CS + c);
              const float y0 = siluf(v[j][0] * rstd * lg[0] + lbv[0]) * bflo(sg.x), y1 = siluf(v[j][1] * rstd * lg[1] + lbv[1]) * bfhi(sg.x);
              const float y2 = siluf(v[j][2] * rstd * lg[2] + lbv[2]) * bflo(sg.y), y3 = siluf(v[j][3] * rstd * lg[3] + lbv[3]) * bfhi(sg.y);
              u32x2 o; o.x = pk2(y0, y1); o.y = pk2(y2, y3);
              *(u32x2*)(arow + j * 65536) = o; }
      } }
    __syncthreads();
}

__device__ __forceinline__ void attn_prompt_item(const Params& p, int item, LAS unsigned char* lds, int tid) {
    const int lane = tid & 63, wave = tid >> 6, l15 = lane & 15, quad = lane >> 4;
    const int n = item >> 6, h = (item >> 4) & 3, qt = item & 15;
    const bf16_t* proj = (const bf16_t*)(p.ws + WS_PROJ9);
    const bf16_t* kb = (const bf16_t*)(p.ws + WS_MKB) + (size_t)(n * 4 + h) * 65536;
    const bf16_t* vt = (const bf16_t*)(p.ws + WS_MVT) + (size_t)(n * 4 + h) * 65536;
    const size_t qrow = (size_t)n * SEQ + qt * 128 + wave * 16 + l15;
    u32x4 st[16];
#pragma unroll
    for (int i = 0; i < 16; ++i) st[i] = *(const u32x4*)(kb + (size_t)(tid + 512 * i) * 8);
    bf16x8 qf[8];
#pragma unroll
    for (int s = 0; s < 8; ++s) qf[s] = *(const bf16x8*)(proj + qrow * LDP + C_AQ + h * 256 + s * 32 + quad * 8);
#pragma unroll
    for (int i = 0; i < 16; ++i) { const int id = tid + 512 * i, r = id >> 5, c = id & 31; *(LAS u32x4*)(lds + r * 512 + ((c ^ (r & 15)) * 16)) = st[i]; }
    __syncthreads();
    f32x4 sc[16];
#pragma unroll
    for (int T = 0; T < 16; ++T) {
        sc[T] = (f32x4){0.f, 0.f, 0.f, 0.f};
        const LAS unsigned char* kr = lds + (T * 16 + l15) * 512;
#pragma unroll
        for (int s = 0; s < 8; ++s) { const bf16x8 a = *(const LAS bf16x8*)(kr + (((s * 4 + quad) ^ l15) * 16)); sc[T] = __builtin_amdgcn_mfma_f32_16x16x32_bf16(a, qf[s], sc[T], 0, 0, 0); }
    }
#pragma unroll
    for (int i = 0; i < 16; ++i) st[i] = *(const u32x4*)(vt + (size_t)(tid + 512 * i) * 8);
    __syncthreads();
    float mx = -3.0e38f;
#pragma unroll
    for (int T = 0; T < 16; ++T) mx = fmaxf(mx, fmaxf(fmaxf(sc[T][0], sc[T][1]), fmaxf(sc[T][2], sc[T][3])));
    mx = fmaxf(mx, __shfl_xor(mx, 16)); mx = fmaxf(mx, __shfl_xor(mx, 32));
    float sum = 0.f;
#pragma unroll
    for (int T = 0; T < 16; ++T) {
#pragma unroll
        for (int e = 0; e < 4; ++e) { sc[T][e] = __expf(sc[T][e] - mx); sum += sc[T][e]; } }
    sum += __shfl_xor(sum, 16); sum += __shfl_xor(sum, 32);
    const float rs = 1.f / sum;
    bf16x8 pb[8];
#pragma unroll
    for (int s2 = 0; s2 < 8; ++s2) {
        u32x4 w; w.x = pk2(sc[2 * s2][0], sc[2 * s2][1]); w.y = pk2(sc[2 * s2][2], sc[2 * s2][3]); w.z = pk2(sc[2 * s2 + 1][0], sc[2 * s2 + 1][1]); w.w = pk2(sc[2 * s2 + 1][2], sc[2 * s2 + 1][3]);
        pb[s2] = __builtin_bit_cast(bf16x8, w);
    }
#pragma unroll
    for (int i = 0; i < 16; ++i) { const int id = tid + 512 * i, r = id >> 5, c = id & 31; *(LAS u32x4*)(lds + r * 512 + ((c ^ (r & 15)) * 16)) = st[i]; }
    __syncthreads();
    bf16_t* aog_row = (bf16_t*)(p.ws + WS_ACT3) + (size_t)2 * 9216 * 1024 + tl(qrow, h * 256 + quad * 4, 1024);
    f32x4 oacc[16];
#pragma unroll
    for (int Tv = 0; Tv < 16; ++Tv) {
        oacc[Tv] = (f32x4){0.f, 0.f, 0.f, 0.f};
        const LAS unsigned char* vr = lds + (Tv * 16 + l15) * 512 + (quad & 1) * 8;
#pragma unroll
        for (int s2 = 0; s2 < 8; ++s2) {
            const int ch = 4 * s2 + (quad >> 1);
            const u32x2 lo = *(const LAS u32x2*)(vr + ((ch ^ l15) * 16)), hi = *(const LAS u32x2*)(vr + (((ch + 2) ^ l15) * 16));
            u32x4 w; w.x = lo.x; w.y = lo.y; w.z = hi.x; w.w = hi.y;
            oacc[Tv] = __builtin_amdgcn_mfma_f32_16x16x32_bf16(__builtin_bit_cast(bf16x8, w), pb[s2], oacc[Tv], 0, 0, 0);
        }
    }
#pragma unroll
    for (int Tv = 0; Tv < 16; ++Tv) {
        const int dv = Tv * 16 + quad * 4;
        const u32x2 sg = *(const u32x2*)(proj + qrow * LDP + C_AS + h * 256 + dv);
        u32x2 o; o.x = pk2(oacc[Tv][0] * rs * bflo(sg.x), oacc[Tv][1] * rs * bfhi(sg.x)); o.y = pk2(oacc[Tv][2] * rs * bflo(sg.y), oacc[Tv][3] * rs * bfhi(sg.y));
        *(u32x2*)(aog_row + (Tv >> 2) * 16384 + (Tv & 3) * 16) = o;
    }
    __syncthreads();
}

__device__ __forceinline__ void attn_sample_item(const Params& p, int item, LAS unsigned char* lds, int tid) {
    LAS float* Ssh = (LAS float*)lds;
    LAS float* Psh = Ssh + 2048;
    LAS float* Opart = Psh + 2048;
    const int lane = tid & 63, wave = tid >> 6, l15 = lane & 15, quad = lane >> 4;
    const int n = item >> 2, h = item & 3;
    const bf16_t* proj = (const bf16_t*)(p.ws + WS_PROJ9);
    const size_t row0 = (size_t)NTP + (size_t)n * 8;
    const float* kc = p.cache_k + ((size_t)n * 256 * 4 + h) * 256;
    const float* vc = p.cache_v + ((size_t)n * 256 * 4 + h) * 256;
    {
        bf16x8 qf[8];
        const size_t qrow = row0 + (lane & 7);
#pragma unroll
        for (int s = 0; s < 8; ++s) qf[s] = *(const bf16x8*)(proj + qrow * LDP + C_AQ + h * 256 + s * 32 + quad * 8);
#pragma unroll
        for (int tl = 0; tl < 2; ++tl) {
            const int T = wave * 2 + tl;
            f32x4 sc = (f32x4){0.f, 0.f, 0.f, 0.f};
            const float* kr = kc + (size_t)(T * 16 + l15) * 1024 + quad * 8;
#pragma unroll
            for (int s = 0; s < 8; ++s) {
                const f32x4 k0 = *(const f32x4*)(kr + s * 32), k1 = *(const f32x4*)(kr + s * 32 + 4);
                u32x4 w; w.x = pk2(k0[0], k0[1]); w.y = pk2(k0[2], k0[3]); w.z = pk2(k1[0], k1[1]); w.w = pk2(k1[2], k1[3]);
                sc = __builtin_amdgcn_mfma_f32_16x16x32_bf16(__builtin_bit_cast(bf16x8, w), qf[s], sc, 0, 0, 0);
            }
            if (l15 < 8) {
#pragma unroll
                for (int e = 0; e < 4; ++e) Ssh[l15 * 256 + T * 16 + quad * 4 + e] = sc[e];
            }
        }
    }
    __syncthreads();
    {
        const f32x4 s4 = *(const LAS f32x4*)(Ssh + wave * 256 + lane * 4);
        const float mx = wave_max(fmaxf(fmaxf(s4[0], s4[1]), fmaxf(s4[2], s4[3])));
        f32x4 e4; e4[0] = __expf(s4[0] - mx); e4[1] = __expf(s4[1] - mx); e4[2] = __expf(s4[2] - mx); e4[3] = __expf(s4[3] - mx);
        const float rs = 1.f / wave_sum((e4[0] + e4[1]) + (e4[2] + e4[3]));
#pragma unroll
        for (int e = 0; e < 4; ++e) Psh[(lane * 4 + e) * 8 + wave] = e4[e] * rs;
    }
    __syncthreads();
    {
        f32x4 acc[8];
#pragma unroll
        for (int q = 0; q < 8; ++q) acc[q] = (f32x4){0.f, 0.f, 0.f, 0.f};
        const float* vr = vc + (size_t)(wave * 32) * 1024 + lane * 4;
#pragma unroll 8
        for (int kk = 0; kk < 32; ++kk) {
            const f32x4 v4 = *(const f32x4*)(vr + (size_t)kk * 1024);
            const f32x4 pa = *(const LAS f32x4*)(Psh + (wave * 32 + kk) * 8), pb = *(const LAS f32x4*)(Psh + (wave * 32 + kk) * 8 + 4);
            acc[0] += v4 * pa[0]; acc[1] += v4 * pa[1]; acc[2] += v4 * pa[2]; acc[3] += v4 * pa[3];
            acc[4] += v4 * pb[0]; acc[5] += v4 * pb[1]; acc[6] += v4 * pb[2]; acc[7] += v4 * pb[3];
        }
#pragma unroll
        for (int q = 0; q < 8; ++q) *(LAS f32x4*)(Opart + (wave * 8 + q) * 256 + lane * 4) = acc[q];
    }
    __syncthreads();
    {
        f32x4 o = (f32x4){0.f, 0.f, 0.f, 0.f};
#pragma unroll
        for (int w = 0; w < 8; ++w) o += *(const LAS f32x4*)(Opart + (w * 8 + wave) * 256 + lane * 4);
        const size_t r = row0 + wave;
        const u32x2 sg = *(const u32x2*)(proj + r * LDP + C_AS + h * 256 + lane * 4);
        u32x2 ov; ov.x = pk2(o[0] * bflo(sg.x), o[1] * bfhi(sg.x)); ov.y = pk2(o[2] * bflo(sg.y), o[3] * bfhi(sg.y));
        bf16_t* aog = (bf16_t*)(p.ws + WS_ACT3) + (size_t)2 * 9216 * 1024;
        *(u32x2*)(aog + tl(r, h * 256 + lane * 4, 1024)) = ov;
    }
    __syncthreads();
}

__device__ __forceinline__ void p2_mixers(const Params& p, LAS unsigned char* lds) {
    const int tid = threadIdx.x, G = gridDim.x, c = blockIdx.x, mask = p.pad;
    if (mask & 1) for (int it = c; it < 256; it += G) hgrn_prompt_item(p, it, lds, tid);
    if (mask & 2) { for (int it = c; it < 256; it += G) conv_item<false>(p, it, lds, tid);
                    for (int it = c; it < 128; it += G) conv_item<true>(p, it, lds, tid); }
    if (mask & 4) for (int it = c; it < 256; it += G) attn_prompt_item(p, it, lds, tid);
    if (mask & 8) for (int it = c; it < 512; it += G) attn_sample_item(p, it, lds, tid);
    if (mask & 16) for (int it = c; it < 1024; it += G) hgrn_sample_item(p, it, lds, tid);
}

__device__ __forceinline__ void p6_final_norm(const Params& p) {
    const int tid = threadIdx.x, lane = tid & 63, gw = blockIdx.x * 8 + (tid >> 6), NGW = gridDim.x * 8;
    for (int r = gw; r < NTOK; r += NGW) {
        float* zr = p.out + (size_t)r * 2048;
        f32x4 v[8]; float ss = 0.f;
#pragma unroll
        for (int j = 0; j < 8; ++j) { v[j] = ((const f32x4*)zr)[lane + 64 * j]; ss += (v[j][0] * v[j][0] + v[j][1] * v[j][1]) + (v[j][2] * v[j][2] + v[j][3] * v[j][3]); }
        ss = wave_sum(ss);
        const float rinv = rsqrtf(ss * (1.f / 2048.f) + EPS);
#pragma unroll
        for (int j = 0; j < 8; ++j) { const f32x4 gg = ((const f32x4*)p.g_final)[lane + 64 * j]; ((f32x4*)zr)[lane + 64 * j] = v[j] * rinv * gg; }
    }
}

__global__ void __launch_bounds__(512, 2) fwd_megakernel(Params p) {
    extern __shared__ __attribute__((aligned(16))) unsigned char shm[];
    LAS unsigned char* lds = (LAS unsigned char*)shm;
    cg::grid_group grid = cg::this_grid();
    const int G = gridDim.x, c = blockIdx.x;
#define SEAM(ph) do { if (p.coop && (ph) + 1 < p.ph_hi) { \
        asm volatile("s_waitcnt vmcnt(0) lgkmcnt(0)" ::: "memory"); __syncthreads(); \
        grid.sync(); \
        if (threadIdx.x < 64) { __builtin_amdgcn_fence(__ATOMIC_ACQUIRE, "agent"); asm volatile("s_waitcnt vmcnt(0)" ::: "memory"); } \
        __syncthreads(); } } while (0)
#define RUNS(ph) (p.ph_lo <= (ph) && (ph) < p.ph_hi)
    if (RUNS(0)) { p0_prologue(p, lds); SEAM(0); }
    if (RUNS(1)) {
        SchedP1 S; S.G = G; S.c = c; S.A = (const char*)(p.ws + WS_HA); S.Bt = (const char*)(p.ws + WS_WT1);
        EpiP1 E; E.proj = (bf16_t*)(p.ws + WS_PROJ9); E.gate = (bf16_t*)(p.ws + WS_GATE); E.F = (float*)(p.ws + WS_F); E.lb = (const float*)(p.ws + WS_LB);
        E.b_gate = p.b_gate; E.out = p.out; E.mkb = (bf16_t*)(p.ws + WS_MKB); E.mvt = (bf16_t*)(p.ws + WS_MVT);
        pg8::gemm_phase(lds, 2048, S, E); SEAM(1);
    }
    if (RUNS(2)) { p2_mixers(p, lds); SEAM(2); }
    if (RUNS(3)) { hgrn_norm_rows(p); SEAM(3); }
    if (RUNS(4)) {
        SchedP4 S; S.G = G; S.c = c; S.A = (const char*)(p.ws + WS_ACT3); S.Bt = (const char*)(p.ws + WS_WT3);
        EpiP4 E; E.gate = (const bf16_t*)(p.ws + WS_GATE); E.merged = (bf16_t*)(p.ws + WS_MERGED);
        pg8::gemm_phase(lds, 1024, S, E); SEAM(4);
    }
    if (RUNS(5)) {
        SchedP5 S; S.G = G; S.c = c; S.A = (const char*)(p.ws + WS_MERGED); S.Bt = (const char*)(p.ws + WS_WTO);
        EpiP5 E; E.xp = p.x_prompt; E.xs = p.x_sample; E.out = p.out;
        pg8::gemm_phase(lds, 2048, S, E); SEAM(5);
    }
    if (RUNS(6)) { p6_final_norm(p); }
#undef RUNS
#undef SEAM
}

extern "C" void kernel_launch(void* const* d_in, const int* in_sizes, int n_in, void* d_out, int out_size, void* d_ws, size_t ws_size, hipStream_t stream) {
    static int grid = 0;
    if (grid == 0) {
        if (n_in != 23 || ws_size < WS_END) { fprintf(stderr, "kernel_launch: expected 23 inputs and >= %zu bytes of workspace, got %d / %zu\n", (size_t)WS_END, n_in, ws_size); grid = -1; return; }
        int dev = 0, cus = 0, per_cu = 0;
        hipGetDevice(&dev); hipDeviceGetAttribute(&cus, hipDeviceAttributeMultiprocessorCount, dev);
        if (hipFuncSetAttribute((const void*)fwd_megakernel, hipFuncAttributeMaxDynamicSharedMemorySize, LDS_BYTES) != hipSuccess) { fprintf(stderr, "kernel_launch: hipFuncSetAttribute failed\n"); grid = -1; return; }
        if (hipOccupancyMaxActiveBlocksPerMultiprocessor(&per_cu, (const void*)fwd_megakernel, 512, LDS_BYTES) != hipSuccess || per_cu < 1) { fprintf(stderr, "kernel_launch: occupancy query failed (%d)\n", per_cu); (void)hipGetLastError(); per_cu = 1; }
        grid = cus * 1;
        if (grid <= 0) grid = 256;
    }
    if (grid < 0) return;
    Params p{};
    const float** pp = (const float**)&p;
    for (int i = 0; i < 23; ++i) pp[i] = (const float*)d_in[i];
    p.out = (float*)d_out; p.ws = (unsigned char*)d_ws; p.pad = 31;
#if N_LAUNCH_MODE == 1
    p.ph_lo = 0; p.ph_hi = N_PHASES; p.coop = 1;
    void* args[] = {&p};
    hipError_t e = hipLaunchCooperativeKernel((const void*)fwd_megakernel, dim3(grid), dim3(512), args, LDS_BYTES, stream);
    if (e != hipSuccess) fprintf(stderr, "cooperative launch failed: %s (grid %d)\n", hipGetErrorString(e), grid);
#else
    for (int ph = 0; ph < N_PHASES; ++ph) {
        p.ph_lo = ph; p.ph_hi = ph + 1; p.coop = 0;
        hipLaunchKernelGGL(fwd_megakernel, dim3(grid), dim3(512), LDS_BYTES, stream, p);
        if ((REP_MASK >> ph) & 1) { if (ph == 2) p.pad = P2_SUBMASK; hipLaunchKernelGGL(fwd_megakernel, dim3(grid), dim3(512), LDS_BYTES, stream, p); p.pad = 31; }
    }
#endif
}
```

```cpp
#include <hip/hip_runtime.h>
#include <hip/hip_cooperative_groups.h>
#include <cstdio>
namespace cg = cooperative_groups;

#define LAS __attribute__((address_space(3)))
typedef unsigned short bf16_t;
typedef short bf16x8 __attribute__((ext_vector_type(8)));
typedef float f32x4 __attribute__((ext_vector_type(4)));
typedef float f32x2 __attribute__((ext_vector_type(2)));
typedef unsigned u32x4 __attribute__((ext_vector_type(4)));
typedef unsigned u32x2 __attribute__((ext_vector_type(2)));

#ifndef REP_MASK
#define REP_MASK 0
#endif
#ifndef P2_SUBMASK
#define P2_SUBMASK 31
#endif
#ifndef N_LAUNCH_MODE
#define N_LAUNCH_MODE 1
#endif

constexpr int DM = 2048, NTP = 8192, NTS = 1024, NTOK = 9216, SEQ = 2048;
constexpr int LDP = 9216;
constexpr int C_CV = 0, C_CG = 1024, C_CS = 2048, C_HQ = 3072, C_HF = 4096, C_HI = 5120, C_HOG = 6144, C_AQ = 7168, C_AS = 8192;
constexpr int LDG = 6144;
constexpr float EPS = 1e-6f;
constexpr size_t O_YP = 0, O_YS = 16777216, O_CONV_P = 18874368, O_HGRN_P = 18997248, O_MK = 19521536, O_MV = 20570112, O_CONV_S = 21618688, O_HGRN_S = 25550848;
constexpr size_t WS_WT1 = 0;
constexpr size_t WS_WT3 = WS_WT1 + (size_t)17408 * 2048 * 2;
constexpr size_t WS_WTO = WS_WT3 + (size_t)3 * 2048 * 1024 * 2;
constexpr size_t WS_HA = WS_WTO + (size_t)2048 * 2048 * 2;
constexpr size_t WS_ORAW = WS_HA;
constexpr size_t WS_PROJ9 = WS_HA + (size_t)10240 * 2048 * 2;
constexpr size_t WS_MF = WS_PROJ9;
constexpr size_t WS_MERGED = WS_MF + (size_t)9216 * 2048 * 4;
constexpr size_t WS_GATE = WS_PROJ9 + (size_t)9216 * 9216 * 2;
constexpr size_t WS_F = WS_GATE + (size_t)9216 * 6144 * 2;
constexpr size_t WS_MKB = WS_F + (size_t)9216 * 1024 * 4;
constexpr size_t WS_MVT = WS_MKB + (size_t)2097152;
constexpr size_t WS_ACT3 = WS_MVT + (size_t)2097152;
constexpr size_t WS_LB = WS_ACT3 + (size_t)3 * 9216 * 1024 * 2;
constexpr size_t WS_BAR = WS_LB + 4096;
constexpr size_t WS_BAR_BYTES = 16384;
constexpr size_t WS_END = WS_BAR + WS_BAR_BYTES;
constexpr int LDS_PHASE_BYTES = 131072, LDS_BYTES = LDS_PHASE_BYTES + 64;
constexpr int N_PHASES = 7;

struct Params {
    const float *x_prompt, *x_sample, *state_conv, *state_hgrn, *cache_k, *cache_v, *mem_prompt, *g_pre, *w_in, *conv_w, *conv_b, *ln_g, *ln_b,
        *w_conv_out, *lb_logits, *g_hgrn, *w_hgrn_out, *g_mem, *w_mem_kv, *w_attn_out, *b_gate, *w_out, *g_final;
    float* out; unsigned char* ws; int ph_lo, ph_hi, coop, pad;
};

__device__ __forceinline__ unsigned f2bf(float f) { unsigned u = __builtin_bit_cast(unsigned, f); return (u + 0x7fffu + ((u >> 16) & 1u)) >> 16; }
typedef __bf16 bf16x2_t __attribute__((ext_vector_type(2)));
__device__ __forceinline__ unsigned pk2(float lo, float hi) { const f32x2 v = {lo, hi}; const bf16x2_t r = __builtin_convertvector(v, bf16x2_t); return __builtin_bit_cast(unsigned, r); }
__device__ __forceinline__ float bflo(unsigned w) { return __builtin_bit_cast(float, w << 16); }
__device__ __forceinline__ float bfhi(unsigned w) { return __builtin_bit_cast(float, w & 0xffff0000u); }
__device__ __forceinline__ float bf2f(unsigned short b) { return __builtin_bit_cast(float, ((unsigned)b) << 16); }
__device__ __forceinline__ float sigm(float x) { return __builtin_amdgcn_rcpf(1.f + __expf(-x)); }
__device__ __forceinline__ float siluf(float x) { return x * sigm(x); }
__device__ __forceinline__ size_t tl(size_t row, int col, int K) { return (row >> 8) * ((size_t)256 * K) + (size_t)(col >> 6) * (256 * 64) + (row & 255) * 64 + (col & 63); }
__device__ __forceinline__ float wave_sum(float v) {
#pragma unroll
    for (int o = 1; o < 64; o <<= 1) v += __shfl_xor(v, o);
    return v;
}
__device__ __forceinline__ float wave_max(float v) {
#pragma unroll
    for (int o = 1; o < 64; o <<= 1) v = fmaxf(v, __shfl_xor(v, o));
    return v;
}

namespace pg8 {
constexpr int BM = 256, BK = 64, HALF = 128, HTB = HALF * BK * 2, STAGE_BYTES = 8 * HTB, NXCD = 8, WGM = 8;
__host__ __device__ __forceinline__ int lds_byte(int r, int c) { const int st = (r >> 4) * 2 + (c >> 5), rr = r & 15, cc = c & 31, ob = rr * 64 + cc * 2; return st * 1024 + (ob ^ (((ob >> 9) & 1) << 5)); }
__host__ __device__ __forceinline__ void stage_rc(int b, int& R, int& C) { const int st = b / 1024, sb = b % 1024, swz = sb ^ (((sb >> 9) & 1) << 5); R = (st >> 1) * 16 + swz / 64; C = (st & 1) * 32 + (swz % 64) / 2; }
__host__ __device__ __forceinline__ int perm32(int rho) { const int n = rho >> 4, i = rho & 15; return 8 * (i >> 2) + 4 * n + (i & 3); }
struct Unit { int pm, pn, br; };
__device__ __forceinline__ void tile_of(int wgid, int nM, int nN, int& pm, int& pn) {
    const int nwg = nM * nN;
    { const int q = nwg / NXCD, r = nwg % NXCD, xcd = wgid % NXCD, off = wgid / NXCD; wgid = (xcd < r ? xcd * (q + 1) : r * (q + 1) + (xcd - r) * q) + off; }
    const int nig = WGM * nN, gid = wgid / nig, fm = gid * WGM, gsz = (nM - fm) < WGM ? (nM - fm) : WGM;
    pm = fm + ((wgid % nig) % gsz); pn = (wgid % nig) / gsz;
}

template <class Epi, class Sched>
__device__ __forceinline__ void gemm_phase(LAS unsigned char* lds, const int K, const Sched& S, const Epi& E) {
    const int tid = threadIdx.x, wid = __builtin_amdgcn_readfirstlane(tid >> 6), lane = tid & 63, wr = wid >> 2, wc = wid & 3, fr = lane & 15, fq = lane >> 4;
    const int nt = K / BK;
    unsigned voffA[2], voffB[2];
#pragma unroll
    for (int i = 0; i < 2; ++i) { int R, C; stage_rc(tid * 16 + i * 8192, R, C); const int Rb = (R & ~31) + perm32(R & 31);
        voffA[i] = (unsigned)(R * BK + C) * 2u; voffB[i] = (unsigned)(Rb * BK + C) * 2u; }
    const size_t kstep = (size_t)(BM * BK * 2);
    const size_t hstep = (size_t)HALF * BK * 2;
    const unsigned ldsw = (unsigned)wid * 1024u;
    const int aoff = lds_byte(wr * 64 + fr, fq * 8), boff = lds_byte(wc * 32 + fr, fq * 8);
#define PG8_SA(b, h) (((b) * 2 + (h)) * HTB)
#define PG8_SB(b, h) ((4 + (b) * 2 + (h)) * HTB)
#define PG8_STAGE(bufoff, gbase, voff) do { _Pragma("unroll") for (int _i = 0; _i < 2; ++_i) \
        __builtin_amdgcn_global_load_lds((const unsigned*)((const char*)(gbase) + (voff)[_i]), (LAS unsigned*)(lds + (bufoff) + ldsw + _i * 8192), 16, 0, 0); } while (0)
#define PG8_LDA(dst, b, h) do { _Pragma("unroll") for (int m = 0; m < 4; ++m) _Pragma("unroll") for (int k = 0; k < 2; ++k) dst[m][k] = *(const LAS bf16x8*)(lds + PG8_SA(b, h) + aoff + m * 2048 + k * 1024); } while (0)
#define PG8_LDB(dst, b, h) do { _Pragma("unroll") for (int n = 0; n < 2; ++n) _Pragma("unroll") for (int k = 0; k < 2; ++k) dst[n][k] = *(const LAS bf16x8*)(lds + PG8_SB(b, h) + boff + n * 2048 + k * 1024); } while (0)
#define PG8_MMA(ai, bj, At, Bt) do { __builtin_amdgcn_s_setprio(1); _Pragma("unroll") for (int m = 0; m < 4; ++m) _Pragma("unroll") for (int n = 0; n < 2; ++n) _Pragma("unroll") for (int k = 0; k < 2; ++k) \
        acc[ai][bj][m][n] = __builtin_amdgcn_mfma_f32_16x16x32_bf16(Bt[n][k], At[m][k], acc[ai][bj][m][n], 0, 0, 0); __builtin_amdgcn_s_setprio(0); } while (0)
#define PG8_WAIT_V(n) asm volatile("s_waitcnt vmcnt(" #n ")" ::: "memory")
#define PG8_WAIT_L(n) asm volatile("s_waitcnt lgkmcnt(" #n ")" ::: "memory")
#define PG8_BAR __builtin_amdgcn_s_barrier()
#define PG8_SCHED __builtin_amdgcn_sched_barrier(0)
    Unit cur, nxt; int ui = 0;
    if (!S.next(0, cur)) return;
    f32x4 acc[2][2][4][2];
#pragma unroll
    for (int a = 0; a < 2; ++a)
#pragma unroll
        for (int b = 0; b < 2; ++b)
#pragma unroll
            for (int m = 0; m < 4; ++m)
#pragma unroll
                for (int n = 0; n < 2; ++n) acc[a][b][m][n] = (f32x4){0.f, 0.f, 0.f, 0.f};
    bf16x8 At[4][2], B0[2][2], B1[2][2];
    const char* cA = S.a_base(cur); const char* cB = S.b_base(cur);
    PG8_STAGE(PG8_SB(0, 0), cB, voffB); PG8_STAGE(PG8_SA(0, 0), cA, voffA); PG8_STAGE(PG8_SB(0, 1), cB + hstep, voffB); PG8_STAGE(PG8_SA(0, 1), cA + hstep, voffA);
    if (wr == 1) PG8_BAR;
    PG8_WAIT_V(4); PG8_BAR;
    PG8_STAGE(PG8_SB(1, 0), cB + kstep, voffB); PG8_STAGE(PG8_SA(1, 0), cA + kstep, voffA); PG8_STAGE(PG8_SB(1, 1), cB + hstep + kstep, voffB);
    PG8_WAIT_V(6); PG8_BAR;
    for (;;) {
        const bool has_next = S.next(ui + 1, nxt);
        const char* nA = has_next ? S.a_base(nxt) : cA; const char* nB = has_next ? S.b_base(nxt) : cB;
        for (int t = 0; t < nt; t += 2) {
            const bool last = (t == nt - 2);
            const char* a1 = cA + (size_t)(t + 1) * kstep;
            const char* a2 = last ? nA : cA + (size_t)(t + 2) * kstep; const char* b2 = last ? nB : cB + (size_t)(t + 2) * kstep;
            const char* a3 = a2 + kstep; const char* b3 = b2 + kstep;
            PG8_LDB(B0, 0, 0); PG8_SCHED; PG8_LDA(At, 0, 0); PG8_STAGE(PG8_SA(1, 1), a1 + hstep, voffA);
            PG8_WAIT_L(8); PG8_BAR; PG8_WAIT_L(0); PG8_MMA(0, 0, At, B0); PG8_BAR; PG8_SCHED;
            PG8_LDB(B1, 0, 1); PG8_STAGE(PG8_SB(0, 0), b2, voffB);
            PG8_BAR; PG8_WAIT_L(0); PG8_MMA(0, 1, At, B1); PG8_BAR;
            PG8_LDA(At, 0, 1); PG8_STAGE(PG8_SA(0, 0), a2, voffA);
            PG8_BAR; PG8_WAIT_L(0); PG8_MMA(1, 0, At, B0); PG8_BAR; PG8_SCHED;
            PG8_STAGE(PG8_SB(0, 1), b2 + hstep, voffB);
            PG8_WAIT_V(6); PG8_BAR; PG8_MMA(1, 1, At, B1); PG8_BAR;
            PG8_LDB(B0, 1, 0); PG8_SCHED; PG8_LDA(At, 1, 0); PG8_STAGE(PG8_SA(0, 1), a2 + hstep, voffA);
            PG8_WAIT_L(8); PG8_BAR; PG8_WAIT_L(0); PG8_MMA(0, 0, At, B0); PG8_BAR; PG8_SCHED;
            PG8_LDB(B1, 1, 1); PG8_STAGE(PG8_SB(1, 0), b3, voffB);
            PG8_BAR; PG8_WAIT_L(0); PG8_MMA(0, 1, At, B1); PG8_BAR;
            PG8_LDA(At, 1, 1); PG8_STAGE(PG8_SA(1, 0), a3, voffA);
            PG8_BAR; PG8_WAIT_L(0); PG8_MMA(1, 0, At, B0); PG8_BAR; PG8_SCHED;
            PG8_STAGE(PG8_SB(1, 1), b3 + hstep, voffB);
            PG8_WAIT_V(6); PG8_BAR; PG8_MMA(1, 1, At, B1); PG8_BAR;
        }
        const bool keep = E(acc, cur, wr, wc, fr, fq);
        if (!has_next) break;
        if (!keep)
#pragma unroll
        for (int a = 0; a < 2; ++a)
#pragma unroll
            for (int b = 0; b < 2; ++b)
#pragma unroll
                for (int m = 0; m < 4; ++m)
#pragma unroll
                    for (int n = 0; n < 2; ++n) acc[a][b][m][n] = (f32x4){0.f, 0.f, 0.f, 0.f};
        cur = nxt; cA = nA; cB = nB; ++ui;
    }
    PG8_WAIT_V(0);
    if (wr == 0) PG8_BAR;
    PG8_BAR;
#undef PG8_SA
#undef PG8_SB
#undef PG8_STAGE
#undef PG8_LDA
#undef PG8_LDB
#undef PG8_MMA
#undef PG8_WAIT_V
#undef PG8_WAIT_L
#undef PG8_BAR
#undef PG8_SCHED
}
}
using pg8::Unit;

struct SchedP1 {
    int G, c; const char* A; const char* Bt;
    __device__ __forceinline__ bool next(int i, Unit& u) const {
        const int L = i * G + c; if (L >= 2192) return false;
        u.br = 0;
        if (L >= 2160) { const int idx = L - 2160; u.pm = 36 + (idx >> 3); u.pn = 60 + (idx & 7); return true; }
        pg8::tile_of(L, 36, 60, u.pm, u.pn); return true;
    }
    __device__ __forceinline__ const char* a_base(const Unit& u) const { return A + (size_t)u.pm * (256 * 2048 * 2); }
    __device__ __forceinline__ const char* b_base(const Unit& u) const { return Bt + (size_t)u.pn * (256 * 2048 * 2); }
};
struct EpiP1 {
    bf16_t* proj; bf16_t* gate; float* F; const float* lb; const float* b_gate; float* out; bf16_t* mkb; bf16_t* mvt;
    __device__ __forceinline__ bool operator()(f32x4 (&acc)[2][2][4][2], const Unit& u, int wr, int wc, int fr, int fq) const {
        const int rloc = wr * 64 + fr, cloc = wc * 32 + 8 * fq;
        if (u.pn < 36) {
            const int seg = u.pn >> 2;
#pragma unroll
            for (int bj = 0; bj < 2; ++bj) {
                const int col = u.pn * 256 + bj * 128 + cloc;
                f32x4 l0 = (f32x4){0.f, 0.f, 0.f, 0.f}, l1 = l0;
                if (seg == 4) { l0 = *(const f32x4*)(lb + (col - C_HF)); l1 = *(const f32x4*)(lb + (col - C_HF) + 4); }
#pragma unroll
                for (int ai = 0; ai < 2; ++ai)
#pragma unroll
                    for (int m = 0; m < 4; ++m) {
                        const size_t row = (size_t)u.pm * 256 + ai * 128 + m * 16 + rloc;
                        f32x4 v0 = acc[ai][bj][m][0], v1 = acc[ai][bj][m][1];
                        if (seg == 4) {
#pragma unroll
                            for (int e = 0; e < 4; ++e) { v0[e] = l0[e] + (1.f - l0[e]) * sigm(v0[e]); v1[e] = l1[e] + (1.f - l1[e]) * sigm(v1[e]); }
                            float* fp = F + row * 1024 + (col - C_HF);
                            *(f32x4*)fp = v0; *(f32x4*)(fp + 4) = v1;
                        } else {
                            if (seg == 1) {
#pragma unroll
                                for (int e = 0; e < 4; ++e) { v0[e] = sigm(v0[e]); v1[e] = sigm(v1[e]); }
                            } else if (seg == 2 || seg == 6 || seg == 8) {
#pragma unroll
                                for (int e = 0; e < 4; ++e) { v0[e] = siluf(v0[e]); v1[e] = siluf(v1[e]); }
                            } else if (seg == 3) { v0 *= 0.08838834764831845f; v1 *= 0.08838834764831845f; }
                            else if (seg == 7) { v0 *= 0.0625f; v1 *= 0.0625f; }
                            u32x4 o; o.x = pk2(v0[0], v0[1]); o.y = pk2(v0[2], v0[3]); o.z = pk2(v1[0], v1[1]); o.w = pk2(v1[2], v1[3]);
                            *(u32x4*)(proj + row * LDP + col) = o;
                        }
                    }
            }
        } else if (u.pn < 60) {
            const int etid = (wr * 4 + wc) * 64 + fq * 16 + fr;
#pragma unroll
            for (int bj = 0; bj < 2; ++bj) {
                const int col = (u.pn - 36) * 256 + bj * 128 + cloc;
                const f32x4 b0 = *(const f32x4*)(b_gate + col), b1 = *(const f32x4*)(b_gate + col + 4);
#pragma unroll
                for (int ai = 0; ai < 2; ++ai)
#pragma unroll
                    for (int m = 0; m < 4; ++m) {
                        const size_t row = (size_t)u.pm * 256 + ai * 128 + m * 16 + rloc;
                        f32x4 v0 = acc[ai][bj][m][0] + b0, v1 = acc[ai][bj][m][1] + b1;
#pragma unroll
                        for (int e = 0; e < 4; ++e) { v0[e] = fmaxf(sigm(v0[e]), 1e-6f); v1[e] = fmaxf(sigm(v1[e]), 1e-6f); }
                        u32x4 o; o.x = pk2(v0[0], v0[1]); o.y = pk2(v0[2], v0[3]); o.z = pk2(v1[0], v1[1]); o.w = pk2(v1[2], v1[3]);
                        *(u32x4*)(gate + ((((size_t)u.pm * 24 + (u.pn - 36)) * 16 + (ai * 8 + m * 2 + bj)) * 512 + etid) * 8) = o;
                    }
            }
        } else {
            const int n = u.pm - 36, isv = (u.pn >= 64) ? 1 : 0, h = (u.pn - 60) & 3;
            float* ob = out + (isv ? O_MV : O_MK);
#pragma unroll
            for (int bj = 0; bj < 2; ++bj) {
                const int d = bj * 128 + cloc;
#pragma unroll
                for (int ai = 0; ai < 2; ++ai)
#pragma unroll
                    for (int m = 0; m < 4; ++m) {
                        const int key = ai * 128 + m * 16 + rloc;
                        const f32x4 v0 = acc[ai][bj][m][0], v1 = acc[ai][bj][m][1];
                        float* op = ob + ((size_t)(n * 256 + key) * 4 + h) * 256 + d;
                        *(f32x4*)op = v0; *(f32x4*)(op + 4) = v1;
                        if (!isv) {
                            u32x4 o; o.x = pk2(v0[0], v0[1]); o.y = pk2(v0[2], v0[3]); o.z = pk2(v1[0], v1[1]); o.w = pk2(v1[2], v1[3]);
                            *(u32x4*)(mkb + ((size_t)(n * 4 + h) * 256 + key) * 256 + d) = o;
                        } else {
                            bf16_t* vp = mvt + ((size_t)(n * 4 + h) * 256 + d) * 256 + key;
#pragma unroll
                            for (int e = 0; e < 4; ++e) { vp[(size_t)e * 256] = (bf16_t)f2bf(v0[e]); vp[(size_t)(e + 4) * 256] = (bf16_t)f2bf(v1[e]); }
                        }
                    }
            }
        }
        return false;
    }
};

struct SchedP4 {
    int G, c; const char* A; const char* Bt;
    __device__ __forceinline__ bool next(int i, Unit& u) const {
        const int tri = i / 3, L = tri * G + c; if (L >= 288) return false;
        u.br = i - tri * 3; pg8::tile_of(L, 36, 8, u.pm, u.pn); return true;
    }
    __device__ __forceinline__ const char* a_base(const Unit& u) const { return A + (size_t)u.br * ((size_t)9216 * 1024 * 2) + (size_t)u.pm * (256 * 1024 * 2); }
    __device__ __forceinline__ const char* b_base(const Unit& u) const { return Bt + (size_t)u.br * ((size_t)2048 * 1024 * 2) + (size_t)u.pn * (256 * 1024 * 2); }
};
struct EpiP4 {
    const bf16_t* gate; bf16_t* merged;
    __device__ __forceinline__ bool operator()(f32x4 (&acc)[2][2][4][2], const Unit& u, int wr, int wc, int fr, int fq) const {
        const int rloc = wr * 64 + fr, cloc = wc * 32 + 8 * fq;
        const int etid = (wr * 4 + wc) * 64 + fq * 16 + fr;
        bf16_t* mbase = merged + tl((size_t)u.pm * 256 + rloc, u.pn * 256 + cloc, 2048);
#pragma unroll
        for (int bj = 0; bj < 2; ++bj) {
            const int col = u.pn * 256 + bj * 128 + cloc;
#pragma unroll
            for (int ai = 0; ai < 2; ++ai)
#pragma unroll
                for (int m = 0; m < 4; ++m) {
                    const size_t row = (size_t)u.pm * 256 + ai * 128 + m * 16 + rloc;
                    const bf16_t* gp = gate + ((((size_t)u.pm * 24 + (u.br * 8 + u.pn)) * 16 + (ai * 8 + m * 2 + bj)) * 512 + etid) * 8;
                    const u32x4 g = *(const u32x4*)gp;
                    f32x4 s0 = (f32x4){bflo(g.x), bfhi(g.x), bflo(g.y), bfhi(g.y)}, s1 = (f32x4){bflo(g.z), bfhi(g.z), bflo(g.w), bfhi(g.w)};
                    if (u.br < 2) {
                        const u32x4 h = *(const u32x4*)(gp + (size_t)8 * 16 * 512 * 8);
                        s0[0] *= __builtin_amdgcn_rcpf(bflo(h.x)); s0[1] *= __builtin_amdgcn_rcpf(bfhi(h.x)); s0[2] *= __builtin_amdgcn_rcpf(bflo(h.y)); s0[3] *= __builtin_amdgcn_rcpf(bfhi(h.y));
                        s1[0] *= __builtin_amdgcn_rcpf(bflo(h.z)); s1[1] *= __builtin_amdgcn_rcpf(bfhi(h.z)); s1[2] *= __builtin_amdgcn_rcpf(bflo(h.w)); s1[3] *= __builtin_amdgcn_rcpf(bfhi(h.w));
                    }
                    acc[ai][bj][m][0] *= s0; acc[ai][bj][m][1] *= s1;
                    if (u.br == 2) { const f32x4 v0 = acc[ai][bj][m][0], v1 = acc[ai][bj][m][1];
                        u32x4 o; o.x = pk2(v0[0], v0[1]); o.y = pk2(v0[2], v0[3]); o.z = pk2(v1[0], v1[1]); o.w = pk2(v1[2], v1[3]);
                        *(u32x4*)(mbase + bj * 32768 + (ai * 128 + m * 16) * 64) = o; }
                }
        }
        return u.br < 2;
    }
};

struct SchedP5 {
    int G, c; const char* A; const char* Bt;
    __device__ __forceinline__ bool next(int i, Unit& u) const {
        const int L = i * G + c; if (L >= 288) return false;
        u.br = 0; pg8::tile_of(L, 36, 8, u.pm, u.pn); return true;
    }
    __device__ __forceinline__ const char* a_base(const Unit& u) const { return A + (size_t)u.pm * (256 * 2048 * 2); }
    __device__ __forceinline__ const char* b_base(const Unit& u) const { return Bt + (size_t)u.pn * (256 * 2048 * 2); }
};
struct EpiP5 {
    const float* xp; const float* xs; float* out;
    __device__ __forceinline__ bool operator()(f32x4 (&acc)[2][2][4][2], const Unit& u, int wr, int wc, int fr, int fq) const {
        const int rloc = wr * 64 + fr, cloc = wc * 32 + 8 * fq;
#pragma unroll
        for (int bj = 0; bj < 2; ++bj) {
            const int col = u.pn * 256 + bj * 128 + cloc;
#pragma unroll
            for (int ai = 0; ai < 2; ++ai)
#pragma unroll
                for (int m = 0; m < 4; ++m) {
                    const size_t row = (size_t)u.pm * 256 + ai * 128 + m * 16 + rloc;
                    const float* xr = (row < (size_t)NTP) ? (xp + row * 2048 + col) : (xs + (row - NTP) * 2048 + col);
                    const f32x4 v0 = acc[ai][bj][m][0] + *(const f32x4*)xr, v1 = acc[ai][bj][m][1] + *(const f32x4*)(xr + 4);
                    float* op = out + row * 2048 + col;
                    *(f32x4*)op = v0; *(f32x4*)(op + 4) = v1;
                }
        }
        return false;
    }
};

struct EpiNull {
    __device__ __forceinline__ bool operator()(f32x4 (&acc)[2][2][4][2], const Unit& u, int wr, int wc, int fr, int fq) const {
        f32x4 t = (f32x4){0.f, 0.f, 0.f, 0.f};
#pragma unroll
        for (int ai = 0; ai < 2; ++ai)
#pragma unroll
            for (int bj = 0; bj < 2; ++bj)
#pragma unroll
                for (int m = 0; m < 4; ++m) t += acc[ai][bj][m][0] + acc[ai][bj][m][1];
        asm volatile("" :: "v"(t[0]), "v"(t[1]), "v"(t[2]), "v"(t[3]));
        return false;
    }
};
#define P0_DESC(it_, W_, WT_, K_, N_, ro_, kb_, nb_) do { int r_ = (it_); \
    if (r_ < 1920) { W_ = p.w_in; WT_ = WT1; K_ = 2048; N_ = 15360; ro_ = 0; kb_ = r_ / 120; nb_ = r_ % 120; } \
    else if (r_ < 2176) { r_ -= 1920; W_ = p.w_mem_kv; WT_ = WT1; K_ = 2048; N_ = 2048; ro_ = 15360; kb_ = r_ >> 4; nb_ = r_ & 15; } \
    else if (r_ < 2304) { r_ -= 2176; W_ = p.w_conv_out; WT_ = WT3; K_ = 1024; N_ = 2048; ro_ = 0; kb_ = r_ >> 4; nb_ = r_ & 15; } \
    else if (r_ < 2432) { r_ -= 2304; W_ = p.w_hgrn_out; WT_ = WT3 + (size_t)2048 * 1024; K_ = 1024; N_ = 2048; ro_ = 0; kb_ = r_ >> 4; nb_ = r_ & 15; } \
    else if (r_ < 2560) { r_ -= 2432; W_ = p.w_attn_out; WT_ = WT3 + (size_t)2 * 2048 * 1024; K_ = 1024; N_ = 2048; ro_ = 0; kb_ = r_ >> 4; nb_ = r_ & 15; } \
    else { r_ -= 2560; W_ = p.w_out; WT_ = WTO; K_ = 2048; N_ = 2048; ro_ = 0; kb_ = r_ >> 4; nb_ = r_ & 15; } } while (0)
__device__ __forceinline__ void p0_prologue(const Params& p, LAS unsigned char* lds) {
    const int tid = threadIdx.x, lane = tid & 63, wave = tid >> 6, G = gridDim.x, c = blockIdx.x;
    LAS unsigned* T32 = (LAS unsigned*)lds;
    constexpr int T_ALL = 1920 + 256 + 3 * 128 + 256;
    const int nq = tid & 31, kp0 = tid >> 5;
    f32x4 r0[4], r1[4];
#define P0_LOAD(W_, N_, kb_, nb_) do { _Pragma("unroll") for (int i = 0; i < 4; ++i) { const int kpair = kp0 + 16 * i; \
        const float* src = (W_) + (size_t)((kb_) * 128 + 2 * kpair) * (N_) + (nb_) * 128 + 4 * nq; r0[i] = *(const f32x4*)src; r1[i] = *(const f32x4*)(src + (N_)); } } while (0)
    bf16_t* WT1 = (bf16_t*)(p.ws + WS_WT1); bf16_t* WT3 = (bf16_t*)(p.ws + WS_WT3); bf16_t* WTO = (bf16_t*)(p.ws + WS_WTO);
    int it = c;
    const float* dW = p.w_in; bf16_t* dWT = WT1; int dK = 2048, dN = 15360, dro = 0, dkb = 0, dnb = 0;
    if (it < T_ALL) { P0_DESC(it, dW, dWT, dK, dN, dro, dkb, dnb); P0_LOAD(dW, dN, dkb, dnb); }
    while (it < T_ALL) {
#pragma unroll
        for (int i = 0; i < 4; ++i) { const int kpair = kp0 + 16 * i;
            T32[(4 * nq + 0) * 65 + kpair] = pk2(r0[i][0], r1[i][0]); T32[(4 * nq + 1) * 65 + kpair] = pk2(r0[i][1], r1[i][1]);
            T32[(4 * nq + 2) * 65 + kpair] = pk2(r0[i][2], r1[i][2]); T32[(4 * nq + 3) * 65 + kpair] = pk2(r0[i][3], r1[i][3]); }
        __syncthreads();
        const int itn = it + G;
        const float* nW = dW; bf16_t* nWT = dWT; int nK = dK, nN = dN, nro = dro, nkb = dkb, nnb = dnb;
        if (itn < T_ALL) { P0_DESC(itn, nW, nWT, nK, nN, nro, nkb, nnb); P0_LOAD(nW, nN, nkb, nnb); }
#pragma unroll
        for (int i = 0; i < 4; ++i) {
            const int id = tid + 512 * i, n = id >> 4, cc = id & 15;
            u32x4 o; o.x = T32[n * 65 + 4 * cc]; o.y = T32[n * 65 + 4 * cc + 1]; o.z = T32[n * 65 + 4 * cc + 2]; o.w = T32[n * 65 + 4 * cc + 3];
            *(u32x4*)(dWT + tl((size_t)(dro + dnb * 128 + n), dkb * 128 + 8 * cc, dK)) = o;
        }
        __syncthreads();
        it = itn; dW = nW; dWT = nWT; dK = nK; dN = nN; dro = nro; dkb = nkb; dnb = nnb;
    }
#undef P0_LOAD
#undef P0_DESC
    bf16_t* HA = (bf16_t*)(p.ws + WS_HA);
    const int gw = c * 8 + wave, NGW = G * 8;
#define P0_ROWPTR(m) ((m) < NTP ? p.x_prompt + (size_t)(m) * 2048 : ((m) < NTOK ? p.x_sample + (size_t)((m) - NTP) * 2048 : p.mem_prompt + (size_t)((m) - NTOK) * 2048))
    f32x4 v[8];
    int m = gw;
    if (m < 10240) { const float* xr = P0_ROWPTR(m);
#pragma unroll
        for (int j = 0; j < 8; ++j) v[j] = ((const f32x4*)xr)[lane + 64 * j]; }
    while (m < 10240) {
        const int mn = m + NGW; f32x4 vn[8];
        if (mn < 10240) { const float* xr = P0_ROWPTR(mn);
#pragma unroll
            for (int j = 0; j < 8; ++j) vn[j] = ((const f32x4*)xr)[lane + 64 * j]; }
        float ss = 0.f;
#pragma unroll
        for (int j = 0; j < 8; ++j) ss += (v[j][0] * v[j][0] + v[j][1] * v[j][1]) + (v[j][2] * v[j][2] + v[j][3] * v[j][3]);
        ss = wave_sum(ss);
        const float rinv = rsqrtf(ss * (1.f / 2048.f) + EPS);
        const float* g = (m < NTOK) ? p.g_pre : p.g_mem;
#pragma unroll
        for (int j = 0; j < 8; ++j) { const f32x4 gg = ((const f32x4*)g)[lane + 64 * j];
            u32x2 o; o.x = pk2(v[j][0] * rinv * gg[0], v[j][1] * rinv * gg[1]); o.y = pk2(v[j][2] * rinv * gg[2], v[j][3] * rinv * gg[3]);
            *(u32x2*)(HA + tl((size_t)m, 4 * (lane + 64 * j), 2048)) = o; }
        if (mn < 10240) {
#pragma unroll
            for (int j = 0; j < 8; ++j) v[j] = vn[j]; }
        m = mn;
    }
#undef P0_ROWPTR
    if (c == 0) { float* LB = (float*)(p.ws + WS_LB);
        for (int i = tid; i < 1024; i += 512) LB[i] = 1.f / (1.f + __expf(p.lb_logits[1024 + i] - p.lb_logits[i])); }
}

__device__ __forceinline__ void hgrn_prompt_item(const Params& p, int item, LAS unsigned char* lds, int tid) {
    LAS float* qs = (LAS float*)lds;
    LAS float* fs = qs + 4096;
    LAS float* vs = fs + 4096;
    LAS float* part = vs + 512;
    const int s = item >> 3, n = s >> 3, h = s & 7, dvg = item & 7;
    const int vcol = tid & 15, kg = tid >> 4;
    const bf16_t* proj = (const bf16_t*)(p.ws + WS_PROJ9);
    const float* F = (const float*)(p.ws + WS_F);
    float* oraw = (float*)(p.ws + WS_ORAW);
    const size_t row0 = (size_t)n * SEQ;
    const bf16_t* qsrc = proj + (row0 + kg) * LDP + C_HQ + h * 128 + vcol * 8;
    const float* fsrc = F + (row0 + kg) * 1024 + h * 128 + vcol * 8;
    const bf16_t* vsrc = proj + (row0 + kg) * LDP + C_HI + h * 128 + dvg * 16 + vcol;
    f32x2 S01 = (f32x2){0.f, 0.f}, S23 = (f32x2){0.f, 0.f};
    u32x4 rq[4]; f32x4 rfa[4], rfb[4]; bf16_t rv[4];
#define HG_FETCH(R, tb) do { const size_t adv = (size_t)(tb); rq[R] = *(const u32x4*)(qsrc + adv * LDP); rfa[R] = *(const f32x4*)(fsrc + adv * 1024); \
        rfb[R] = *(const f32x4*)(fsrc + adv * 1024 + 4); rv[R] = *(vsrc + adv * LDP); } while (0)
#define HG_BATCH(R, tb) do { \
        { LAS float* qd = qs + kg * 128 + vcol * 8; \
          *(LAS f32x4*)qd = (f32x4){bflo(rq[R].x), bfhi(rq[R].x), bflo(rq[R].y), bfhi(rq[R].y)}; *(LAS f32x4*)(qd + 4) = (f32x4){bflo(rq[R].z), bfhi(rq[R].z), bflo(rq[R].w), bfhi(rq[R].w)}; \
          LAS float* fd = fs + kg * 128 + vcol * 8; *(LAS f32x4*)fd = rfa[R]; *(LAS f32x4*)(fd + 4) = rfb[R]; \
          vs[kg * 16 + vcol] = bf2f(rv[R]); } \
        __syncthreads(); \
        if ((tb) + 128 < SEQ) HG_FETCH(R, (tb) + 128); \
        f32x4 cf[4], cq[4]; float cv[4]; \
        _Pragma("unroll") for (int i = 0; i < 4; ++i) { cf[i] = *(const LAS f32x4*)(fs + i * 128 + kg * 4); cq[i] = *(const LAS f32x4*)(qs + i * 128 + kg * 4); cv[i] = vs[i * 16 + vcol]; } \
        _Pragma("unroll") for (int g = 0; g < 8; ++g) { \
            f32x4 nf[4], nq[4]; float nv[4]; \
            if (g < 7) { _Pragma("unroll") for (int i = 0; i < 4; ++i) { const int tt = (g + 1) * 4 + i; \
                nf[i] = *(const LAS f32x4*)(fs + tt * 128 + kg * 4); nq[i] = *(const LAS f32x4*)(qs + tt * 128 + kg * 4); nv[i] = vs[tt * 16 + vcol]; } } \
            _Pragma("unroll") for (int i = 0; i < 4; ++i) { \
                const f32x2 f01 = (f32x2){cf[i][0], cf[i][1]}, f23 = (f32x2){cf[i][2], cf[i][3]}, q01 = (f32x2){cq[i][0], cq[i][1]}, q23 = (f32x2){cq[i][2], cq[i][3]}; \
                const f32x2 vv = (f32x2){cv[i], cv[i]}; \
                S01 = f01 * (S01 - vv) + vv; S23 = f23 * (S23 - vv) + vv; \
                f32x2 t = S01 * q01; t = S23 * q23 + t; \
                part[(g * 4 + i) * 528 + tid] = t[0] + t[1]; } \
            if (g < 7) { _Pragma("unroll") for (int i = 0; i < 4; ++i) { cf[i] = nf[i]; cq[i] = nq[i]; cv[i] = nv[i]; } } } \
        __syncthreads(); \
        { float a = 0.f; \
          _Pragma("unroll 8") for (int k2 = 0; k2 < 32; ++k2) a += part[kg * 528 + k2 * 16 + vcol]; \
          oraw[(row0 + (tb) + kg) * 1024 + h * 128 + dvg * 16 + vcol] = a; } } while (0)
    HG_FETCH(0, 0); HG_FETCH(1, 32); HG_FETCH(2, 64); HG_FETCH(3, 96);
#pragma unroll 1
    for (int t0 = 0; t0 < SEQ; t0 += 128) { HG_BATCH(0, t0); HG_BATCH(1, t0 + 32); HG_BATCH(2, t0 + 64); HG_BATCH(3, t0 + 96); }
#undef HG_FETCH
#undef HG_BATCH
    float* so = p.out + O_HGRN_P + ((size_t)(n * 8 + h) * 128 + kg * 4) * 128 + dvg * 16 + vcol;
    so[0] = S01[0]; so[128] = S01[1]; so[256] = S23[0]; so[384] = S23[1];
    __syncthreads();
}

__device__ __forceinline__ void hgrn_sample_item(const Params& p, int item, LAS unsigned char* lds, int tid) {
    LAS float* qs = (LAS float*)lds;
    LAS float* fs = qs + 1024;
    LAS float* vs = fs + 1024;
    LAS float* opart = vs + 1024;
    const int n = item >> 3, h = item & 7, lane = tid & 63, wave = tid >> 6;
    const bf16_t* proj = (const bf16_t*)(p.ws + WS_PROJ9);
    const float* F = (const float*)(p.ws + WS_F);
    const size_t row0 = (size_t)NTP + (size_t)n * 8;
    { const int tt = tid >> 6, k2 = (tid & 63) * 2; const size_t r = row0 + tt;
      const unsigned qw = *(const unsigned*)(proj + r * LDP + C_HQ + h * 128 + k2); const f32x2 ff = *(const f32x2*)(F + r * 1024 + h * 128 + k2);
      const unsigned vw = *(const unsigned*)(proj + r * LDP + C_HI + h * 128 + k2);
      qs[tt * 128 + k2] = bflo(qw); qs[tt * 128 + k2 + 1] = bfhi(qw); fs[tt * 128 + k2] = ff[0]; fs[tt * 128 + k2 + 1] = ff[1];
      vs[tt * 128 + k2] = bflo(vw); vs[tt * 128 + k2 + 1] = bfhi(vw); }
    const int v4 = tid & 31, kg = tid >> 5;
    const size_t sbase = ((size_t)(n * 8 + h) * 128 + kg * 8) * 128 + v4 * 4;
    f32x4 S[8];
#pragma unroll
    for (int i = 0; i < 8; ++i) S[i] = *(const f32x4*)(p.state_hgrn + sbase + (size_t)i * 128);
    __syncthreads();
#pragma unroll
    for (int tt = 0; tt < 8; ++tt) {
        const f32x4 fa = *(const LAS f32x4*)(fs + tt * 128 + kg * 8), fb = *(const LAS f32x4*)(fs + tt * 128 + kg * 8 + 4);
        const f32x4 qa = *(const LAS f32x4*)(qs + tt * 128 + kg * 8), qb = *(const LAS f32x4*)(qs + tt * 128 + kg * 8 + 4);
        const f32x4 vv = *(const LAS f32x4*)(vs + tt * 128 + v4 * 4);
        f32x4 po = (f32x4){0.f, 0.f, 0.f, 0.f};
#pragma unroll
        for (int i = 0; i < 8; ++i) { const float f = (i < 4) ? fa[i & 3] : fb[i & 3], q = (i < 4) ? qa[i & 3] : qb[i & 3];
            S[i] = S[i] * f + vv * (1.f - f); po += S[i] * q; }
#pragma unroll
        for (int e = 0; e < 4; ++e) po[e] += __shfl_xor(po[e], 32);
        if (lane < 32) *(LAS f32x4*)(opart + (tt * 8 + wave) * 128 + v4 * 4) = po;
    }
    float* so = p.out + O_HGRN_S + sbase;
#pragma unroll
    for (int i = 0; i < 8; ++i) *(f32x4*)(so + (size_t)i * 128) = S[i];
    __syncthreads();
    { const int tt = tid >> 6, v = (tid & 63) * 2; float o0 = 0.f, o1 = 0.f;
#pragma unroll
      for (int w = 0; w < 8; ++w) { const f32x2 t = *(const LAS f32x2*)(opart + (tt * 8 + w) * 128 + v); o0 += t[0]; o1 += t[1]; }
      const float ss = wave_sum(o0 * o0 + o1 * o1), rinv = rsqrtf(ss * (1.f / 128.f) + EPS);
      const size_t r = row0 + tt; const f32x2 gg = *(const f32x2*)(p.g_hgrn + h * 128 + v);
      const unsigned gw = *(const unsigned*)(proj + r * LDP + C_HOG + h * 128 + v);
      bf16_t* og = (bf16_t*)(p.ws + WS_ACT3) + (size_t)9216 * 1024 + tl(r, h * 128 + v, 1024);
      *(unsigned*)og = pk2(o0 * rinv * gg[0] * bflo(gw), o1 * rinv * gg[1] * bfhi(gw)); }
    __syncthreads();
}

__device__ __forceinline__ void hgrn_norm_rows(const Params& p) {
    const int tid = threadIdx.x, lane = tid & 63, gw = blockIdx.x * 8 + (tid >> 6), NGW = gridDim.x * 8;
    const bf16_t* proj = (const bf16_t*)(p.ws + WS_PROJ9); const float* oraw = (const float*)(p.ws + WS_ORAW);
    bf16_t* og = (bf16_t*)(p.ws + WS_ACT3) + (size_t)9216 * 1024;
    for (int r = gw; r < NTP; r += NGW) {
        f32x4 o[4]; float ss = 0.f;
#pragma unroll
        for (int j = 0; j < 4; ++j) { o[j] = *(const f32x4*)(oraw + (size_t)r * 1024 + lane * 16 + j * 4); ss += (o[j][0] * o[j][0] + o[j][1] * o[j][1]) + (o[j][2] * o[j][2] + o[j][3] * o[j][3]); }
        ss += __shfl_xor(ss, 1); ss += __shfl_xor(ss, 2); ss += __shfl_xor(ss, 4);
        const float rinv = rsqrtf(ss * (1.f / 128.f) + EPS);
        const u32x4 ga = *(const u32x4*)(proj + (size_t)r * LDP + C_HOG + lane * 16), gb = *(const u32x4*)(proj + (size_t)r * LDP + C_HOG + lane * 16 + 8);
        f32x4 g[4];
#pragma unroll
        for (int j = 0; j < 4; ++j) g[j] = *(const f32x4*)(p.g_hgrn + lane * 16 + j * 4);
        u32x4 oa, ob;
        oa.x = pk2(o[0][0] * rinv * g[0][0] * bflo(ga.x), o[0][1] * rinv * g[0][1] * bfhi(ga.x)); oa.y = pk2(o[0][2] * rinv * g[0][2] * bflo(ga.y), o[0][3] * rinv * g[0][3] * bfhi(ga.y));
        oa.z = pk2(o[1][0] * rinv * g[1][0] * bflo(ga.z), o[1][1] * rinv * g[1][1] * bfhi(ga.z)); oa.w = pk2(o[1][2] * rinv * g[1][2] * bflo(ga.w), o[1][3] * rinv * g[1][3] * bfhi(ga.w));
        ob.x = pk2(o[2][0] * rinv * g[2][0] * bflo(gb.x), o[2][1] * rinv * g[2][1] * bfhi(gb.x)); ob.y = pk2(o[2][2] * rinv * g[2][2] * bflo(gb.y), o[2][3] * rinv * g[2][3] * bfhi(gb.y));
        ob.z = pk2(o[3][0] * rinv * g[3][0] * bflo(gb.z), o[3][1] * rinv * g[3][1] * bfhi(gb.z)); ob.w = pk2(o[3][2] * rinv * g[3][2] * bflo(gb.w), o[3][3] * rinv * g[3][3] * bfhi(gb.w));
        *(u32x4*)(og + tl((size_t)r, lane * 16, 1024)) = oa; *(u32x4*)(og + tl((size_t)r, lane * 16 + 8, 1024)) = ob;
    }
}

template <bool SAMPLE>
__device__ __forceinline__ void conv_item(const Params& p, int item, LAS unsigned char* lds, int tid) {
    constexpr int T = SAMPLE ? 8 : 32;
    constexpr int GP = 4, NG = (T + 32) / GP, G0 = 32 / GP;
    LAS float* dcs = (LAS float*)lds;
    const bf16_t* proj = (const bf16_t*)(p.ws + WS_PROJ9);
    const int n = SAMPLE ? item : (item >> 6), t0 = SAMPLE ? 0 : (item & 63) * 32;
    const size_t rowb = SAMPLE ? ((size_t)NTP + (size_t)n * 8) : ((size_t)n * SEQ);
    const int c0 = 2 * tid;
    float w0[31], w1[31], x0[31], x1[31];
#pragma unroll
    for (int j = 0; j < 31; ++j) { const f32x2 w = *(const f32x2*)(p.conv_w + j * 1024 + c0); w0[j] = w[0]; w1[j] = w[1]; x0[j] = 0.f; x1[j] = 0.f; }
    const f32x2 bias = *(const f32x2*)(p.conv_b + c0);
    unsigned ra[GP], rg[GP];
#define CONV_ISSUE(g) do { \
        if (SAMPLE && (g) < G0) { _Pragma("unroll") for (int i = 0; i < GP; ++i) { const int ti = -2 + GP * (g) + i; \
            const unsigned* tp = (const unsigned*)(p.state_conv + ((size_t)n * 30 + (ti < 0 ? 0 : ti)) * 1024 + c0); ra[i] = tp[0]; rg[i] = tp[1]; } } \
        else { _Pragma("unroll") for (int i = 0; i < GP; ++i) { const int t = t0 - 32 + GP * (g) + i; const bf16_t* rp = proj + (rowb + (t < 0 ? 0 : t)) * LDP + c0; \
            ra[i] = *(const unsigned*)(rp + C_CV); rg[i] = *(const unsigned*)(rp + C_CG); } } } while (0)
    CONV_ISSUE(0);
#pragma unroll 1
    for (int g = 0; g < NG; ++g) {
        float u0[GP], u1[GP];
        if (SAMPLE && g < G0) {
#pragma unroll
            for (int i = 0; i < GP; ++i) { const bool ok = (-2 + GP * g + i) >= 0; u0[i] = ok ? __builtin_bit_cast(float, ra[i]) : 0.f; u1[i] = ok ? __builtin_bit_cast(float, rg[i]) : 0.f; }
        } else {
#pragma unroll
            for (int i = 0; i < GP; ++i) { const bool ok = (t0 - 32 + GP * g + i) >= 0; u0[i] = ok ? bflo(ra[i]) * bflo(rg[i]) : 0.f; u1[i] = ok ? bfhi(ra[i]) * bfhi(rg[i]) : 0.f; }
        }
        if (g + 1 < NG) CONV_ISSUE(g + 1);
#pragma unroll
        for (int i = 0; i < GP; ++i) {
            const int pp = -32 + GP * g + i, t = t0 + pp;
            if (SAMPLE) { if (pp >= -22) *(f32x2*)(p.out + O_CONV_S + ((size_t)n * 30 + (pp + 22)) * 1024 + c0) = (f32x2){u0[i], u1[i]}; }
            else { if (t >= SEQ - 30) *(f32x2*)(p.out + O_CONV_P + ((size_t)n * 30 + (t - (SEQ - 30))) * 1024 + c0) = (f32x2){u0[i], u1[i]}; }
#pragma unroll
            for (int j = 0; j < 30; ++j) { x0[j] = x0[j + 1]; x1[j] = x1[j + 1]; }
            x0[30] = u0[i]; x1[30] = u1[i];
            if (g >= G0) {
                float d0 = bias[0], d1 = bias[1];
#pragma unroll
                for (int j = 0; j < 31; ++j) { d0 += w0[j] * x0[j]; d1 += w1[j] * x1[j]; }
                *(LAS f32x2*)(dcs + (pp) * 1024 + c0) = (f32x2){d0, d1};
            }
        }
    }
#undef CONV_ISSUE
    __syncthreads();
    { const int lane = tid & 63, wave = tid >> 6;
      bf16_t* aact = (bf16_t*)(p.ws + WS_ACT3);
      for (int pp = wave; pp < T; pp += 8) {
          f32x4 v[4]; float s = 0.f;
#pragma unroll
          for (int j = 0; j < 4; ++j) { v[j] = *(const LAS f32x4*)(dcs + pp * 1024 + j * 256 + lane * 4); s += (v[j][0] + v[j][1]) + (v[j][2] + v[j][3]); }
          const float mean = wave_sum(s) * (1.f / 1024.f); float s2 = 0.f;
#pragma unroll
          for (int j = 0; j < 4; ++j) { v[j] = v[j] - mean; s2 += (v[j][0] * v[j][0] + v[j][1] * v[j][1]) + (v[j][2] * v[j][2] + v[j][3] * v[j][3]); }
          const float rstd = rsqrtf(wave_sum(s2) * (1.f / 1024.f) + EPS);
          const size_t r = rowb + t0 + pp;
          bf16_t* arow = aact + tl(r, lane * 4, 1024);
#pragma unroll
          for (int j = 0; j < 4; ++j) { const int c = j * 256 + lane * 4;
              const f32x4 lg = *(const f32x4*)(p.ln_g + c), lbv = *(const f32x4*)(p.ln_b + c);
              const u32x2 sg = *(const u32x2*)(proj + r * LDP + C_CS + c);
              const float y0 = siluf(v[j][0] * rstd * lg[0] + lbv[0]) * bflo(sg.x), y1 = siluf(v[j][1] * rstd * lg[1] + lbv[1]) * bfhi(sg.x);
              const float y2 = siluf(v[j][2] * rstd * lg[2] + lbv[2]) * bflo(sg.y), y3 = siluf(v[j][3] * rstd * lg[3] + lbv[3]) * bfhi(sg.y);
              u32x2 o; o.x = pk2(y0, y1); o.y = pk2(y2, y3);
              *(u32x2*)(arow + j * 65536) = o; }
      } }
    __syncthreads();
}

__device__ __forceinline__ void attn_prompt_item(const Params& p, int item, LAS unsigned char* lds, int tid) {
    const int lane = tid & 63, wave = tid >> 6, l15 = lane & 15, quad = lane >> 4;
    const int n = item >> 6, h = (item >> 4) & 3, qt = item & 15;
    const bf16_t* proj = (const bf16_t*)(p.ws + WS_PROJ9);
    const bf16_t* kb = (const bf16_t*)(p.ws + WS_MKB) + (size_t)(n * 4 + h) * 65536;
    const bf16_t* vt = (const bf16_t*)(p.ws + WS_MVT) + (size_t)(n * 4 + h) * 65536;
    const size_t qrow = (size_t)n * SEQ + qt * 128 + wave * 16 + l15;
    u32x4 st[16];
#pragma unroll
    for (int i = 0; i < 16; ++i) st[i] = *(const u32x4*)(kb + (size_t)(tid + 512 * i) * 8);
    bf16x8 qf[8];
#pragma unroll
    for (int s = 0; s < 8; ++s) qf[s] = *(const bf16x8*)(proj + qrow * LDP + C_AQ + h * 256 + s * 32 + quad * 8);
#pragma unroll
    for (int i = 0; i < 16; ++i) { const int id = tid + 512 * i, r = id >> 5, c = id & 31; *(LAS u32x4*)(lds + r * 512 + ((c ^ (r & 15)) * 16)) = st[i]; }
    __syncthreads();
    f32x4 sc[16];
#pragma unroll
    for (int T = 0; T < 16; ++T) {
        sc[T] = (f32x4){0.f, 0.f, 0.f, 0.f};
        const LAS unsigned char* kr = lds + (T * 16 + l15) * 512;
#pragma unroll
        for (int s = 0; s < 8; ++s) { const bf16x8 a = *(const LAS bf16x8*)(kr + (((s * 4 + quad) ^ l15) * 16)); sc[T] = __builtin_amdgcn_mfma_f32_16x16x32_bf16(a, qf[s], sc[T], 0, 0, 0); }
    }
#pragma unroll
    for (int i = 0; i < 16; ++i) st[i] = *(const u32x4*)(vt + (size_t)(tid + 512 * i) * 8);
    __syncthreads();
    float mx = -3.0e38f;
#pragma unroll
    for (int T = 0; T < 16; ++T) mx = fmaxf(mx, fmaxf(fmaxf(sc[T][0], sc[T][1]), fmaxf(sc[T][2], sc[T][3])));
    mx = fmaxf(mx, __shfl_xor(mx, 16)); mx = fmaxf(mx, __shfl_xor(mx, 32));
    float sum = 0.f;
#pragma unroll
    for (int T = 0; T < 16; ++T) {
#pragma unroll
        for (int e = 0; e < 4; ++e) { sc[T][e] = __expf(sc[T][e] - mx); sum += sc[T][e]; } }
    sum += __shfl_xor(sum, 16); sum += __shfl_xor(sum, 32);
    const float rs = 1.f / sum;
    bf16x8 pb[8];
#pragma unroll
    for (int s2 = 0; s2 < 8; ++s2) {
        u32x4 w; w.x = pk2(sc[2 * s2][0], sc[2 * s2][1]); w.y = pk2(sc[2 * s2][2], sc[2 * s2][3]); w.z = pk2(sc[2 * s2 + 1][0], sc[2 * s2 + 1][1]); w.w = pk2(sc[2 * s2 + 1][2], sc[2 * s2 + 1][3]);
        pb[s2] = __builtin_bit_cast(bf16x8, w);
    }
#pragma unroll
    for (int i = 0; i < 16; ++i) { const int id = tid + 512 * i, r = id >> 5, c = id & 31; *(LAS u32x4*)(lds + r * 512 + ((c ^ (r & 15)) * 16)) = st[i]; }
    __syncthreads();
    bf16_t* aog_row = (bf16_t*)(p.ws + WS_ACT3) + (size_t)2 * 9216 * 1024 + tl(qrow, h * 256 + quad * 4, 1024);
    f32x4 oacc[16];
#pragma unroll
    for (int Tv = 0; Tv < 16; ++Tv) {
        oacc[Tv] = (f32x4){0.f, 0.f, 0.f, 0.f};
        const LAS unsigned char* vr = lds + (Tv * 16 + l15) * 512 + (quad & 1) * 8;
#pragma unroll
        for (int s2 = 0; s2 < 8; ++s2) {
            const int ch = 4 * s2 + (quad >> 1);
            const u32x2 lo = *(const LAS u32x2*)(vr + ((ch ^ l15) * 16)), hi = *(const LAS u32x2*)(vr + (((ch + 2) ^ l15) * 16));
            u32x4 w; w.x = lo.x; w.y = lo.y; w.z = hi.x; w.w = hi.y;
            oacc[Tv] = __builtin_amdgcn_mfma_f32_16x16x32_bf16(__builtin_bit_cast(bf16x8, w), pb[s2], oacc[Tv], 0, 0, 0);
        }
    }
#pragma unroll
    for (int Tv = 0; Tv < 16; ++Tv) {
        const int dv = Tv * 16 + quad * 4;
        const u32x2 sg = *(const u32x2*)(proj + qrow * LDP + C_AS + h * 256 + dv);
        u32x2 o; o.x = pk2(oacc[Tv][0] * rs * bflo(sg.x), oacc[Tv][1] * rs * bfhi(sg.x)); o.y = pk2(oacc[Tv][2] * rs * bflo(sg.y), oacc[Tv][3] * rs * bfhi(sg.y));
        *(u32x2*)(aog_row + (Tv >> 2) * 16384 + (Tv & 3) * 16) = o;
    }
    __syncthreads();
}

__device__ __forceinline__ void attn_sample_item(const Params& p, int item, LAS unsigned char* lds, int tid) {
    LAS float* Ssh = (LAS float*)lds;
    LAS float* Psh = Ssh + 2048;
    LAS float* Opart = Psh + 2048;
    const int lane = tid & 63, wave = tid >> 6, l15 = lane & 15, quad = lane >> 4;
    const int n = item >> 2, h = item & 3;
    const bf16_t* proj = (const bf16_t*)(p.ws + WS_PROJ9);
    const size_t row0 = (size_t)NTP + (size_t)n * 8;
    const float* kc = p.cache_k + ((size_t)n * 256 * 4 + h) * 256;
    const float* vc = p.cache_v + ((size_t)n * 256 * 4 + h) * 256;
    {
        bf16x8 qf[8];
        const size_t qrow = row0 + (lane & 7);
#pragma unroll
        for (int s = 0; s < 8; ++s) qf[s] = *(const bf16x8*)(proj + qrow * LDP + C_AQ + h * 256 + s * 32 + quad * 8);
#pragma unroll
        for (int tl = 0; tl < 2; ++tl) {
            const int T = wave * 2 + tl;
            f32x4 sc = (f32x4){0.f, 0.f, 0.f, 0.f};
            const float* kr = kc + (size_t)(T * 16 + l15) * 1024 + quad * 8;
#pragma unroll
            for (int s = 0; s < 8; ++s) {
                const f32x4 k0 = *(const f32x4*)(kr + s * 32), k1 = *(const f32x4*)(kr + s * 32 + 4);
                u32x4 w; w.x = pk2(k0[0], k0[1]); w.y = pk2(k0[2], k0[3]); w.z = pk2(k1[0], k1[1]); w.w = pk2(k1[2], k1[3]);
                sc = __builtin_amdgcn_mfma_f32_16x16x32_bf16(__builtin_bit_cast(bf16x8, w), qf[s], sc, 0, 0, 0);
            }
            if (l15 < 8) {
#pragma unroll
                for (int e = 0; e < 4; ++e) Ssh[l15 * 256 + T * 16 + quad * 4 + e] = sc[e];
            }
        }
    }
    __syncthreads();
    {
        const f32x4 s4 = *(const LAS f32x4*)(Ssh + wave * 256 + lane * 4);
        const float mx = wave_max(fmaxf(fmaxf(s4[0], s4[1]), fmaxf(s4[2], s4[3])));
        f32x4 e4; e4[0] = __expf(s4[0] - mx); e4[1] = __expf(s4[1] - mx); e4[2] = __expf(s4[2] - mx); e4[3] = __expf(s4[3] - mx);
        const float rs = 1.f / wave_sum((e4[0] + e4[1]) + (e4[2] + e4[3]));
#pragma unroll
        for (int e = 0; e < 4; ++e) Psh[(lane * 4 + e) * 8 + wave] = e4[e] * rs;
    }
    __syncthreads();
    {
        f32x4 acc[8];
#pragma unroll
        for (int q = 0; q < 8; ++q) acc[q] = (f32x4){0.f, 0.f, 0.f, 0.f};
        const float* vr = vc + (size_t)(wave * 32) * 1024 + lane * 4;
#pragma unroll 8
        for (int kk = 0; kk < 32; ++kk) {
            const f32x4 v4 = *(const f32x4*)(vr + (size_t)kk * 1024);
            const f32x4 pa = *(const LAS f32x4*)(Psh + (wave * 32 + kk) * 8), pb = *(const LAS f32x4*)(Psh + (wave * 32 + kk) * 8 + 4);
            acc[0] += v4 * pa[0]; acc[1] += v4 * pa[1]; acc[2] += v4 * pa[2]; acc[3] += v4 * pa[3];
            acc[4] += v4 * pb[0]; acc[5] += v4 * pb[1]; acc[6] += v4 * pb[2]; acc[7] += v4 * pb[3];
        }
#pragma unroll
        for (int q = 0; q < 8; ++q) *(LAS f32x4*)(Opart + (wave * 8 + q) * 256 + lane * 4) = acc[q];
    }
    __syncthreads();
    {
        f32x4 o = (f32x4){0.f, 0.f, 0.f, 0.f};
#pragma unroll
        for (int w = 0; w < 8; ++w) o += *(const LAS f32x4*)(Opart + (w * 8 + wave) * 256 + lane * 4);
        const size_t r = row0 + wave;
        const u32x2 sg = *(const u32x2*)(proj + r * LDP + C_AS + h * 256 + lane * 4);
        u32x2 ov; ov.x = pk2(o[0] * bflo(sg.x), o[1] * bfhi(sg.x)); ov.y = pk2(o[2] * bflo(sg.y), o[3] * bfhi(sg.y));
        bf16_t* aog = (bf16_t*)(p.ws + WS_ACT3) + (size_t)2 * 9216 * 1024;
        *(u32x2*)(aog + tl(r, h * 256 + lane * 4, 1024)) = ov;
    }
    __syncthreads();
}

__device__ __forceinline__ void p2_mixers(const Params& p, LAS unsigned char* lds) {
    const int tid = threadIdx.x, G = gridDim.x, c = blockIdx.x, mask = p.pad;
    if (mask & 1) for (int it = c; it < 256; it += G) hgrn_prompt_item(p, it, lds, tid);
    if (mask & 2) { for (int it = c; it < 256; it += G) conv_item<false>(p, it, lds, tid);
                    for (int it = c; it < 128; it += G) conv_item<true>(p, it, lds, tid); }
    if (mask & 4) for (int it = c; it < 256; it += G) attn_prompt_item(p, it, lds, tid);
    if (mask & 8) for (int it = c; it < 512; it += G) attn_sample_item(p, it, lds, tid);
    if (mask & 16) for (int it = c; it < 1024; it += G) hgrn_sample_item(p, it, lds, tid);
}

__device__ __forceinline__ void p6_final_norm(const Params& p) {
    const int tid = threadIdx.x, lane = tid & 63, gw = blockIdx.x * 8 + (tid >> 6), NGW = gridDim.x * 8;
    for (int r = gw; r < NTOK; r += NGW) {
        float* zr = p.out + (size_t)r * 2048;
        f32x4 v[8]; float ss = 0.f;
#pragma unroll
        for (int j = 0; j < 8; ++j) { v[j] = ((const f32x4*)zr)[lane + 64 * j]; ss += (v[j][0] * v[j][0] + v[j][1] * v[j][1]) + (v[j][2] * v[j][2] + v[j][3] * v[j][3]); }
        ss = wave_sum(ss);
        const float rinv = rsqrtf(ss * (1.f / 2048.f) + EPS);
#pragma unroll
        for (int j = 0; j < 8; ++j) { const f32x4 gg = ((const f32x4*)p.g_final)[lane + 64 * j]; ((f32x4*)zr)[lane + 64 * j] = v[j] * rinv * gg; }
    }
}

#define XB_TMO      128
#define XB_XCNT(j)  (256  + 64 * (j))
#define XB_XSUB(j)  (1280 + 64 * (j))
#define XB_XGEN(j)  (2304 + 64 * (j))
#define XB_TOP      3328
#define XB_TOPGEN   3392
#define XCD_BAR_WORDS 3456
#define XB_SPIN_CAP (1u << 18)
__device__ __forceinline__ unsigned xb_ld(unsigned* p)              { return __hip_atomic_load(p, __ATOMIC_RELAXED, __HIP_MEMORY_SCOPE_AGENT); }
__device__ __forceinline__ unsigned xb_add(unsigned* p, unsigned v) { return __hip_atomic_fetch_add(p, v, __ATOMIC_RELAXED, __HIP_MEMORY_SCOPE_AGENT); }
__device__ __forceinline__ unsigned xb_xcc_id() { return (unsigned)__builtin_amdgcn_s_getreg((3 << 11) | 20) & 0xFu; }
#define XB_SPIN(cond, bar) do { unsigned _sp = 0; while (cond) { __builtin_amdgcn_s_sleep(1); \
    if ((++_sp & 255u) == 0u) { if (xb_ld(&(bar)[XB_TMO])) break; if (_sp > XB_SPIN_CAP) { atomicAdd(&(bar)[XB_TMO], 1u); break; } } } } while (0)
struct XcdBarrier { unsigned* bar; unsigned x; volatile LAS unsigned* st; };
__device__ __forceinline__ XcdBarrier xcd_barrier_post(unsigned* bar, volatile LAS unsigned* st) {
    XcdBarrier b; b.bar = bar; b.x = xb_xcc_id(); b.st = st;
    if (threadIdx.x == 0) (void)xb_add(&bar[XB_XCNT(b.x)], 1u);
    return b;
}
__device__ __forceinline__ void xcd_barrier_complete(unsigned* bar, unsigned x, unsigned& nloc, unsigned& nx) {
    const unsigned G = gridDim.x * gridDim.y * gridDim.z;
    unsigned sum, cnt, mine, sp = 0u;
    for (;;) {
        sum = 0u; cnt = 0u; mine = 0u;
#pragma unroll
        for (unsigned j = 0; j < 16; ++j) { const unsigned c = xb_ld(&bar[XB_XCNT(j)]); sum += c; cnt += (c > 0u) ? 1u : 0u; mine = (j == x) ? c : mine; }
        if (sum == G) break;
        __builtin_amdgcn_s_sleep(1);
        if ((++sp & 255u) == 0u) { if (xb_ld(&bar[XB_TMO])) break; if (sp > XB_SPIN_CAP) { atomicAdd(&bar[XB_TMO], 1u); break; } }
    }
    nloc = mine > 0u ? mine : 1u; nx = cnt > 0u ? cnt : 1u;
}
__device__ __forceinline__ void xcd_barrier(unsigned* bar, unsigned bx, volatile LAS unsigned* st) {
    asm volatile("s_waitcnt vmcnt(0)" ::: "memory");
    __syncthreads();
    if (threadIdx.x == 0) {
        __builtin_amdgcn_s_waitcnt(0);
        unsigned nloc = st[0], nx = st[1];
        if (nloc == 0u) { xcd_barrier_complete(bar, bx, nloc, nx); st[0] = nloc; st[1] = nx; }
        const unsigned old = xb_add(&bar[XB_XSUB(bx)], 1u);
        const unsigned gen = old / nloc;
        if (old + 1u == (gen + 1u) * nloc) {
            __builtin_amdgcn_fence(__ATOMIC_RELEASE, "agent");
            asm volatile("s_waitcnt vmcnt(0)" ::: "memory");
            const unsigned og = xb_add(&bar[XB_TOP], 1u);
            const unsigned tg = og / nx;
            if (og + 1u == (tg + 1u) * nx) xb_add(&bar[XB_TOPGEN], 1u);
            else XB_SPIN(xb_ld(&bar[XB_TOPGEN]) == tg, bar);
            __builtin_amdgcn_fence(__ATOMIC_ACQUIRE, "agent");
            xb_add(&bar[XB_XGEN(bx)], 1u);
            asm volatile("s_waitcnt vmcnt(0)" ::: "memory");
        } else {
            XB_SPIN(xb_ld(&bar[XB_XGEN(bx)]) == gen, bar);
            __builtin_amdgcn_fence(__ATOMIC_ACQUIRE, "agent");
            asm volatile("s_waitcnt vmcnt(0)" ::: "memory");
        }
    }
    __syncthreads();
}

__global__ void __launch_bounds__(512, 2) fwd_megakernel(Params p) {
    extern __shared__ __attribute__((aligned(16))) unsigned char shm[];
    LAS unsigned char* lds = (LAS unsigned char*)shm;
    cg::grid_group grid = cg::this_grid();
    const int G = gridDim.x, c = blockIdx.x;
    volatile LAS unsigned* xst = (volatile LAS unsigned*)(lds + LDS_PHASE_BYTES);
    unsigned* xbar = (unsigned*)(p.ws + WS_BAR); unsigned xbx = 0u;
    if (p.coop) { if (threadIdx.x == 0) { xst[0] = 0u; xst[1] = 0u; } __syncthreads(); const XcdBarrier xb = xcd_barrier_post(xbar, xst); xbx = xb.x; }
#define SEAM(ph) do { if (p.coop && (ph) + 1 < p.ph_hi) { \
        if ((ph) == 0) { \
            asm volatile("s_waitcnt vmcnt(0) lgkmcnt(0)" ::: "memory"); __syncthreads(); \
            grid.sync(); \
            if (threadIdx.x < 64) { __builtin_amdgcn_fence(__ATOMIC_ACQUIRE, "agent"); asm volatile("s_waitcnt vmcnt(0)" ::: "memory"); } \
            __syncthreads(); \
        } else { xcd_barrier(xbar, xbx, xst); } } } while (0)
#define RUNS(ph) (p.ph_lo <= (ph) && (ph) < p.ph_hi)
    if (RUNS(0)) { p0_prologue(p, lds); SEAM(0); }
    if (RUNS(1)) {
        SchedP1 S; S.G = G; S.c = c; S.A = (const char*)(p.ws + WS_HA); S.Bt = (const char*)(p.ws + WS_WT1);
        EpiP1 E; E.proj = (bf16_t*)(p.ws + WS_PROJ9); E.gate = (bf16_t*)(p.ws + WS_GATE); E.F = (float*)(p.ws + WS_F); E.lb = (const float*)(p.ws + WS_LB);
        E.b_gate = p.b_gate; E.out = p.out; E.mkb = (bf16_t*)(p.ws + WS_MKB); E.mvt = (bf16_t*)(p.ws + WS_MVT);
        pg8::gemm_phase(lds, 2048, S, E); SEAM(1);
    }
    if (RUNS(2)) { p2_mixers(p, lds); SEAM(2); }
    if (RUNS(3)) { hgrn_norm_rows(p); SEAM(3); }
    if (RUNS(4)) {
        SchedP4 S; S.G = G; S.c = c; S.A = (const char*)(p.ws + WS_ACT3); S.Bt = (const char*)(p.ws + WS_WT3);
        EpiP4 E; E.gate = (const bf16_t*)(p.ws + WS_GATE); E.merged = (bf16_t*)(p.ws + WS_MERGED);
        pg8::gemm_phase(lds, 1024, S, E); SEAM(4);
    }
    if (RUNS(5)) {
        SchedP5 S; S.G = G; S.c = c; S.A = (const char*)(p.ws + WS_MERGED); S.Bt = (const char*)(p.ws + WS_WTO);
        EpiP5 E; E.xp = p.x_prompt; E.xs = p.x_sample; E.out = p.out;
        pg8::gemm_phase(lds, 2048, S, E); SEAM(5);
    }
    if (RUNS(6)) { p6_final_norm(p); }
#undef RUNS
#undef SEAM
}

extern "C" void kernel_launch(void* const* d_in, const int* in_sizes, int n_in, void* d_out, int out_size, void* d_ws, size_t ws_size, hipStream_t stream) {
    static int grid = 0;
    if (grid == 0) {
        if (n_in != 23 || ws_size < WS_END) { fprintf(stderr, "kernel_launch: expected 23 inputs and >= %zu bytes of workspace, got %d / %zu\n", (size_t)WS_END, n_in, ws_size); grid = -1; return; }
        int dev = 0, cus = 0, per_cu = 0;
        hipGetDevice(&dev); hipDeviceGetAttribute(&cus, hipDeviceAttributeMultiprocessorCount, dev);
        if (hipFuncSetAttribute((const void*)fwd_megakernel, hipFuncAttributeMaxDynamicSharedMemorySize, LDS_BYTES) != hipSuccess) { fprintf(stderr, "kernel_launch: hipFuncSetAttribute failed\n"); grid = -1; return; }
        if (hipOccupancyMaxActiveBlocksPerMultiprocessor(&per_cu, (const void*)fwd_megakernel, 512, LDS_BYTES) != hipSuccess || per_cu < 1) { fprintf(stderr, "kernel_launch: occupancy query failed (%d)\n", per_cu); (void)hipGetLastError(); per_cu = 1; }
        grid = cus * 1;
        if (grid <= 0) grid = 256;
    }
    if (grid < 0) return;
    Params p{};
    const float** pp = (const float**)&p;
    for (int i = 0; i < 23; ++i) pp[i] = (const float*)d_in[i];
    p.out = (float*)d_out; p.ws = (unsigned char*)d_ws; p.pad = 31;
#if N_LAUNCH_MODE == 1
    p.ph_lo = 0; p.ph_hi = N_PHASES; p.coop = 1;
    if (hipMemsetAsync((char*)d_ws + WS_BAR, 0, WS_BAR_BYTES, stream) != hipSuccess) { fprintf(stderr, "kernel_launch: memset of the barrier words failed\n"); return; }
    void* args[] = {&p};
    hipError_t e = hipLaunchCooperativeKernel((const void*)fwd_megakernel, dim3(grid), dim3(512), args, LDS_BYTES, stream);
    if (e != hipSuccess) fprintf(stderr, "cooperative launch failed: %s (grid %d)\n", hipGetErrorString(e), grid);
#else
    for (int ph = 0; ph < N_PHASES; ++ph) {
        p.ph_lo = ph; p.ph_hi = ph + 1; p.coop = 0;
        hipLaunchKernelGGL(fwd_megakernel, dim3(grid), dim3(512), LDS_BYTES, stream, p);
        if ((REP_MASK >> ph) & 1) { if (ph == 2) p.pad = P2_SUBMASK; hipLaunchKernelGGL(fwd_megakernel, dim3(grid), dim3(512), LDS_BYTES, stream, p); p.pad = 31; }
    }
#endif
}
```

```cpp
#include <hip/hip_runtime.h>
#include <hip/hip_cooperative_groups.h>
#include <cstdio>
namespace cg = cooperative_groups;

#define LAS __attribute__((address_space(3)))
typedef unsigned short bf16_t;
typedef short bf16x8 __attribute__((ext_vector_type(8)));
typedef float f32x4 __attribute__((ext_vector_type(4)));
typedef float f32x2 __attribute__((ext_vector_type(2)));
typedef unsigned u32x4 __attribute__((ext_vector_type(4)));
typedef unsigned u32x2 __attribute__((ext_vector_type(2)));

#ifndef REP_MASK
#define REP_MASK 0
#endif
#ifndef P2_SUBMASK
#define P2_SUBMASK 31
#endif
#ifndef N_LAUNCH_MODE
#define N_LAUNCH_MODE 1
#endif

constexpr int DM = 2048, NTP = 8192, NTS = 1024, NTOK = 9216, SEQ = 2048;
constexpr int LDP = 9216;
constexpr int C_CV = 0, C_CG = 1024, C_CS = 2048, C_HQ = 3072, C_HF = 4096, C_HI = 5120, C_HOG = 6144, C_AQ = 7168, C_AS = 8192;
constexpr int LDG = 6144;
constexpr float EPS = 1e-6f;
constexpr size_t O_YP = 0, O_YS = 16777216, O_CONV_P = 18874368, O_HGRN_P = 18997248, O_MK = 19521536, O_MV = 20570112, O_CONV_S = 21618688, O_HGRN_S = 25550848;
constexpr size_t WS_WT1 = 0;
constexpr size_t WS_WT3 = WS_WT1 + (size_t)17408 * 2048 * 2;
constexpr size_t WS_WTO = WS_WT3 + (size_t)3 * 2048 * 1024 * 2;
constexpr size_t WS_HA = WS_WTO + (size_t)2048 * 2048 * 2;
constexpr size_t WS_ORAW = WS_HA;
constexpr size_t WS_PROJ9 = WS_HA + (size_t)10240 * 2048 * 2;
constexpr size_t WS_MF = WS_PROJ9;
constexpr size_t WS_MERGED = WS_MF + (size_t)9216 * 2048 * 4;
constexpr size_t WS_GATE = WS_PROJ9 + (size_t)9216 * 9216 * 2;
constexpr size_t WS_F = WS_GATE + (size_t)9216 * 6144 * 2;
constexpr size_t WS_MKB = WS_F + (size_t)9216 * 1024 * 4;
constexpr size_t WS_MVT = WS_MKB + (size_t)2097152;
constexpr size_t WS_ACT3 = WS_MVT + (size_t)2097152;
constexpr size_t WS_LB = WS_ACT3 + (size_t)3 * 9216 * 1024 * 2;
constexpr size_t WS_BAR = WS_LB + 4096;
constexpr size_t WS_BAR_BYTES = 16384;
constexpr size_t WS_END = WS_BAR + WS_BAR_BYTES;
constexpr int LDS_PHASE_BYTES = 131072, LDS_BYTES = LDS_PHASE_BYTES + 64;
constexpr int N_PHASES = 7;

struct Params {
    const float *x_prompt, *x_sample, *state_conv, *state_hgrn, *cache_k, *cache_v, *mem_prompt, *g_pre, *w_in, *conv_w, *conv_b, *ln_g, *ln_b,
        *w_conv_out, *lb_logits, *g_hgrn, *w_hgrn_out, *g_mem, *w_mem_kv, *w_attn_out, *b_gate, *w_out, *g_final;
    float* out; unsigned char* ws; int ph_lo, ph_hi, coop, pad;
};

__device__ __forceinline__ unsigned f2bf(float f) { unsigned u = __builtin_bit_cast(unsigned, f); return (u + 0x7fffu + ((u >> 16) & 1u)) >> 16; }
typedef __bf16 bf16x2_t __attribute__((ext_vector_type(2)));
__device__ __forceinline__ unsigned pk2(float lo, float hi) { const f32x2 v = {lo, hi}; const bf16x2_t r = __builtin_convertvector(v, bf16x2_t); return __builtin_bit_cast(unsigned, r); }
__device__ __forceinline__ float bflo(unsigned w) { return __builtin_bit_cast(float, w << 16); }
__device__ __forceinline__ float bfhi(unsigned w) { return __builtin_bit_cast(float, w & 0xffff0000u); }
__device__ __forceinline__ float bf2f(unsigned short b) { return __builtin_bit_cast(float, ((unsigned)b) << 16); }
__device__ __forceinline__ float sigm(float x) { return __builtin_amdgcn_rcpf(1.f + __expf(-x)); }
__device__ __forceinline__ float siluf(float x) { return x * sigm(x); }
__device__ __forceinline__ size_t tl(size_t row, int col, int K) { return (row >> 8) * ((size_t)256 * K) + (size_t)(col >> 6) * (256 * 64) + (row & 255) * 64 + (col & 63); }
__device__ __forceinline__ float wave_sum(float v) {
#pragma unroll
    for (int o = 1; o < 64; o <<= 1) v += __shfl_xor(v, o);
    return v;
}
__device__ __forceinline__ float wave_max(float v) {
#pragma unroll
    for (int o = 1; o < 64; o <<= 1) v = fmaxf(v, __shfl_xor(v, o));
    return v;
}

namespace pg8 {
constexpr int BM = 256, BK = 64, HALF = 128, HTB = HALF * BK * 2, STAGE_BYTES = 8 * HTB, NXCD = 8, WGM = 8;
__host__ __device__ __forceinline__ int lds_byte(int r, int c) { const int st = (r >> 4) * 2 + (c >> 5), rr = r & 15, cc = c & 31, ob = rr * 64 + cc * 2; return st * 1024 + (ob ^ (((ob >> 9) & 1) << 5)); }
__host__ __device__ __forceinline__ void stage_rc(int b, int& R, int& C) { const int st = b / 1024, sb = b % 1024, swz = sb ^ (((sb >> 9) & 1) << 5); R = (st >> 1) * 16 + swz / 64; C = (st & 1) * 32 + (swz % 64) / 2; }
__host__ __device__ __forceinline__ int perm32(int rho) { const int n = rho >> 4, i = rho & 15; return 8 * (i >> 2) + 4 * n + (i & 3); }
struct Unit { int pm, pn, br; };
__device__ __forceinline__ void tile_of(int wgid, int nM, int nN, int& pm, int& pn) {
    const int nwg = nM * nN;
    { const int q = nwg / NXCD, r = nwg % NXCD, xcd = wgid % NXCD, off = wgid / NXCD; wgid = (xcd < r ? xcd * (q + 1) : r * (q + 1) + (xcd - r) * q) + off; }
    const int nig = WGM * nN, gid = wgid / nig, fm = gid * WGM, gsz = (nM - fm) < WGM ? (nM - fm) : WGM;
    pm = fm + ((wgid % nig) % gsz); pn = (wgid % nig) / gsz;
}

template <class Epi, class Sched>
__device__ __forceinline__ void gemm_phase(LAS unsigned char* lds, const int K, const Sched& S, const Epi& E) {
    const int tid = threadIdx.x, wid = __builtin_amdgcn_readfirstlane(tid >> 6), lane = tid & 63, wr = wid >> 2, wc = wid & 3, fr = lane & 15, fq = lane >> 4;
    const int nt = K / BK;
    unsigned voffA[2], voffB[2];
#pragma unroll
    for (int i = 0; i < 2; ++i) { int R, C; stage_rc(tid * 16 + i * 8192, R, C); const int Rb = (R & ~31) + perm32(R & 31);
        voffA[i] = (unsigned)(R * BK + C) * 2u; voffB[i] = (unsigned)(Rb * BK + C) * 2u; }
    const size_t kstep = (size_t)(BM * BK * 2);
    const size_t hstep = (size_t)HALF * BK * 2;
    const unsigned ldsw = (unsigned)wid * 1024u;
    const int aoff = lds_byte(wr * 64 + fr, fq * 8), boff = lds_byte(wc * 32 + fr, fq * 8);
#define PG8_SA(b, h) (((b) * 2 + (h)) * HTB)
#define PG8_SB(b, h) ((4 + (b) * 2 + (h)) * HTB)
#define PG8_STAGE(bufoff, gbase, voff) do { _Pragma("unroll") for (int _i = 0; _i < 2; ++_i) \
        __builtin_amdgcn_global_load_lds((const unsigned*)((const char*)(gbase) + (voff)[_i]), (LAS unsigned*)(lds + (bufoff) + ldsw + _i * 8192), 16, 0, 0); } while (0)
#define PG8_LDA(dst, b, h) do { _Pragma("unroll") for (int m = 0; m < 4; ++m) _Pragma("unroll") for (int k = 0; k < 2; ++k) dst[m][k] = *(const LAS bf16x8*)(lds + PG8_SA(b, h) + aoff + m * 2048 + k * 1024); } while (0)
#define PG8_LDB(dst, b, h) do { _Pragma("unroll") for (int n = 0; n < 2; ++n) _Pragma("unroll") for (int k = 0; k < 2; ++k) dst[n][k] = *(const LAS bf16x8*)(lds + PG8_SB(b, h) + boff + n * 2048 + k * 1024); } while (0)
#define PG8_MMA(ai, bj, At, Bt) do { __builtin_amdgcn_s_setprio(1); _Pragma("unroll") for (int m = 0; m < 4; ++m) _Pragma("unroll") for (int n = 0; n < 2; ++n) _Pragma("unroll") for (int k = 0; k < 2; ++k) \
        acc[ai][bj][m][n] = __builtin_amdgcn_mfma_f32_16x16x32_bf16(Bt[n][k], At[m][k], acc[ai][bj][m][n], 0, 0, 0); __builtin_amdgcn_s_setprio(0); } while (0)
#define PG8_WAIT_V(n) asm volatile("s_waitcnt vmcnt(" #n ")" ::: "memory")
#define PG8_WAIT_L(n) asm volatile("s_waitcnt lgkmcnt(" #n ")" ::: "memory")
#define PG8_BAR __builtin_amdgcn_s_barrier()
#define PG8_SCHED __builtin_amdgcn_sched_barrier(0)
    Unit cur, nxt; int ui = 0;
    if (!S.next(0, cur)) return;
    f32x4 acc[2][2][4][2];
#pragma unroll
    for (int a = 0; a < 2; ++a)
#pragma unroll
        for (int b = 0; b < 2; ++b)
#pragma unroll
            for (int m = 0; m < 4; ++m)
#pragma unroll
                for (int n = 0; n < 2; ++n) acc[a][b][m][n] = (f32x4){0.f, 0.f, 0.f, 0.f};
    bf16x8 At[4][2], B0[2][2], B1[2][2];
    const char* cA = S.a_base(cur); const char* cB = S.b_base(cur);
    PG8_STAGE(PG8_SB(0, 0), cB, voffB); PG8_STAGE(PG8_SA(0, 0), cA, voffA); PG8_STAGE(PG8_SB(0, 1), cB + hstep, voffB); PG8_STAGE(PG8_SA(0, 1), cA + hstep, voffA);
    if (wr == 1) PG8_BAR;
    PG8_WAIT_V(4); PG8_BAR;
    PG8_STAGE(PG8_SB(1, 0), cB + kstep, voffB); PG8_STAGE(PG8_SA(1, 0), cA + kstep, voffA); PG8_STAGE(PG8_SB(1, 1), cB + hstep + kstep, voffB);
    PG8_WAIT_V(6); PG8_BAR;
    for (;;) {
        const bool has_next = S.next(ui + 1, nxt);
        const char* nA = has_next ? S.a_base(nxt) : cA; const char* nB = has_next ? S.b_base(nxt) : cB;
        for (int t = 0; t < nt; t += 2) {
            const bool last = (t == nt - 2);
            const char* a1 = cA + (size_t)(t + 1) * kstep;
            const char* a2 = last ? nA : cA + (size_t)(t + 2) * kstep; const char* b2 = last ? nB : cB + (size_t)(t + 2) * kstep;
            const char* a3 = a2 + kstep; const char* b3 = b2 + kstep;
            PG8_LDB(B0, 0, 0); PG8_SCHED; PG8_LDA(At, 0, 0); PG8_STAGE(PG8_SA(1, 1), a1 + hstep, voffA);
            PG8_WAIT_L(8); PG8_BAR; PG8_WAIT_L(0); PG8_MMA(0, 0, At, B0); PG8_BAR; PG8_SCHED;
            PG8_LDB(B1, 0, 1); PG8_STAGE(PG8_SB(0, 0), b2, voffB);
            PG8_BAR; PG8_WAIT_L(0); PG8_MMA(0, 1, At, B1); PG8_BAR;
            PG8_LDA(At, 0, 1); PG8_STAGE(PG8_SA(0, 0), a2, voffA);
            PG8_BAR; PG8_WAIT_L(0); PG8_MMA(1, 0, At, B0); PG8_BAR; PG8_SCHED;
            PG8_STAGE(PG8_SB(0, 1), b2 + hstep, voffB);
            PG8_WAIT_V(6); PG8_BAR; PG8_MMA(1, 1, At, B1); PG8_BAR;
            PG8_LDB(B0, 1, 0); PG8_SCHED; PG8_LDA(At, 1, 0); PG8_STAGE(PG8_SA(0, 1), a2 + hstep, voffA);
            PG8_WAIT_L(8); PG8_BAR; PG8_WAIT_L(0); PG8_MMA(0, 0, At, B0); PG8_BAR; PG8_SCHED;
            PG8_LDB(B1, 1, 1); PG8_STAGE(PG8_SB(1, 0), b3, voffB);
            PG8_BAR; PG8_WAIT_L(0); PG8_MMA(0, 1, At, B1); PG8_BAR;
            PG8_LDA(At, 1, 1); PG8_STAGE(PG8_SA(1, 0), a3, voffA);
            PG8_BAR; PG8_WAIT_L(0); PG8_MMA(1, 0, At, B0); PG8_BAR; PG8_SCHED;
            PG8_STAGE(PG8_SB(1, 1), b3 + hstep, voffB);
            PG8_WAIT_V(6); PG8_BAR; PG8_MMA(1, 1, At, B1); PG8_BAR;
        }
        const bool keep = E(acc, cur, wr, wc, fr, fq);
        if (!has_next) break;
        if (!keep)
#pragma unroll
        for (int a = 0; a < 2; ++a)
#pragma unroll
            for (int b = 0; b < 2; ++b)
#pragma unroll
                for (int m = 0; m < 4; ++m)
#pragma unroll
                    for (int n = 0; n < 2; ++n) acc[a][b][m][n] = (f32x4){0.f, 0.f, 0.f, 0.f};
        cur = nxt; cA = nA; cB = nB; ++ui;
    }
    PG8_WAIT_V(0);
    if (wr == 0) PG8_BAR;
    PG8_BAR;
#undef PG8_SA
#undef PG8_SB
#undef PG8_STAGE
#undef PG8_LDA
#undef PG8_LDB
#undef PG8_MMA
#undef PG8_WAIT_V
#undef PG8_WAIT_L
#undef PG8_BAR
#undef PG8_SCHED
}
}
using pg8::Unit;

struct SchedP1 {
    int G, c; const char* A; const char* Bt;
    __device__ __forceinline__ bool next(int i, Unit& u) const {
        const int L = i * G + c; if (L >= 2192) return false;
        u.br = 0;
        if (L >= 2160) { const int idx = L - 2160; u.pm = 36 + (idx >> 3); u.pn = 60 + (idx & 7); return true; }
        pg8::tile_of(L, 36, 60, u.pm, u.pn); return true;
    }
    __device__ __forceinline__ const char* a_base(const Unit& u) const { return A + (size_t)u.pm * (256 * 2048 * 2); }
    __device__ __forceinline__ const char* b_base(const Unit& u) const { return Bt + (size_t)u.pn * (256 * 2048 * 2); }
};
struct EpiP1 {
    bf16_t* proj; bf16_t* gate; float* F; const float* lb; const float* b_gate; float* out; bf16_t* mkb; bf16_t* mvt;
    __device__ __forceinline__ bool operator()(f32x4 (&acc)[2][2][4][2], const Unit& u, int wr, int wc, int fr, int fq) const {
        const int rloc = wr * 64 + fr, cloc = wc * 32 + 8 * fq;
        if (u.pn < 36) {
            const int seg = u.pn >> 2;
#pragma unroll
            for (int bj = 0; bj < 2; ++bj) {
                const int col = u.pn * 256 + bj * 128 + cloc;
                f32x4 l0 = (f32x4){0.f, 0.f, 0.f, 0.f}, l1 = l0;
                if (seg == 4) { l0 = *(const f32x4*)(lb + (col - C_HF)); l1 = *(const f32x4*)(lb + (col - C_HF) + 4); }
#pragma unroll
                for (int ai = 0; ai < 2; ++ai)
#pragma unroll
                    for (int m = 0; m < 4; ++m) {
                        const size_t row = (size_t)u.pm * 256 + ai * 128 + m * 16 + rloc;
                        f32x4 v0 = acc[ai][bj][m][0], v1 = acc[ai][bj][m][1];
                        if (seg == 4) {
#pragma unroll
                            for (int e = 0; e < 4; ++e) { v0[e] = l0[e] + (1.f - l0[e]) * sigm(v0[e]); v1[e] = l1[e] + (1.f - l1[e]) * sigm(v1[e]); }
                            float* fp = F + row * 1024 + (col - C_HF);
                            *(f32x4*)fp = v0; *(f32x4*)(fp + 4) = v1;
                        } else {
                            if (seg == 1) {
#pragma unroll
                                for (int e = 0; e < 4; ++e) { v0[e] = sigm(v0[e]); v1[e] = sigm(v1[e]); }
                            } else if (seg == 2 || seg == 6 || seg == 8) {
#pragma unroll
                                for (int e = 0; e < 4; ++e) { v0[e] = siluf(v0[e]); v1[e] = siluf(v1[e]); }
                            } else if (seg == 3) { v0 *= 0.08838834764831845f; v1 *= 0.08838834764831845f; }
                            else if (seg == 7) { v0 *= 0.0625f; v1 *= 0.0625f; }
                            u32x4 o; o.x = pk2(v0[0], v0[1]); o.y = pk2(v0[2], v0[3]); o.z = pk2(v1[0], v1[1]); o.w = pk2(v1[2], v1[3]);
                            *(u32x4*)(proj + row * LDP + col) = o;
                        }
                    }
            }
        } else if (u.pn < 60) {
            const int etid = (wr * 4 + wc) * 64 + fq * 16 + fr;
#pragma unroll
            for (int bj = 0; bj < 2; ++bj) {
                const int col = (u.pn - 36) * 256 + bj * 128 + cloc;
                const f32x4 b0 = *(const f32x4*)(b_gate + col), b1 = *(const f32x4*)(b_gate + col + 4);
#pragma unroll
                for (int ai = 0; ai < 2; ++ai)
#pragma unroll
                    for (int m = 0; m < 4; ++m) {
                        const size_t row = (size_t)u.pm * 256 + ai * 128 + m * 16 + rloc;
                        f32x4 v0 = acc[ai][bj][m][0] + b0, v1 = acc[ai][bj][m][1] + b1;
#pragma unroll
                        for (int e = 0; e < 4; ++e) { v0[e] = fmaxf(sigm(v0[e]), 1e-6f); v1[e] = fmaxf(sigm(v1[e]), 1e-6f); }
                        u32x4 o; o.x = pk2(v0[0], v0[1]); o.y = pk2(v0[2], v0[3]); o.z = pk2(v1[0], v1[1]); o.w = pk2(v1[2], v1[3]);
                        *(u32x4*)(gate + ((((size_t)u.pm * 24 + (u.pn - 36)) * 16 + (ai * 8 + m * 2 + bj)) * 512 + etid) * 8) = o;
                    }
            }
        } else {
            const int n = u.pm - 36, isv = (u.pn >= 64) ? 1 : 0, h = (u.pn - 60) & 3;
            float* ob = out + (isv ? O_MV : O_MK);
#pragma unroll
            for (int bj = 0; bj < 2; ++bj) {
                const int d = bj * 128 + cloc;
#pragma unroll
                for (int ai = 0; ai < 2; ++ai)
#pragma unroll
                    for (int m = 0; m < 4; ++m) {
                        const int key = ai * 128 + m * 16 + rloc;
                        const f32x4 v0 = acc[ai][bj][m][0], v1 = acc[ai][bj][m][1];
                        float* op = ob + ((size_t)(n * 256 + key) * 4 + h) * 256 + d;
                        *(f32x4*)op = v0; *(f32x4*)(op + 4) = v1;
                        if (!isv) {
                            u32x4 o; o.x = pk2(v0[0], v0[1]); o.y = pk2(v0[2], v0[3]); o.z = pk2(v1[0], v1[1]); o.w = pk2(v1[2], v1[3]);
                            *(u32x4*)(mkb + ((size_t)(n * 4 + h) * 256 + key) * 256 + d) = o;
                        } else {
                            bf16_t* vp = mvt + ((size_t)(n * 4 + h) * 256 + d) * 256 + key;
#pragma unroll
                            for (int e = 0; e < 4; ++e) { vp[(size_t)e * 256] = (bf16_t)f2bf(v0[e]); vp[(size_t)(e + 4) * 256] = (bf16_t)f2bf(v1[e]); }
                        }
                    }
            }
        }
        return false;
    }
};

struct SchedP4 {
    int G, c; const char* A; const char* Bt;
    __device__ __forceinline__ bool next(int i, Unit& u) const {
        const int tri = i / 3, L = tri * G + c; if (L >= 288) return false;
        u.br = i - tri * 3; pg8::tile_of(L, 36, 8, u.pm, u.pn); return true;
    }
    __device__ __forceinline__ const char* a_base(const Unit& u) const { return A + (size_t)u.br * ((size_t)9216 * 1024 * 2) + (size_t)u.pm * (256 * 1024 * 2); }
    __device__ __forceinline__ const char* b_base(const Unit& u) const { return Bt + (size_t)u.br * ((size_t)2048 * 1024 * 2) + (size_t)u.pn * (256 * 1024 * 2); }
};
struct EpiP4 {
    const bf16_t* gate; bf16_t* merged;
    __device__ __forceinline__ bool operator()(f32x4 (&acc)[2][2][4][2], const Unit& u, int wr, int wc, int fr, int fq) const {
        const int rloc = wr * 64 + fr, cloc = wc * 32 + 8 * fq;
        const int etid = (wr * 4 + wc) * 64 + fq * 16 + fr;
        bf16_t* mbase = merged + tl((size_t)u.pm * 256 + rloc, u.pn * 256 + cloc, 2048);
#pragma unroll
        for (int bj = 0; bj < 2; ++bj) {
            const int col = u.pn * 256 + bj * 128 + cloc;
#pragma unroll
            for (int ai = 0; ai < 2; ++ai)
#pragma unroll
                for (int m = 0; m < 4; ++m) {
                    const size_t row = (size_t)u.pm * 256 + ai * 128 + m * 16 + rloc;
                    const bf16_t* gp = gate + ((((size_t)u.pm * 24 + (u.br * 8 + u.pn)) * 16 + (ai * 8 + m * 2 + bj)) * 512 + etid) * 8;
                    const u32x4 g = *(const u32x4*)gp;
                    f32x4 s0 = (f32x4){bflo(g.x), bfhi(g.x), bflo(g.y), bfhi(g.y)}, s1 = (f32x4){bflo(g.z), bfhi(g.z), bflo(g.w), bfhi(g.w)};
                    if (u.br < 2) {
                        const u32x4 h = *(const u32x4*)(gp + (size_t)8 * 16 * 512 * 8);
                        s0[0] *= __builtin_amdgcn_rcpf(bflo(h.x)); s0[1] *= __builtin_amdgcn_rcpf(bfhi(h.x)); s0[2] *= __builtin_amdgcn_rcpf(bflo(h.y)); s0[3] *= __builtin_amdgcn_rcpf(bfhi(h.y));
                        s1[0] *= __builtin_amdgcn_rcpf(bflo(h.z)); s1[1] *= __builtin_amdgcn_rcpf(bfhi(h.z)); s1[2] *= __builtin_amdgcn_rcpf(bflo(h.w)); s1[3] *= __builtin_amdgcn_rcpf(bfhi(h.w));
                    }
                    acc[ai][bj][m][0] *= s0; acc[ai][bj][m][1] *= s1;
                    if (u.br == 2) { const f32x4 v0 = acc[ai][bj][m][0], v1 = acc[ai][bj][m][1];
                        u32x4 o; o.x = pk2(v0[0], v0[1]); o.y = pk2(v0[2], v0[3]); o.z = pk2(v1[0], v1[1]); o.w = pk2(v1[2], v1[3]);
                        *(u32x4*)(mbase + bj * 32768 + (ai * 128 + m * 16) * 64) = o; }
                }
        }
        return u.br < 2;
    }
};

struct SchedP5 {
    int G, c; const char* A; const char* Bt;
    __device__ __forceinline__ bool next(int i, Unit& u) const {
        const int L = i * G + c; if (L >= 288) return false;
        u.br = 0; pg8::tile_of(L, 36, 8, u.pm, u.pn); return true;
    }
    __device__ __forceinline__ const char* a_base(const Unit& u) const { return A + (size_t)u.pm * (256 * 2048 * 2); }
    __device__ __forceinline__ const char* b_base(const Unit& u) const { return Bt + (size_t)u.pn * (256 * 2048 * 2); }
};
struct EpiP5 {
    const float* xp; const float* xs; float* out;
    __device__ __forceinline__ bool operator()(f32x4 (&acc)[2][2][4][2], const Unit& u, int wr, int wc, int fr, int fq) const {
        const int rloc = wr * 64 + fr, cloc = wc * 32 + 8 * fq;
#pragma unroll
        for (int bj = 0; bj < 2; ++bj) {
            const int col = u.pn * 256 + bj * 128 + cloc;
#pragma unroll
            for (int ai = 0; ai < 2; ++ai)
#pragma unroll
                for (int m = 0; m < 4; ++m) {
                    const size_t row = (size_t)u.pm * 256 + ai * 128 + m * 16 + rloc;
                    const float* xr = (row < (size_t)NTP) ? (xp + row * 2048 + col) : (xs + (row - NTP) * 2048 + col);
                    const f32x4 v0 = acc[ai][bj][m][0] + *(const f32x4*)xr, v1 = acc[ai][bj][m][1] + *(const f32x4*)(xr + 4);
                    float* op = out + row * 2048 + col;
                    *(f32x4*)op = v0; *(f32x4*)(op + 4) = v1;
                }
        }
        return false;
    }
};

struct EpiNull {
    __device__ __forceinline__ bool operator()(f32x4 (&acc)[2][2][4][2], const Unit& u, int wr, int wc, int fr, int fq) const {
        f32x4 t = (f32x4){0.f, 0.f, 0.f, 0.f};
#pragma unroll
        for (int ai = 0; ai < 2; ++ai)
#pragma unroll
            for (int bj = 0; bj < 2; ++bj)
#pragma unroll
                for (int m = 0; m < 4; ++m) t += acc[ai][bj][m][0] + acc[ai][bj][m][1];
        asm volatile("" :: "v"(t[0]), "v"(t[1]), "v"(t[2]), "v"(t[3]));
        return false;
    }
};
#define P0_DESC(it_, W_, WT_, K_, N_, ro_, kb_, nb_) do { int r_ = (it_); \
    if (r_ < 1920) { W_ = p.w_in; WT_ = WT1; K_ = 2048; N_ = 15360; ro_ = 0; kb_ = r_ / 120; nb_ = r_ % 120; } \
    else if (r_ < 2176) { r_ -= 1920; W_ = p.w_mem_kv; WT_ = WT1; K_ = 2048; N_ = 2048; ro_ = 15360; kb_ = r_ >> 4; nb_ = r_ & 15; } \
    else if (r_ < 2304) { r_ -= 2176; W_ = p.w_conv_out; WT_ = WT3; K_ = 1024; N_ = 2048; ro_ = 0; kb_ = r_ >> 4; nb_ = r_ & 15; } \
    else if (r_ < 2432) { r_ -= 2304; W_ = p.w_hgrn_out; WT_ = WT3 + (size_t)2048 * 1024; K_ = 1024; N_ = 2048; ro_ = 0; kb_ = r_ >> 4; nb_ = r_ & 15; } \
    else if (r_ < 2560) { r_ -= 2432; W_ = p.w_attn_out; WT_ = WT3 + (size_t)2 * 2048 * 1024; K_ = 1024; N_ = 2048; ro_ = 0; kb_ = r_ >> 4; nb_ = r_ & 15; } \
    else { r_ -= 2560; W_ = p.w_out; WT_ = WTO; K_ = 2048; N_ = 2048; ro_ = 0; kb_ = r_ >> 4; nb_ = r_ & 15; } } while (0)
__device__ __forceinline__ void p0_prologue(const Params& p, LAS unsigned char* lds) {
    const int tid = threadIdx.x, lane = tid & 63, wave = tid >> 6, G = gridDim.x, c = blockIdx.x;
    LAS unsigned* T32 = (LAS unsigned*)lds;
    constexpr int T_ALL = 1920 + 256 + 3 * 128 + 256;
    const int nq = tid & 31, kp0 = tid >> 5;
    f32x4 r0[4], r1[4];
#define P0_LOAD(W_, N_, kb_, nb_) do { _Pragma("unroll") for (int i = 0; i < 4; ++i) { const int kpair = kp0 + 16 * i; \
        const float* src = (W_) + (size_t)((kb_) * 128 + 2 * kpair) * (N_) + (nb_) * 128 + 4 * nq; r0[i] = *(const f32x4*)src; r1[i] = *(const f32x4*)(src + (N_)); } } while (0)
    bf16_t* WT1 = (bf16_t*)(p.ws + WS_WT1); bf16_t* WT3 = (bf16_t*)(p.ws + WS_WT3); bf16_t* WTO = (bf16_t*)(p.ws + WS_WTO);
    int it = c;
    const float* dW = p.w_in; bf16_t* dWT = WT1; int dK = 2048, dN = 15360, dro = 0, dkb = 0, dnb = 0;
    if (it < T_ALL) { P0_DESC(it, dW, dWT, dK, dN, dro, dkb, dnb); P0_LOAD(dW, dN, dkb, dnb); }
    while (it < T_ALL) {
#pragma unroll
        for (int i = 0; i < 4; ++i) { const int kpair = kp0 + 16 * i;
            T32[(4 * nq + 0) * 65 + kpair] = pk2(r0[i][0], r1[i][0]); T32[(4 * nq + 1) * 65 + kpair] = pk2(r0[i][1], r1[i][1]);
            T32[(4 * nq + 2) * 65 + kpair] = pk2(r0[i][2], r1[i][2]); T32[(4 * nq + 3) * 65 + kpair] = pk2(r0[i][3], r1[i][3]); }
        __syncthreads();
        const int itn = it + G;
        const float* nW = dW; bf16_t* nWT = dWT; int nK = dK, nN = dN, nro = dro, nkb = dkb, nnb = dnb;
        if (itn < T_ALL) { P0_DESC(itn, nW, nWT, nK, nN, nro, nkb, nnb); P0_LOAD(nW, nN, nkb, nnb); }
#pragma unroll
        for (int i = 0; i < 4; ++i) {
            const int id = tid + 512 * i, n = id >> 4, cc = id & 15;
            u32x4 o; o.x = T32[n * 65 + 4 * cc]; o.y = T32[n * 65 + 4 * cc + 1]; o.z = T32[n * 65 + 4 * cc + 2]; o.w = T32[n * 65 + 4 * cc + 3];
            *(u32x4*)(dWT + tl((size_t)(dro + dnb * 128 + n), dkb * 128 + 8 * cc, dK)) = o;
        }
        __syncthreads();
        it = itn; dW = nW; dWT = nWT; dK = nK; dN = nN; dro = nro; dkb = nkb; dnb = nnb;
    }
#undef P0_LOAD
#undef P0_DESC
    bf16_t* HA = (bf16_t*)(p.ws + WS_HA);
    const int gw = c * 8 + wave, NGW = G * 8;
#define P0_ROWPTR(m) ((m) < NTP ? p.x_prompt + (size_t)(m) * 2048 : ((m) < NTOK ? p.x_sample + (size_t)((m) - NTP) * 2048 : p.mem_prompt + (size_t)((m) - NTOK) * 2048))
    f32x4 v[8];
    int m = gw;
    if (m < 10240) { const float* xr = P0_ROWPTR(m);
#pragma unroll
        for (int j = 0; j < 8; ++j) v[j] = ((const f32x4*)xr)[lane + 64 * j]; }
    while (m < 10240) {
        const int mn = m + NGW; f32x4 vn[8];
        if (mn < 10240) { const float* xr = P0_ROWPTR(mn);
#pragma unroll
            for (int j = 0; j < 8; ++j) vn[j] = ((const f32x4*)xr)[lane + 64 * j]; }
        float ss = 0.f;
#pragma unroll
        for (int j = 0; j < 8; ++j) ss += (v[j][0] * v[j][0] + v[j][1] * v[j][1]) + (v[j][2] * v[j][2] + v[j][3] * v[j][3]);
        ss = wave_sum(ss);
        const float rinv = rsqrtf(ss * (1.f / 2048.f) + EPS);
        const float* g = (m < NTOK) ? p.g_pre : p.g_mem;
#pragma unroll
        for (int j = 0; j < 8; ++j) { const f32x4 gg = ((const f32x4*)g)[lane + 64 * j];
            u32x2 o; o.x = pk2(v[j][0] * rinv * gg[0], v[j][1] * rinv * gg[1]); o.y = pk2(v[j][2] * rinv * gg[2], v[j][3] * rinv * gg[3]);
            *(u32x2*)(HA + tl((size_t)m, 4 * (lane + 64 * j), 2048)) = o; }
        if (mn < 10240) {
#pragma unroll
            for (int j = 0; j < 8; ++j) v[j] = vn[j]; }
        m = mn;
    }
#undef P0_ROWPTR
    if (c == 0) { float* LB = (float*)(p.ws + WS_LB);
        for (int i = tid; i < 1024; i += 512) LB[i] = 1.f / (1.f + __expf(p.lb_logits[1024 + i] - p.lb_logits[i])); }
}

__device__ __forceinline__ void hgrn_prompt_item(const Params& p, int item, LAS unsigned char* lds, int tid) {
    LAS float* qs = (LAS float*)lds;
    LAS float* fs = qs + 4096;
    LAS float* vs = fs + 4096;
    LAS float* part = vs + 512;
    const int s = item >> 3, n = s >> 3, h = s & 7, dvg = item & 7;
    const int vcol = tid & 15, kg = tid >> 4;
    const bf16_t* proj = (const bf16_t*)(p.ws + WS_PROJ9);
    const float* F = (const float*)(p.ws + WS_F);
    float* oraw = (float*)(p.ws + WS_ORAW);
    const size_t row0 = (size_t)n * SEQ;
    const bf16_t* qsrc = proj + (row0 + kg) * LDP + C_HQ + h * 128 + vcol * 8;
    const float* fsrc = F + (row0 + kg) * 1024 + h * 128 + vcol * 8;
    const bf16_t* vsrc = proj + (row0 + kg) * LDP + C_HI + h * 128 + dvg * 16 + vcol;
    f32x2 S01 = (f32x2){0.f, 0.f}, S23 = (f32x2){0.f, 0.f};
    u32x4 rq[4]; f32x4 rfa[4], rfb[4]; bf16_t rv[4];
#define HG_FETCH(R, tb) do { const size_t adv = (size_t)(tb); rq[R] = *(const u32x4*)(qsrc + adv * LDP); rfa[R] = *(const f32x4*)(fsrc + adv * 1024); \
        rfb[R] = *(const f32x4*)(fsrc + adv * 1024 + 4); rv[R] = *(vsrc + adv * LDP); } while (0)
#define HG_BATCH(R, tb) do { \
        { LAS float* qd = qs + kg * 128 + vcol * 8; \
          *(LAS f32x4*)qd = (f32x4){bflo(rq[R].x), bfhi(rq[R].x), bflo(rq[R].y), bfhi(rq[R].y)}; *(LAS f32x4*)(qd + 4) = (f32x4){bflo(rq[R].z), bfhi(rq[R].z), bflo(rq[R].w), bfhi(rq[R].w)}; \
          LAS float* fd = fs + kg * 128 + vcol * 8; *(LAS f32x4*)fd = rfa[R]; *(LAS f32x4*)(fd + 4) = rfb[R]; \
          vs[kg * 16 + vcol] = bf2f(rv[R]); } \
        __syncthreads(); \
        if ((tb) + 128 < SEQ) HG_FETCH(R, (tb) + 128); \
        f32x4 cf[4], cq[4]; float cv[4]; \
        _Pragma("unroll") for (int i = 0; i < 4; ++i) { cf[i] = *(const LAS f32x4*)(fs + i * 128 + kg * 4); cq[i] = *(const LAS f32x4*)(qs + i * 128 + kg * 4); cv[i] = vs[i * 16 + vcol]; } \
        _Pragma("unroll") for (int g = 0; g < 8; ++g) { \
            f32x4 nf[4], nq[4]; float nv[4]; \
            if (g < 7) { _Pragma("unroll") for (int i = 0; i < 4; ++i) { const int tt = (g + 1) * 4 + i; \
                nf[i] = *(const LAS f32x4*)(fs + tt * 128 + kg * 4); nq[i] = *(const LAS f32x4*)(qs + tt * 128 + kg * 4); nv[i] = vs[tt * 16 + vcol]; } } \
            _Pragma("unroll") for (int i = 0; i < 4; ++i) { \
                const f32x2 f01 = (f32x2){cf[i][0], cf[i][1]}, f23 = (f32x2){cf[i][2], cf[i][3]}, q01 = (f32x2){cq[i][0], cq[i][1]}, q23 = (f32x2){cq[i][2], cq[i][3]}; \
                const f32x2 vv = (f32x2){cv[i], cv[i]}; \
                S01 = f01 * (S01 - vv) + vv; S23 = f23 * (S23 - vv) + vv; \
                f32x2 t = S01 * q01; t = S23 * q23 + t; \
                part[(g * 4 + i) * 528 + tid] = t[0] + t[1]; } \
            if (g < 7) { _Pragma("unroll") for (int i = 0; i < 4; ++i) { cf[i] = nf[i]; cq[i] = nq[i]; cv[i] = nv[i]; } } } \
        __syncthreads(); \
        { float a = 0.f; \
          _Pragma("unroll 8") for (int k2 = 0; k2 < 32; ++k2) a += part[kg * 528 + k2 * 16 + vcol]; \
          oraw[(row0 + (tb) + kg) * 1024 + h * 128 + dvg * 16 + vcol] = a; } } while (0)
    HG_FETCH(0, 0); HG_FETCH(1, 32); HG_FETCH(2, 64); HG_FETCH(3, 96);
#pragma unroll 1
    for (int t0 = 0; t0 < SEQ; t0 += 128) { HG_BATCH(0, t0); HG_BATCH(1, t0 + 32); HG_BATCH(2, t0 + 64); HG_BATCH(3, t0 + 96); }
#undef HG_FETCH
#undef HG_BATCH
    float* so = p.out + O_HGRN_P + ((size_t)(n * 8 + h) * 128 + kg * 4) * 128 + dvg * 16 + vcol;
    so[0] = S01[0]; so[128] = S01[1]; so[256] = S23[0]; so[384] = S23[1];
    __syncthreads();
}

__device__ __forceinline__ void hgrn_sample_item(const Params& p, int item, LAS unsigned char* lds, int tid) {
    LAS float* qs = (LAS float*)lds;
    LAS float* fs = qs + 1024;
    LAS float* vs = fs + 1024;
    LAS float* opart = vs + 1024;
    const int n = item >> 3, h = item & 7, lane = tid & 63, wave = tid >> 6;
    const bf16_t* proj = (const bf16_t*)(p.ws + WS_PROJ9);
    const float* F = (const float*)(p.ws + WS_F);
    const size_t row0 = (size_t)NTP + (size_t)n * 8;
    { const int tt = tid >> 6, k2 = (tid & 63) * 2; const size_t r = row0 + tt;
      const unsigned qw = *(const unsigned*)(proj + r * LDP + C_HQ + h * 128 + k2); const f32x2 ff = *(const f32x2*)(F + r * 1024 + h * 128 + k2);
      const unsigned vw = *(const unsigned*)(proj + r * LDP + C_HI + h * 128 + k2);
      qs[tt * 128 + k2] = bflo(qw); qs[tt * 128 + k2 + 1] = bfhi(qw); fs[tt * 128 + k2] = ff[0]; fs[tt * 128 + k2 + 1] = ff[1];
      vs[tt * 128 + k2] = bflo(vw); vs[tt * 128 + k2 + 1] = bfhi(vw); }
    const int v4 = tid & 31, kg = tid >> 5;
    const size_t sbase = ((size_t)(n * 8 + h) * 128 + kg * 8) * 128 + v4 * 4;
    f32x4 S[8];
#pragma unroll
    for (int i = 0; i < 8; ++i) S[i] = *(const f32x4*)(p.state_hgrn + sbase + (size_t)i * 128);
    __syncthreads();
#pragma unroll
    for (int tt = 0; tt < 8; ++tt) {
        const f32x4 fa = *(const LAS f32x4*)(fs + tt * 128 + kg * 8), fb = *(const LAS f32x4*)(fs + tt * 128 + kg * 8 + 4);
        const f32x4 qa = *(const LAS f32x4*)(qs + tt * 128 + kg * 8), qb = *(const LAS f32x4*)(qs + tt * 128 + kg * 8 + 4);
        const f32x4 vv = *(const LAS f32x4*)(vs + tt * 128 + v4 * 4);
        f32x4 po = (f32x4){0.f, 0.f, 0.f, 0.f};
#pragma unroll
        for (int i = 0; i < 8; ++i) { const float f = (i < 4) ? fa[i & 3] : fb[i & 3], q = (i < 4) ? qa[i & 3] : qb[i & 3];
            S[i] = S[i] * f + vv * (1.f - f); po += S[i] * q; }
#pragma unroll
        for (int e = 0; e < 4; ++e) po[e] += __shfl_xor(po[e], 32);
        if (lane < 32) *(LAS f32x4*)(opart + (tt * 8 + wave) * 128 + v4 * 4) = po;
    }
    float* so = p.out + O_HGRN_S + sbase;
#pragma unroll
    for (int i = 0; i < 8; ++i) *(f32x4*)(so + (size_t)i * 128) = S[i];
    __syncthreads();
    { const int tt = tid >> 6, v = (tid & 63) * 2; float o0 = 0.f, o1 = 0.f;
#pragma unroll
      for (int w = 0; w < 8; ++w) { const f32x2 t = *(const LAS f32x2*)(opart + (tt * 8 + w) * 128 + v); o0 += t[0]; o1 += t[1]; }
      const float ss = wave_sum(o0 * o0 + o1 * o1), rinv = rsqrtf(ss * (1.f / 128.f) + EPS);
      const size_t r = row0 + tt; const f32x2 gg = *(const f32x2*)(p.g_hgrn + h * 128 + v);
      const unsigned gw = *(const unsigned*)(proj + r * LDP + C_HOG + h * 128 + v);
      bf16_t* og = (bf16_t*)(p.ws + WS_ACT3) + (size_t)9216 * 1024 + tl(r, h * 128 + v, 1024);
      *(unsigned*)og = pk2(o0 * rinv * gg[0] * bflo(gw), o1 * rinv * gg[1] * bfhi(gw)); }
    __syncthreads();
}

__device__ __forceinline__ void hgrn_norm_rows(const Params& p) {
    const int tid = threadIdx.x, lane = tid & 63, gw = blockIdx.x * 8 + (tid >> 6), NGW = gridDim.x * 8;
    const bf16_t* proj = (const bf16_t*)(p.ws + WS_PROJ9); const float* oraw = (const float*)(p.ws + WS_ORAW);
    bf16_t* og = (bf16_t*)(p.ws + WS_ACT3) + (size_t)9216 * 1024;
    for (int r = gw; r < NTP; r += NGW) {
        f32x4 o[4]; float ss = 0.f;
#pragma unroll
        for (int j = 0; j < 4; ++j) { o[j] = *(const f32x4*)(oraw + (size_t)r * 1024 + lane * 16 + j * 4); ss += (o[j][0] * o[j][0] + o[j][1] * o[j][1]) + (o[j][2] * o[j][2] + o[j][3] * o[j][3]); }
        ss += __shfl_xor(ss, 1); ss += __shfl_xor(ss, 2); ss += __shfl_xor(ss, 4);
        const float rinv = rsqrtf(ss * (1.f / 128.f) + EPS);
        const u32x4 ga = *(const u32x4*)(proj + (size_t)r * LDP + C_HOG + lane * 16), gb = *(const u32x4*)(proj + (size_t)r * LDP + C_HOG + lane * 16 + 8);
        f32x4 g[4];
#pragma unroll
        for (int j = 0; j < 4; ++j) g[j] = *(const f32x4*)(p.g_hgrn + lane * 16 + j * 4);
        u32x4 oa, ob;
        oa.x = pk2(o[0][0] * rinv * g[0][0] * bflo(ga.x), o[0][1] * rinv * g[0][1] * bfhi(ga.x)); oa.y = pk2(o[0][2] * rinv * g[0][2] * bflo(ga.y), o[0][3] * rinv * g[0][3] * bfhi(ga.y));
        oa.z = pk2(o[1][0] * rinv * g[1][0] * bflo(ga.z), o[1][1] * rinv * g[1][1] * bfhi(ga.z)); oa.w = pk2(o[1][2] * rinv * g[1][2] * bflo(ga.w), o[1][3] * rinv * g[1][3] * bfhi(ga.w));
        ob.x = pk2(o[2][0] * rinv * g[2][0] * bflo(gb.x), o[2][1] * rinv * g[2][1] * bfhi(gb.x)); ob.y = pk2(o[2][2] * rinv * g[2][2] * bflo(gb.y), o[2][3] * rinv * g[2][3] * bfhi(gb.y));
        ob.z = pk2(o[3][0] * rinv * g[3][0] * bflo(gb.z), o[3][1] * rinv * g[3][1] * bfhi(gb.z)); ob.w = pk2(o[3][2] * rinv * g[3][2] * bflo(gb.w), o[3][3] * rinv * g[3][3] * bfhi(gb.w));
        *(u32x4*)(og + tl((size_t)r, lane * 16, 1024)) = oa; *(u32x4*)(og + tl((size_t)r, lane * 16 + 8, 1024)) = ob;
    }
}

template <bool SAMPLE>
__device__ __forceinline__ void conv_item(const Params& p, int item, LAS unsigned char* lds, int tid) {
    constexpr int T = SAMPLE ? 8 : 32;
    constexpr int GP = 4, NG = (T + 32) / GP, G0 = 32 / GP;
    LAS float* dcs = (LAS float*)lds;
    const bf16_t* proj = (const bf16_t*)(p.ws + WS_PROJ9);
    const int n = SAMPLE ? item : (item >> 6), t0 = SAMPLE ? 0 : (item & 63) * 32;
    const size_t rowb = SAMPLE ? ((size_t)NTP + (size_t)n * 8) : ((size_t)n * SEQ);
    const int c0 = 2 * tid;
    float w0[31], w1[31], x0[31], x1[31];
#pragma unroll
    for (int j = 0; j < 31; ++j) { const f32x2 w = *(const f32x2*)(p.conv_w + j * 1024 + c0); w0[j] = w[0]; w1[j] = w[1]; x0[j] = 0.f; x1[j] = 0.f; }
    const f32x2 bias = *(const f32x2*)(p.conv_b + c0);
    unsigned ra[GP], rg[GP];
#define CONV_ISSUE(g) do { \
        if (SAMPLE && (g) < G0) { _Pragma("unroll") for (int i = 0; i < GP; ++i) { const int ti = -2 + GP * (g) + i; \
            const unsigned* tp = (const unsigned*)(p.state_conv + ((size_t)n * 30 + (ti < 0 ? 0 : ti)) * 1024 + c0); ra[i] = tp[0]; rg[i] = tp[1]; } } \
        else { _Pragma("unroll") for (int i = 0; i < GP; ++i) { const int t = t0 - 32 + GP * (g) + i; const bf16_t* rp = proj + (rowb + (t < 0 ? 0 : t)) * LDP + c0; \
            ra[i] = *(const unsigned*)(rp + C_CV); rg[i] = *(const unsigned*)(rp + C_CG); } } } while (0)
    CONV_ISSUE(0);
#pragma unroll 1
    for (int g = 0; g < NG; ++g) {
        float u0[GP], u1[GP];
        if (SAMPLE && g < G0) {
#pragma unroll
            for (int i = 0; i < GP; ++i) { const bool ok = (-2 + GP * g + i) >= 0; u0[i] = ok ? __builtin_bit_cast(float, ra[i]) : 0.f; u1[i] = ok ? __builtin_bit_cast(float, rg[i]) : 0.f; }
        } else {
#pragma unroll
            for (int i = 0; i < GP; ++i) { const bool ok = (t0 - 32 + GP * g + i) >= 0; u0[i] = ok ? bflo(ra[i]) * bflo(rg[i]) : 0.f; u1[i] = ok ? bfhi(ra[i]) * bfhi(rg[i]) : 0.f; }
        }
        if (g + 1 < NG) CONV_ISSUE(g + 1);
#pragma unroll
        for (int i = 0; i < GP; ++i) {
            const int pp = -32 + GP * g + i, t = t0 + pp;
            if (SAMPLE) { if (pp >= -22) *(f32x2*)(p.out + O_CONV_S + ((size_t)n * 30 + (pp + 22)) * 1024 + c0) = (f32x2){u0[i], u1[i]}; }
            else { if (t >= SEQ - 30) *(f32x2*)(p.out + O_CONV_P + ((size_t)n * 30 + (t - (SEQ - 30))) * 1024 + c0) = (f32x2){u0[i], u1[i]}; }
#pragma unroll
            for (int j = 0; j < 30; ++j) { x0[j] = x0[j + 1]; x1[j] = x1[j + 1]; }
            x0[30] = u0[i]; x1[30] = u1[i];
            if (g >= G0) {
                float d0 = bias[0], d1 = bias[1];
#pragma unroll
                for (int j = 0; j < 31; ++j) { d0 += w0[j] * x0[j]; d1 += w1[j] * x1[j]; }
                *(LAS f32x2*)(dcs + (pp) * 1024 + c0) = (f32x2){d0, d1};
            }
        }
    }
#undef CONV_ISSUE
    __syncthreads();
    { const int lane = tid & 63, wave = tid >> 6;
      bf16_t* aact = (bf16_t*)(p.ws + WS_ACT3);
      for (int pp = wave; pp < T; pp += 8) {
          f32x4 v[4]; float s = 0.f;
#pragma unroll
          for (int j = 0; j < 4; ++j) { v[j] = *(const LAS f32x4*)(dcs + pp * 1024 + j * 256 + lane * 4); s += (v[j][0] + v[j][1]) + (v[j][2] + v[j][3]); }
          const float mean = wave_sum(s) * (1.f / 1024.f); float s2 = 0.f;
#pragma unroll
          for (int j = 0; j < 4; ++j) { v[j] = v[j] - mean; s2 += (v[j][0] * v[j][0] + v[j][1] * v[j][1]) + (v[j][2] * v[j][2] + v[j][3] * v[j][3]); }
          const float rstd = rsqrtf(wave_sum(s2) * (1.f / 1024.f) + EPS);
          const size_t r = rowb + t0 + pp;
          bf16_t* arow = aact + tl(r, lane * 4, 1024);
#pragma unroll
          for (int j = 0; j < 4; ++j) { const int c = j * 256 + lane * 4;
              const f32x4 lg = *(const f32x4*)(p.ln_g + c), lbv = *(const f32x4*)(p.ln_b + c);
              const u32x2 sg = *(const u32x2*)(proj + r * LDP + C_CS + c);
              const float y0 = siluf(v[j][0] * rstd * lg[0] + lbv[0]) * bflo(sg.x), y1 = siluf(v[j][1] * rstd * lg[1] + lbv[1]) * bfhi(sg.x);
              const float y2 = siluf(v[j][2] * rstd * lg[2] + lbv[2]) * bflo(sg.y), y3 = siluf(v[j][3] * rstd * lg[3] + lbv[3]) * bfhi(sg.y);
              u32x2 o; o.x = pk2(y0, y1); o.y = pk2(y2, y3);
              *(u32x2*)(arow + j * 65536) = o; }
      } }
    __syncthreads();
}

__device__ __forceinline__ void attn_prompt_item(const Params& p, int item, LAS unsigned char* lds, int tid) {
    const int lane = tid & 63, wave = tid >> 6, l15 = lane & 15, quad = lane >> 4;
    const int n = item >> 6, h = (item >> 4) & 3, qt = item & 15;
    const bf16_t* proj = (const bf16_t*)(p.ws + WS_PROJ9);
    const bf16_t* kb = (const bf16_t*)(p.ws + WS_MKB) + (size_t)(n * 4 + h) * 65536;
    const bf16_t* vt = (const bf16_t*)(p.ws + WS_MVT) + (size_t)(n * 4 + h) * 65536;
    const size_t qrow = (size_t)n * SEQ + qt * 128 + wave * 16 + l15;
    u32x4 st[16];
#pragma unroll
    for (int i = 0; i < 16; ++i) st[i] = *(const u32x4*)(kb + (size_t)(tid + 512 * i) * 8);
    bf16x8 qf[8];
#pragma unroll
    for (int s = 0; s < 8; ++s) qf[s] = *(const bf16x8*)(proj + qrow * LDP + C_AQ + h * 256 + s * 32 + quad * 8);
#pragma unroll
    for (int i = 0; i < 16; ++i) { const int id = tid + 512 * i, r = id >> 5, c = id & 31; *(LAS u32x4*)(lds + r * 512 + ((c ^ (r & 15)) * 16)) = st[i]; }
    __syncthreads();
    f32x4 sc[16];
#pragma unroll
    for (int T = 0; T < 16; ++T) {
        sc[T] = (f32x4){0.f, 0.f, 0.f, 0.f};
        const LAS unsigned char* kr = lds + (T * 16 + l15) * 512;
#pragma unroll
        for (int s = 0; s < 8; ++s) { const bf16x8 a = *(const LAS bf16x8*)(kr + (((s * 4 + quad) ^ l15) * 16)); sc[T] = __builtin_amdgcn_mfma_f32_16x16x32_bf16(a, qf[s], sc[T], 0, 0, 0); }
    }
#pragma unroll
    for (int i = 0; i < 16; ++i) st[i] = *(const u32x4*)(vt + (size_t)(tid + 512 * i) * 8);
    __syncthreads();
    float mx = -3.0e38f;
#pragma unroll
    for (int T = 0; T < 16; ++T) mx = fmaxf(mx, fmaxf(fmaxf(sc[T][0], sc[T][1]), fmaxf(sc[T][2], sc[T][3])));
    mx = fmaxf(mx, __shfl_xor(mx, 16)); mx = fmaxf(mx, __shfl_xor(mx, 32));
    float sum = 0.f;
#pragma unroll
    for (int T = 0; T < 16; ++T) {
#pragma unroll
        for (int e = 0; e < 4; ++e) { sc[T][e] = __expf(sc[T][e] - mx); sum += sc[T][e]; } }
    sum += __shfl_xor(sum, 16); sum += __shfl_xor(sum, 32);
    const float rs = 1.f / sum;
    bf16x8 pb[8];
#pragma unroll
    for (int s2 = 0; s2 < 8; ++s2) {
        u32x4 w; w.x = pk2(sc[2 * s2][0], sc[2 * s2][1]); w.y = pk2(sc[2 * s2][2], sc[2 * s2][3]); w.z = pk2(sc[2 * s2 + 1][0], sc[2 * s2 + 1][1]); w.w = pk2(sc[2 * s2 + 1][2], sc[2 * s2 + 1][3]);
        pb[s2] = __builtin_bit_cast(bf16x8, w);
    }
#pragma unroll
    for (int i = 0; i < 16; ++i) { const int id = tid + 512 * i, r = id >> 5, c = id & 31; *(LAS u32x4*)(lds + r * 512 + ((c ^ (r & 15)) * 16)) = st[i]; }
    __syncthreads();
    bf16_t* aog_row = (bf16_t*)(p.ws + WS_ACT3) + (size_t)2 * 9216 * 1024 + tl(qrow, h * 256 + quad * 4, 1024);
    f32x4 oacc[16];
#pragma unroll
    for (int Tv = 0; Tv < 16; ++Tv) {
        oacc[Tv] = (f32x4){0.f, 0.f, 0.f, 0.f};
        const LAS unsigned char* vr = lds + (Tv * 16 + l15) * 512 + (quad & 1) * 8;
#pragma unroll
        for (int s2 = 0; s2 < 8; ++s2) {
            const int ch = 4 * s2 + (quad >> 1);
            const u32x2 lo = *(const LAS u32x2*)(vr + ((ch ^ l15) * 16)), hi = *(const LAS u32x2*)(vr + (((ch + 2) ^ l15) * 16));
            u32x4 w; w.x = lo.x; w.y = lo.y; w.z = hi.x; w.w = hi.y;
            oacc[Tv] = __builtin_amdgcn_mfma_f32_16x16x32_bf16(__builtin_bit_cast(bf16x8, w), pb[s2], oacc[Tv], 0, 0, 0);
        }
    }
#pragma unroll
    for (int Tv = 0; Tv < 16; ++Tv) {
        const int dv = Tv * 16 + quad * 4;
        const u32x2 sg = *(const u32x2*)(proj + qrow * LDP + C_AS + h * 256 + dv);
        u32x2 o; o.x = pk2(oacc[Tv][0] * rs * bflo(sg.x), oacc[Tv][1] * rs * bfhi(sg.x)); o.y = pk2(oacc[Tv][2] * rs * bflo(sg.y), oacc[Tv][3] * rs * bfhi(sg.y));
        *(u32x2*)(aog_row + (Tv >> 2) * 16384 + (Tv & 3) * 16) = o;
    }
    __syncthreads();
}

__device__ __forceinline__ void attn_sample_item(const Params& p, int item, LAS unsigned char* lds, int tid) {
    LAS float* Ssh = (LAS float*)lds;
    LAS float* Psh = Ssh + 2048;
    LAS float* Opart = Psh + 2048;
    const int lane = tid & 63, wave = tid >> 6, l15 = lane & 15, quad = lane >> 4;
    const int n = item >> 2, h = item & 3;
    const bf16_t* proj = (const bf16_t*)(p.ws + WS_PROJ9);
    const size_t row0 = (size_t)NTP + (size_t)n * 8;
    const float* kc = p.cache_k + ((size_t)n * 256 * 4 + h) * 256;
    const float* vc = p.cache_v + ((size_t)n * 256 * 4 + h) * 256;
    {
        bf16x8 qf[8];
        const size_t qrow = row0 + (lane & 7);
#pragma unroll
        for (int s = 0; s < 8; ++s) qf[s] = *(const bf16x8*)(proj + qrow * LDP + C_AQ + h * 256 + s * 32 + quad * 8);
#pragma unroll
        for (int tl = 0; tl < 2; ++tl) {
            const int T = wave * 2 + tl;
            f32x4 sc = (f32x4){0.f, 0.f, 0.f, 0.f};
            const float* kr = kc + (size_t)(T * 16 + l15) * 1024 + quad * 8;
#pragma unroll
            for (int s = 0; s < 8; ++s) {
                const f32x4 k0 = *(const f32x4*)(kr + s * 32), k1 = *(const f32x4*)(kr + s * 32 + 4);
                u32x4 w; w.x = pk2(k0[0], k0[1]); w.y = pk2(k0[2], k0[3]); w.z = pk2(k1[0], k1[1]); w.w = pk2(k1[2], k1[3]);
                sc = __builtin_amdgcn_mfma_f32_16x16x32_bf16(__builtin_bit_cast(bf16x8, w), qf[s], sc, 0, 0, 0);
            }
            if (l15 < 8) {
#pragma unroll
                for (int e = 0; e < 4; ++e) Ssh[l15 * 256 + T * 16 + quad * 4 + e] = sc[e];
            }
        }
    }
    __syncthreads();
    {
        const f32x4 s4 = *(const LAS f32x4*)(Ssh + wave * 256 + lane * 4);
        const float mx = wave_max(fmaxf(fmaxf(s4[0], s4[1]), fmaxf(s4[2], s4[3])));
        f32x4 e4; e4[0] = __expf(s4[0] - mx); e4[1] = __expf(s4[1] - mx); e4[2] = __expf(s4[2] - mx); e4[3] = __expf(s4[3] - mx);
        const float rs = 1.f / wave_sum((e4[0] + e4[1]) + (e4[2] + e4[3]));
#pragma unroll
        for (int e = 0; e < 4; ++e) Psh[(lane * 4 + e) * 8 + wave] = e4[e] * rs;
    }
    __syncthreads();
    {
        f32x4 acc[8];
#pragma unroll
        for (int q = 0; q < 8; ++q) acc[q] = (f32x4){0.f, 0.f, 0.f, 0.f};
        const float* vr = vc + (size_t)(wave * 32) * 1024 + lane * 4;
#pragma unroll 8
        for (int kk = 0; kk < 32; ++kk) {
            const f32x4 v4 = *(const f32x4*)(vr + (size_t)kk * 1024);
            const f32x4 pa = *(const LAS f32x4*)(Psh + (wave * 32 + kk) * 8), pb = *(const LAS f32x4*)(Psh + (wave * 32 + kk) * 8 + 4);
            acc[0] += v4 * pa[0]; acc[1] += v4 * pa[1]; acc[2] += v4 * pa[2]; acc[3] += v4 * pa[3];
            acc[4] += v4 * pb[0]; acc[5] += v4 * pb[1]; acc[6] += v4 * pb[2]; acc[7] += v4 * pb[3];
        }
#pragma unroll
        for (int q = 0; q < 8; ++q) *(LAS f32x4*)(Opart + (wave * 8 + q) * 256 + lane * 4) = acc[q];
    }
    __syncthreads();
    {
        f32x4 o = (f32x4){0.f, 0.f, 0.f, 0.f};
#pragma unroll
        for (int w = 0; w < 8; ++w) o += *(const LAS f32x4*)(Opart + (w * 8 + wave) * 256 + lane * 4);
        const size_t r = row0 + wave;
        const u32x2 sg = *(const u32x2*)(proj + r * LDP + C_AS + h * 256 + lane * 4);
        u32x2 ov; ov.x = pk2(o[0] * bflo(sg.x), o[1] * bfhi(sg.x)); ov.y = pk2(o[2] * bflo(sg.y), o[3] * bfhi(sg.y));
        bf16_t* aog = (bf16_t*)(p.ws + WS_ACT3) + (size_t)2 * 9216 * 1024;
        *(u32x2*)(aog + tl(r, h * 256 + lane * 4, 1024)) = ov;
    }
    __syncthreads();
}

__device__ __forceinline__ void p2_mixers(const Params& p, LAS unsigned char* lds) {
    const int tid = threadIdx.x, G = gridDim.x, c = blockIdx.x, mask = p.pad;
    if (mask & 1) for (int it = c; it < 256; it += G) hgrn_prompt_item(p, it, lds, tid);
    if (mask & 2) { for (int it = c; it < 256; it += G) conv_item<false>(p, it, lds, tid);
                    for (int it = c; it < 128; it += G) conv_item<true>(p, it, lds, tid); }
    if (mask & 4) for (int it = c; it < 256; it += G) attn_prompt_item(p, it, lds, tid);
    if (mask & 8) for (int it = c; it < 512; it += G) attn_sample_item(p, it, lds, tid);
    if (mask & 16) for (int it = c; it < 1024; it += G) hgrn_sample_item(p, it, lds, tid);
}

__device__ __forceinline__ void p6_final_norm(const Params& p) {
    const int tid = threadIdx.x, lane = tid & 63, gw = blockIdx.x * 8 + (tid >> 6), NGW = gridDim.x * 8;
    for (int r = gw; r < NTOK; r += NGW) {
        float* zr = p.out + (size_t)r * 2048;
        f32x4 v[8]; float ss = 0.f;
#pragma unroll
        for (int j = 0; j < 8; ++j) { v[j] = ((const f32x4*)zr)[lane + 64 * j]; ss += (v[j][0] * v[j][0] + v[j][1] * v[j][1]) + (v[j][2] * v[j][2] + v[j][3] * v[j][3]); }
        ss = wave_sum(ss);
        const float rinv = rsqrtf(ss * (1.f / 2048.f) + EPS);
#pragma unroll
        for (int j = 0; j < 8; ++j) { const f32x4 gg = ((const f32x4*)p.g_final)[lane + 64 * j]; ((f32x4*)zr)[lane + 64 * j] = v[j] * rinv * gg; }
    }
}

#define XB_TMO      128
#define XB_XCNT(j)  (256  + 64 * (j))
#define XB_XSUB(j)  (1280 + 64 * (j))
#define XB_XGEN(j)  (2304 + 64 * (j))
#define XB_TOP      3328
#define XB_TOPGEN   3392
#define XCD_BAR_WORDS 3456
#define XB_SPIN_CAP (1u << 18)
__device__ __forceinline__ unsigned xb_ld(unsigned* p)              { return __hip_atomic_load(p, __ATOMIC_RELAXED, __HIP_MEMORY_SCOPE_AGENT); }
__device__ __forceinline__ unsigned xb_add(unsigned* p, unsigned v) { return __hip_atomic_fetch_add(p, v, __ATOMIC_RELAXED, __HIP_MEMORY_SCOPE_AGENT); }
__device__ __forceinline__ unsigned xb_xcc_id() { return (unsigned)__builtin_amdgcn_s_getreg((3 << 11) | 20) & 0xFu; }
#define XB_SPIN(cond, bar) do { unsigned _sp = 0; while (cond) { __builtin_amdgcn_s_sleep(1); \
    if ((++_sp & 255u) == 0u) { if (xb_ld(&(bar)[XB_TMO])) break; if (_sp > XB_SPIN_CAP) { atomicAdd(&(bar)[XB_TMO], 1u); break; } } } } while (0)
struct XcdBarrier { unsigned* bar; unsigned x; volatile LAS unsigned* st; };
__device__ __forceinline__ XcdBarrier xcd_barrier_post(unsigned* bar, volatile LAS unsigned* st) {
    XcdBarrier b; b.bar = bar; b.x = xb_xcc_id(); b.st = st;
    if (threadIdx.x == 0) (void)xb_add(&bar[XB_XCNT(b.x)], 1u);
    return b;
}
__device__ __forceinline__ void xcd_barrier_complete(unsigned* bar, unsigned x, unsigned& nloc, unsigned& nx) {
    const unsigned G = gridDim.x * gridDim.y * gridDim.z;
    unsigned sum, cnt, mine, sp = 0u;
    for (;;) {
        sum = 0u; cnt = 0u; mine = 0u;
#pragma unroll
        for (unsigned j = 0; j < 16; ++j) { const unsigned c = xb_ld(&bar[XB_XCNT(j)]); sum += c; cnt += (c > 0u) ? 1u : 0u; mine = (j == x) ? c : mine; }
        if (sum == G) break;
        __builtin_amdgcn_s_sleep(1);
        if ((++sp & 255u) == 0u) { if (xb_ld(&bar[XB_TMO])) break; if (sp > XB_SPIN_CAP) { atomicAdd(&bar[XB_TMO], 1u); break; } }
    }
    nloc = mine > 0u ? mine : 1u; nx = cnt > 0u ? cnt : 1u;
}
__device__ __forceinline__ void xcd_barrier(unsigned* bar, unsigned bx, volatile LAS unsigned* st) {
    asm volatile("s_waitcnt vmcnt(0)" ::: "memory");
    __syncthreads();
    if (threadIdx.x == 0) {
        __builtin_amdgcn_s_waitcnt(0);
        unsigned nloc = st[0], nx = st[1];
        if (nloc == 0u) { xcd_barrier_complete(bar, bx, nloc, nx); st[0] = nloc; st[1] = nx; }
        const unsigned old = xb_add(&bar[XB_XSUB(bx)], 1u);
        const unsigned gen = old / nloc;
        if (old + 1u == (gen + 1u) * nloc) {
            __builtin_amdgcn_fence(__ATOMIC_RELEASE, "agent");
            asm volatile("s_waitcnt vmcnt(0)" ::: "memory");
            const unsigned og = xb_add(&bar[XB_TOP], 1u);
            const unsigned tg = og / nx;
            if (og + 1u == (tg + 1u) * nx) xb_add(&bar[XB_TOPGEN], 1u);
            else XB_SPIN(xb_ld(&bar[XB_TOPGEN]) == tg, bar);
            __builtin_amdgcn_fence(__ATOMIC_ACQUIRE, "agent");
            xb_add(&bar[XB_XGEN(bx)], 1u);
            asm volatile("s_waitcnt vmcnt(0)" ::: "memory");
        } else {
            XB_SPIN(xb_ld(&bar[XB_XGEN(bx)]) == gen, bar);
            __builtin_amdgcn_fence(__ATOMIC_ACQUIRE, "agent");
            asm volatile("s_waitcnt vmcnt(0)" ::: "memory");
        }
    }
    __syncthreads();
}

__global__ void __launch_bounds__(512, 2) fwd_megakernel(Params p) {
    extern __shared__ __attribute__((aligned(16))) unsigned char shm[];
    LAS unsigned char* lds = (LAS unsigned char*)shm;
    cg::grid_group grid = cg::this_grid();
    const int G = gridDim.x, c = blockIdx.x;
    volatile LAS unsigned* xst = (volatile LAS unsigned*)(lds + LDS_PHASE_BYTES);
    unsigned* xbar = (unsigned*)(p.ws + WS_BAR); unsigned xbx = 0u;
    if (p.coop) { if (threadIdx.x == 0) { xst[0] = 0u; xst[1] = 0u; } __syncthreads(); const XcdBarrier xb = xcd_barrier_post(xbar, xst); xbx = xb.x;
        grid.sync(); }
#define SEAM(ph) do { if (p.coop && (ph) + 1 < p.ph_hi) xcd_barrier(xbar, xbx, xst); } while (0)
#define RUNS(ph) (p.ph_lo <= (ph) && (ph) < p.ph_hi)
    if (RUNS(0)) { p0_prologue(p, lds); SEAM(0); }
    if (RUNS(1)) {
        SchedP1 S; S.G = G; S.c = c; S.A = (const char*)(p.ws + WS_HA); S.Bt = (const char*)(p.ws + WS_WT1);
        EpiP1 E; E.proj = (bf16_t*)(p.ws + WS_PROJ9); E.gate = (bf16_t*)(p.ws + WS_GATE); E.F = (float*)(p.ws + WS_F); E.lb = (const float*)(p.ws + WS_LB);
        E.b_gate = p.b_gate; E.out = p.out; E.mkb = (bf16_t*)(p.ws + WS_MKB); E.mvt = (bf16_t*)(p.ws + WS_MVT);
        pg8::gemm_phase(lds, 2048, S, E); SEAM(1);
    }
    if (RUNS(2)) { p2_mixers(p, lds); SEAM(2); }
    if (RUNS(3)) { hgrn_norm_rows(p); SEAM(3); }
    if (RUNS(4)) {
        SchedP4 S; S.G = G; S.c = c; S.A = (const char*)(p.ws + WS_ACT3); S.Bt = (const char*)(p.ws + WS_WT3);
        EpiP4 E; E.gate = (const bf16_t*)(p.ws + WS_GATE); E.merged = (bf16_t*)(p.ws + WS_MERGED);
        pg8::gemm_phase(lds, 1024, S, E); SEAM(4);
    }
    if (RUNS(5)) {
        SchedP5 S; S.G = G; S.c = c; S.A = (const char*)(p.ws + WS_MERGED); S.Bt = (const char*)(p.ws + WS_WTO);
        EpiP5 E; E.xp = p.x_prompt; E.xs = p.x_sample; E.out = p.out;
        pg8::gemm_phase(lds, 2048, S, E); SEAM(5);
    }
    if (RUNS(6)) { p6_final_norm(p); }
#undef RUNS
#undef SEAM
}

extern "C" void kernel_launch(void* const* d_in, const int* in_sizes, int n_in, void* d_out, int out_size, void* d_ws, size_t ws_size, hipStream_t stream) {
    static int grid = 0;
    if (grid == 0) {
        if (n_in != 23 || ws_size < WS_END) { fprintf(stderr, "kernel_launch: expected 23 inputs and >= %zu bytes of workspace, got %d / %zu\n", (size_t)WS_END, n_in, ws_size); grid = -1; return; }
        int dev = 0, cus = 0, per_cu = 0;
        hipGetDevice(&dev); hipDeviceGetAttribute(&cus, hipDeviceAttributeMultiprocessorCount, dev);
        if (hipFuncSetAttribute((const void*)fwd_megakernel, hipFuncAttributeMaxDynamicSharedMemorySize, LDS_BYTES) != hipSuccess) { fprintf(stderr, "kernel_launch: hipFuncSetAttribute failed\n"); grid = -1; return; }
        if (hipOccupancyMaxActiveBlocksPerMultiprocessor(&per_cu, (const void*)fwd_megakernel, 512, LDS_BYTES) != hipSuccess || per_cu < 1) { fprintf(stderr, "kernel_launch: occupancy query failed (%d)\n", per_cu); (void)hipGetLastError(); per_cu = 1; }
        grid = cus * 1;
        if (grid <= 0) grid = 256;
    }
    if (grid < 0) return;
    Params p{};
    const float** pp = (const float**)&p;
    for (int i = 0; i < 23; ++i) pp[i] = (const float*)d_in[i];
    p.out = (float*)d_out; p.ws = (unsigned char*)d_ws; p.pad = 31;
#if N_LAUNCH_MODE == 1
    p.ph_lo = 0; p.ph_hi = N_PHASES; p.coop = 1;
    if (hipMemsetAsync((char*)d_ws + WS_BAR, 0, WS_BAR_BYTES, stream) != hipSuccess) { fprintf(stderr, "kernel_launch: memset of the barrier words failed\n"); return; }
    void* args[] = {&p};
    hipError_t e = hipLaunchCooperativeKernel((const void*)fwd_megakernel, dim3(grid), dim3(512), args, LDS_BYTES, stream);
    if (e != hipSuccess) fprintf(stderr, "cooperative launch failed: %s (grid %d)\n", hipGetErrorString(e), grid);
#else
    for (int ph = 0; ph < N_PHASES; ++ph) {
        p.ph_lo = ph; p.ph_hi = ph + 1; p.coop = 0;
        hipLaunchKernelGGL(fwd_megakernel, dim3(grid), dim3(512), LDS_BYTES, stream, p);
        if ((REP_MASK >> ph) & 1) { if (ph == 2) p.pad = P2_SUBMASK; hipLaunchKernelGGL(fwd_megakernel, dim3(grid), dim3(512), LDS_BYTES, stream, p); p.pad = 31; }
    }
#endif
}
```

```cpp
#include <hip/hip_runtime.h>
#include <hip/hip_cooperative_groups.h>
#include <cstdio>
namespace cg = cooperative_groups;

#define LAS __attribute__((address_space(3)))
typedef unsigned short bf16_t;
typedef short bf16x8 __attribute__((ext_vector_type(8)));
typedef float f32x4 __attribute__((ext_vector_type(4)));
typedef float f32x2 __attribute__((ext_vector_type(2)));
typedef unsigned u32x4 __attribute__((ext_vector_type(4)));
typedef unsigned u32x2 __attribute__((ext_vector_type(2)));

#ifndef REP_MASK
#define REP_MASK 0
#endif
#ifndef P2_SUBMASK
#define P2_SUBMASK 31
#endif
#ifndef N_LAUNCH_MODE
#define N_LAUNCH_MODE 1
#endif

constexpr int DM = 2048, NTP = 8192, NTS = 1024, NTOK = 9216, SEQ = 2048;
constexpr int LDP = 9216;
constexpr int C_CV = 0, C_CG = 1024, C_CS = 2048, C_HQ = 3072, C_HF = 4096, C_HI = 5120, C_HOG = 6144, C_AQ = 7168, C_AS = 8192;
constexpr int LDG = 6144;
constexpr float EPS = 1e-6f;
constexpr size_t O_YP = 0, O_YS = 16777216, O_CONV_P = 18874368, O_HGRN_P = 18997248, O_MK = 19521536, O_MV = 20570112, O_CONV_S = 21618688, O_HGRN_S = 25550848;
constexpr size_t WS_WT1 = 0;
constexpr size_t WS_WT3 = WS_WT1 + (size_t)17408 * 2048 * 2;
constexpr size_t WS_WTO = WS_WT3 + (size_t)3 * 2048 * 1024 * 2;
constexpr size_t WS_HA = WS_WTO + (size_t)2048 * 2048 * 2;
constexpr size_t WS_ORAW = WS_HA;
constexpr size_t WS_PROJ9 = WS_HA + (size_t)10240 * 2048 * 2;
constexpr size_t WS_MF = WS_PROJ9;
constexpr size_t WS_MERGED = WS_MF + (size_t)9216 * 2048 * 4;
constexpr size_t WS_GATE = WS_PROJ9 + (size_t)9216 * 9216 * 2;
constexpr size_t WS_F = WS_GATE + (size_t)9216 * 6144 * 2;
constexpr size_t WS_MKB = WS_F + (size_t)9216 * 1024 * 4;
constexpr size_t WS_MVT = WS_MKB + (size_t)2097152;
constexpr size_t WS_ACT3 = WS_MVT + (size_t)2097152;
constexpr size_t WS_LB = WS_ACT3 + (size_t)3 * 9216 * 1024 * 2;
constexpr size_t WS_BAR = WS_LB + 4096;
constexpr size_t WS_BAR_BYTES = 16384;
constexpr size_t WS_END = WS_BAR + WS_BAR_BYTES;
constexpr int LDS_PHASE_BYTES = 131072, LDS_BYTES = LDS_PHASE_BYTES + 64;
constexpr int N_PHASES = 7;

struct Params {
    const float *x_prompt, *x_sample, *state_conv, *state_hgrn, *cache_k, *cache_v, *mem_prompt, *g_pre, *w_in, *conv_w, *conv_b, *ln_g, *ln_b,
        *w_conv_out, *lb_logits, *g_hgrn, *w_hgrn_out, *g_mem, *w_mem_kv, *w_attn_out, *b_gate, *w_out, *g_final;
    float* out; unsigned char* ws; int ph_lo, ph_hi, coop, pad;
};

__device__ __forceinline__ unsigned f2bf(float f) { unsigned u = __builtin_bit_cast(unsigned, f); return (u + 0x7fffu + ((u >> 16) & 1u)) >> 16; }
typedef __bf16 bf16x2_t __attribute__((ext_vector_type(2)));
__device__ __forceinline__ unsigned pk2(float lo, float hi) { const f32x2 v = {lo, hi}; const bf16x2_t r = __builtin_convertvector(v, bf16x2_t); return __builtin_bit_cast(unsigned, r); }
__device__ __forceinline__ float bflo(unsigned w) { return __builtin_bit_cast(float, w << 16); }
__device__ __forceinline__ float bfhi(unsigned w) { return __builtin_bit_cast(float, w & 0xffff0000u); }
__device__ __forceinline__ float bf2f(unsigned short b) { return __builtin_bit_cast(float, ((unsigned)b) << 16); }
__device__ __forceinline__ float sigm(float x) { return __builtin_amdgcn_rcpf(1.f + __expf(-x)); }
__device__ __forceinline__ float siluf(float x) { return x * sigm(x); }
__device__ __forceinline__ size_t tl(size_t row, int col, int K) { return (row >> 8) * ((size_t)256 * K) + (size_t)(col >> 6) * (256 * 64) + (row & 255) * 64 + (col & 63); }
__device__ __forceinline__ float wave_sum(float v) {
#pragma unroll
    for (int o = 1; o < 64; o <<= 1) v += __shfl_xor(v, o);
    return v;
}
__device__ __forceinline__ float wave_max(float v) {
#pragma unroll
    for (int o = 1; o < 64; o <<= 1) v = fmaxf(v, __shfl_xor(v, o));
    return v;
}

namespace pg8 {
constexpr int BM = 256, BK = 64, HALF = 128, HTB = HALF * BK * 2, STAGE_BYTES = 8 * HTB, NXCD = 8, WGM = 8;
__host__ __device__ __forceinline__ int lds_byte(int r, int c) { const int st = (r >> 4) * 2 + (c >> 5), rr = r & 15, cc = c & 31, ob = rr * 64 + cc * 2; return st * 1024 + (ob ^ (((ob >> 9) & 1) << 5)); }
__host__ __device__ __forceinline__ void stage_rc(int b, int& R, int& C) { const int st = b / 1024, sb = b % 1024, swz = sb ^ (((sb >> 9) & 1) << 5); R = (st >> 1) * 16 + swz / 64; C = (st & 1) * 32 + (swz % 64) / 2; }
__host__ __device__ __forceinline__ int perm32(int rho) { const int n = rho >> 4, i = rho & 15; return 8 * (i >> 2) + 4 * n + (i & 3); }
struct Unit { int pm, pn, br; };
__device__ __forceinline__ void tile_of(int wgid, int nM, int nN, int& pm, int& pn) {
    const int nwg = nM * nN;
    { const int q = nwg / NXCD, r = nwg % NXCD, xcd = wgid % NXCD, off = wgid / NXCD; wgid = (xcd < r ? xcd * (q + 1) : r * (q + 1) + (xcd - r) * q) + off; }
    const int nig = WGM * nN, gid = wgid / nig, fm = gid * WGM, gsz = (nM - fm) < WGM ? (nM - fm) : WGM;
    pm = fm + ((wgid % nig) % gsz); pn = (wgid % nig) / gsz;
}

template <class Epi, class Sched>
__device__ __forceinline__ void gemm_phase(LAS unsigned char* lds, const int K, const Sched& S, const Epi& E) {
    const int tid = threadIdx.x, wid = __builtin_amdgcn_readfirstlane(tid >> 6), lane = tid & 63, wr = wid >> 2, wc = wid & 3, fr = lane & 15, fq = lane >> 4;
    const int nt = K / BK;
    unsigned voffA[2], voffB[2];
#pragma unroll
    for (int i = 0; i < 2; ++i) { int R, C; stage_rc(tid * 16 + i * 8192, R, C); const int Rb = (R & ~31) + perm32(R & 31);
        voffA[i] = (unsigned)(R * BK + C) * 2u; voffB[i] = (unsigned)(Rb * BK + C) * 2u; }
    const size_t kstep = (size_t)(BM * BK * 2);
    const size_t hstep = (size_t)HALF * BK * 2;
    const unsigned ldsw = (unsigned)wid * 1024u;
    const int aoff = lds_byte(wr * 64 + fr, fq * 8), boff = lds_byte(wc * 32 + fr, fq * 8);
#define PG8_SA(b, h) (((b) * 2 + (h)) * HTB)
#define PG8_SB(b, h) ((4 + (b) * 2 + (h)) * HTB)
#define PG8_STAGE(bufoff, gbase, voff) do { _Pragma("unroll") for (int _i = 0; _i < 2; ++_i) \
        __builtin_amdgcn_global_load_lds((const unsigned*)((const char*)(gbase) + (voff)[_i]), (LAS unsigned*)(lds + (bufoff) + ldsw + _i * 8192), 16, 0, 0); } while (0)
#define PG8_LDA(dst, b, h) do { _Pragma("unroll") for (int m = 0; m < 4; ++m) _Pragma("unroll") for (int k = 0; k < 2; ++k) dst[m][k] = *(const LAS bf16x8*)(lds + PG8_SA(b, h) + aoff + m * 2048 + k * 1024); } while (0)
#define PG8_LDB(dst, b, h) do { _Pragma("unroll") for (int n = 0; n < 2; ++n) _Pragma("unroll") for (int k = 0; k < 2; ++k) dst[n][k] = *(const LAS bf16x8*)(lds + PG8_SB(b, h) + boff + n * 2048 + k * 1024); } while (0)
#define PG8_MMA(ai, bj, At, Bt) do { __builtin_amdgcn_s_setprio(1); _Pragma("unroll") for (int m = 0; m < 4; ++m) _Pragma("unroll") for (int n = 0; n < 2; ++n) _Pragma("unroll") for (int k = 0; k < 2; ++k) \
        acc[ai][bj][m][n] = __builtin_amdgcn_mfma_f32_16x16x32_bf16(Bt[n][k], At[m][k], acc[ai][bj][m][n], 0, 0, 0); __builtin_amdgcn_s_setprio(0); } while (0)
#define PG8_WAIT_V(n) asm volatile("s_waitcnt vmcnt(" #n ")" ::: "memory")
#define PG8_WAIT_L(n) asm volatile("s_waitcnt lgkmcnt(" #n ")" ::: "memory")
#define PG8_BAR __builtin_amdgcn_s_barrier()
#define PG8_SCHED __builtin_amdgcn_sched_barrier(0)
    Unit cur, nxt; int ui = 0;
    if (!S.next(0, cur)) return;
    f32x4 acc[2][2][4][2];
#pragma unroll
    for (int a = 0; a < 2; ++a)
#pragma unroll
        for (int b = 0; b < 2; ++b)
#pragma unroll
            for (int m = 0; m < 4; ++m)
#pragma unroll
                for (int n = 0; n < 2; ++n) acc[a][b][m][n] = (f32x4){0.f, 0.f, 0.f, 0.f};
    bf16x8 At[4][2], B0[2][2], B1[2][2];
    const char* cA = S.a_base(cur); const char* cB = S.b_base(cur);
    PG8_STAGE(PG8_SB(0, 0), cB, voffB); PG8_STAGE(PG8_SA(0, 0), cA, voffA); PG8_STAGE(PG8_SB(0, 1), cB + hstep, voffB); PG8_STAGE(PG8_SA(0, 1), cA + hstep, voffA);
    if (wr == 1) PG8_BAR;
    PG8_WAIT_V(4); PG8_BAR;
    PG8_STAGE(PG8_SB(1, 0), cB + kstep, voffB); PG8_STAGE(PG8_SA(1, 0), cA + kstep, voffA); PG8_STAGE(PG8_SB(1, 1), cB + hstep + kstep, voffB);
    PG8_WAIT_V(6); PG8_BAR;
    for (;;) {
        const bool has_next = S.next(ui + 1, nxt);
        const char* nA = has_next ? S.a_base(nxt) : cA; const char* nB = has_next ? S.b_base(nxt) : cB;
        for (int t = 0; t < nt; t += 2) {
            const bool last = (t == nt - 2);
            const char* a1 = cA + (size_t)(t + 1) * kstep;
            const char* a2 = last ? nA : cA + (size_t)(t + 2) * kstep; const char* b2 = last ? nB : cB + (size_t)(t + 2) * kstep;
            const char* a3 = a2 + kstep; const char* b3 = b2 + kstep;
            PG8_LDB(B0, 0, 0); PG8_SCHED; PG8_LDA(At, 0, 0); PG8_STAGE(PG8_SA(1, 1), a1 + hstep, voffA);
            PG8_WAIT_L(8); PG8_BAR; PG8_WAIT_L(0); PG8_MMA(0, 0, At, B0); PG8_BAR; PG8_SCHED;
            PG8_LDB(B1, 0, 1); PG8_STAGE(PG8_SB(0, 0), b2, voffB);
            PG8_BAR; PG8_WAIT_L(0); PG8_MMA(0, 1, At, B1); PG8_BAR;
            PG8_LDA(At, 0, 1); PG8_STAGE(PG8_SA(0, 0), a2, voffA);
            PG8_BAR; PG8_WAIT_L(0); PG8_MMA(1, 0, At, B0); PG8_BAR; PG8_SCHED;
            PG8_STAGE(PG8_SB(0, 1), b2 + hstep, voffB);
            PG8_WAIT_V(6); PG8_BAR; PG8_MMA(1, 1, At, B1); PG8_BAR;
            PG8_LDB(B0, 1, 0); PG8_SCHED; PG8_LDA(At, 1, 0); PG8_STAGE(PG8_SA(0, 1), a2 + hstep, voffA);
            PG8_WAIT_L(8); PG8_BAR; PG8_WAIT_L(0); PG8_MMA(0, 0, At, B0); PG8_BAR; PG8_SCHED;
            PG8_LDB(B1, 1, 1); PG8_STAGE(PG8_SB(1, 0), b3, voffB);
            PG8_BAR; PG8_WAIT_L(0); PG8_MMA(0, 1, At, B1); PG8_BAR;
            PG8_LDA(At, 1, 1); PG8_STAGE(PG8_SA(1, 0), a3, voffA);
            PG8_BAR; PG8_WAIT_L(0); PG8_MMA(1, 0, At, B0); PG8_BAR; PG8_SCHED;
            PG8_STAGE(PG8_SB(1, 1), b3 + hstep, voffB);
            PG8_WAIT_V(6); PG8_BAR; PG8_MMA(1, 1, At, B1); PG8_BAR;
        }
        const bool keep = E(acc, cur, wr, wc, fr, fq);
        if (!has_next) break;
        if (!keep)
#pragma unroll
        for (int a = 0; a < 2; ++a)
#pragma unroll
            for (int b = 0; b < 2; ++b)
#pragma unroll
                for (int m = 0; m < 4; ++m)
#pragma unroll
                    for (int n = 0; n < 2; ++n) acc[a][b][m][n] = (f32x4){0.f, 0.f, 0.f, 0.f};
        cur = nxt; cA = nA; cB = nB; ++ui;
    }
    PG8_WAIT_V(0);
    if (wr == 0) PG8_BAR;
    PG8_BAR;
#undef PG8_SA
#undef PG8_SB
#undef PG8_STAGE
#undef PG8_LDA
#undef PG8_LDB
#undef PG8_MMA
#undef PG8_WAIT_V
#undef PG8_WAIT_L
#undef PG8_BAR
#undef PG8_SCHED
}
}
using pg8::Unit;

struct SchedP1 {
    int G, c; const char* A; const char* Bt;
    __device__ __forceinline__ bool next(int i, Unit& u) const {
        const int L = i * G + c; if (L >= 2192) return false;
        u.br = 0;
        if (L >= 2160) { const int idx = L - 2160; u.pm = 36 + (idx >> 3); u.pn = 60 + (idx & 7); return true; }
        pg8::tile_of(L, 36, 60, u.pm, u.pn); return true;
    }
    __device__ __forceinline__ const char* a_base(const Unit& u) const { return A + (size_t)u.pm * (256 * 2048 * 2); }
    __device__ __forceinline__ const char* b_base(const Unit& u) const { return Bt + (size_t)u.pn * (256 * 2048 * 2); }
};
struct EpiP1 {
    bf16_t* proj; bf16_t* gate; float* F; const float* lb; const float* b_gate; float* out; bf16_t* mkb; bf16_t* mvt;
    __device__ __forceinline__ bool operator()(f32x4 (&acc)[2][2][4][2], const Unit& u, int wr, int wc, int fr, int fq) const {
        const int rloc = wr * 64 + fr, cloc = wc * 32 + 8 * fq;
        if (u.pn < 36) {
            const int seg = u.pn >> 2;
#pragma unroll
            for (int bj = 0; bj < 2; ++bj) {
                const int col = u.pn * 256 + bj * 128 + cloc;
                f32x4 l0 = (f32x4){0.f, 0.f, 0.f, 0.f}, l1 = l0;
                if (seg == 4) { l0 = *(const f32x4*)(lb + (col - C_HF)); l1 = *(const f32x4*)(lb + (col - C_HF) + 4); }
#pragma unroll
                for (int ai = 0; ai < 2; ++ai)
#pragma unroll
                    for (int m = 0; m < 4; ++m) {
                        const size_t row = (size_t)u.pm * 256 + ai * 128 + m * 16 + rloc;
                        f32x4 v0 = acc[ai][bj][m][0], v1 = acc[ai][bj][m][1];
                        if (seg == 4) {
#pragma unroll
                            for (int e = 0; e < 4; ++e) { v0[e] = l0[e] + (1.f - l0[e]) * sigm(v0[e]); v1[e] = l1[e] + (1.f - l1[e]) * sigm(v1[e]); }
                            float* fp = F + row * 1024 + (col - C_HF);
                            *(f32x4*)fp = v0; *(f32x4*)(fp + 4) = v1;
                        } else {
                            if (seg == 1) {
#pragma unroll
                                for (int e = 0; e < 4; ++e) { v0[e] = sigm(v0[e]); v1[e] = sigm(v1[e]); }
                            } else if (seg == 2 || seg == 6 || seg == 8) {
#pragma unroll
                                for (int e = 0; e < 4; ++e) { v0[e] = siluf(v0[e]); v1[e] = siluf(v1[e]); }
                            } else if (seg == 3) { v0 *= 0.08838834764831845f; v1 *= 0.08838834764831845f; }
                            else if (seg == 7) { v0 *= 0.0625f; v1 *= 0.0625f; }
                            u32x4 o; o.x = pk2(v0[0], v0[1]); o.y = pk2(v0[2], v0[3]); o.z = pk2(v1[0], v1[1]); o.w = pk2(v1[2], v1[3]);
                            *(u32x4*)(proj + row * LDP + col) = o;
                        }
                    }
            }
        } else if (u.pn < 60) {
            const int etid = (wr * 4 + wc) * 64 + fq * 16 + fr;
#pragma unroll
            for (int bj = 0; bj < 2; ++bj) {
                const int col = (u.pn - 36) * 256 + bj * 128 + cloc;
                const f32x4 b0 = *(const f32x4*)(b_gate + col), b1 = *(const f32x4*)(b_gate + col + 4);
#pragma unroll
                for (int ai = 0; ai < 2; ++ai)
#pragma unroll
                    for (int m = 0; m < 4; ++m) {
                        const size_t row = (size_t)u.pm * 256 + ai * 128 + m * 16 + rloc;
                        f32x4 v0 = acc[ai][bj][m][0] + b0, v1 = acc[ai][bj][m][1] + b1;
#pragma unroll
                        for (int e = 0; e < 4; ++e) { v0[e] = fmaxf(sigm(v0[e]), 1e-6f); v1[e] = fmaxf(sigm(v1[e]), 1e-6f); }
                        u32x4 o; o.x = pk2(v0[0], v0[1]); o.y = pk2(v0[2], v0[3]); o.z = pk2(v1[0], v1[1]); o.w = pk2(v1[2], v1[3]);
                        *(u32x4*)(gate + ((((size_t)u.pm * 24 + (u.pn - 36)) * 16 + (ai * 8 + m * 2 + bj)) * 512 + etid) * 8) = o;
                    }
            }
        } else {
            const int n = u.pm - 36, isv = (u.pn >= 64) ? 1 : 0, h = (u.pn - 60) & 3;
            float* ob = out + (isv ? O_MV : O_MK);
#pragma unroll
            for (int bj = 0; bj < 2; ++bj) {
                const int d = bj * 128 + cloc;
#pragma unroll
                for (int ai = 0; ai < 2; ++ai)
#pragma unroll
                    for (int m = 0; m < 4; ++m) {
                        const int key = ai * 128 + m * 16 + rloc;
                        const f32x4 v0 = acc[ai][bj][m][0], v1 = acc[ai][bj][m][1];
                        float* op = ob + ((size_t)(n * 256 + key) * 4 + h) * 256 + d;
                        *(f32x4*)op = v0; *(f32x4*)(op + 4) = v1;
                        if (!isv) {
                            u32x4 o; o.x = pk2(v0[0], v0[1]); o.y = pk2(v0[2], v0[3]); o.z = pk2(v1[0], v1[1]); o.w = pk2(v1[2], v1[3]);
                            *(u32x4*)(mkb + ((size_t)(n * 4 + h) * 256 + key) * 256 + d) = o;
                        } else {
                            bf16_t* vp = mvt + ((size_t)(n * 4 + h) * 256 + d) * 256 + key;
#pragma unroll
                            for (int e = 0; e < 4; ++e) { vp[(size_t)e * 256] = (bf16_t)f2bf(v0[e]); vp[(size_t)(e + 4) * 256] = (bf16_t)f2bf(v1[e]); }
                        }
                    }
            }
        }
        return false;
    }
};

struct SchedP4 {
    int G, c; const char* A; const char* Bt;
    __device__ __forceinline__ bool next(int i, Unit& u) const {
        const int tri = i / 3, L = tri * G + c; if (L >= 288) return false;
        u.br = i - tri * 3; pg8::tile_of(L, 36, 8, u.pm, u.pn); return true;
    }
    __device__ __forceinline__ const char* a_base(const Unit& u) const { return A + (size_t)u.br * ((size_t)9216 * 1024 * 2) + (size_t)u.pm * (256 * 1024 * 2); }
    __device__ __forceinline__ const char* b_base(const Unit& u) const { return Bt + (size_t)u.br * ((size_t)2048 * 1024 * 2) + (size_t)u.pn * (256 * 1024 * 2); }
};
struct EpiP4 {
    const bf16_t* gate; bf16_t* merged;
    __device__ __forceinline__ bool operator()(f32x4 (&acc)[2][2][4][2], const Unit& u, int wr, int wc, int fr, int fq) const {
        const int rloc = wr * 64 + fr, cloc = wc * 32 + 8 * fq;
        const int etid = (wr * 4 + wc) * 64 + fq * 16 + fr;
        bf16_t* mbase = merged + tl((size_t)u.pm * 256 + rloc, u.pn * 256 + cloc, 2048);
#pragma unroll
        for (int bj = 0; bj < 2; ++bj) {
            const int col = u.pn * 256 + bj * 128 + cloc;
#pragma unroll
            for (int ai = 0; ai < 2; ++ai)
#pragma unroll
                for (int m = 0; m < 4; ++m) {
                    const size_t row = (size_t)u.pm * 256 + ai * 128 + m * 16 + rloc;
                    const bf16_t* gp = gate + ((((size_t)u.pm * 24 + (u.br * 8 + u.pn)) * 16 + (ai * 8 + m * 2 + bj)) * 512 + etid) * 8;
                    const u32x4 g = *(const u32x4*)gp;
                    f32x4 s0 = (f32x4){bflo(g.x), bfhi(g.x), bflo(g.y), bfhi(g.y)}, s1 = (f32x4){bflo(g.z), bfhi(g.z), bflo(g.w), bfhi(g.w)};
                    if (u.br < 2) {
                        const u32x4 h = *(const u32x4*)(gp + (size_t)8 * 16 * 512 * 8);
                        s0[0] *= __builtin_amdgcn_rcpf(bflo(h.x)); s0[1] *= __builtin_amdgcn_rcpf(bfhi(h.x)); s0[2] *= __builtin_amdgcn_rcpf(bflo(h.y)); s0[3] *= __builtin_amdgcn_rcpf(bfhi(h.y));
                        s1[0] *= __builtin_amdgcn_rcpf(bflo(h.z)); s1[1] *= __builtin_amdgcn_rcpf(bfhi(h.z)); s1[2] *= __builtin_amdgcn_rcpf(bflo(h.w)); s1[3] *= __builtin_amdgcn_rcpf(bfhi(h.w));
                    }
                    acc[ai][bj][m][0] *= s0; acc[ai][bj][m][1] *= s1;
                    if (u.br == 2) { const f32x4 v0 = acc[ai][bj][m][0], v1 = acc[ai][bj][m][1];
                        u32x4 o; o.x = pk2(v0[0], v0[1]); o.y = pk2(v0[2], v0[3]); o.z = pk2(v1[0], v1[1]); o.w = pk2(v1[2], v1[3]);
                        *(u32x4*)(mbase + bj * 32768 + (ai * 128 + m * 16) * 64) = o; }
                }
        }
        return u.br < 2;
    }
};

struct SchedP5 {
    int G, c; const char* A; const char* Bt;
    __device__ __forceinline__ bool next(int i, Unit& u) const {
        const int L = i * G + c; if (L >= 288) return false;
        u.br = 0; pg8::tile_of(L, 36, 8, u.pm, u.pn); return true;
    }
    __device__ __forceinline__ const char* a_base(const Unit& u) const { return A + (size_t)u.pm * (256 * 2048 * 2); }
    __device__ __forceinline__ const char* b_base(const Unit& u) const { return Bt + (size_t)u.pn * (256 * 2048 * 2); }
};
struct EpiP5 {
    const float* xp; const float* xs; float* out;
    __device__ __forceinline__ bool operator()(f32x4 (&acc)[2][2][4][2], const Unit& u, int wr, int wc, int fr, int fq) const {
        const int rloc = wr * 64 + fr, cloc = wc * 32 + 8 * fq;
#pragma unroll
        for (int bj = 0; bj < 2; ++bj) {
            const int col = u.pn * 256 + bj * 128 + cloc;
#pragma unroll
            for (int ai = 0; ai < 2; ++ai)
#pragma unroll
                for (int m = 0; m < 4; ++m) {
                    const size_t row = (size_t)u.pm * 256 + ai * 128 + m * 16 + rloc;
                    const float* xr = (row < (size_t)NTP) ? (xp + row * 2048 + col) : (xs + (row - NTP) * 2048 + col);
                    const f32x4 v0 = acc[ai][bj][m][0] + *(const f32x4*)xr, v1 = acc[ai][bj][m][1] + *(const f32x4*)(xr + 4);
                    float* op = out + row * 2048 + col;
                    *(f32x4*)op = v0; *(f32x4*)(op + 4) = v1;
                }
        }
        return false;
    }
};

struct EpiNull {
    __device__ __forceinline__ bool operator()(f32x4 (&acc)[2][2][4][2], const Unit& u, int wr, int wc, int fr, int fq) const {
        f32x4 t = (f32x4){0.f, 0.f, 0.f, 0.f};
#pragma unroll
        for (int ai = 0; ai < 2; ++ai)
#pragma unroll
            for (int bj = 0; bj < 2; ++bj)
#pragma unroll
                for (int m = 0; m < 4; ++m) t += acc[ai][bj][m][0] + acc[ai][bj][m][1];
        asm volatile("" :: "v"(t[0]), "v"(t[1]), "v"(t[2]), "v"(t[3]));
        return false;
    }
};
#define P0_DESC(it_, W_, WT_, K_, N_, ro_, kb_, nb_) do { int r_ = (it_); \
    if (r_ < 1920) { W_ = p.w_in; WT_ = WT1; K_ = 2048; N_ = 15360; ro_ = 0; kb_ = r_ / 120; nb_ = r_ % 120; } \
    else if (r_ < 2176) { r_ -= 1920; W_ = p.w_mem_kv; WT_ = WT1; K_ = 2048; N_ = 2048; ro_ = 15360; kb_ = r_ >> 4; nb_ = r_ & 15; } \
    else if (r_ < 2304) { r_ -= 2176; W_ = p.w_conv_out; WT_ = WT3; K_ = 1024; N_ = 2048; ro_ = 0; kb_ = r_ >> 4; nb_ = r_ & 15; } \
    else if (r_ < 2432) { r_ -= 2304; W_ = p.w_hgrn_out; WT_ = WT3 + (size_t)2048 * 1024; K_ = 1024; N_ = 2048; ro_ = 0; kb_ = r_ >> 4; nb_ = r_ & 15; } \
    else if (r_ < 2560) { r_ -= 2432; W_ = p.w_attn_out; WT_ = WT3 + (size_t)2 * 2048 * 1024; K_ = 1024; N_ = 2048; ro_ = 0; kb_ = r_ >> 4; nb_ = r_ & 15; } \
    else { r_ -= 2560; W_ = p.w_out; WT_ = WTO; K_ = 2048; N_ = 2048; ro_ = 0; kb_ = r_ >> 4; nb_ = r_ & 15; } } while (0)
__device__ __forceinline__ void p0_prologue(const Params& p, LAS unsigned char* lds) {
    const int tid = threadIdx.x, lane = tid & 63, wave = tid >> 6, G = gridDim.x, c = blockIdx.x;
    LAS unsigned* T32 = (LAS unsigned*)lds;
    constexpr int T_ALL = 1920 + 256 + 3 * 128 + 256;
    const int nq = tid & 31, kp0 = tid >> 5;
    f32x4 r0[4], r1[4];
#define P0_LOAD(W_, N_, kb_, nb_) do { _Pragma("unroll") for (int i = 0; i < 4; ++i) { const int kpair = kp0 + 16 * i; \
        const float* src = (W_) + (size_t)((kb_) * 128 + 2 * kpair) * (N_) + (nb_) * 128 + 4 * nq; r0[i] = *(const f32x4*)src; r1[i] = *(const f32x4*)(src + (N_)); } } while (0)
    bf16_t* WT1 = (bf16_t*)(p.ws + WS_WT1); bf16_t* WT3 = (bf16_t*)(p.ws + WS_WT3); bf16_t* WTO = (bf16_t*)(p.ws + WS_WTO);
    int it = c;
    const float* dW = p.w_in; bf16_t* dWT = WT1; int dK = 2048, dN = 15360, dro = 0, dkb = 0, dnb = 0;
    if (it < T_ALL) { P0_DESC(it, dW, dWT, dK, dN, dro, dkb, dnb); P0_LOAD(dW, dN, dkb, dnb); }
    while (it < T_ALL) {
#pragma unroll
        for (int i = 0; i < 4; ++i) { const int kpair = kp0 + 16 * i;
            T32[(4 * nq + 0) * 65 + kpair] = pk2(r0[i][0], r1[i][0]); T32[(4 * nq + 1) * 65 + kpair] = pk2(r0[i][1], r1[i][1]);
            T32[(4 * nq + 2) * 65 + kpair] = pk2(r0[i][2], r1[i][2]); T32[(4 * nq + 3) * 65 + kpair] = pk2(r0[i][3], r1[i][3]); }
        __syncthreads();
        const int itn = it + G;
        const float* nW = dW; bf16_t* nWT = dWT; int nK = dK, nN = dN, nro = dro, nkb = dkb, nnb = dnb;
        if (itn < T_ALL) { P0_DESC(itn, nW, nWT, nK, nN, nro, nkb, nnb); P0_LOAD(nW, nN, nkb, nnb); }
#pragma unroll
        for (int i = 0; i < 4; ++i) {
            const int id = tid + 512 * i, n = id >> 4, cc = id & 15;
            u32x4 o; o.x = T32[n * 65 + 4 * cc]; o.y = T32[n * 65 + 4 * cc + 1]; o.z = T32[n * 65 + 4 * cc + 2]; o.w = T32[n * 65 + 4 * cc + 3];
            *(u32x4*)(dWT + tl((size_t)(dro + dnb * 128 + n), dkb * 128 + 8 * cc, dK)) = o;
        }
        __syncthreads();
        it = itn; dW = nW; dWT = nWT; dK = nK; dN = nN; dro = nro; dkb = nkb; dnb = nnb;
    }
#undef P0_LOAD
#undef P0_DESC
    bf16_t* HA = (bf16_t*)(p.ws + WS_HA);
    const int gw = c * 8 + wave, NGW = G * 8;
#define P0_ROWPTR(m) ((m) < NTP ? p.x_prompt + (size_t)(m) * 2048 : ((m) < NTOK ? p.x_sample + (size_t)((m) - NTP) * 2048 : p.mem_prompt + (size_t)((m) - NTOK) * 2048))
    f32x4 v[8];
    int m = gw;
    if (m < 10240) { const float* xr = P0_ROWPTR(m);
#pragma unroll
        for (int j = 0; j < 8; ++j) v[j] = ((const f32x4*)xr)[lane + 64 * j]; }
    while (m < 10240) {
        const int mn = m + NGW; f32x4 vn[8];
        if (mn < 10240) { const float* xr = P0_ROWPTR(mn);
#pragma unroll
            for (int j = 0; j < 8; ++j) vn[j] = ((const f32x4*)xr)[lane + 64 * j]; }
        float ss = 0.f;
#pragma unroll
        for (int j = 0; j < 8; ++j) ss += (v[j][0] * v[j][0] + v[j][1] * v[j][1]) + (v[j][2] * v[j][2] + v[j][3] * v[j][3]);
        ss = wave_sum(ss);
        const float rinv = rsqrtf(ss * (1.f / 2048.f) + EPS);
        const float* g = (m < NTOK) ? p.g_pre : p.g_mem;
#pragma unroll
        for (int j = 0; j < 8; ++j) { const f32x4 gg = ((const f32x4*)g)[lane + 64 * j];
            u32x2 o; o.x = pk2(v[j][0] * rinv * gg[0], v[j][1] * rinv * gg[1]); o.y = pk2(v[j][2] * rinv * gg[2], v[j][3] * rinv * gg[3]);
            *(u32x2*)(HA + tl((size_t)m, 4 * (lane + 64 * j), 2048)) = o; }
        if (mn < 10240) {
#pragma unroll
            for (int j = 0; j < 8; ++j) v[j] = vn[j]; }
        m = mn;
    }
#undef P0_ROWPTR
    if (c == 0) { float* LB = (float*)(p.ws + WS_LB);
        for (int i = tid; i < 1024; i += 512) LB[i] = 1.f / (1.f + __expf(p.lb_logits[1024 + i] - p.lb_logits[i])); }
}

__device__ __forceinline__ void hgrn_prompt_item(const Params& p, int item, LAS unsigned char* lds, int tid) {
    LAS float* qs = (LAS float*)lds;
    LAS float* fs = qs + 4096;
    LAS float* vs = fs + 4096;
    LAS float* part = vs + 512;
    const int s = item >> 3, n = s >> 3, h = s & 7, dvg = item & 7;
    const int vcol = tid & 15, kg = tid >> 4;
    const bf16_t* proj = (const bf16_t*)(p.ws + WS_PROJ9);
    const float* F = (const float*)(p.ws + WS_F);
    float* oraw = (float*)(p.ws + WS_ORAW);
    const size_t row0 = (size_t)n * SEQ;
    const bf16_t* qsrc = proj + (row0 + kg) * LDP + C_HQ + h * 128 + vcol * 8;
    const float* fsrc = F + (row0 + kg) * 1024 + h * 128 + vcol * 8;
    const bf16_t* vsrc = proj + (row0 + kg) * LDP + C_HI + h * 128 + dvg * 16 + vcol;
    f32x2 S01 = (f32x2){0.f, 0.f}, S23 = (f32x2){0.f, 0.f};
    u32x4 rq[4]; f32x4 rfa[4], rfb[4]; bf16_t rv[4];
#define HG_FETCH(R, tb) do { const size_t adv = (size_t)(tb); rq[R] = *(const u32x4*)(qsrc + adv * LDP); rfa[R] = *(const f32x4*)(fsrc + adv * 1024); \
        rfb[R] = *(const f32x4*)(fsrc + adv * 1024 + 4); rv[R] = *(vsrc + adv * LDP); } while (0)
#define HG_BATCH(R, tb) do { \
        { LAS float* qd = qs + kg * 128 + vcol * 8; \
          *(LAS f32x4*)qd = (f32x4){bflo(rq[R].x), bfhi(rq[R].x), bflo(rq[R].y), bfhi(rq[R].y)}; *(LAS f32x4*)(qd + 4) = (f32x4){bflo(rq[R].z), bfhi(rq[R].z), bflo(rq[R].w), bfhi(rq[R].w)}; \
          LAS float* fd = fs + kg * 128 + vcol * 8; *(LAS f32x4*)fd = rfa[R]; *(LAS f32x4*)(fd + 4) = rfb[R]; \
          vs[kg * 16 + vcol] = bf2f(rv[R]); } \
        __syncthreads(); \
        if ((tb) + 128 < SEQ) HG_FETCH(R, (tb) + 128); \
        f32x4 cf[4], cq[4]; float cv[4]; \
        _Pragma("unroll") for (int i = 0; i < 4; ++i) { cf[i] = *(const LAS f32x4*)(fs + i * 128 + kg * 4); cq[i] = *(const LAS f32x4*)(qs + i * 128 + kg * 4); cv[i] = vs[i * 16 + vcol]; } \
        _Pragma("unroll") for (int g = 0; g < 8; ++g) { \
            f32x4 nf[4], nq[4]; float nv[4]; \
            if (g < 7) { _Pragma("unroll") for (int i = 0; i < 4; ++i) { const int tt = (g + 1) * 4 + i; \
                nf[i] = *(const LAS f32x4*)(fs + tt * 128 + kg * 4); nq[i] = *(const LAS f32x4*)(qs + tt * 128 + kg * 4); nv[i] = vs[tt * 16 + vcol]; } } \
            _Pragma("unroll") for (int i = 0; i < 4; ++i) { \
                const f32x2 f01 = (f32x2){cf[i][0], cf[i][1]}, f23 = (f32x2){cf[i][2], cf[i][3]}, q01 = (f32x2){cq[i][0], cq[i][1]}, q23 = (f32x2){cq[i][2], cq[i][3]}; \
                const f32x2 vv = (f32x2){cv[i], cv[i]}; \
                S01 = f01 * (S01 - vv) + vv; S23 = f23 * (S23 - vv) + vv; \
                f32x2 t = S01 * q01; t = S23 * q23 + t; \
                part[(g * 4 + i) * 528 + tid] = t[0] + t[1]; } \
            if (g < 7) { _Pragma("unroll") for (int i = 0; i < 4; ++i) { cf[i] = nf[i]; cq[i] = nq[i]; cv[i] = nv[i]; } } } \
        __syncthreads(); \
        { float a = 0.f; \
          _Pragma("unroll 8") for (int k2 = 0; k2 < 32; ++k2) a += part[kg * 528 + k2 * 16 + vcol]; \
          oraw[(row0 + (tb) + kg) * 1024 + h * 128 + dvg * 16 + vcol] = a; } } while (0)
    HG_FETCH(0, 0); HG_FETCH(1, 32); HG_FETCH(2, 64); HG_FETCH(3, 96);
#pragma unroll 1
    for (int t0 = 0; t0 < SEQ; t0 += 128) { HG_BATCH(0, t0); HG_BATCH(1, t0 + 32); HG_BATCH(2, t0 + 64); HG_BATCH(3, t0 + 96); }
#undef HG_FETCH
#undef HG_BATCH
    float* so = p.out + O_HGRN_P + ((size_t)(n * 8 + h) * 128 + kg * 4) * 128 + dvg * 16 + vcol;
    so[0] = S01[0]; so[128] = S01[1]; so[256] = S23[0]; so[384] = S23[1];
    __syncthreads();
}

__device__ __forceinline__ void hgrn_sample_item(const Params& p, int item, LAS unsigned char* lds, int tid) {
    LAS float* qs = (LAS float*)lds;
    LAS float* fs = qs + 1024;
    LAS float* vs = fs + 1024;
    LAS float* opart = vs + 1024;
    const int n = item >> 3, h = item & 7, lane = tid & 63, wave = tid >> 6;
    const bf16_t* proj = (const bf16_t*)(p.ws + WS_PROJ9);
    const float* F = (const float*)(p.ws + WS_F);
    const size_t row0 = (size_t)NTP + (size_t)n * 8;
    { const int tt = tid >> 6, k2 = (tid & 63) * 2; const size_t r = row0 + tt;
      const unsigned qw = *(const unsigned*)(proj + r * LDP + C_HQ + h * 128 + k2); const f32x2 ff = *(const f32x2*)(F + r * 1024 + h * 128 + k2);
      const unsigned vw = *(const unsigned*)(proj + r * LDP + C_HI + h * 128 + k2);
      qs[tt * 128 + k2] = bflo(qw); qs[tt * 128 + k2 + 1] = bfhi(qw); fs[tt * 128 + k2] = ff[0]; fs[tt * 128 + k2 + 1] = ff[1];
      vs[tt * 128 + k2] = bflo(vw); vs[tt * 128 + k2 + 1] = bfhi(vw); }
    const int v4 = tid & 31, kg = tid >> 5;
    const size_t sbase = ((size_t)(n * 8 + h) * 128 + kg * 8) * 128 + v4 * 4;
    f32x4 S[8];
#pragma unroll
    for (int i = 0; i < 8; ++i) S[i] = *(const f32x4*)(p.state_hgrn + sbase + (size_t)i * 128);
    __syncthreads();
#pragma unroll
    for (int tt = 0; tt < 8; ++tt) {
        const f32x4 fa = *(const LAS f32x4*)(fs + tt * 128 + kg * 8), fb = *(const LAS f32x4*)(fs + tt * 128 + kg * 8 + 4);
        const f32x4 qa = *(const LAS f32x4*)(qs + tt * 128 + kg * 8), qb = *(const LAS f32x4*)(qs + tt * 128 + kg * 8 + 4);
        const f32x4 vv = *(const LAS f32x4*)(vs + tt * 128 + v4 * 4);
        f32x4 po = (f32x4){0.f, 0.f, 0.f, 0.f};
#pragma unroll
        for (int i = 0; i < 8; ++i) { const float f = (i < 4) ? fa[i & 3] : fb[i & 3], q = (i < 4) ? qa[i & 3] : qb[i & 3];
            S[i] = S[i] * f + vv * (1.f - f); po += S[i] * q; }
#pragma unroll
        for (int e = 0; e < 4; ++e) po[e] += __shfl_xor(po[e], 32);
        if (lane < 32) *(LAS f32x4*)(opart + (tt * 8 + wave) * 128 + v4 * 4) = po;
    }
    float* so = p.out + O_HGRN_S + sbase;
#pragma unroll
    for (int i = 0; i < 8; ++i) *(f32x4*)(so + (size_t)i * 128) = S[i];
    __syncthreads();
    { const int tt = tid >> 6, v = (tid & 63) * 2; float o0 = 0.f, o1 = 0.f;
#pragma unroll
      for (int w = 0; w < 8; ++w) { const f32x2 t = *(const LAS f32x2*)(opart + (tt * 8 + w) * 128 + v); o0 += t[0]; o1 += t[1]; }
      const float ss = wave_sum(o0 * o0 + o1 * o1), rinv = rsqrtf(ss * (1.f / 128.f) + EPS);
      const size_t r = row0 + tt; const f32x2 gg = *(const f32x2*)(p.g_hgrn + h * 128 + v);
      const unsigned gw = *(const unsigned*)(proj + r * LDP + C_HOG + h * 128 + v);
      bf16_t* og = (bf16_t*)(p.ws + WS_ACT3) + (size_t)9216 * 1024 + tl(r, h * 128 + v, 1024);
      *(unsigned*)og = pk2(o0 * rinv * gg[0] * bflo(gw), o1 * rinv * gg[1] * bfhi(gw)); }
    __syncthreads();
}

__device__ __forceinline__ void hgrn_norm_rows(const Params& p) {
    const int tid = threadIdx.x, lane = tid & 63, gw = blockIdx.x * 8 + (tid >> 6), NGW = gridDim.x * 8;
    const bf16_t* proj = (const bf16_t*)(p.ws + WS_PROJ9); const float* oraw = (const float*)(p.ws + WS_ORAW);
    bf16_t* og = (bf16_t*)(p.ws + WS_ACT3) + (size_t)9216 * 1024;
    for (int r = gw; r < NTP; r += NGW) {
        f32x4 o[4]; float ss = 0.f;
#pragma unroll
        for (int j = 0; j < 4; ++j) { o[j] = *(const f32x4*)(oraw + (size_t)r * 1024 + lane * 16 + j * 4); ss += (o[j][0] * o[j][0] + o[j][1] * o[j][1]) + (o[j][2] * o[j][2] + o[j][3] * o[j][3]); }
        ss += __shfl_xor(ss, 1); ss += __shfl_xor(ss, 2); ss += __shfl_xor(ss, 4);
        const float rinv = rsqrtf(ss * (1.f / 128.f) + EPS);
        const u32x4 ga = *(const u32x4*)(proj + (size_t)r * LDP + C_HOG + lane * 16), gb = *(const u32x4*)(proj + (size_t)r * LDP + C_HOG + lane * 16 + 8);
        f32x4 g[4];
#pragma unroll
        for (int j = 0; j < 4; ++j) g[j] = *(const f32x4*)(p.g_hgrn + lane * 16 + j * 4);
        u32x4 oa, ob;
        oa.x = pk2(o[0][0] * rinv * g[0][0] * bflo(ga.x), o[0][1] * rinv * g[0][1] * bfhi(ga.x)); oa.y = pk2(o[0][2] * rinv * g[0][2] * bflo(ga.y), o[0][3] * rinv * g[0][3] * bfhi(ga.y));
        oa.z = pk2(o[1][0] * rinv * g[1][0] * bflo(ga.z), o[1][1] * rinv * g[1][1] * bfhi(ga.z)); oa.w = pk2(o[1][2] * rinv * g[1][2] * bflo(ga.w), o[1][3] * rinv * g[1][3] * bfhi(ga.w));
        ob.x = pk2(o[2][0] * rinv * g[2][0] * bflo(gb.x), o[2][1] * rinv * g[2][1] * bfhi(gb.x)); ob.y = pk2(o[2][2] * rinv * g[2][2] * bflo(gb.y), o[2][3] * rinv * g[2][3] * bfhi(gb.y));
        ob.z = pk2(o[3][0] * rinv * g[3][0] * bflo(gb.z), o[3][1] * rinv * g[3][1] * bfhi(gb.z)); ob.w = pk2(o[3][2] * rinv * g[3][2] * bflo(gb.w), o[3][3] * rinv * g[3][3] * bfhi(gb.w));
        *(u32x4*)(og + tl((size_t)r, lane * 16, 1024)) = oa; *(u32x4*)(og + tl((size_t)r, lane * 16 + 8, 1024)) = ob;
    }
}

template <bool SAMPLE>
__device__ __forceinline__ void conv_item(const Params& p, int item, LAS unsigned char* lds, int tid) {
    constexpr int T = SAMPLE ? 8 : 32;
    constexpr int GP = 4, NG = (T + 32) / GP, G0 = 32 / GP;
    LAS float* dcs = (LAS float*)lds;
    const bf16_t* proj = (const bf16_t*)(p.ws + WS_PROJ9);
    const int n = SAMPLE ? item : (item >> 6), t0 = SAMPLE ? 0 : (item & 63) * 32;
    const size_t rowb = SAMPLE ? ((size_t)NTP + (size_t)n * 8) : ((size_t)n * SEQ);
    const int c0 = 2 * tid;
    float w0[31], w1[31], x0[31], x1[31];
#pragma unroll
    for (int j = 0; j < 31; ++j) { const f32x2 w = *(const f32x2*)(p.conv_w + j * 1024 + c0); w0[j] = w[0]; w1[j] = w[1]; x0[j] = 0.f; x1[j] = 0.f; }
    const f32x2 bias = *(const f32x2*)(p.conv_b + c0);
    unsigned ra[GP], rg[GP];
#define CONV_ISSUE(g) do { \
        if (SAMPLE && (g) < G0) { _Pragma("unroll") for (int i = 0; i < GP; ++i) { const int ti = -2 + GP * (g) + i; \
            const unsigned* tp = (const unsigned*)(p.state_conv + ((size_t)n * 30 + (ti < 0 ? 0 : ti)) * 1024 + c0); ra[i] = tp[0]; rg[i] = tp[1]; } } \
        else { _Pragma("unroll") for (int i = 0; i < GP; ++i) { const int t = t0 - 32 + GP * (g) + i; const bf16_t* rp = proj + (rowb + (t < 0 ? 0 : t)) * LDP + c0; \
            ra[i] = *(const unsigned*)(rp + C_CV); rg[i] = *(const unsigned*)(rp + C_CG); } } } while (0)
    CONV_ISSUE(0);
#pragma unroll 1
    for (int g = 0; g < NG; ++g) {
        float u0[GP], u1[GP];
        if (SAMPLE && g < G0) {
#pragma unroll
            for (int i = 0; i < GP; ++i) { const bool ok = (-2 + GP * g + i) >= 0; u0[i] = ok ? __builtin_bit_cast(float, ra[i]) : 0.f; u1[i] = ok ? __builtin_bit_cast(float, rg[i]) : 0.f; }
        } else {
#pragma unroll
            for (int i = 0; i < GP; ++i) { const bool ok = (t0 - 32 + GP * g + i) >= 0; u0[i] = ok ? bflo(ra[i]) * bflo(rg[i]) : 0.f; u1[i] = ok ? bfhi(ra[i]) * bfhi(rg[i]) : 0.f; }
        }
        if (g + 1 < NG) CONV_ISSUE(g + 1);
#pragma unroll
        for (int i = 0; i < GP; ++i) {
            const int pp = -32 + GP * g + i, t = t0 + pp;
            if (SAMPLE) { if (pp >= -22) *(f32x2*)(p.out + O_CONV_S + ((size_t)n * 30 + (pp + 22)) * 1024 + c0) = (f32x2){u0[i], u1[i]}; }
            else { if (t >= SEQ - 30) *(f32x2*)(p.out + O_CONV_P + ((size_t)n * 30 + (t - (SEQ - 30))) * 1024 + c0) = (f32x2){u0[i], u1[i]}; }
#pragma unroll
            for (int j = 0; j < 30; ++j) { x0[j] = x0[j + 1]; x1[j] = x1[j + 1]; }
            x0[30] = u0[i]; x1[30] = u1[i];
            if (g >= G0) {
                float d0 = bias[0], d1 = bias[1];
#pragma unroll
                for (int j = 0; j < 31; ++j) { d0 += w0[j] * x0[j]; d1 += w1[j] * x1[j]; }
                *(LAS f32x2*)(dcs + (pp) * 1024 + c0) = (f32x2){d0, d1};
            }
        }
    }
#undef CONV_ISSUE
    __syncthreads();
    { const int lane = tid & 63, wave = tid >> 6;
      bf16_t* aact = (bf16_t*)(p.ws + WS_ACT3);
      for (int pp = wave; pp < T; pp += 8) {
          f32x4 v[4]; float s = 0.f;
#pragma unroll
          for (int j = 0; j < 4; ++j) { v[j] = *(const LAS f32x4*)(dcs + pp * 1024 + j * 256 + lane * 4); s += (v[j][0] + v[j][1]) + (v[j][2] + v[j][3]); }
          const float mean = wave_sum(s) * (1.f / 1024.f); float s2 = 0.f;
#pragma unroll
          for (int j = 0; j < 4; ++j) { v[j] = v[j] - mean; s2 += (v[j][0] * v[j][0] + v[j][1] * v[j][1]) + (v[j][2] * v[j][2] + v[j][3] * v[j][3]); }
          const float rstd = rsqrtf(wave_sum(s2) * (1.f / 1024.f) + EPS);
          const size_t r = rowb + t0 + pp;
          bf16_t* arow = aact + tl(r, lane * 4, 1024);
#pragma unroll
          for (int j = 0; j < 4; ++j) { const int c = j * 256 + lane * 4;
              const f32x4 lg = *(const f32x4*)(p.ln_g + c), lbv = *(const f32x4*)(p.ln_b + c);
              const u32x2 sg = *(const u32x2*)(proj + r * LDP + C_CS + c);
              const float y0 = siluf(v[j][0] * rstd * lg[0] + lbv[0]) * bflo(sg.x), y1 = siluf(v[j][1] * rstd * lg[1] + lbv[1]) * bfhi(sg.x);
              const float y2 = siluf(v[j][2] * rstd * lg[2] + lbv[2]) * bflo(sg.y), y3 = siluf(v[j][3] * rstd * lg[3] + lbv[3]) * bfhi(sg.y);
              u32x2 o; o.x = pk2(y0, y1); o.y = pk2(y2, y3);
              *(u32x2*)(arow + j * 65536) = o; }
      } }
    __syncthreads();
}

__device__ __forceinline__ void attn_prompt_item(const Params& p, int item, LAS unsigned char* lds, int tid) {
    const int lane = tid & 63, wave = tid >> 6, l15 = lane & 15, quad = lane >> 4;
    const int n = item >> 6, h = (item >> 4) & 3, qt = item & 15;
    const bf16_t* proj = (const bf16_t*)(p.ws + WS_PROJ9);
    const bf16_t* kb = (const bf16_t*)(p.ws + WS_MKB) + (size_t)(n * 4 + h) * 65536;
    const bf16_t* vt = (const bf16_t*)(p.ws + WS_MVT) + (size_t)(n * 4 + h) * 65536;
    const size_t qrow = (size_t)n * SEQ + qt * 128 + wave * 16 + l15;
    u32x4 st[16];
#pragma unroll
    for (int i = 0; i < 16; ++i) st[i] = *(const u32x4*)(kb + (size_t)(tid + 512 * i) * 8);
    bf16x8 qf[8];
#pragma unroll
    for (int s = 0; s < 8; ++s) qf[s] = *(const bf16x8*)(proj + qrow * LDP + C_AQ + h * 256 + s * 32 + quad * 8);
#pragma unroll
    for (int i = 0; i < 16; ++i) { const int id = tid + 512 * i, r = id >> 5, c = id & 31; *(LAS u32x4*)(lds + r * 512 + ((c ^ (r & 15)) * 16)) = st[i]; }
    __syncthreads();
    f32x4 sc[16];
#pragma unroll
    for (int T = 0; T < 16; ++T) {
        sc[T] = (f32x4){0.f, 0.f, 0.f, 0.f};
        const LAS unsigned char* kr = lds + (T * 16 + l15) * 512;
#pragma unroll
        for (int s = 0; s < 8; ++s) { const bf16x8 a = *(const LAS bf16x8*)(kr + (((s * 4 + quad) ^ l15) * 16)); sc[T] = __builtin_amdgcn_mfma_f32_16x16x32_bf16(a, qf[s], sc[T], 0, 0, 0); }
    }
#pragma unroll
    for (int i = 0; i < 16; ++i) st[i] = *(const u32x4*)(vt + (size_t)(tid + 512 * i) * 8);
    __syncthreads();
    float mx = -3.0e38f;
#pragma unroll
    for (int T = 0; T < 16; ++T) mx = fmaxf(mx, fmaxf(fmaxf(sc[T][0], sc[T][1]), fmaxf(sc[T][2], sc[T][3])));
    mx = fmaxf(mx, __shfl_xor(mx, 16)); mx = fmaxf(mx, __shfl_xor(mx, 32));
    float sum = 0.f;
#pragma unroll
    for (int T = 0; T < 16; ++T) {
#pragma unroll
        for (int e = 0; e < 4; ++e) { sc[T][e] = __expf(sc[T][e] - mx); sum += sc[T][e]; } }
    sum += __shfl_xor(sum, 16); sum += __shfl_xor(sum, 32);
    const float rs = 1.f / sum;
    bf16x8 pb[8];
#pragma unroll
    for (int s2 = 0; s2 < 8; ++s2) {
        u32x4 w; w.x = pk2(sc[2 * s2][0], sc[2 * s2][1]); w.y = pk2(sc[2 * s2][2], sc[2 * s2][3]); w.z = pk2(sc[2 * s2 + 1][0], sc[2 * s2 + 1][1]); w.w = pk2(sc[2 * s2 + 1][2], sc[2 * s2 + 1][3]);
        pb[s2] = __builtin_bit_cast(bf16x8, w);
    }
#pragma unroll
    for (int i = 0; i < 16; ++i) { const int id = tid + 512 * i, r = id >> 5, c = id & 31; *(LAS u32x4*)(lds + r * 512 + ((c ^ (r & 15)) * 16)) = st[i]; }
    __syncthreads();
    bf16_t* aog_row = (bf16_t*)(p.ws + WS_ACT3) + (size_t)2 * 9216 * 1024 + tl(qrow, h * 256 + quad * 4, 1024);
    f32x4 oacc[16];
#pragma unroll
    for (int Tv = 0; Tv < 16; ++Tv) {
        oacc[Tv] = (f32x4){0.f, 0.f, 0.f, 0.f};
        const LAS unsigned char* vr = lds + (Tv * 16 + l15) * 512 + (quad & 1) * 8;
#pragma unroll
        for (int s2 = 0; s2 < 8; ++s2) {
            const int ch = 4 * s2 + (quad >> 1);
            const u32x2 lo = *(const LAS u32x2*)(vr + ((ch ^ l15) * 16)), hi = *(const LAS u32x2*)(vr + (((ch + 2) ^ l15) * 16));
            u32x4 w; w.x = lo.x; w.y = lo.y; w.z = hi.x; w.w = hi.y;
            oacc[Tv] = __builtin_amdgcn_mfma_f32_16x16x32_bf16(__builtin_bit_cast(bf16x8, w), pb[s2], oacc[Tv], 0, 0, 0);
        }
    }
#pragma unroll
    for (int Tv = 0; Tv < 16; ++Tv) {
        const int dv = Tv * 16 + quad * 4;
        const u32x2 sg = *(const u32x2*)(proj + qrow * LDP + C_AS + h * 256 + dv);
        u32x2 o; o.x = pk2(oacc[Tv][0] * rs * bflo(sg.x), oacc[Tv][1] * rs * bfhi(sg.x)); o.y = pk2(oacc[Tv][2] * rs * bflo(sg.y), oacc[Tv][3] * rs * bfhi(sg.y));
        *(u32x2*)(aog_row + (Tv >> 2) * 16384 + (Tv & 3) * 16) = o;
    }
    __syncthreads();
}

__device__ __forceinline__ void attn_sample_item(const Params& p, int item, LAS unsigned char* lds, int tid) {
    LAS float* Ssh = (LAS float*)lds;
    LAS float* Psh = Ssh + 2048;
    LAS float* Opart = Psh + 2048;
    const int lane = tid & 63, wave = tid >> 6, l15 = lane & 15, quad = lane >> 4;
    const int n = item >> 2, h = item & 3;
    const bf16_t* proj = (const bf16_t*)(p.ws + WS_PROJ9);
    const size_t row0 = (size_t)NTP + (size_t)n * 8;
    const float* kc = p.cache_k + ((size_t)n * 256 * 4 + h) * 256;
    const float* vc = p.cache_v + ((size_t)n * 256 * 4 + h) * 256;
    {
        bf16x8 qf[8];
        const size_t qrow = row0 + (lane & 7);
#pragma unroll
        for (int s = 0; s < 8; ++s) qf[s] = *(const bf16x8*)(proj + qrow * LDP + C_AQ + h * 256 + s * 32 + quad * 8);
#pragma unroll
        for (int tl = 0; tl < 2; ++tl) {
            const int T = wave * 2 + tl;
            f32x4 sc = (f32x4){0.f, 0.f, 0.f, 0.f};
            const float* kr = kc + (size_t)(T * 16 + l15) * 1024 + quad * 8;
#pragma unroll
            for (int s = 0; s < 8; ++s) {
                const f32x4 k0 = *(const f32x4*)(kr + s * 32), k1 = *(const f32x4*)(kr + s * 32 + 4);
                u32x4 w; w.x = pk2(k0[0], k0[1]); w.y = pk2(k0[2], k0[3]); w.z = pk2(k1[0], k1[1]); w.w = pk2(k1[2], k1[3]);
                sc = __builtin_amdgcn_mfma_f32_16x16x32_bf16(__builtin_bit_cast(bf16x8, w), qf[s], sc, 0, 0, 0);
            }
            if (l15 < 8) {
#pragma unroll
                for (int e = 0; e < 4; ++e) Ssh[l15 * 256 + T * 16 + quad * 4 + e] = sc[e];
            }
        }
    }
    __syncthreads();
    {
        const f32x4 s4 = *(const LAS f32x4*)(Ssh + wave * 256 + lane * 4);
        const float mx = wave_max(fmaxf(fmaxf(s4[0], s4[1]), fmaxf(s4[2], s4[3])));
        f32x4 e4; e4[0] = __expf(s4[0] - mx); e4[1] = __expf(s4[1] - mx); e4[2] = __expf(s4[2] - mx); e4[3] = __expf(s4[3] - mx);
        const float rs = 1.f / wave_sum((e4[0] + e4[1]) + (e4[2] + e4[3]));
#pragma unroll
        for (int e = 0; e < 4; ++e) Psh[(lane * 4 + e) * 8 + wave] = e4[e] * rs;
    }
    __syncthreads();
    {
        f32x4 acc[8];
#pragma unroll
        for (int q = 0; q < 8; ++q) acc[q] = (f32x4){0.f, 0.f, 0.f, 0.f};
        const float* vr = vc + (size_t)(wave * 32) * 1024 + lane * 4;
#pragma unroll 8
        for (int kk = 0; kk < 32; ++kk) {
            const f32x4 v4 = *(const f32x4*)(vr + (size_t)kk * 1024);
            const f32x4 pa = *(const LAS f32x4*)(Psh + (wave * 32 + kk) * 8), pb = *(const LAS f32x4*)(Psh + (wave * 32 + kk) * 8 + 4);
            acc[0] += v4 * pa[0]; acc[1] += v4 * pa[1]; acc[2] += v4 * pa[2]; acc[3] += v4 * pa[3];
            acc[4] += v4 * pb[0]; acc[5] += v4 * pb[1]; acc[6] += v4 * pb[2]; acc[7] += v4 * pb[3];
        }
#pragma unroll
        for (int q = 0; q < 8; ++q) *(LAS f32x4*)(Opart + (wave * 8 + q) * 256 + lane * 4) = acc[q];
    }
    __syncthreads();
    {
        f32x4 o = (f32x4){0.f, 0.f, 0.f, 0.f};
#pragma unroll
        for (int w = 0; w < 8; ++w) o += *(const LAS f32x4*)(Opart + (w * 8 + wave) * 256 + lane * 4);
        const size_t r = row0 + wave;
        const u32x2 sg = *(const u32x2*)(proj + r * LDP + C_AS + h * 256 + lane * 4);
        u32x2 ov; ov.x = pk2(o[0] * bflo(sg.x), o[1] * bfhi(sg.x)); ov.y = pk2(o[2] * bflo(sg.y), o[3] * bfhi(sg.y));
        bf16_t* aog = (bf16_t*)(p.ws + WS_ACT3) + (size_t)2 * 9216 * 1024;
        *(u32x2*)(aog + tl(r, h * 256 + lane * 4, 1024)) = ov;
    }
    __syncthreads();
}

__device__ __forceinline__ void p2_mixers(const Params& p, LAS unsigned char* lds) {
    const int tid = threadIdx.x, G = gridDim.x, c = blockIdx.x, mask = p.pad;
    if ((mask & 1) && !(c & 1)) for (int it = c; it < 256; it += G) hgrn_prompt_item(p, it, lds, tid);
    if (mask & 2) { for (int it = c; it < 256; it += G) conv_item<false>(p, it, lds, tid);
                    for (int it = c; it < 128; it += G) conv_item<true>(p, it, lds, tid); }
    if (mask & 4) for (int it = c; it < 256; it += G) attn_prompt_item(p, it, lds, tid);
    if (mask & 8) for (int it = c; it < 512; it += G) attn_sample_item(p, it, lds, tid);
    if (mask & 16) for (int it = c; it < 1024; it += G) hgrn_sample_item(p, it, lds, tid);
    if ((mask & 1) && (c & 1)) for (int it = c; it < 256; it += G) hgrn_prompt_item(p, it, lds, tid);
}

__device__ __forceinline__ void p6_final_norm(const Params& p) {
    const int tid = threadIdx.x, lane = tid & 63, gw = blockIdx.x * 8 + (tid >> 6), NGW = gridDim.x * 8;
    for (int r = gw; r < NTOK; r += NGW) {
        float* zr = p.out + (size_t)r * 2048;
        f32x4 v[8]; float ss = 0.f;
#pragma unroll
        for (int j = 0; j < 8; ++j) { v[j] = ((const f32x4*)zr)[lane + 64 * j]; ss += (v[j][0] * v[j][0] + v[j][1] * v[j][1]) + (v[j][2] * v[j][2] + v[j][3] * v[j][3]); }
        ss = wave_sum(ss);
        const float rinv = rsqrtf(ss * (1.f / 2048.f) + EPS);
#pragma unroll
        for (int j = 0; j < 8; ++j) { const f32x4 gg = ((const f32x4*)p.g_final)[lane + 64 * j]; ((f32x4*)zr)[lane + 64 * j] = v[j] * rinv * gg; }
    }
}

#define XB_TMO      128
#define XB_XCNT(j)  (256  + 64 * (j))
#define XB_XSUB(j)  (1280 + 64 * (j))
#define XB_XGEN(j)  (2304 + 64 * (j))
#define XB_TOP      3328
#define XB_TOPGEN   3392
#define XCD_BAR_WORDS 3456
#define XB_SPIN_CAP (1u << 18)
__device__ __forceinline__ unsigned xb_ld(unsigned* p)              { return __hip_atomic_load(p, __ATOMIC_RELAXED, __HIP_MEMORY_SCOPE_AGENT); }
__device__ __forceinline__ unsigned xb_add(unsigned* p, unsigned v) { return __hip_atomic_fetch_add(p, v, __ATOMIC_RELAXED, __HIP_MEMORY_SCOPE_AGENT); }
__device__ __forceinline__ unsigned xb_xcc_id() { return (unsigned)__builtin_amdgcn_s_getreg((3 << 11) | 20) & 0xFu; }
#define XB_SPIN(cond, bar) do { unsigned _sp = 0; while (cond) { __builtin_amdgcn_s_sleep(1); \
    if ((++_sp & 255u) == 0u) { if (xb_ld(&(bar)[XB_TMO])) break; if (_sp > XB_SPIN_CAP) { atomicAdd(&(bar)[XB_TMO], 1u); break; } } } } while (0)
struct XcdBarrier { unsigned* bar; unsigned x; volatile LAS unsigned* st; };
__device__ __forceinline__ XcdBarrier xcd_barrier_post(unsigned* bar, volatile LAS unsigned* st) {
    XcdBarrier b; b.bar = bar; b.x = xb_xcc_id(); b.st = st;
    if (threadIdx.x == 0) (void)xb_add(&bar[XB_XCNT(b.x)], 1u);
    return b;
}
__device__ __forceinline__ void xcd_barrier_complete(unsigned* bar, unsigned x, unsigned& nloc, unsigned& nx) {
    const unsigned G = gridDim.x * gridDim.y * gridDim.z;
    unsigned sum, cnt, mine, sp = 0u;
    for (;;) {
        sum = 0u; cnt = 0u; mine = 0u;
#pragma unroll
        for (unsigned j = 0; j < 16; ++j) { const unsigned c = xb_ld(&bar[XB_XCNT(j)]); sum += c; cnt += (c > 0u) ? 1u : 0u; mine = (j == x) ? c : mine; }
        if (sum == G) break;
        __builtin_amdgcn_s_sleep(1);
        if ((++sp & 255u) == 0u) { if (xb_ld(&bar[XB_TMO])) break; if (sp > XB_SPIN_CAP) { atomicAdd(&bar[XB_TMO], 1u); break; } }
    }
    nloc = mine > 0u ? mine : 1u; nx = cnt > 0u ? cnt : 1u;
}
__device__ __forceinline__ void xcd_barrier(unsigned* bar, unsigned bx, volatile LAS unsigned* st) {
    asm volatile("s_waitcnt vmcnt(0)" ::: "memory");
    __syncthreads();
    if (threadIdx.x == 0) {
        __builtin_amdgcn_s_waitcnt(0);
        unsigned nloc = st[0], nx = st[1];
        if (nloc == 0u) { xcd_barrier_complete(bar, bx, nloc, nx); st[0] = nloc; st[1] = nx; }
        const unsigned old = xb_add(&bar[XB_XSUB(bx)], 1u);
        const unsigned gen = old / nloc;
        if (old + 1u == (gen + 1u) * nloc) {
            __builtin_amdgcn_fence(__ATOMIC_RELEASE, "agent");
            asm volatile("s_waitcnt vmcnt(0)" ::: "memory");
            const unsigned og = xb_add(&bar[XB_TOP], 1u);
            const unsigned tg = og / nx;
            if (og + 1u == (tg + 1u) * nx) xb_add(&bar[XB_TOPGEN], 1u);
            else XB_SPIN(xb_ld(&bar[XB_TOPGEN]) == tg, bar);
            __builtin_amdgcn_fence(__ATOMIC_ACQUIRE, "agent");
            xb_add(&bar[XB_XGEN(bx)], 1u);
            asm volatile("s_waitcnt vmcnt(0)" ::: "memory");
        } else {
            XB_SPIN(xb_ld(&bar[XB_XGEN(bx)]) == gen, bar);
            __builtin_amdgcn_fence(__ATOMIC_ACQUIRE, "agent");
            asm volatile("s_waitcnt vmcnt(0)" ::: "memory");
        }
    }
    __syncthreads();
}

__global__ void __launch_bounds__(512, 2) fwd_megakernel(Params p) {
    extern __shared__ __attribute__((aligned(16))) unsigned char shm[];
    LAS unsigned char* lds = (LAS unsigned char*)shm;
    cg::grid_group grid = cg::this_grid();
    const int G = gridDim.x, c = blockIdx.x;
    volatile LAS unsigned* xst = (volatile LAS unsigned*)(lds + LDS_PHASE_BYTES);
    unsigned* xbar = (unsigned*)(p.ws + WS_BAR); unsigned xbx = 0u;
    if (p.coop) { if (threadIdx.x == 0) { xst[0] = 0u; xst[1] = 0u; } __syncthreads(); const XcdBarrier xb = xcd_barrier_post(xbar, xst); xbx = xb.x;
        grid.sync(); }
#define SEAM(ph) do { if (p.coop && (ph) + 1 < p.ph_hi) xcd_barrier(xbar, xbx, xst); } while (0)
#define RUNS(ph) (p.ph_lo <= (ph) && (ph) < p.ph_hi)
    if (RUNS(0)) { p0_prologue(p, lds); SEAM(0); }
    if (RUNS(1)) {
        SchedP1 S; S.G = G; S.c = c; S.A = (const char*)(p.ws + WS_HA); S.Bt = (const char*)(p.ws + WS_WT1);
        EpiP1 E; E.proj = (bf16_t*)(p.ws + WS_PROJ9); E.gate = (bf16_t*)(p.ws + WS_GATE); E.F = (float*)(p.ws + WS_F); E.lb = (const float*)(p.ws + WS_LB);
        E.b_gate = p.b_gate; E.out = p.out; E.mkb = (bf16_t*)(p.ws + WS_MKB); E.mvt = (bf16_t*)(p.ws + WS_MVT);
        pg8::gemm_phase(lds, 2048, S, E); SEAM(1);
    }
    if (RUNS(2)) { p2_mixers(p, lds); SEAM(2); }
    if (RUNS(3)) { hgrn_norm_rows(p); SEAM(3); }
    if (RUNS(4)) {
        SchedP4 S; S.G = G; S.c = c; S.A = (const char*)(p.ws + WS_ACT3); S.Bt = (const char*)(p.ws + WS_WT3);
        EpiP4 E; E.gate = (const bf16_t*)(p.ws + WS_GATE); E.merged = (bf16_t*)(p.ws + WS_MERGED);
        pg8::gemm_phase(lds, 1024, S, E); SEAM(4);
    }
    if (RUNS(5)) {
        SchedP5 S; S.G = G; S.c = c; S.A = (const char*)(p.ws + WS_MERGED); S.Bt = (const char*)(p.ws + WS_WTO);
        EpiP5 E; E.xp = p.x_prompt; E.xs = p.x_sample; E.out = p.out;
        pg8::gemm_phase(lds, 2048, S, E); SEAM(5);
    }
    if (RUNS(6)) { p6_final_norm(p); }
#undef RUNS
#undef SEAM
}

extern "C" void kernel_launch(void* const* d_in, const int* in_sizes, int n_in, void* d_out, int out_size, void* d_ws, size_t ws_size, hipStream_t stream) {
    static int grid = 0;
    if (grid == 0) {
        if (n_in != 23 || ws_size < WS_END) { fprintf(stderr, "kernel_launch: expected 23 inputs and >= %zu bytes of workspace, got %d / %zu\n", (size_t)WS_END, n_in, ws_size); grid = -1; return; }
        int dev = 0, cus = 0, per_cu = 0;
        hipGetDevice(&dev); hipDeviceGetAttribute(&cus, hipDeviceAttributeMultiprocessorCount, dev);
        if (hipFuncSetAttribute((const void*)fwd_megakernel, hipFuncAttributeMaxDynamicSharedMemorySize, LDS_BYTES) != hipSuccess) { fprintf(stderr, "kernel_launch: hipFuncSetAttribute failed\n"); grid = -1; return; }
        if (hipOccupancyMaxActiveBlocksPerMultiprocessor(&per_cu, (const void*)fwd_megakernel, 512, LDS_BYTES) != hipSuccess || per_cu < 1) { fprintf(stderr, "kernel_launch: occupancy query failed (%d)\n", per_cu); (void)hipGetLastError(); per_cu = 1; }
        grid = cus * 1;
        if (grid <= 0) grid = 256;
    }
    if (grid < 0) return;
    Params p{};
    const float** pp = (const float**)&p;
    for (int i = 0; i < 23; ++i) pp[i] = (const float*)d_in[i];
    p.out = (float*)d_out; p.ws = (unsigned char*)d_ws; p.pad = 31;
#if N_LAUNCH_MODE == 1
    p.ph_lo = 0; p.ph_hi = N_PHASES; p.coop = 1;
    if (hipMemsetAsync((char*)d_ws + WS_BAR, 0, WS_BAR_BYTES, stream) != hipSuccess) { fprintf(stderr, "kernel_launch: memset of the barrier words failed\n"); return; }
    void* args[] = {&p};
    hipError_t e = hipLaunchCooperativeKernel((const void*)fwd_megakernel, dim3(grid), dim3(512), args, LDS_BYTES, stream);
    if (e != hipSuccess) fprintf(stderr, "cooperative launch failed: %s (grid %d)\n", hipGetErrorString(e), grid);
#else
    for (int ph = 0; ph < N_PHASES; ++ph) {
        p.ph_lo = ph; p.ph_hi = ph + 1; p.coop = 0;
        hipLaunchKernelGGL(fwd_megakernel, dim3(grid), dim3(512), LDS_BYTES, stream, p);
        if ((REP_MASK >> ph) & 1) { if (ph == 2) p.pad = P2_SUBMASK; hipLaunchKernelGGL(fwd_megakernel, dim3(grid), dim3(512), LDS_BYTES, stream, p); p.pad = 31; }
    }
#endif
}
```

```cpp
#include <hip/hip_runtime.h>
#include <hip/hip_cooperative_groups.h>
#include <cstdio>
namespace cg = cooperative_groups;

#define LAS __attribute__((address_space(3)))
typedef unsigned short bf16_t;
typedef short bf16x8 __attribute__((ext_vector_type(8)));
typedef float f32x4 __attribute__((ext_vector_type(4)));
typedef float f32x2 __attribute__((ext_vector_type(2)));
typedef unsigned u32x4 __attribute__((ext_vector_type(4)));
typedef unsigned u32x2 __attribute__((ext_vector_type(2)));

#ifndef REP_MASK
#define REP_MASK 0
#endif
#ifndef P2_SUBMASK
#define P2_SUBMASK 31
#endif
#ifndef N_LAUNCH_MODE
#define N_LAUNCH_MODE 1
#endif

constexpr int DM = 2048, NTP = 8192, NTS = 1024, NTOK = 9216, SEQ = 2048;
constexpr int LDP = 9216;
constexpr int C_CV = 0, C_CG = 1024, C_CS = 2048, C_HQ = 3072, C_HF = 4096, C_HI = 5120, C_HOG = 6144, C_AQ = 7168, C_AS = 8192;
constexpr int LDG = 6144;
constexpr float EPS = 1e-6f;
constexpr size_t O_YP = 0, O_YS = 16777216, O_CONV_P = 18874368, O_HGRN_P = 18997248, O_MK = 19521536, O_MV = 20570112, O_CONV_S = 21618688, O_HGRN_S = 25550848;
constexpr size_t WS_WT1 = 0;
constexpr size_t WS_WT3 = WS_WT1 + (size_t)17408 * 2048 * 2;
constexpr size_t WS_WTO = WS_WT3 + (size_t)3 * 2048 * 1024 * 2;
constexpr size_t WS_HA = WS_WTO + (size_t)2048 * 2048 * 2;
constexpr size_t WS_ORAW = WS_HA;
constexpr size_t WS_ST = WS_HA;
constexpr size_t WS_DD = WS_HA + (size_t)33554432;
constexpr size_t WS_UT = WS_WT1;
constexpr size_t WS_PROJ9 = WS_HA + (size_t)10240 * 2048 * 2;
constexpr size_t WS_MF = WS_PROJ9;
constexpr size_t WS_MERGED = WS_MF + (size_t)9216 * 2048 * 4;
constexpr size_t WS_GATE = WS_PROJ9 + (size_t)9216 * 9216 * 2;
constexpr size_t WS_F = WS_GATE + (size_t)9216 * 6144 * 2;
constexpr size_t WS_MKB = WS_F + (size_t)9216 * 1024 * 4;
constexpr size_t WS_MVT = WS_MKB + (size_t)2097152;
constexpr size_t WS_ACT3 = WS_MVT + (size_t)2097152;
constexpr size_t WS_LB = WS_ACT3 + (size_t)3 * 9216 * 1024 * 2;
constexpr size_t WS_BAR = WS_LB + 4096;
constexpr size_t WS_BAR_BYTES = 16384;
constexpr size_t WS_END = WS_BAR + WS_BAR_BYTES;
constexpr int LDS_PHASE_BYTES = 131072, LDS_BYTES = LDS_PHASE_BYTES + 64;
constexpr int N_PHASES = 9;

struct Params {
    const float *x_prompt, *x_sample, *state_conv, *state_hgrn, *cache_k, *cache_v, *mem_prompt, *g_pre, *w_in, *conv_w, *conv_b, *ln_g, *ln_b,
        *w_conv_out, *lb_logits, *g_hgrn, *w_hgrn_out, *g_mem, *w_mem_kv, *w_attn_out, *b_gate, *w_out, *g_final;
    float* out; unsigned char* ws; int ph_lo, ph_hi, coop, pad;
};

__device__ __forceinline__ unsigned f2bf(float f) { unsigned u = __builtin_bit_cast(unsigned, f); return (u + 0x7fffu + ((u >> 16) & 1u)) >> 16; }
typedef __bf16 bf16x2_t __attribute__((ext_vector_type(2)));
__device__ __forceinline__ unsigned pk2(float lo, float hi) { const f32x2 v = {lo, hi}; const bf16x2_t r = __builtin_convertvector(v, bf16x2_t); return __builtin_bit_cast(unsigned, r); }
__device__ __forceinline__ float bflo(unsigned w) { return __builtin_bit_cast(float, w << 16); }
__device__ __forceinline__ float bfhi(unsigned w) { return __builtin_bit_cast(float, w & 0xffff0000u); }
__device__ __forceinline__ float bf2f(unsigned short b) { return __builtin_bit_cast(float, ((unsigned)b) << 16); }
__device__ __forceinline__ float sigm(float x) { return __builtin_amdgcn_rcpf(1.f + __expf(-x)); }
__device__ __forceinline__ float siluf(float x) { return x * sigm(x); }
__device__ __forceinline__ size_t tl(size_t row, int col, int K) { return (row >> 8) * ((size_t)256 * K) + (size_t)(col >> 6) * (256 * 64) + (row & 255) * 64 + (col & 63); }
__device__ __forceinline__ float wave_sum(float v) {
#pragma unroll
    for (int o = 1; o < 64; o <<= 1) v += __shfl_xor(v, o);
    return v;
}
__device__ __forceinline__ float wave_max(float v) {
#pragma unroll
    for (int o = 1; o < 64; o <<= 1) v = fmaxf(v, __shfl_xor(v, o));
    return v;
}

namespace pg8 {
constexpr int BM = 256, BK = 64, HALF = 128, HTB = HALF * BK * 2, STAGE_BYTES = 8 * HTB, NXCD = 8, WGM = 8;
__host__ __device__ __forceinline__ int lds_byte(int r, int c) { const int st = (r >> 4) * 2 + (c >> 5), rr = r & 15, cc = c & 31, ob = rr * 64 + cc * 2; return st * 1024 + (ob ^ (((ob >> 9) & 1) << 5)); }
__host__ __device__ __forceinline__ void stage_rc(int b, int& R, int& C) { const int st = b / 1024, sb = b % 1024, swz = sb ^ (((sb >> 9) & 1) << 5); R = (st >> 1) * 16 + swz / 64; C = (st & 1) * 32 + (swz % 64) / 2; }
__host__ __device__ __forceinline__ int perm32(int rho) { const int n = rho >> 4, i = rho & 15; return 8 * (i >> 2) + 4 * n + (i & 3); }
struct Unit { int pm, pn, br, sl; };
__device__ __forceinline__ void tile_of(int wgid, int nM, int nN, int& pm, int& pn) {
    const int nwg = nM * nN;
    { const int q = nwg / NXCD, r = nwg % NXCD, xcd = wgid % NXCD, off = wgid / NXCD; wgid = (xcd < r ? xcd * (q + 1) : r * (q + 1) + (xcd - r) * q) + off; }
    const int nig = WGM * nN, gid = wgid / nig, fm = gid * WGM, gsz = (nM - fm) < WGM ? (nM - fm) : WGM;
    pm = fm + ((wgid % nig) % gsz); pn = (wgid % nig) / gsz;
}

template <class Epi, class Sched>
__device__ __forceinline__ void gemm_phase(LAS unsigned char* lds, const int K, const Sched& S, const Epi& E) {
    const int tid = threadIdx.x, wid = __builtin_amdgcn_readfirstlane(tid >> 6), lane = tid & 63, wr = wid >> 2, wc = wid & 3, fr = lane & 15, fq = lane >> 4;
    unsigned voffA[2], voffB[2];
#pragma unroll
    for (int i = 0; i < 2; ++i) { int R, C; stage_rc(tid * 16 + i * 8192, R, C); const int Rb = (R & ~31) + perm32(R & 31);
        voffA[i] = (unsigned)(R * BK + C) * 2u; voffB[i] = (unsigned)(Rb * BK + C) * 2u; }
    const size_t kstep = (size_t)(BM * BK * 2);
    const size_t hstep = (size_t)HALF * BK * 2;
    const unsigned ldsw = (unsigned)wid * 1024u;
    const int aoff = lds_byte(wr * 64 + fr, fq * 8), boff = lds_byte(wc * 32 + fr, fq * 8);
#define PG8_SA(b, h) (((b) * 2 + (h)) * HTB)
#define PG8_SB(b, h) ((4 + (b) * 2 + (h)) * HTB)
#define PG8_STAGE(bufoff, gbase, voff) do { _Pragma("unroll") for (int _i = 0; _i < 2; ++_i) \
        __builtin_amdgcn_global_load_lds((const unsigned*)((const char*)(gbase) + (voff)[_i]), (LAS unsigned*)(lds + (bufoff) + ldsw + _i * 8192), 16, 0, 0); } while (0)
#define PG8_LDA(dst, b, h) do { _Pragma("unroll") for (int m = 0; m < 4; ++m) _Pragma("unroll") for (int k = 0; k < 2; ++k) dst[m][k] = *(const LAS bf16x8*)(lds + PG8_SA(b, h) + aoff + m * 2048 + k * 1024); } while (0)
#define PG8_LDB(dst, b, h) do { _Pragma("unroll") for (int n = 0; n < 2; ++n) _Pragma("unroll") for (int k = 0; k < 2; ++k) dst[n][k] = *(const LAS bf16x8*)(lds + PG8_SB(b, h) + boff + n * 2048 + k * 1024); } while (0)
#define PG8_MMA(ai, bj, At, Bt) do { __builtin_amdgcn_s_setprio(1); _Pragma("unroll") for (int m = 0; m < 4; ++m) _Pragma("unroll") for (int n = 0; n < 2; ++n) _Pragma("unroll") for (int k = 0; k < 2; ++k) \
        acc[ai][bj][m][n] = __builtin_amdgcn_mfma_f32_16x16x32_bf16(Bt[n][k], At[m][k], acc[ai][bj][m][n], 0, 0, 0); __builtin_amdgcn_s_setprio(0); } while (0)
#define PG8_WAIT_V(n) asm volatile("s_waitcnt vmcnt(" #n ")" ::: "memory")
#define PG8_WAIT_L(n) asm volatile("s_waitcnt lgkmcnt(" #n ")" ::: "memory")
#define PG8_BAR __builtin_amdgcn_s_barrier()
#define PG8_SCHED __builtin_amdgcn_sched_barrier(0)
    Unit cur, nxt; int ui = 0;
    if (!S.next(0, cur)) return;
    f32x4 acc[2][2][4][2];
#pragma unroll
    for (int a = 0; a < 2; ++a)
#pragma unroll
        for (int b = 0; b < 2; ++b)
#pragma unroll
            for (int m = 0; m < 4; ++m)
#pragma unroll
                for (int n = 0; n < 2; ++n) acc[a][b][m][n] = (f32x4){0.f, 0.f, 0.f, 0.f};
    bf16x8 At[4][2], B0[2][2], B1[2][2];
    const char* cA = S.a_base(cur); const char* cB = S.b_base(cur);
    PG8_STAGE(PG8_SB(0, 0), cB, voffB); PG8_STAGE(PG8_SB(0, 1), cB + hstep, voffB); PG8_STAGE(PG8_SA(0, 0), cA, voffA); PG8_STAGE(PG8_SA(0, 1), cA + hstep, voffA);
    if (wr == 1) PG8_BAR;
    PG8_WAIT_V(2); PG8_BAR;
    PG8_STAGE(PG8_SB(1, 0), cB + kstep, voffB); PG8_STAGE(PG8_SA(1, 0), cA + kstep, voffA); PG8_STAGE(PG8_SB(1, 1), cB + hstep + kstep, voffB);
    PG8_WAIT_V(6); PG8_BAR;
    for (;;) {
        const bool has_next = S.next(ui + 1, nxt);
        const char* nA = has_next ? S.a_base(nxt) : cA; const char* nB = has_next ? S.b_base(nxt) : cB;
        const int nt = S.nt(cur);
        for (int t = 0; t < nt; t += 2) {
            const bool last = (t == nt - 2);
            const char* a1 = cA + (size_t)(t + 1) * kstep;
            const char* a2 = last ? nA : cA + (size_t)(t + 2) * kstep; const char* b2 = last ? nB : cB + (size_t)(t + 2) * kstep;
            const char* a3 = a2 + kstep; const char* b3 = b2 + kstep;
            PG8_LDB(B0, 0, 0); PG8_LDB(B1, 0, 1); PG8_SCHED; PG8_LDA(At, 0, 0); PG8_STAGE(PG8_SA(1, 1), a1 + hstep, voffA);
            PG8_WAIT_V(8); PG8_WAIT_L(0); PG8_BAR; PG8_MMA(0, 0, At, B0); PG8_MMA(0, 1, At, B1); PG8_BAR; PG8_SCHED;
            PG8_LDA(At, 0, 1); PG8_STAGE(PG8_SB(0, 0), b2, voffB); PG8_STAGE(PG8_SB(0, 1), b2 + hstep, voffB); PG8_STAGE(PG8_SA(0, 0), a2, voffA);
            PG8_WAIT_V(8); PG8_WAIT_L(0); PG8_BAR; PG8_MMA(1, 0, At, B0); PG8_MMA(1, 1, At, B1); PG8_BAR; PG8_SCHED;
            PG8_LDB(B0, 1, 0); PG8_LDB(B1, 1, 1); PG8_SCHED; PG8_LDA(At, 1, 0); PG8_STAGE(PG8_SA(0, 1), a2 + hstep, voffA);
            PG8_WAIT_V(8); PG8_WAIT_L(0); PG8_BAR; PG8_MMA(0, 0, At, B0); PG8_MMA(0, 1, At, B1); PG8_BAR; PG8_SCHED;
            PG8_LDA(At, 1, 1); PG8_STAGE(PG8_SB(1, 0), b3, voffB); PG8_STAGE(PG8_SB(1, 1), b3 + hstep, voffB); PG8_STAGE(PG8_SA(1, 0), a3, voffA);
            PG8_WAIT_V(8); PG8_WAIT_L(0); PG8_BAR; PG8_MMA(1, 0, At, B0); PG8_MMA(1, 1, At, B1); PG8_BAR; PG8_SCHED;
        }
        if (wr == 0) PG8_BAR;
        const bool keep = E(acc, cur, wr, wc, fr, fq);
        if (!has_next) break;
        if (!keep)
#pragma unroll
        for (int a = 0; a < 2; ++a)
#pragma unroll
            for (int b = 0; b < 2; ++b)
#pragma unroll
                for (int m = 0; m < 4; ++m)
#pragma unroll
                    for (int n = 0; n < 2; ++n) acc[a][b][m][n] = (f32x4){0.f, 0.f, 0.f, 0.f};
        cur = nxt; cA = nA; cB = nB; ++ui;
        if (wr == 1) PG8_BAR;
    }
    PG8_WAIT_V(0);
    PG8_BAR;
#undef PG8_SA
#undef PG8_SB
#undef PG8_STAGE
#undef PG8_LDA
#undef PG8_LDB
#undef PG8_MMA
#undef PG8_WAIT_V
#undef PG8_WAIT_L
#undef PG8_BAR
#undef PG8_SCHED
}
}
using pg8::Unit;

struct SchedP1 {
    int G, c; const char* A; const char* Bt;
    __device__ __forceinline__ bool next(int i, Unit& u) const {
        const int L = i * G + c; if (L >= 2192) return false;
        u.br = 0; u.sl = 0;
        if (L >= 2160) { const int idx = L - 2160; u.pm = 36 + (idx >> 3); u.pn = 60 + (idx & 7); return true; }
        pg8::tile_of(L, 36, 60, u.pm, u.pn); return true;
    }
    __device__ __forceinline__ const char* a_base(const Unit& u) const { return A + (size_t)u.pm * (256 * 2048 * 2); }
    __device__ __forceinline__ const char* b_base(const Unit& u) const { return Bt + (size_t)u.pn * (256 * 2048 * 2); }
    __device__ __forceinline__ int nt(const Unit&) const { return 32; }
};
struct EpiP1 {
    bf16_t* proj; bf16_t* gate; float* F; const float* lb; const float* b_gate; float* out; bf16_t* mkb; bf16_t* mvt;
    __device__ __forceinline__ bool operator()(f32x4 (&acc)[2][2][4][2], const Unit& u, int wr, int wc, int fr, int fq) const {
        const int rloc = wr * 64 + fr, cloc = wc * 32 + 8 * fq;
        if (u.pn < 36) {
            const int seg = u.pn >> 2;
#pragma unroll
            for (int bj = 0; bj < 2; ++bj) {
                const int col = u.pn * 256 + bj * 128 + cloc;
                f32x4 l0 = (f32x4){0.f, 0.f, 0.f, 0.f}, l1 = l0;
                if (seg == 4) { l0 = *(const f32x4*)(lb + (col - C_HF)); l1 = *(const f32x4*)(lb + (col - C_HF) + 4); }
#pragma unroll
                for (int ai = 0; ai < 2; ++ai)
#pragma unroll
                    for (int m = 0; m < 4; ++m) {
                        const size_t row = (size_t)u.pm * 256 + ai * 128 + m * 16 + rloc;
                        f32x4 v0 = acc[ai][bj][m][0], v1 = acc[ai][bj][m][1];
                        if (seg == 4) {
#pragma unroll
                            for (int e = 0; e < 4; ++e) { v0[e] = l0[e] + (1.f - l0[e]) * sigm(v0[e]); v1[e] = l1[e] + (1.f - l1[e]) * sigm(v1[e]); }
                            float* fp = F + row * 1024 + (col - C_HF);
                            *(f32x4*)fp = v0; *(f32x4*)(fp + 4) = v1;
                        } else {
                            if (seg == 1) {
#pragma unroll
                                for (int e = 0; e < 4; ++e) { v0[e] = sigm(v0[e]); v1[e] = sigm(v1[e]); }
                            } else if (seg == 2 || seg == 6 || seg == 8) {
#pragma unroll
                                for (int e = 0; e < 4; ++e) { v0[e] = siluf(v0[e]); v1[e] = siluf(v1[e]); }
                            } else if (seg == 3) { v0 *= 0.08838834764831845f; v1 *= 0.08838834764831845f; }
                            else if (seg == 7) { v0 *= 0.0625f; v1 *= 0.0625f; }
                            u32x4 o; o.x = pk2(v0[0], v0[1]); o.y = pk2(v0[2], v0[3]); o.z = pk2(v1[0], v1[1]); o.w = pk2(v1[2], v1[3]);
                            *(u32x4*)(proj + row * LDP + col) = o;
                        }
                    }
            }
        } else if (u.pn < 60) {
            const int etid = (wr * 4 + wc) * 64 + fq * 16 + fr;
#pragma unroll
            for (int bj = 0; bj < 2; ++bj) {
                const int col = (u.pn - 36) * 256 + bj * 128 + cloc;
                const f32x4 b0 = *(const f32x4*)(b_gate + col), b1 = *(const f32x4*)(b_gate + col + 4);
#pragma unroll
                for (int ai = 0; ai < 2; ++ai)
#pragma unroll
                    for (int m = 0; m < 4; ++m) {
                        const size_t row = (size_t)u.pm * 256 + ai * 128 + m * 16 + rloc;
                        f32x4 v0 = acc[ai][bj][m][0] + b0, v1 = acc[ai][bj][m][1] + b1;
#pragma unroll
                        for (int e = 0; e < 4; ++e) { v0[e] = fmaxf(sigm(v0[e]), 1e-6f); v1[e] = fmaxf(sigm(v1[e]), 1e-6f); }
                        u32x4 o; o.x = pk2(v0[0], v0[1]); o.y = pk2(v0[2], v0[3]); o.z = pk2(v1[0], v1[1]); o.w = pk2(v1[2], v1[3]);
                        *(u32x4*)(gate + ((((size_t)u.pm * 24 + (u.pn - 36)) * 16 + (ai * 8 + m * 2 + bj)) * 512 + etid) * 8) = o;
                    }
            }
        } else {
            const int n = u.pm - 36, isv = (u.pn >= 64) ? 1 : 0, h = (u.pn - 60) & 3;
            float* ob = out + (isv ? O_MV : O_MK);
#pragma unroll
            for (int bj = 0; bj < 2; ++bj) {
                const int d = bj * 128 + cloc;
#pragma unroll
                for (int ai = 0; ai < 2; ++ai)
#pragma unroll
                    for (int m = 0; m < 4; ++m) {
                        const int key = ai * 128 + m * 16 + rloc;
                        const f32x4 v0 = acc[ai][bj][m][0], v1 = acc[ai][bj][m][1];
                        float* op = ob + ((size_t)(n * 256 + key) * 4 + h) * 256 + d;
                        *(f32x4*)op = v0; *(f32x4*)(op + 4) = v1;
                        if (!isv) {
                            u32x4 o; o.x = pk2(v0[0], v0[1]); o.y = pk2(v0[2], v0[3]); o.z = pk2(v1[0], v1[1]); o.w = pk2(v1[2], v1[3]);
                            *(u32x4*)(mkb + ((size_t)(n * 4 + h) * 256 + key) * 256 + d) = o;
                        } else {
                            bf16_t* vp = mvt + ((size_t)(n * 4 + h) * 256 + d) * 256 + key;
#pragma unroll
                            for (int e = 0; e < 4; ++e) { vp[(size_t)e * 256] = (bf16_t)f2bf(v0[e]); vp[(size_t)(e + 4) * 256] = (bf16_t)f2bf(v1[e]); }
                        }
                    }
            }
        }
        return false;
    }
};

struct SchedP4 {
    int G, c; const char* A; const char* Bt;
    __device__ __forceinline__ bool next(int i, Unit& u) const {
        int tri = i / 3; const int b = i - tri * 3;
        if (c < 128 && G == 256) tri ^= 1;
        const int L = tri * G + c;
        u.br = b;
        if (L < 256) { u.sl = 0; pg8::tile_of(L, 32, 8, u.pm, u.pn); return true; }
        const int j = L - 256; if (j >= 128) return false;
        const int tj = j >> 2; u.sl = 1 + (j & 3); u.pm = 32 + (tj >> 3); u.pn = tj & 7; return true;
    }
    __device__ __forceinline__ const char* a_base(const Unit& u) const {
        return A + (size_t)u.br * ((size_t)9216 * 1024 * 2) + (size_t)u.pm * (256 * 1024 * 2) + (u.sl ? (size_t)(u.sl - 1) * (4 * 32768) : 0); }
    __device__ __forceinline__ const char* b_base(const Unit& u) const {
        return Bt + (size_t)u.br * ((size_t)2048 * 1024 * 2) + (size_t)u.pn * (256 * 1024 * 2) + (u.sl ? (size_t)(u.sl - 1) * (4 * 32768) : 0); }
    __device__ __forceinline__ int nt(const Unit& u) const { return u.sl ? 4 : 16; }
};
struct EpiP4 {
    const bf16_t* gate; bf16_t* merged; float* partm;
    __device__ __forceinline__ bool operator()(f32x4 (&acc)[2][2][4][2], const Unit& u, int wr, int wc, int fr, int fq) const {
        const int rloc = wr * 64 + fr, cloc = wc * 32 + 8 * fq;
        const int sl = u.sl, ubr = u.br;
        float* pbase = partm + ((size_t)(sl ? sl - 1 : 0) * 1024 + (size_t)((u.pm >= 32 ? u.pm - 32 : 0) * 256 + rloc)) * 2048 + u.pn * 256 + cloc;
        const int etid = (wr * 4 + wc) * 64 + fq * 16 + fr;
        bf16_t* mbase = merged + tl((size_t)u.pm * 256 + rloc, u.pn * 256 + cloc, 2048);
#pragma unroll
        for (int bj = 0; bj < 2; ++bj) {
            const int col = u.pn * 256 + bj * 128 + cloc;
#pragma unroll
            for (int ai = 0; ai < 2; ++ai)
#pragma unroll
                for (int m = 0; m < 4; ++m) {
                    const size_t row = (size_t)u.pm * 256 + ai * 128 + m * 16 + rloc;
                    const bf16_t* gp = gate + ((((size_t)u.pm * 24 + (ubr * 8 + u.pn)) * 16 + (ai * 8 + m * 2 + bj)) * 512 + etid) * 8;
                    const u32x4 g = *(const u32x4*)gp;
                    f32x4 s0 = (f32x4){bflo(g.x), bfhi(g.x), bflo(g.y), bfhi(g.y)}, s1 = (f32x4){bflo(g.z), bfhi(g.z), bflo(g.w), bfhi(g.w)};
                    if (ubr < 2) {
                        const u32x4 h = *(const u32x4*)(gp + (size_t)8 * 16 * 512 * 8);
                        s0[0] *= __builtin_amdgcn_rcpf(bflo(h.x)); s0[1] *= __builtin_amdgcn_rcpf(bfhi(h.x)); s0[2] *= __builtin_amdgcn_rcpf(bflo(h.y)); s0[3] *= __builtin_amdgcn_rcpf(bfhi(h.y));
                        s1[0] *= __builtin_amdgcn_rcpf(bflo(h.z)); s1[1] *= __builtin_amdgcn_rcpf(bfhi(h.z)); s1[2] *= __builtin_amdgcn_rcpf(bflo(h.w)); s1[3] *= __builtin_amdgcn_rcpf(bfhi(h.w));
                    }
                    acc[ai][bj][m][0] *= s0; acc[ai][bj][m][1] *= s1;
                    if (ubr == 2) { const f32x4 v0 = acc[ai][bj][m][0], v1 = acc[ai][bj][m][1];
                        if (sl == 0) { u32x4 o; o.x = pk2(v0[0], v0[1]); o.y = pk2(v0[2], v0[3]); o.z = pk2(v1[0], v1[1]); o.w = pk2(v1[2], v1[3]);
                            *(u32x4*)(mbase + bj * 32768 + (ai * 128 + m * 16) * 64) = o; }
                        else { float* op = pbase + (ai * 128 + m * 16) * 2048 + bj * 128; *(f32x4*)op = v0; *(f32x4*)(op + 4) = v1; } }
                }
        }
        return ubr < 2;
    }
};

struct SchedP5 {
    int G, c; const char* A; const char* Bt;
    __device__ __forceinline__ bool next(int i, Unit& u) const {
        const int ii = ((c & 1) && G == 256 && i < 2) ? (i ^ 1) : i;
        const int L = ii * G + c; if (L >= 512) return false;
        u.sl = 0;
        if (L < 256) { u.br = 0; pg8::tile_of(L, 32, 8, u.pm, u.pn); return true; }
        const int j = L - 256, tj = j >> 3; u.br = 1 + (j & 7); u.pm = 32 + (tj >> 3); u.pn = tj & 7; return true;
    }
    __device__ __forceinline__ const char* a_base(const Unit& u) const { return A + (size_t)u.pm * (256 * 2048 * 2) + (u.br ? (size_t)(u.br - 1) * (4 * 32768) : 0); }
    __device__ __forceinline__ const char* b_base(const Unit& u) const { return Bt + (size_t)u.pn * (256 * 2048 * 2) + (u.br ? (size_t)(u.br - 1) * (4 * 32768) : 0); }
    __device__ __forceinline__ int nt(const Unit& u) const { return u.br ? 4 : 32; }
};
struct EpiP5 {
    const float* xp; const float* xs; float* out; float* part;
    __device__ __forceinline__ bool operator()(f32x4 (&acc)[2][2][4][2], const Unit& u, int wr, int wc, int fr, int fq) const {
        const int rloc = wr * 64 + fr, cloc = wc * 32 + 8 * fq;
#pragma unroll
        for (int bj = 0; bj < 2; ++bj) {
            const int col = u.pn * 256 + bj * 128 + cloc;
#pragma unroll
            for (int ai = 0; ai < 2; ++ai)
#pragma unroll
                for (int m = 0; m < 4; ++m) {
                    const size_t row = (size_t)u.pm * 256 + ai * 128 + m * 16 + rloc;
                    if (u.br == 0) {
                        const float* xr = xp + row * 2048 + col;
                        const f32x4 v0 = acc[ai][bj][m][0] + *(const f32x4*)xr, v1 = acc[ai][bj][m][1] + *(const f32x4*)(xr + 4);
                        float* op = out + row * 2048 + col;
                        *(f32x4*)op = v0; *(f32x4*)(op + 4) = v1;
                    } else {
                        float* op = part + ((size_t)(u.br - 1) * 1024 + (row - NTP)) * 2048 + col;
                        *(f32x4*)op = acc[ai][bj][m][0]; *(f32x4*)(op + 4) = acc[ai][bj][m][1];
                    }
                }
        }
        return false;
    }
};

struct EpiNull {
    __device__ __forceinline__ bool operator()(f32x4 (&acc)[2][2][4][2], const Unit& u, int wr, int wc, int fr, int fq) const {
        f32x4 t = (f32x4){0.f, 0.f, 0.f, 0.f};
#pragma unroll
        for (int ai = 0; ai < 2; ++ai)
#pragma unroll
            for (int bj = 0; bj < 2; ++bj)
#pragma unroll
                for (int m = 0; m < 4; ++m) t += acc[ai][bj][m][0] + acc[ai][bj][m][1];
        asm volatile("" :: "v"(t[0]), "v"(t[1]), "v"(t[2]), "v"(t[3]));
        return false;
    }
};
#define P0_DESC(it_, W_, WT_, K_, N_, ro_, kb_, nb_) do { int r_ = (it_); \
    if (r_ < 1920) { W_ = p.w_in; WT_ = WT1; K_ = 2048; N_ = 15360; ro_ = 0; kb_ = r_ / 120; nb_ = r_ % 120; } \
    else if (r_ < 2176) { r_ -= 1920; W_ = p.w_mem_kv; WT_ = WT1; K_ = 2048; N_ = 2048; ro_ = 15360; kb_ = r_ >> 4; nb_ = r_ & 15; } \
    else if (r_ < 2304) { r_ -= 2176; W_ = p.w_conv_out; WT_ = WT3; K_ = 1024; N_ = 2048; ro_ = 0; kb_ = r_ >> 4; nb_ = r_ & 15; } \
    else if (r_ < 2432) { r_ -= 2304; W_ = p.w_hgrn_out; WT_ = WT3 + (size_t)2048 * 1024; K_ = 1024; N_ = 2048; ro_ = 0; kb_ = r_ >> 4; nb_ = r_ & 15; } \
    else if (r_ < 2560) { r_ -= 2432; W_ = p.w_attn_out; WT_ = WT3 + (size_t)2 * 2048 * 1024; K_ = 1024; N_ = 2048; ro_ = 0; kb_ = r_ >> 4; nb_ = r_ & 15; } \
    else { r_ -= 2560; W_ = p.w_out; WT_ = WTO; K_ = 2048; N_ = 2048; ro_ = 0; kb_ = r_ >> 4; nb_ = r_ & 15; } } while (0)
__device__ __forceinline__ void p0_prologue(const Params& p, LAS unsigned char* lds) {
    const int tid = threadIdx.x, lane = tid & 63, wave = tid >> 6, G = gridDim.x, c = blockIdx.x;
    LAS unsigned* T32 = (LAS unsigned*)lds;
    constexpr int T_ALL = 1920 + 256 + 3 * 128 + 256;
    const int nq = tid & 31, kp0 = tid >> 5;
    f32x4 r0[4], r1[4];
#define P0_LOAD(W_, N_, kb_, nb_) do { _Pragma("unroll") for (int i = 0; i < 4; ++i) { const int kpair = kp0 + 16 * i; \
        const float* src = (W_) + (size_t)((kb_) * 128 + 2 * kpair) * (N_) + (nb_) * 128 + 4 * nq; r0[i] = *(const f32x4*)src; r1[i] = *(const f32x4*)(src + (N_)); } } while (0)
    bf16_t* WT1 = (bf16_t*)(p.ws + WS_WT1); bf16_t* WT3 = (bf16_t*)(p.ws + WS_WT3); bf16_t* WTO = (bf16_t*)(p.ws + WS_WTO);
    int it = c;
    const float* dW = p.w_in; bf16_t* dWT = WT1; int dK = 2048, dN = 15360, dro = 0, dkb = 0, dnb = 0;
    if (it < T_ALL) { P0_DESC(it, dW, dWT, dK, dN, dro, dkb, dnb); P0_LOAD(dW, dN, dkb, dnb); }
    while (it < T_ALL) {
#pragma unroll
        for (int i = 0; i < 4; ++i) { const int kpair = kp0 + 16 * i;
            T32[(4 * nq + 0) * 65 + kpair] = pk2(r0[i][0], r1[i][0]); T32[(4 * nq + 1) * 65 + kpair] = pk2(r0[i][1], r1[i][1]);
            T32[(4 * nq + 2) * 65 + kpair] = pk2(r0[i][2], r1[i][2]); T32[(4 * nq + 3) * 65 + kpair] = pk2(r0[i][3], r1[i][3]); }
        __syncthreads();
        const int itn = it + G;
        const float* nW = dW; bf16_t* nWT = dWT; int nK = dK, nN = dN, nro = dro, nkb = dkb, nnb = dnb;
        if (itn < T_ALL) { P0_DESC(itn, nW, nWT, nK, nN, nro, nkb, nnb); P0_LOAD(nW, nN, nkb, nnb); }
#pragma unroll
        for (int i = 0; i < 4; ++i) {
            const int id = tid + 512 * i, n = id >> 4, cc = id & 15;
            u32x4 o; o.x = T32[n * 65 + 4 * cc]; o.y = T32[n * 65 + 4 * cc + 1]; o.z = T32[n * 65 + 4 * cc + 2]; o.w = T32[n * 65 + 4 * cc + 3];
            *(u32x4*)(dWT + tl((size_t)(dro + dnb * 128 + n), dkb * 128 + 8 * cc, dK)) = o;
        }
        __syncthreads();
        it = itn; dW = nW; dWT = nWT; dK = nK; dN = nN; dro = nro; dkb = nkb; dnb = nnb;
    }
#undef P0_LOAD
#undef P0_DESC
    bf16_t* HA = (bf16_t*)(p.ws + WS_HA);
    const int gw = c * 8 + wave, NGW = G * 8;
#define P0_ROWPTR(m) ((m) < NTP ? p.x_prompt + (size_t)(m) * 2048 : ((m) < NTOK ? p.x_sample + (size_t)((m) - NTP) * 2048 : p.mem_prompt + (size_t)((m) - NTOK) * 2048))
    f32x4 v[8];
    int m = gw;
    if (m < 10240) { const float* xr = P0_ROWPTR(m);
#pragma unroll
        for (int j = 0; j < 8; ++j) v[j] = ((const f32x4*)xr)[lane + 64 * j]; }
    while (m < 10240) {
        const int mn = m + NGW; f32x4 vn[8];
        if (mn < 10240) { const float* xr = P0_ROWPTR(mn);
#pragma unroll
            for (int j = 0; j < 8; ++j) vn[j] = ((const f32x4*)xr)[lane + 64 * j]; }
        float ss = 0.f;
#pragma unroll
        for (int j = 0; j < 8; ++j) ss += (v[j][0] * v[j][0] + v[j][1] * v[j][1]) + (v[j][2] * v[j][2] + v[j][3] * v[j][3]);
        ss = wave_sum(ss);
        const float rinv = rsqrtf(ss * (1.f / 2048.f) + EPS);
        const float* g = (m < NTOK) ? p.g_pre : p.g_mem;
#pragma unroll
        for (int j = 0; j < 8; ++j) { const f32x4 gg = ((const f32x4*)g)[lane + 64 * j];
            u32x2 o; o.x = pk2(v[j][0] * rinv * gg[0], v[j][1] * rinv * gg[1]); o.y = pk2(v[j][2] * rinv * gg[2], v[j][3] * rinv * gg[3]);
            *(u32x2*)(HA + tl((size_t)m, 4 * (lane + 64 * j), 2048)) = o; }
        if (mn < 10240) {
#pragma unroll
            for (int j = 0; j < 8; ++j) v[j] = vn[j]; }
        m = mn;
    }
#undef P0_ROWPTR
    if (c == 0) { float* LB = (float*)(p.ws + WS_LB);
        for (int i = tid; i < 1024; i += 512) LB[i] = 1.f / (1.f + __expf(p.lb_logits[1024 + i] - p.lb_logits[i])); }
}

__device__ __forceinline__ void hgrn_prompt_item(const Params& p, int item, LAS unsigned char* lds, int tid) {
    LAS float* qs = (LAS float*)lds;
    LAS float* fs = qs + 4096;
    LAS float* vs = fs + 4096;
    LAS float* part = vs + 512;
    const int s = item >> 3, n = s >> 3, h = s & 7, dvg = item & 7;
    const int vcol = tid & 15, kg = tid >> 4;
    const bf16_t* proj = (const bf16_t*)(p.ws + WS_PROJ9);
    const float* F = (const float*)(p.ws + WS_F);
    float* oraw = (float*)(p.ws + WS_ORAW);
    const size_t row0 = (size_t)n * SEQ;
    const bf16_t* qsrc = proj + (row0 + kg) * LDP + C_HQ + h * 128 + vcol * 8;
    const float* fsrc = F + (row0 + kg) * 1024 + h * 128 + vcol * 8;
    const bf16_t* vsrc = proj + (row0 + kg) * LDP + C_HI + h * 128 + dvg * 16 + vcol;
    f32x2 S01 = (f32x2){0.f, 0.f}, S23 = (f32x2){0.f, 0.f};
    u32x4 rq[4]; f32x4 rfa[4], rfb[4]; bf16_t rv[4];
#define HG_FETCH(R, tb) do { const size_t adv = (size_t)(tb); rq[R] = *(const u32x4*)(qsrc + adv * LDP); rfa[R] = *(const f32x4*)(fsrc + adv * 1024); \
        rfb[R] = *(const f32x4*)(fsrc + adv * 1024 + 4); rv[R] = *(vsrc + adv * LDP); } while (0)
#define HG_BATCH(R, tb) do { \
        { LAS float* qd = qs + kg * 128 + vcol * 8; \
          *(LAS f32x4*)qd = (f32x4){bflo(rq[R].x), bfhi(rq[R].x), bflo(rq[R].y), bfhi(rq[R].y)}; *(LAS f32x4*)(qd + 4) = (f32x4){bflo(rq[R].z), bfhi(rq[R].z), bflo(rq[R].w), bfhi(rq[R].w)}; \
          LAS float* fd = fs + kg * 128 + vcol * 8; *(LAS f32x4*)fd = rfa[R]; *(LAS f32x4*)(fd + 4) = rfb[R]; \
          vs[kg * 16 + vcol] = bf2f(rv[R]); } \
        __syncthreads(); \
        if ((tb) + 128 < SEQ) HG_FETCH(R, (tb) + 128); \
        f32x4 cf[4], cq[4]; float cv[4]; \
        _Pragma("unroll") for (int i = 0; i < 4; ++i) { cf[i] = *(const LAS f32x4*)(fs + i * 128 + kg * 4); cq[i] = *(const LAS f32x4*)(qs + i * 128 + kg * 4); cv[i] = vs[i * 16 + vcol]; } \
        _Pragma("unroll") for (int g = 0; g < 8; ++g) { \
            f32x4 nf[4], nq[4]; float nv[4]; \
            if (g < 7) { _Pragma("unroll") for (int i = 0; i < 4; ++i) { const int tt = (g + 1) * 4 + i; \
                nf[i] = *(const LAS f32x4*)(fs + tt * 128 + kg * 4); nq[i] = *(const LAS f32x4*)(qs + tt * 128 + kg * 4); nv[i] = vs[tt * 16 + vcol]; } } \
            _Pragma("unroll") for (int i = 0; i < 4; ++i) { \
                const f32x2 f01 = (f32x2){cf[i][0], cf[i][1]}, f23 = (f32x2){cf[i][2], cf[i][3]}, q01 = (f32x2){cq[i][0], cq[i][1]}, q23 = (f32x2){cq[i][2], cq[i][3]}; \
                const f32x2 vv = (f32x2){cv[i], cv[i]}; \
                S01 = f01 * (S01 - vv) + vv; S23 = f23 * (S23 - vv) + vv; \
                f32x2 t = S01 * q01; t = S23 * q23 + t; \
                part[(g * 4 + i) * 528 + tid] = t[0] + t[1]; } \
            if (g < 7) { _Pragma("unroll") for (int i = 0; i < 4; ++i) { cf[i] = nf[i]; cq[i] = nq[i]; cv[i] = nv[i]; } } } \
        __syncthreads(); \
        { float a = 0.f; \
          _Pragma("unroll 8") for (int k2 = 0; k2 < 32; ++k2) a += part[kg * 528 + k2 * 16 + vcol]; \
          oraw[(row0 + (tb) + kg) * 1024 + h * 128 + dvg * 16 + vcol] = a; } } while (0)
    HG_FETCH(0, 0); HG_FETCH(1, 32); HG_FETCH(2, 64); HG_FETCH(3, 96);
#pragma unroll 1
    for (int t0 = 0; t0 < SEQ; t0 += 128) { HG_BATCH(0, t0); HG_BATCH(1, t0 + 32); HG_BATCH(2, t0 + 64); HG_BATCH(3, t0 + 96); }
#undef HG_FETCH
#undef HG_BATCH
    float* so = p.out + O_HGRN_P + ((size_t)(n * 8 + h) * 128 + kg * 4) * 128 + dvg * 16 + vcol;
    so[0] = S01[0]; so[128] = S01[1]; so[256] = S23[0]; so[384] = S23[1];
    __syncthreads();
}


constexpr int HG_GS = 0, HG_SEG = 32768, HG_VT = 36864, HG_QB = 53248, HG_KB = 69632, HG_SSQ = 86016;
__device__ __forceinline__ void hg_prep(const float* F, size_t row0, int h, LAS unsigned char* lds, int tid, f32x4 (&fr)[4]) {
    LAS float* Gs = (LAS float*)(lds + HG_GS); LAS float* SEG = (LAS float*)(lds + HG_SEG);
    const int er = tid >> 5, k4 = (tid & 31) * 4;
#pragma unroll
    for (int i = 0; i < 4; ++i) { const int t = 2 * er + (i & 1) + 32 * (i >> 1); fr[i] = *(const f32x4*)(F + (row0 + t) * 1024 + h * 128 + k4); }
#pragma unroll
    for (int i = 0; i < 4; ++i) { const int t = 2 * er + (i & 1) + 32 * (i >> 1);
        *(LAS f32x4*)(Gs + t * 128 + k4) = (f32x4){__logf(fr[i][0]), __logf(fr[i][1]), __logf(fr[i][2]), __logf(fr[i][3])}; }
    __syncthreads();
    const int k = tid & 127, seg = tid >> 7;
    { float g[16];
#pragma unroll
      for (int i = 0; i < 16; ++i) g[i] = Gs[(seg * 16 + i) * 128 + k];
#pragma unroll
      for (int i = 1; i < 16; ++i) g[i] += g[i - 1];
      SEG[seg * 128 + k] = g[15];
      __syncthreads();
      float off = 0.f;
#pragma unroll
      for (int s2 = 0; s2 < 3; ++s2) off += (s2 < seg) ? SEG[s2 * 128 + k] : 0.f;
#pragma unroll
      for (int i = 0; i < 16; ++i) Gs[(seg * 16 + i) * 128 + k] = g[i] + off; }
    __syncthreads();
}
__device__ __forceinline__ void hg_load_v(const bf16_t* proj, size_t row0, int h, int tid, unsigned (&a)[4], unsigned (&b)[4]) {
    const int d2 = (tid & 63) * 2;
#pragma unroll
    for (int i = 0; i < 4; ++i) { const int t = 2 * ((tid >> 6) + 8 * i);
        a[i] = *(const unsigned*)(proj + (row0 + t) * LDP + C_HI + h * 128 + d2); b[i] = *(const unsigned*)(proj + (row0 + t + 1) * LDP + C_HI + h * 128 + d2); }
}
__device__ __forceinline__ void hg_stage_vt(const unsigned (&a)[4], const unsigned (&b)[4], LAS unsigned char* lds, int tid) {
    LAS bf16_t* VT = (LAS bf16_t*)(lds + HG_VT);
    const int d2 = (tid & 63) * 2;
#pragma unroll
    for (int i = 0; i < 4; ++i) { const int t = 2 * ((tid >> 6) + 8 * i);
        const int c0 = ((t >> 3) ^ ((d2 >> 1) & 7)) * 8 + (t & 7);
        *(LAS unsigned*)(VT + d2 * 64 + c0) = (a[i] & 0xffffu) | (b[i] << 16);
        *(LAS unsigned*)(VT + (d2 + 1) * 64 + c0) = (a[i] >> 16) | (b[i] & 0xffff0000u); }
}
__device__ __forceinline__ void hgrn_h1_item(const Params& p, int item, LAS unsigned char* lds, int tid) {
    const int s = item >> 5, c = item & 31, n = s >> 3, h = s & 7;
    const size_t row0 = (size_t)n * SEQ + c * 64;
    const bf16_t* proj = (const bf16_t*)(p.ws + WS_PROJ9); const float* F = (const float*)(p.ws + WS_F);
    LAS float* Gs = (LAS float*)(lds + HG_GS); LAS bf16_t* KDT = (LAS bf16_t*)(lds + HG_QB); LAS bf16_t* VT = (LAS bf16_t*)(lds + HG_VT);
    f32x4 fr[4]; unsigned va[4], vb[4];
    hg_load_v(proj, row0, h, tid, va, vb);
    hg_prep(F, row0, h, lds, tid, fr);
    hg_stage_vt(va, vb, lds, tid);
    { const int er = tid >> 5, k4 = (tid & 31) * 4;
      const f32x4 bc = *(const LAS f32x4*)(Gs + 63 * 128 + k4);
      if (er == 0) *(f32x4*)((float*)(p.ws + WS_DD) + (size_t)item * 128 + k4) = (f32x4){__expf(bc[0]), __expf(bc[1]), __expf(bc[2]), __expf(bc[3])};
#pragma unroll
      for (int ip = 0; ip < 2; ++ip) { const int t = 2 * er + 32 * ip;
          const f32x4 b0 = *(const LAS f32x4*)(Gs + t * 128 + k4), b1 = *(const LAS f32x4*)(Gs + (t + 1) * 128 + k4);
#pragma unroll
          for (int e = 0; e < 4; ++e) { const int k = k4 + e;
              const float kd0 = (1.f - fr[2 * ip][e]) * __expf(bc[e] - b0[e]), kd1 = (1.f - fr[2 * ip + 1][e]) * __expf(bc[e] - b1[e]);
              *(LAS unsigned*)(KDT + k * 64 + (((t >> 3) ^ ((k >> 1) & 7)) * 8 + (t & 7))) = pk2(kd0, kd1); } } }
    __syncthreads();
    { const int lane = tid & 63, w = tid >> 6, l15 = lane & 15, quad = lane >> 4;
      const int d = 16 * w + l15;
      bf16x8 av[2];
#pragma unroll
      for (int s2 = 0; s2 < 2; ++s2) av[s2] = *(const LAS bf16x8*)(VT + d * 64 + (((4 * s2 + quad) ^ ((d >> 1) & 7)) * 8));
      float* ut = (float*)(p.ws + WS_UT) + ((size_t)item * 128 + 16 * w + quad * 4) * 128 + l15;
#pragma unroll
      for (int kt = 0; kt < 8; ++kt) { const int k = 16 * kt + l15;
          f32x4 acc = (f32x4){0.f, 0.f, 0.f, 0.f};
#pragma unroll
          for (int s2 = 0; s2 < 2; ++s2) { const bf16x8 bk = *(const LAS bf16x8*)(KDT + k * 64 + (((4 * s2 + quad) ^ ((k >> 1) & 7)) * 8));
              acc = __builtin_amdgcn_mfma_f32_16x16x32_bf16(av[s2], bk, acc, 0, 0, 0); }
          ut[kt * 16] = acc[0]; ut[kt * 16 + 128] = acc[1]; ut[kt * 16 + 256] = acc[2]; ut[kt * 16 + 384] = acc[3]; } }
    __syncthreads();
}
__device__ __forceinline__ void hgrn_h2_scan(const Params& p) {
    const float* UT = (const float*)(p.ws + WS_UT); const float* DD = (const float*)(p.ws + WS_DD); bf16_t* ST = (bf16_t*)(p.ws + WS_ST);
    for (int idx = blockIdx.x * 512 + threadIdx.x; idx < 32 * 128 * 32; idx += gridDim.x * 512) {
        const int s = idx >> 12, d = (idx >> 5) & 127, k4 = (idx & 31) * 4;
        f32x4 S = (f32x4){0.f, 0.f, 0.f, 0.f};
#pragma unroll 4
        for (int c = 0; c < 32; ++c) { const size_t item = (size_t)s * 32 + c;
            const f32x4 u = *(const f32x4*)(UT + (item * 128 + d) * 128 + k4), dd = *(const f32x4*)(DD + item * 128 + k4);
            u32x2 o; o.x = pk2(S[0], S[1]); o.y = pk2(S[2], S[3]);
            *(u32x2*)(ST + (item * 128 + d) * 128 + k4) = o;
            S = dd * S + u; }
        float* so = p.out + O_HGRN_P + ((size_t)s * 128 + k4) * 128 + d;
        so[0] = S[0]; so[128] = S[1]; so[256] = S[2]; so[384] = S[3];
    }
}
__device__ __forceinline__ void hgrn_h3_item(const Params& p, int item, LAS unsigned char* lds, int tid) {
    const int s = item >> 5, c = item & 31, n = s >> 3, h = s & 7;
    const size_t row0 = (size_t)n * SEQ + c * 64;
    const bf16_t* proj = (const bf16_t*)(p.ws + WS_PROJ9); const float* F = (const float*)(p.ws + WS_F);
    LAS float* Gs = (LAS float*)(lds + HG_GS); LAS bf16_t* QB = (LAS bf16_t*)(lds + HG_QB); LAS bf16_t* KB = (LAS bf16_t*)(lds + HG_KB); LAS bf16_t* VT = (LAS bf16_t*)(lds + HG_VT);
    LAS float* SSQ = (LAS float*)(lds + HG_SSQ);
    const int lane = tid & 63, w = tid >> 6, l15 = lane & 15, quad = lane >> 4, tt = w & 3, dh = w >> 2;
    const bf16_t* st = (const bf16_t*)(p.ws + WS_ST) + ((size_t)item * 128 + 64 * dh + l15) * 128 + quad * 8;
    bf16x8 sf[4][4];
#pragma unroll
    for (int dt = 0; dt < 4; ++dt)
#pragma unroll
        for (int ks = 0; ks < 4; ++ks) sf[dt][ks] = *(const bf16x8*)(st + (size_t)dt * 16 * 128 + ks * 32);
    f32x4 fr[4]; unsigned va[4], vb[4]; u32x2 qws[4];
    hg_load_v(proj, row0, h, tid, va, vb);
#pragma unroll
    for (int i = 0; i < 4; ++i) { const int t = 2 * (tid >> 5) + (i & 1) + 32 * (i >> 1); qws[i] = *(const u32x2*)(proj + (row0 + t) * LDP + C_HQ + h * 128 + (tid & 31) * 4); }
    hg_prep(F, row0, h, lds, tid, fr);
    hg_stage_vt(va, vb, lds, tid);
    { const int er = tid >> 5, k4 = (tid & 31) * 4;
#pragma unroll
      for (int i = 0; i < 4; ++i) { const int t = 2 * er + (i & 1) + 32 * (i >> 1);
          const f32x4 b = *(const LAS f32x4*)(Gs + t * 128 + k4);
          const u32x2 qw = qws[i];
          const float e0 = __expf(b[0]), e1 = __expf(b[1]), e2 = __expf(b[2]), e3 = __expf(b[3]);
          u32x2 qo, ko;
          qo.x = pk2(bflo(qw.x) * e0, bfhi(qw.x) * e1); qo.y = pk2(bflo(qw.y) * e2, bfhi(qw.y) * e3);
          ko.x = pk2((1.f - fr[i][0]) * __builtin_amdgcn_rcpf(e0), (1.f - fr[i][1]) * __builtin_amdgcn_rcpf(e1));
          ko.y = pk2((1.f - fr[i][2]) * __builtin_amdgcn_rcpf(e2), (1.f - fr[i][3]) * __builtin_amdgcn_rcpf(e3));
          const int off = t * 128 + (((k4 >> 3) ^ (t & 15)) * 8) + (k4 & 7);
          *(LAS u32x2*)(QB + off) = qo; *(LAS u32x2*)(KB + off) = ko; } }
    __syncthreads();
    bf16x8 qf[4];
#pragma unroll
    for (int ks = 0; ks < 4; ++ks) qf[ks] = *(const LAS bf16x8*)(QB + (16 * tt + l15) * 128 + (((4 * ks + quad) ^ l15) * 8));
    f32x4 at[4];
#pragma unroll
    for (int st4 = 0; st4 < 4; ++st4) {
        at[st4] = (f32x4){0.f, 0.f, 0.f, 0.f};
        if (st4 <= tt) {
#pragma unroll
            for (int ks = 0; ks < 4; ++ks) { const bf16x8 kf = *(const LAS bf16x8*)(KB + (16 * st4 + l15) * 128 + (((4 * ks + quad) ^ l15) * 8));
                at[st4] = __builtin_amdgcn_mfma_f32_16x16x32_bf16(kf, qf[ks], at[st4], 0, 0, 0); }
            if (st4 == tt) {
#pragma unroll
                for (int j = 0; j < 4; ++j) at[st4][j] = (quad * 4 + j <= l15) ? at[st4][j] : 0.f;
            }
        }
    }
    bf16x8 pb[2];
#pragma unroll
    for (int s2 = 0; s2 < 2; ++s2) { u32x4 wv; wv.x = pk2(at[2 * s2][0], at[2 * s2][1]); wv.y = pk2(at[2 * s2][2], at[2 * s2][3]);
        wv.z = pk2(at[2 * s2 + 1][0], at[2 * s2 + 1][1]); wv.w = pk2(at[2 * s2 + 1][2], at[2 * s2 + 1][3]); pb[s2] = __builtin_bit_cast(bf16x8, wv); }
    f32x4 oacc[4]; float ssq = 0.f;
#pragma unroll
    for (int dt = 0; dt < 4; ++dt) {
        const int d = 16 * (4 * dh + dt) + l15;
        oacc[dt] = (f32x4){0.f, 0.f, 0.f, 0.f};
#pragma unroll
        for (int ks = 0; ks < 4; ++ks) oacc[dt] = __builtin_amdgcn_mfma_f32_16x16x32_bf16(sf[dt][ks], qf[ks], oacc[dt], 0, 0, 0);
#pragma unroll
        for (int s2 = 0; s2 < 2; ++s2) {
            const int ch = 4 * s2 + (quad >> 1), sw = (d >> 1) & 7;
            const u32x2 lo = *(const LAS u32x2*)(VT + d * 64 + ((ch ^ sw) * 8) + (quad & 1) * 4), hi = *(const LAS u32x2*)(VT + d * 64 + (((ch + 2) ^ sw) * 8) + (quad & 1) * 4);
            u32x4 wv; wv.x = lo.x; wv.y = lo.y; wv.z = hi.x; wv.w = hi.y;
            oacc[dt] = __builtin_amdgcn_mfma_f32_16x16x32_bf16(__builtin_bit_cast(bf16x8, wv), pb[s2], oacc[dt], 0, 0, 0);
        }
        ssq += (oacc[dt][0] * oacc[dt][0] + oacc[dt][1] * oacc[dt][1]) + (oacc[dt][2] * oacc[dt][2] + oacc[dt][3] * oacc[dt][3]);
    }
    ssq += __shfl_xor(ssq, 16); ssq += __shfl_xor(ssq, 32);
    if (quad == 0) SSQ[dh * 64 + 16 * tt + l15] = ssq;
    __syncthreads();
    { const float tot = SSQ[16 * tt + l15] + SSQ[64 + 16 * tt + l15], rinv = rsqrtf(tot * (1.f / 128.f) + EPS);
      const size_t row = row0 + 16 * tt + l15;
      bf16_t* og = (bf16_t*)(p.ws + WS_ACT3) + (size_t)9216 * 1024;
#pragma unroll
      for (int dt = 0; dt < 4; ++dt) { const int d0 = 16 * (4 * dh + dt) + quad * 4;
          const f32x4 gn = *(const f32x4*)(p.g_hgrn + h * 128 + d0);
          const u32x2 hg = *(const u32x2*)(proj + row * LDP + C_HOG + h * 128 + d0);
          u32x2 o; o.x = pk2(oacc[dt][0] * rinv * gn[0] * bflo(hg.x), oacc[dt][1] * rinv * gn[1] * bfhi(hg.x)); o.y = pk2(oacc[dt][2] * rinv * gn[2] * bflo(hg.y), oacc[dt][3] * rinv * gn[3] * bfhi(hg.y));
          *(u32x2*)(og + tl(row, h * 128 + d0, 1024)) = o; } }
    __syncthreads();
}

__device__ __forceinline__ void hgrn_sample_item(const Params& p, int item, LAS unsigned char* lds, int tid) {
    LAS float* qs = (LAS float*)lds;
    LAS float* fs = qs + 1024;
    LAS float* vs = fs + 1024;
    LAS float* opart = vs + 1024;
    const int n = item >> 3, h = item & 7, lane = tid & 63, wave = tid >> 6;
    const bf16_t* proj = (const bf16_t*)(p.ws + WS_PROJ9);
    const float* F = (const float*)(p.ws + WS_F);
    const size_t row0 = (size_t)NTP + (size_t)n * 8;
    { const int tt = tid >> 6, k2 = (tid & 63) * 2; const size_t r = row0 + tt;
      const unsigned qw = *(const unsigned*)(proj + r * LDP + C_HQ + h * 128 + k2); const f32x2 ff = *(const f32x2*)(F + r * 1024 + h * 128 + k2);
      const unsigned vw = *(const unsigned*)(proj + r * LDP + C_HI + h * 128 + k2);
      qs[tt * 128 + k2] = bflo(qw); qs[tt * 128 + k2 + 1] = bfhi(qw); fs[tt * 128 + k2] = ff[0]; fs[tt * 128 + k2 + 1] = ff[1];
      vs[tt * 128 + k2] = bflo(vw); vs[tt * 128 + k2 + 1] = bfhi(vw); }
    const int v4 = tid & 31, kg = tid >> 5;
    const size_t sbase = ((size_t)(n * 8 + h) * 128 + kg * 8) * 128 + v4 * 4;
    f32x4 S[8];
#pragma unroll
    for (int i = 0; i < 8; ++i) S[i] = *(const f32x4*)(p.state_hgrn + sbase + (size_t)i * 128);
    __syncthreads();
#pragma unroll
    for (int tt = 0; tt < 8; ++tt) {
        const f32x4 fa = *(const LAS f32x4*)(fs + tt * 128 + kg * 8), fb = *(const LAS f32x4*)(fs + tt * 128 + kg * 8 + 4);
        const f32x4 qa = *(const LAS f32x4*)(qs + tt * 128 + kg * 8), qb = *(const LAS f32x4*)(qs + tt * 128 + kg * 8 + 4);
        const f32x4 vv = *(const LAS f32x4*)(vs + tt * 128 + v4 * 4);
        f32x4 po = (f32x4){0.f, 0.f, 0.f, 0.f};
#pragma unroll
        for (int i = 0; i < 8; ++i) { const float f = (i < 4) ? fa[i & 3] : fb[i & 3], q = (i < 4) ? qa[i & 3] : qb[i & 3];
            S[i] = S[i] * f + vv * (1.f - f); po += S[i] * q; }
#pragma unroll
        for (int e = 0; e < 4; ++e) po[e] += __shfl_xor(po[e], 32);
        if (lane < 32) *(LAS f32x4*)(opart + (tt * 8 + wave) * 128 + v4 * 4) = po;
    }
    float* so = p.out + O_HGRN_S + sbase;
#pragma unroll
    for (int i = 0; i < 8; ++i) *(f32x4*)(so + (size_t)i * 128) = S[i];
    __syncthreads();
    { const int tt = tid >> 6, v = (tid & 63) * 2; float o0 = 0.f, o1 = 0.f;
#pragma unroll
      for (int w = 0; w < 8; ++w) { const f32x2 t = *(const LAS f32x2*)(opart + (tt * 8 + w) * 128 + v); o0 += t[0]; o1 += t[1]; }
      const float ss = wave_sum(o0 * o0 + o1 * o1), rinv = rsqrtf(ss * (1.f / 128.f) + EPS);
      const size_t r = row0 + tt; const f32x2 gg = *(const f32x2*)(p.g_hgrn + h * 128 + v);
      const unsigned gw = *(const unsigned*)(proj + r * LDP + C_HOG + h * 128 + v);
      bf16_t* og = (bf16_t*)(p.ws + WS_ACT3) + (size_t)9216 * 1024 + tl(r, h * 128 + v, 1024);
      *(unsigned*)og = pk2(o0 * rinv * gg[0] * bflo(gw), o1 * rinv * gg[1] * bfhi(gw)); }
    __syncthreads();
}

__device__ __forceinline__ void hgrn_norm_rows(const Params& p) {
    const int tid = threadIdx.x, lane = tid & 63, gw = blockIdx.x * 8 + (tid >> 6), NGW = gridDim.x * 8;
    const bf16_t* proj = (const bf16_t*)(p.ws + WS_PROJ9); const float* oraw = (const float*)(p.ws + WS_ORAW);
    bf16_t* og = (bf16_t*)(p.ws + WS_ACT3) + (size_t)9216 * 1024;
    for (int r = gw; r < NTP; r += NGW) {
        f32x4 o[4]; float ss = 0.f;
#pragma unroll
        for (int j = 0; j < 4; ++j) { o[j] = *(const f32x4*)(oraw + (size_t)r * 1024 + lane * 16 + j * 4); ss += (o[j][0] * o[j][0] + o[j][1] * o[j][1]) + (o[j][2] * o[j][2] + o[j][3] * o[j][3]); }
        ss += __shfl_xor(ss, 1); ss += __shfl_xor(ss, 2); ss += __shfl_xor(ss, 4);
        const float rinv = rsqrtf(ss * (1.f / 128.f) + EPS);
        const u32x4 ga = *(const u32x4*)(proj + (size_t)r * LDP + C_HOG + lane * 16), gb = *(const u32x4*)(proj + (size_t)r * LDP + C_HOG + lane * 16 + 8);
        f32x4 g[4];
#pragma unroll
        for (int j = 0; j < 4; ++j) g[j] = *(const f32x4*)(p.g_hgrn + lane * 16 + j * 4);
        u32x4 oa, ob;
        oa.x = pk2(o[0][0] * rinv * g[0][0] * bflo(ga.x), o[0][1] * rinv * g[0][1] * bfhi(ga.x)); oa.y = pk2(o[0][2] * rinv * g[0][2] * bflo(ga.y), o[0][3] * rinv * g[0][3] * bfhi(ga.y));
        oa.z = pk2(o[1][0] * rinv * g[1][0] * bflo(ga.z), o[1][1] * rinv * g[1][1] * bfhi(ga.z)); oa.w = pk2(o[1][2] * rinv * g[1][2] * bflo(ga.w), o[1][3] * rinv * g[1][3] * bfhi(ga.w));
        ob.x = pk2(o[2][0] * rinv * g[2][0] * bflo(gb.x), o[2][1] * rinv * g[2][1] * bfhi(gb.x)); ob.y = pk2(o[2][2] * rinv * g[2][2] * bflo(gb.y), o[2][3] * rinv * g[2][3] * bfhi(gb.y));
        ob.z = pk2(o[3][0] * rinv * g[3][0] * bflo(gb.z), o[3][1] * rinv * g[3][1] * bfhi(gb.z)); ob.w = pk2(o[3][2] * rinv * g[3][2] * bflo(gb.w), o[3][3] * rinv * g[3][3] * bfhi(gb.w));
        *(u32x4*)(og + tl((size_t)r, lane * 16, 1024)) = oa; *(u32x4*)(og + tl((size_t)r, lane * 16 + 8, 1024)) = ob;
    }
}

template <bool SAMPLE>
__device__ __forceinline__ void conv_item(const Params& p, int item, LAS unsigned char* lds, int tid) {
    constexpr int T = SAMPLE ? 8 : 32;
    constexpr int GP = 4, NG = (T + 32) / GP, G0 = 32 / GP;
    LAS float* dcs = (LAS float*)lds;
    const bf16_t* proj = (const bf16_t*)(p.ws + WS_PROJ9);
    const int n = SAMPLE ? item : (item >> 6), t0 = SAMPLE ? 0 : (item & 63) * 32;
    const size_t rowb = SAMPLE ? ((size_t)NTP + (size_t)n * 8) : ((size_t)n * SEQ);
    const int c0 = 2 * tid;
    float w0[31], w1[31], x0[31], x1[31];
#pragma unroll
    for (int j = 0; j < 31; ++j) { const f32x2 w = *(const f32x2*)(p.conv_w + j * 1024 + c0); w0[j] = w[0]; w1[j] = w[1]; x0[j] = 0.f; x1[j] = 0.f; }
    const f32x2 bias = *(const f32x2*)(p.conv_b + c0);
    unsigned ra[GP], rg[GP];
#define CONV_ISSUE(g) do { \
        if (SAMPLE && (g) < G0) { _Pragma("unroll") for (int i = 0; i < GP; ++i) { const int ti = -2 + GP * (g) + i; \
            const unsigned* tp = (const unsigned*)(p.state_conv + ((size_t)n * 30 + (ti < 0 ? 0 : ti)) * 1024 + c0); ra[i] = tp[0]; rg[i] = tp[1]; } } \
        else { _Pragma("unroll") for (int i = 0; i < GP; ++i) { const int t = t0 - 32 + GP * (g) + i; const bf16_t* rp = proj + (rowb + (t < 0 ? 0 : t)) * LDP + c0; \
            ra[i] = *(const unsigned*)(rp + C_CV); rg[i] = *(const unsigned*)(rp + C_CG); } } } while (0)
    CONV_ISSUE(0);
#pragma unroll 1
    for (int g = 0; g < NG; ++g) {
        float u0[GP], u1[GP];
        if (SAMPLE && g < G0) {
#pragma unroll
            for (int i = 0; i < GP; ++i) { const bool ok = (-2 + GP * g + i) >= 0; u0[i] = ok ? __builtin_bit_cast(float, ra[i]) : 0.f; u1[i] = ok ? __builtin_bit_cast(float, rg[i]) : 0.f; }
        } else {
#pragma unroll
            for (int i = 0; i < GP; ++i) { const bool ok = (t0 - 32 + GP * g + i) >= 0; u0[i] = ok ? bflo(ra[i]) * bflo(rg[i]) : 0.f; u1[i] = ok ? bfhi(ra[i]) * bfhi(rg[i]) : 0.f; }
        }
        if (g + 1 < NG) CONV_ISSUE(g + 1);
#pragma unroll
        for (int i = 0; i < GP; ++i) {
            const int pp = -32 + GP * g + i, t = t0 + pp;
            if (SAMPLE) { if (pp >= -22) *(f32x2*)(p.out + O_CONV_S + ((size_t)n * 30 + (pp + 22)) * 1024 + c0) = (f32x2){u0[i], u1[i]}; }
            else { if (t >= SEQ - 30) *(f32x2*)(p.out + O_CONV_P + ((size_t)n * 30 + (t - (SEQ - 30))) * 1024 + c0) = (f32x2){u0[i], u1[i]}; }
#pragma unroll
            for (int j = 0; j < 30; ++j) { x0[j] = x0[j + 1]; x1[j] = x1[j + 1]; }
            x0[30] = u0[i]; x1[30] = u1[i];
            if (g >= G0) {
                float d0 = bias[0], d1 = bias[1];
#pragma unroll
                for (int j = 0; j < 31; ++j) { d0 += w0[j] * x0[j]; d1 += w1[j] * x1[j]; }
                *(LAS f32x2*)(dcs + (pp) * 1024 + c0) = (f32x2){d0, d1};
            }
        }
    }
#undef CONV_ISSUE
    __syncthreads();
    { const int lane = tid & 63, wave = tid >> 6;
      bf16_t* aact = (bf16_t*)(p.ws + WS_ACT3);
      for (int pp = wave; pp < T; pp += 8) {
          f32x4 v[4]; float s = 0.f;
#pragma unroll
          for (int j = 0; j < 4; ++j) { v[j] = *(const LAS f32x4*)(dcs + pp * 1024 + j * 256 + lane * 4); s += (v[j][0] + v[j][1]) + (v[j][2] + v[j][3]); }
          const float mean = wave_sum(s) * (1.f / 1024.f); float s2 = 0.f;
#pragma unroll
          for (int j = 0; j < 4; ++j) { v[j] = v[j] - mean; s2 += (v[j][0] * v[j][0] + v[j][1] * v[j][1]) + (v[j][2] * v[j][2] + v[j][3] * v[j][3]); }
          const float rstd = rsqrtf(wave_sum(s2) * (1.f / 1024.f) + EPS);
          const size_t r = rowb + t0 + pp;
          bf16_t* arow = aact + tl(r, lane * 4, 1024);
#pragma unroll
          for (int j = 0; j < 4; ++j) { const int c = j * 256 + lane * 4;
              const f32x4 lg = *(const f32x4*)(p.ln_g + c), lbv = *(const f32x4*)(p.ln_b + c);
              const u32x2 sg = *(const u32x2*)(proj + r * LDP + C_CS + c);
              const float y0 = siluf(v[j][0] * rstd * lg[0] + lbv[0]) * bflo(sg.x), y1 = siluf(v[j][1] * rstd * lg[1] + lbv[1]) * bfhi(sg.x);
              const float y2 = siluf(v[j][2] * rstd * lg[2] + lbv[2]) * bflo(sg.y), y3 = siluf(v[j][3] * rstd * lg[3] + lbv[3]) * bfhi(sg.y);
              u32x2 o; o.x = pk2(y0, y1); o.y = pk2(y2, y3);
              *(u32x2*)(arow + j * 65536) = o; }
      } }
    __syncthreads();
}

__device__ __forceinline__ void attn_prompt_item(const Params& p, int item, LAS unsigned char* lds, int tid) {
    const int lane = tid & 63, wave = tid >> 6, l15 = lane & 15, quad = lane >> 4;
    const int n = item >> 6, h = (item >> 4) & 3, qt = item & 15;
    const bf16_t* proj = (const bf16_t*)(p.ws + WS_PROJ9);
    const bf16_t* kb = (const bf16_t*)(p.ws + WS_MKB) + (size_t)(n * 4 + h) * 65536;
    const bf16_t* vt = (const bf16_t*)(p.ws + WS_MVT) + (size_t)(n * 4 + h) * 65536;
    const size_t qrow = (size_t)n * SEQ + qt * 128 + wave * 16 + l15;
    u32x4 st[16];
#pragma unroll
    for (int i = 0; i < 16; ++i) st[i] = *(const u32x4*)(kb + (size_t)(tid + 512 * i) * 8);
    bf16x8 qf[8];
#pragma unroll
    for (int s = 0; s < 8; ++s) qf[s] = *(const bf16x8*)(proj + qrow * LDP + C_AQ + h * 256 + s * 32 + quad * 8);
#pragma unroll
    for (int i = 0; i < 16; ++i) { const int id = tid + 512 * i, r = id >> 5, c = id & 31; *(LAS u32x4*)(lds + r * 512 + ((c ^ (r & 15)) * 16)) = st[i]; }
    __syncthreads();
    f32x4 sc[16];
#pragma unroll
    for (int T = 0; T < 16; ++T) {
        sc[T] = (f32x4){0.f, 0.f, 0.f, 0.f};
        const LAS unsigned char* kr = lds + (T * 16 + l15) * 512;
#pragma unroll
        for (int s = 0; s < 8; ++s) { const bf16x8 a = *(const LAS bf16x8*)(kr + (((s * 4 + quad) ^ l15) * 16)); sc[T] = __builtin_amdgcn_mfma_f32_16x16x32_bf16(a, qf[s], sc[T], 0, 0, 0); }
    }
#pragma unroll
    for (int i = 0; i < 16; ++i) st[i] = *(const u32x4*)(vt + (size_t)(tid + 512 * i) * 8);
    __syncthreads();
    float mx = -3.0e38f;
#pragma unroll
    for (int T = 0; T < 16; ++T) mx = fmaxf(mx, fmaxf(fmaxf(sc[T][0], sc[T][1]), fmaxf(sc[T][2], sc[T][3])));
    mx = fmaxf(mx, __shfl_xor(mx, 16)); mx = fmaxf(mx, __shfl_xor(mx, 32));
    float sum = 0.f;
#pragma unroll
    for (int T = 0; T < 16; ++T) {
#pragma unroll
        for (int e = 0; e < 4; ++e) { sc[T][e] = __expf(sc[T][e] - mx); sum += sc[T][e]; } }
    sum += __shfl_xor(sum, 16); sum += __shfl_xor(sum, 32);
    const float rs = 1.f / sum;
    bf16x8 pb[8];
#pragma unroll
    for (int s2 = 0; s2 < 8; ++s2) {
        u32x4 w; w.x = pk2(sc[2 * s2][0], sc[2 * s2][1]); w.y = pk2(sc[2 * s2][2], sc[2 * s2][3]); w.z = pk2(sc[2 * s2 + 1][0], sc[2 * s2 + 1][1]); w.w = pk2(sc[2 * s2 + 1][2], sc[2 * s2 + 1][3]);
        pb[s2] = __builtin_bit_cast(bf16x8, w);
    }
#pragma unroll
    for (int i = 0; i < 16; ++i) { const int id = tid + 512 * i, r = id >> 5, c = id & 31; *(LAS u32x4*)(lds + r * 512 + ((c ^ (r & 15)) * 16)) = st[i]; }
    __syncthreads();
    bf16_t* aog_row = (bf16_t*)(p.ws + WS_ACT3) + (size_t)2 * 9216 * 1024 + tl(qrow, h * 256 + quad * 4, 1024);
    f32x4 oacc[16];
#pragma unroll
    for (int Tv = 0; Tv < 16; ++Tv) {
        oacc[Tv] = (f32x4){0.f, 0.f, 0.f, 0.f};
        const LAS unsigned char* vr = lds + (Tv * 16 + l15) * 512 + (quad & 1) * 8;
#pragma unroll
        for (int s2 = 0; s2 < 8; ++s2) {
            const int ch = 4 * s2 + (quad >> 1);
            const u32x2 lo = *(const LAS u32x2*)(vr + ((ch ^ l15) * 16)), hi = *(const LAS u32x2*)(vr + (((ch + 2) ^ l15) * 16));
            u32x4 w; w.x = lo.x; w.y = lo.y; w.z = hi.x; w.w = hi.y;
            oacc[Tv] = __builtin_amdgcn_mfma_f32_16x16x32_bf16(__builtin_bit_cast(bf16x8, w), pb[s2], oacc[Tv], 0, 0, 0);
        }
    }
#pragma unroll
    for (int Tv = 0; Tv < 16; ++Tv) {
        const int dv = Tv * 16 + quad * 4;
        const u32x2 sg = *(const u32x2*)(proj + qrow * LDP + C_AS + h * 256 + dv);
        u32x2 o; o.x = pk2(oacc[Tv][0] * rs * bflo(sg.x), oacc[Tv][1] * rs * bfhi(sg.x)); o.y = pk2(oacc[Tv][2] * rs * bflo(sg.y), oacc[Tv][3] * rs * bfhi(sg.y));
        *(u32x2*)(aog_row + (Tv >> 2) * 16384 + (Tv & 3) * 16) = o;
    }
    __syncthreads();
}

__device__ __forceinline__ void attn_sample_item(const Params& p, int item, LAS unsigned char* lds, int tid) {
    LAS float* Ssh = (LAS float*)lds;
    LAS float* Psh = Ssh + 2048;
    LAS float* Opart = Psh + 2048;
    const int lane = tid & 63, wave = tid >> 6, l15 = lane & 15, quad = lane >> 4;
    const int n = item >> 2, h = item & 3;
    const bf16_t* proj = (const bf16_t*)(p.ws + WS_PROJ9);
    const size_t row0 = (size_t)NTP + (size_t)n * 8;
    const float* kc = p.cache_k + ((size_t)n * 256 * 4 + h) * 256;
    const float* vc = p.cache_v + ((size_t)n * 256 * 4 + h) * 256;
    {
        bf16x8 qf[8];
        const size_t qrow = row0 + (lane & 7);
#pragma unroll
        for (int s = 0; s < 8; ++s) qf[s] = *(const bf16x8*)(proj + qrow * LDP + C_AQ + h * 256 + s * 32 + quad * 8);
#pragma unroll
        for (int tl = 0; tl < 2; ++tl) {
            const int T = wave * 2 + tl;
            f32x4 sc = (f32x4){0.f, 0.f, 0.f, 0.f};
            const float* kr = kc + (size_t)(T * 16 + l15) * 1024 + quad * 8;
#pragma unroll
            for (int s = 0; s < 8; ++s) {
                const f32x4 k0 = *(const f32x4*)(kr + s * 32), k1 = *(const f32x4*)(kr + s * 32 + 4);
                u32x4 w; w.x = pk2(k0[0], k0[1]); w.y = pk2(k0[2], k0[3]); w.z = pk2(k1[0], k1[1]); w.w = pk2(k1[2], k1[3]);
                sc = __builtin_amdgcn_mfma_f32_16x16x32_bf16(__builtin_bit_cast(bf16x8, w), qf[s], sc, 0, 0, 0);
            }
            if (l15 < 8) {
#pragma unroll
                for (int e = 0; e < 4; ++e) Ssh[l15 * 256 + T * 16 + quad * 4 + e] = sc[e];
            }
        }
    }
    __syncthreads();
    {
        const f32x4 s4 = *(const LAS f32x4*)(Ssh + wave * 256 + lane * 4);
        const float mx = wave_max(fmaxf(fmaxf(s4[0], s4[1]), fmaxf(s4[2], s4[3])));
        f32x4 e4; e4[0] = __expf(s4[0] - mx); e4[1] = __expf(s4[1] - mx); e4[2] = __expf(s4[2] - mx); e4[3] = __expf(s4[3] - mx);
        const float rs = 1.f / wave_sum((e4[0] + e4[1]) + (e4[2] + e4[3]));
#pragma unroll
        for (int e = 0; e < 4; ++e) Psh[(lane * 4 + e) * 8 + wave] = e4[e] * rs;
    }
    __syncthreads();
    {
        f32x4 acc[8];
#pragma unroll
        for (int q = 0; q < 8; ++q) acc[q] = (f32x4){0.f, 0.f, 0.f, 0.f};
        const float* vr = vc + (size_t)(wave * 32) * 1024 + lane * 4;
#pragma unroll 8
        for (int kk = 0; kk < 32; ++kk) {
            const f32x4 v4 = *(const f32x4*)(vr + (size_t)kk * 1024);
            const f32x4 pa = *(const LAS f32x4*)(Psh + (wave * 32 + kk) * 8), pb = *(const LAS f32x4*)(Psh + (wave * 32 + kk) * 8 + 4);
            acc[0] += v4 * pa[0]; acc[1] += v4 * pa[1]; acc[2] += v4 * pa[2]; acc[3] += v4 * pa[3];
            acc[4] += v4 * pb[0]; acc[5] += v4 * pb[1]; acc[6] += v4 * pb[2]; acc[7] += v4 * pb[3];
        }
#pragma unroll
        for (int q = 0; q < 8; ++q) *(LAS f32x4*)(Opart + (wave * 8 + q) * 256 + lane * 4) = acc[q];
    }
    __syncthreads();
    {
        f32x4 o = (f32x4){0.f, 0.f, 0.f, 0.f};
#pragma unroll
        for (int w = 0; w < 8; ++w) o += *(const LAS f32x4*)(Opart + (w * 8 + wave) * 256 + lane * 4);
        const size_t r = row0 + wave;
        const u32x2 sg = *(const u32x2*)(proj + r * LDP + C_AS + h * 256 + lane * 4);
        u32x2 ov; ov.x = pk2(o[0] * bflo(sg.x), o[1] * bfhi(sg.x)); ov.y = pk2(o[2] * bflo(sg.y), o[3] * bfhi(sg.y));
        bf16_t* aog = (bf16_t*)(p.ws + WS_ACT3) + (size_t)2 * 9216 * 1024;
        *(u32x2*)(aog + tl(r, h * 256 + lane * 4, 1024)) = ov;
    }
    __syncthreads();
}

__device__ __forceinline__ void p2_mixers(const Params& p, LAS unsigned char* lds) {
    const int tid = threadIdx.x, G = gridDim.x, c = blockIdx.x, mask = p.pad;
    if ((mask & 1) && !(c & 1)) for (int it = c; it < 1024; it += G) hgrn_h1_item(p, it, lds, tid);
    if (mask & 2) { for (int it = c; it < 256; it += G) conv_item<false>(p, it, lds, tid);
                    for (int it = c; it < 128; it += G) conv_item<true>(p, it, lds, tid); }
    if (mask & 4) for (int it = c; it < 256; it += G) attn_prompt_item(p, it, lds, tid);
    if (mask & 8) for (int it = c; it < 512; it += G) attn_sample_item(p, it, lds, tid);
    if (mask & 16) for (int it = c; it < 1024; it += G) hgrn_sample_item(p, it, lds, tid);
    if ((mask & 1) && (c & 1)) for (int it = c; it < 1024; it += G) hgrn_h1_item(p, it, lds, tid);
}

__device__ __forceinline__ void p4b_merge(const Params& p) {
    const float* pm = (const float*)(p.ws + WS_MF); bf16_t* merged = (bf16_t*)(p.ws + WS_MERGED);
    for (int idx = blockIdx.x * 512 + threadIdx.x; idx < 1024 * 256; idx += gridDim.x * 512) {
        const int r = idx >> 8, c8 = (idx & 255) * 8;
        f32x4 a0 = (f32x4){0.f, 0.f, 0.f, 0.f}, a1 = a0;
#pragma unroll
        for (int q = 0; q < 4; ++q) { const float* src = pm + ((size_t)q * 1024 + r) * 2048 + c8; a0 += *(const f32x4*)src; a1 += *(const f32x4*)(src + 4); }
        u32x4 o; o.x = pk2(a0[0], a0[1]); o.y = pk2(a0[2], a0[3]); o.z = pk2(a1[0], a1[1]); o.w = pk2(a1[2], a1[3]);
        *(u32x4*)(merged + tl((size_t)NTP + r, c8, 2048)) = o;
    }
}

__device__ __forceinline__ void p6_final_norm(const Params& p) {
    const int tid = threadIdx.x, lane = tid & 63, gw = blockIdx.x * 8 + (tid >> 6), NGW = gridDim.x * 8;
    for (int r = gw; r < NTOK; r += NGW) {
        float* zr = p.out + (size_t)r * 2048;
        f32x4 v[8]; float ss = 0.f;
        if (r < NTP) {
#pragma unroll
            for (int j = 0; j < 8; ++j) v[j] = ((const f32x4*)zr)[lane + 64 * j];
        } else {
            const float* xr = p.x_sample + (size_t)(r - NTP) * 2048; const float* pr = (const float*)(p.ws + WS_MF) + (size_t)(r - NTP) * 2048;
#pragma unroll
            for (int j = 0; j < 8; ++j) v[j] = ((const f32x4*)xr)[lane + 64 * j];
#pragma unroll 2
            for (int ks = 0; ks < 8; ++ks) {
#pragma unroll
                for (int j = 0; j < 8; ++j) v[j] += ((const f32x4*)(pr + (size_t)ks * 1024 * 2048))[lane + 64 * j]; }
        }
#pragma unroll
        for (int j = 0; j < 8; ++j) ss += (v[j][0] * v[j][0] + v[j][1] * v[j][1]) + (v[j][2] * v[j][2] + v[j][3] * v[j][3]);
        ss = wave_sum(ss);
        const float rinv = rsqrtf(ss * (1.f / 2048.f) + EPS);
#pragma unroll
        for (int j = 0; j < 8; ++j) { const f32x4 gg = ((const f32x4*)p.g_final)[lane + 64 * j]; ((f32x4*)zr)[lane + 64 * j] = v[j] * rinv * gg; }
    }
}

#define XB_TMO      128
#define XB_XCNT(j)  (256  + 64 * (j))
#define XB_XSUB(j)  (1280 + 64 * (j))
#define XB_XGEN(j)  (2304 + 64 * (j))
#define XB_TOP      3328
#define XB_TOPGEN   3392
#define XCD_BAR_WORDS 3456
#define XB_SPIN_CAP (1u << 18)
__device__ __forceinline__ unsigned xb_ld(unsigned* p)              { return __hip_atomic_load(p, __ATOMIC_RELAXED, __HIP_MEMORY_SCOPE_AGENT); }
__device__ __forceinline__ unsigned xb_add(unsigned* p, unsigned v) { return __hip_atomic_fetch_add(p, v, __ATOMIC_RELAXED, __HIP_MEMORY_SCOPE_AGENT); }
__device__ __forceinline__ unsigned xb_xcc_id() { return (unsigned)__builtin_amdgcn_s_getreg((3 << 11) | 20) & 0xFu; }
#define XB_SPIN(cond, bar) do { unsigned _sp = 0; while (cond) { __builtin_amdgcn_s_sleep(1); \
    if ((++_sp & 255u) == 0u) { if (xb_ld(&(bar)[XB_TMO])) break; if (_sp > XB_SPIN_CAP) { atomicAdd(&(bar)[XB_TMO], 1u); break; } } } } while (0)
struct XcdBarrier { unsigned* bar; unsigned x; volatile LAS unsigned* st; };
__device__ __forceinline__ XcdBarrier xcd_barrier_post(unsigned* bar, volatile LAS unsigned* st) {
    XcdBarrier b; b.bar = bar; b.x = xb_xcc_id(); b.st = st;
    if (threadIdx.x == 0) (void)xb_add(&bar[XB_XCNT(b.x)], 1u);
    return b;
}
__device__ __forceinline__ void xcd_barrier_complete(unsigned* bar, unsigned x, unsigned& nloc, unsigned& nx) {
    const unsigned G = gridDim.x * gridDim.y * gridDim.z;
    unsigned sum, cnt, mine, sp = 0u;
    for (;;) {
        sum = 0u; cnt = 0u; mine = 0u;
#pragma unroll
        for (unsigned j = 0; j < 16; ++j) { const unsigned c = xb_ld(&bar[XB_XCNT(j)]); sum += c; cnt += (c > 0u) ? 1u : 0u; mine = (j == x) ? c : mine; }
        if (sum == G) break;
        __builtin_amdgcn_s_sleep(1);
        if ((++sp & 255u) == 0u) { if (xb_ld(&bar[XB_TMO])) break; if (sp > XB_SPIN_CAP) { atomicAdd(&bar[XB_TMO], 1u); break; } }
    }
    nloc = mine > 0u ? mine : 1u; nx = cnt > 0u ? cnt : 1u;
}
__device__ __forceinline__ void xcd_barrier(unsigned* bar, unsigned bx, volatile LAS unsigned* st) {
    asm volatile("s_waitcnt vmcnt(0)" ::: "memory");
    __syncthreads();
    if (threadIdx.x == 0) {
        __builtin_amdgcn_s_waitcnt(0);
        unsigned nloc = st[0], nx = st[1];
        if (nloc == 0u) { xcd_barrier_complete(bar, bx, nloc, nx); st[0] = nloc; st[1] = nx; }
        const unsigned old = xb_add(&bar[XB_XSUB(bx)], 1u);
        const unsigned gen = old / nloc;
        if (old + 1u == (gen + 1u) * nloc) {
            __builtin_amdgcn_fence(__ATOMIC_RELEASE, "agent");
            asm volatile("s_waitcnt vmcnt(0)" ::: "memory");
            const unsigned og = xb_add(&bar[XB_TOP], 1u);
            const unsigned tg = og / nx;
            if (og + 1u == (tg + 1u) * nx) xb_add(&bar[XB_TOPGEN], 1u);
            else XB_SPIN(xb_ld(&bar[XB_TOPGEN]) == tg, bar);
            __builtin_amdgcn_fence(__ATOMIC_ACQUIRE, "agent");
            xb_add(&bar[XB_XGEN(bx)], 1u);
            asm volatile("s_waitcnt vmcnt(0)" ::: "memory");
        } else {
            XB_SPIN(xb_ld(&bar[XB_XGEN(bx)]) == gen, bar);
            __builtin_amdgcn_fence(__ATOMIC_ACQUIRE, "agent");
            asm volatile("s_waitcnt vmcnt(0)" ::: "memory");
        }
    }
    __syncthreads();
}

__global__ void __launch_bounds__(512, 2) fwd_megakernel(Params p) {
    extern __shared__ __attribute__((aligned(16))) unsigned char shm[];
    LAS unsigned char* lds = (LAS unsigned char*)shm;
    cg::grid_group grid = cg::this_grid();
    const int G = gridDim.x, c = blockIdx.x;
    volatile LAS unsigned* xst = (volatile LAS unsigned*)(lds + LDS_PHASE_BYTES);
    unsigned* xbar = (unsigned*)(p.ws + WS_BAR); unsigned xbx = 0u;
    if (p.coop) { if (threadIdx.x == 0) { xst[0] = 0u; xst[1] = 0u; } __syncthreads(); const XcdBarrier xb = xcd_barrier_post(xbar, xst); xbx = xb.x;
        grid.sync(); }
#define SEAM(ph) do { if (p.coop && (ph) + 1 < p.ph_hi) xcd_barrier(xbar, xbx, xst); } while (0)
#define RUNS(ph) (p.ph_lo <= (ph) && (ph) < p.ph_hi)
    if (RUNS(0)) { p0_prologue(p, lds); SEAM(0); }
    if (RUNS(1)) {
        SchedP1 S; S.G = G; S.c = c; S.A = (const char*)(p.ws + WS_HA); S.Bt = (const char*)(p.ws + WS_WT1);
        EpiP1 E; E.proj = (bf16_t*)(p.ws + WS_PROJ9); E.gate = (bf16_t*)(p.ws + WS_GATE); E.F = (float*)(p.ws + WS_F); E.lb = (const float*)(p.ws + WS_LB);
        E.b_gate = p.b_gate; E.out = p.out; E.mkb = (bf16_t*)(p.ws + WS_MKB); E.mvt = (bf16_t*)(p.ws + WS_MVT);
        pg8::gemm_phase(lds, 2048, S, E); SEAM(1);
    }
    if (RUNS(2)) { p2_mixers(p, lds); SEAM(2); }
    if (RUNS(3)) { hgrn_h2_scan(p); SEAM(3); }
    if (RUNS(4)) { for (int it = c; it < 1024; it += G) hgrn_h3_item(p, it, lds, threadIdx.x); SEAM(4); }
    if (RUNS(5)) {
        SchedP4 S; S.G = G; S.c = c; S.A = (const char*)(p.ws + WS_ACT3); S.Bt = (const char*)(p.ws + WS_WT3);
        EpiP4 E; E.gate = (const bf16_t*)(p.ws + WS_GATE); E.merged = (bf16_t*)(p.ws + WS_MERGED); E.partm = (float*)(p.ws + WS_MF);
        pg8::gemm_phase(lds, 1024, S, E); SEAM(5);
    }
    if (RUNS(6)) { p4b_merge(p); SEAM(6); }
    if (RUNS(7)) {
        SchedP5 S; S.G = G; S.c = c; S.A = (const char*)(p.ws + WS_MERGED); S.Bt = (const char*)(p.ws + WS_WTO);
        EpiP5 E; E.xp = p.x_prompt; E.xs = p.x_sample; E.out = p.out; E.part = (float*)(p.ws + WS_MF);
        pg8::gemm_phase(lds, 2048, S, E); SEAM(7);
    }
    if (RUNS(8)) { p6_final_norm(p); }
#undef RUNS
#undef SEAM
}

extern "C" void kernel_launch(void* const* d_in, const int* in_sizes, int n_in, void* d_out, int out_size, void* d_ws, size_t ws_size, hipStream_t stream) {
    static int grid = 0;
    if (grid == 0) {
        if (n_in != 23 || ws_size < WS_END) { fprintf(stderr, "kernel_launch: expected 23 inputs and >= %zu bytes of workspace, got %d / %zu\n", (size_t)WS_END, n_in, ws_size); grid = -1; return; }
        int dev = 0, cus = 0, per_cu = 0;
        hipGetDevice(&dev); hipDeviceGetAttribute(&cus, hipDeviceAttributeMultiprocessorCount, dev);
        if (hipFuncSetAttribute((const void*)fwd_megakernel, hipFuncAttributeMaxDynamicSharedMemorySize, LDS_BYTES) != hipSuccess) { fprintf(stderr, "kernel_launch: hipFuncSetAttribute failed\n"); grid = -1; return; }
        if (hipOccupancyMaxActiveBlocksPerMultiprocessor(&per_cu, (const void*)fwd_megakernel, 512, LDS_BYTES) != hipSuccess || per_cu < 1) { fprintf(stderr, "kernel_launch: occupancy query failed (%d)\n", per_cu); (void)hipGetLastError(); per_cu = 1; }
        grid = cus * 1;
        if (grid <= 0) grid = 256;
    }
    if (grid < 0) return;
    Params p{};
    const float** pp = (const float**)&p;
    for (int i = 0; i < 23; ++i) pp[i] = (const float*)d_in[i];
    p.out = (float*)d_out; p.ws = (unsigned char*)d_ws; p.pad = 31;
#if N_LAUNCH_MODE == 1
    p.ph_lo = 0; p.ph_hi = N_PHASES; p.coop = 1;
    if (hipMemsetAsync((char*)d_ws + WS_BAR, 0, WS_BAR_BYTES, stream) != hipSuccess) { fprintf(stderr, "kernel_launch: memset of the barrier words failed\n"); return; }
    void* args[] = {&p};
    hipError_t e = hipLaunchCooperativeKernel((const void*)fwd_megakernel, dim3(grid), dim3(512), args, LDS_BYTES, stream);
    if (e != hipSuccess) fprintf(stderr, "cooperative launch failed: %s (grid %d)\n", hipGetErrorString(e), grid);
#else
    for (int ph = 0; ph < N_PHASES; ++ph) {
        p.ph_lo = ph; p.ph_hi = ph + 1; p.coop = 0;
        hipLaunchKernelGGL(fwd_megakernel, dim3(grid), dim3(512), LDS_BYTES, stream, p);
        if ((REP_MASK >> ph) & 1) { if (ph == 2) p.pad = P2_SUBMASK; hipLaunchKernelGGL(fwd_megakernel, dim3(grid), dim3(512), LDS_BYTES, stream, p); p.pad = 31; }
    }
#endif
}
```

```cpp
#include <hip/hip_runtime.h>
#include <hip/hip_cooperative_groups.h>
#include <cstdio>
namespace cg = cooperative_groups;

#define LAS __attribute__((address_space(3)))
typedef unsigned short bf16_t;
typedef short bf16x8 __attribute__((ext_vector_type(8)));
typedef float f32x4 __attribute__((ext_vector_type(4)));
typedef float f32x2 __attribute__((ext_vector_type(2)));
typedef unsigned u32x4 __attribute__((ext_vector_type(4)));
typedef unsigned u32x2 __attribute__((ext_vector_type(2)));

#ifndef REP_MASK
#define REP_MASK 0
#endif
#ifndef P2_SUBMASK
#define P2_SUBMASK 31
#endif
#ifndef N_LAUNCH_MODE
#define N_LAUNCH_MODE 1
#endif

constexpr int DM = 2048, NTP = 8192, NTS = 1024, NTOK = 9216, SEQ = 2048;
constexpr int LDP = 9216;
constexpr int C_CV = 0, C_CG = 1024, C_CS = 2048, C_HQ = 3072, C_HF = 4096, C_HI = 5120, C_HOG = 6144, C_AQ = 7168, C_AS = 8192;
constexpr int LDG = 6144;
constexpr float EPS = 1e-6f;
constexpr size_t O_YP = 0, O_YS = 16777216, O_CONV_P = 18874368, O_HGRN_P = 18997248, O_MK = 19521536, O_MV = 20570112, O_CONV_S = 21618688, O_HGRN_S = 25550848;
constexpr size_t WS_WT1 = 0;
constexpr size_t WS_WT3 = WS_WT1 + (size_t)17408 * 2048 * 2;
constexpr size_t WS_WTO = WS_WT3 + (size_t)3 * 2048 * 1024 * 2;
constexpr size_t WS_HA = WS_WTO + (size_t)2048 * 2048 * 2;
constexpr size_t WS_ST = WS_HA;
constexpr size_t WS_DD = WS_HA + (size_t)33554432;
constexpr size_t WS_UT = WS_WT1;
constexpr size_t WS_PROJ9 = WS_HA + (size_t)10240 * 2048 * 2;
constexpr size_t WS_MF = WS_PROJ9;
constexpr size_t WS_MERGED = WS_MF + (size_t)9216 * 2048 * 4;
constexpr size_t WS_GATE = WS_PROJ9 + (size_t)9216 * 9216 * 2;
constexpr size_t WS_F = WS_GATE + (size_t)9216 * 6144 * 2;
constexpr size_t WS_MKB = WS_F + (size_t)9216 * 1024 * 4;
constexpr size_t WS_MVT = WS_MKB + (size_t)2097152;
constexpr size_t WS_ACT3 = WS_MVT + (size_t)2097152;
constexpr size_t WS_LB = WS_ACT3 + (size_t)3 * 9216 * 1024 * 2;
constexpr size_t WS_BAR = WS_LB + 4096;
constexpr size_t WS_BAR_BYTES = 16384;
constexpr size_t WS_RS = WS_BAR + WS_BAR_BYTES;
constexpr size_t WS_ZERO_BYTES = WS_BAR_BYTES + 32768;
constexpr size_t WS_END = WS_BAR + WS_ZERO_BYTES;
constexpr int LDS_PHASE_BYTES = 131072, LDS_BYTES = LDS_PHASE_BYTES + 64;
constexpr int N_PHASES = 9;

struct Params {
    const float *x_prompt, *x_sample, *state_conv, *state_hgrn, *cache_k, *cache_v, *mem_prompt, *g_pre, *w_in, *conv_w, *conv_b, *ln_g, *ln_b,
        *w_conv_out, *lb_logits, *g_hgrn, *w_hgrn_out, *g_mem, *w_mem_kv, *w_attn_out, *b_gate, *w_out, *g_final;
    float* out; unsigned char* ws; int ph_lo, ph_hi, coop, pad;
};

__device__ __forceinline__ unsigned f2bf(float f) { unsigned u = __builtin_bit_cast(unsigned, f); return (u + 0x7fffu + ((u >> 16) & 1u)) >> 16; }
typedef __bf16 bf16x2_t __attribute__((ext_vector_type(2)));
__device__ __forceinline__ unsigned pk2(float lo, float hi) { const f32x2 v = {lo, hi}; const bf16x2_t r = __builtin_convertvector(v, bf16x2_t); return __builtin_bit_cast(unsigned, r); }
__device__ __forceinline__ float bflo(unsigned w) { return __builtin_bit_cast(float, w << 16); }
__device__ __forceinline__ float bfhi(unsigned w) { return __builtin_bit_cast(float, w & 0xffff0000u); }
__device__ __forceinline__ float bf2f(unsigned short b) { return __builtin_bit_cast(float, ((unsigned)b) << 16); }
__device__ __forceinline__ float sigm(float x) { return __builtin_amdgcn_rcpf(1.f + __expf(-x)); }
__device__ __forceinline__ float siluf(float x) { return x * sigm(x); }
__device__ __forceinline__ size_t tl(size_t row, int col, int K) { return (row >> 8) * ((size_t)256 * K) + (size_t)(col >> 6) * (256 * 64) + (row & 255) * 64 + (col & 63); }
__device__ __forceinline__ float wave_sum(float v) {
#pragma unroll
    for (int o = 1; o < 64; o <<= 1) v += __shfl_xor(v, o);
    return v;
}
__device__ __forceinline__ void st_nt(u32x4* p, u32x4 v) { __builtin_nontemporal_store(v, p); }
__device__ __forceinline__ void st_nt(f32x4* p, f32x4 v) { __builtin_nontemporal_store(v, p); }
__device__ __forceinline__ u32x4 ld_nt16(const bf16_t* p) { return __builtin_nontemporal_load((const u32x4*)p); }
__device__ __forceinline__ f32x4 ld_nt(const float* p) { return __builtin_nontemporal_load((const f32x4*)p); }
__device__ __forceinline__ float wave_max(float v) {
#pragma unroll
    for (int o = 1; o < 64; o <<= 1) v = fmaxf(v, __shfl_xor(v, o));
    return v;
}

namespace pg8 {
constexpr int BM = 256, BK = 64, HALF = 128, HTB = HALF * BK * 2, STAGE_BYTES = 8 * HTB, NXCD = 8, WGM = 8;
__host__ __device__ __forceinline__ int lds_byte(int r, int c) { const int st = (r >> 4) * 2 + (c >> 5), rr = r & 15, cc = c & 31, ob = rr * 64 + cc * 2; return st * 1024 + (ob ^ (((ob >> 9) & 1) << 5)); }
__host__ __device__ __forceinline__ void stage_rc(int b, int& R, int& C) { const int st = b / 1024, sb = b % 1024, swz = sb ^ (((sb >> 9) & 1) << 5); R = (st >> 1) * 16 + swz / 64; C = (st & 1) * 32 + (swz % 64) / 2; }
__host__ __device__ __forceinline__ int perm32(int rho) { const int n = rho >> 4, i = rho & 15; return 8 * (i >> 2) + 4 * n + (i & 3); }
struct Unit { int pm, pn, br, sl; };
__device__ __forceinline__ void tile_of(int wgid, int nM, int nN, int& pm, int& pn) {
    const int nwg = nM * nN;
    { const int q = nwg / NXCD, r = nwg % NXCD, xcd = wgid % NXCD, off = wgid / NXCD; wgid = (xcd < r ? xcd * (q + 1) : r * (q + 1) + (xcd - r) * q) + off; }
    const int nig = WGM * nN, gid = wgid / nig, fm = gid * WGM, gsz = (nM - fm) < WGM ? (nM - fm) : WGM;
    pm = fm + ((wgid % nig) % gsz); pn = (wgid % nig) / gsz;
}

template <class Epi, class Sched>
__device__ __forceinline__ void gemm_phase(LAS unsigned char* lds, const int K, const Sched& S, const Epi& E) {
    const int tid = threadIdx.x, wid = __builtin_amdgcn_readfirstlane(tid >> 6), lane = tid & 63, wr = wid >> 2, wc = wid & 3, fr = lane & 15, fq = lane >> 4;
    unsigned voffA[2], voffB[2];
#pragma unroll
    for (int i = 0; i < 2; ++i) { int R, C; stage_rc(tid * 16 + i * 8192, R, C); const int Rb = (R & ~31) + perm32(R & 31);
        voffA[i] = (unsigned)(R * BK + C) * 2u; voffB[i] = (unsigned)(Rb * BK + C) * 2u; }
    const size_t kstep = (size_t)(BM * BK * 2);
    const size_t hstep = (size_t)HALF * BK * 2;
    const unsigned ldsw = (unsigned)wid * 1024u;
    const int aoff = lds_byte(wr * 64 + fr, fq * 8), boff = lds_byte(wc * 32 + fr, fq * 8);
#define PG8_SA(b, h) (((b) * 2 + (h)) * HTB)
#define PG8_SB(b, h) ((4 + (b) * 2 + (h)) * HTB)
#define PG8_STAGE(bufoff, gbase, voff) do { _Pragma("unroll") for (int _i = 0; _i < 2; ++_i) \
        __builtin_amdgcn_global_load_lds((const unsigned*)((const char*)(gbase) + (voff)[_i]), (LAS unsigned*)(lds + (bufoff) + ldsw + _i * 8192), 16, 0, 0); } while (0)
#define PG8_LDA(dst, b, h) do { _Pragma("unroll") for (int m = 0; m < 4; ++m) _Pragma("unroll") for (int k = 0; k < 2; ++k) dst[m][k] = *(const LAS bf16x8*)(lds + PG8_SA(b, h) + aoff + m * 2048 + k * 1024); } while (0)
#define PG8_LDB(dst, b, h) do { _Pragma("unroll") for (int n = 0; n < 2; ++n) _Pragma("unroll") for (int k = 0; k < 2; ++k) dst[n][k] = *(const LAS bf16x8*)(lds + PG8_SB(b, h) + boff + n * 2048 + k * 1024); } while (0)
#define PG8_MMA(ai, bj, At, Bt) do { __builtin_amdgcn_s_setprio(1); _Pragma("unroll") for (int m = 0; m < 4; ++m) _Pragma("unroll") for (int n = 0; n < 2; ++n) _Pragma("unroll") for (int k = 0; k < 2; ++k) \
        acc[ai][bj][m][n] = __builtin_amdgcn_mfma_f32_16x16x32_bf16(Bt[n][k], At[m][k], acc[ai][bj][m][n], 0, 0, 0); __builtin_amdgcn_s_setprio(0); } while (0)
#define PG8_WAIT_V(n) asm volatile("s_waitcnt vmcnt(" #n ")" ::: "memory")
#define PG8_WAIT_L(n) asm volatile("s_waitcnt lgkmcnt(" #n ")" ::: "memory")
#define PG8_BAR __builtin_amdgcn_s_barrier()
#define PG8_SCHED __builtin_amdgcn_sched_barrier(0)
    Unit cur, nxt; int ui = 0;
    if (!S.next(0, cur)) return;
    f32x4 acc[2][2][4][2];
#pragma unroll
    for (int a = 0; a < 2; ++a)
#pragma unroll
        for (int b = 0; b < 2; ++b)
#pragma unroll
            for (int m = 0; m < 4; ++m)
#pragma unroll
                for (int n = 0; n < 2; ++n) acc[a][b][m][n] = (f32x4){0.f, 0.f, 0.f, 0.f};
    bf16x8 At[4][2], B0[2][2], B1[2][2];
    const char* cA = S.a_base(cur); const char* cB = S.b_base(cur);
    PG8_STAGE(PG8_SB(0, 0), cB, voffB); PG8_STAGE(PG8_SB(0, 1), cB + hstep, voffB); PG8_STAGE(PG8_SA(0, 0), cA, voffA); PG8_STAGE(PG8_SA(0, 1), cA + hstep, voffA);
    if (wr == 1) PG8_BAR;
    PG8_WAIT_V(2); PG8_BAR;
    PG8_STAGE(PG8_SB(1, 0), cB + kstep, voffB); PG8_STAGE(PG8_SA(1, 0), cA + kstep, voffA); PG8_STAGE(PG8_SB(1, 1), cB + hstep + kstep, voffB);
    PG8_WAIT_V(6); PG8_BAR;
    for (;;) {
        const bool has_next = S.next(ui + 1, nxt);
        const char* nA = has_next ? S.a_base(nxt) : cA; const char* nB = has_next ? S.b_base(nxt) : cB;
        const int nt = S.nt(cur);
        for (int t = 0; t < nt; t += 2) {
            const bool last = (t == nt - 2);
            const char* a1 = cA + (size_t)(t + 1) * kstep;
            const char* a2 = last ? nA : cA + (size_t)(t + 2) * kstep; const char* b2 = last ? nB : cB + (size_t)(t + 2) * kstep;
            const char* a3 = a2 + kstep; const char* b3 = b2 + kstep;
            PG8_LDB(B0, 0, 0); PG8_LDB(B1, 0, 1); PG8_SCHED; PG8_LDA(At, 0, 0); PG8_STAGE(PG8_SA(1, 1), a1 + hstep, voffA);
            PG8_WAIT_V(8); PG8_WAIT_L(0); PG8_BAR; PG8_MMA(0, 0, At, B0); PG8_MMA(0, 1, At, B1); PG8_BAR; PG8_SCHED;
            PG8_LDA(At, 0, 1); PG8_STAGE(PG8_SB(0, 0), b2, voffB); PG8_STAGE(PG8_SB(0, 1), b2 + hstep, voffB); PG8_STAGE(PG8_SA(0, 0), a2, voffA);
            PG8_WAIT_V(8); PG8_WAIT_L(0); PG8_BAR; PG8_MMA(1, 0, At, B0); PG8_MMA(1, 1, At, B1); PG8_BAR; PG8_SCHED;
            PG8_LDB(B0, 1, 0); PG8_LDB(B1, 1, 1); PG8_SCHED; PG8_LDA(At, 1, 0); PG8_STAGE(PG8_SA(0, 1), a2 + hstep, voffA);
            PG8_WAIT_V(8); PG8_WAIT_L(0); PG8_BAR; PG8_MMA(0, 0, At, B0); PG8_MMA(0, 1, At, B1); PG8_BAR; PG8_SCHED;
            PG8_LDA(At, 1, 1); PG8_STAGE(PG8_SB(1, 0), b3, voffB); PG8_STAGE(PG8_SB(1, 1), b3 + hstep, voffB); PG8_STAGE(PG8_SA(1, 0), a3, voffA);
            PG8_WAIT_V(8); PG8_WAIT_L(0); PG8_BAR; PG8_MMA(1, 0, At, B0); PG8_MMA(1, 1, At, B1); PG8_BAR; PG8_SCHED;
        }
        if (wr == 0) PG8_BAR;
        const bool keep = E(acc, cur, wr, wc, fr, fq);
        if (!has_next) break;
        if (!keep)
#pragma unroll
        for (int a = 0; a < 2; ++a)
#pragma unroll
            for (int b = 0; b < 2; ++b)
#pragma unroll
                for (int m = 0; m < 4; ++m)
#pragma unroll
                    for (int n = 0; n < 2; ++n) acc[a][b][m][n] = (f32x4){0.f, 0.f, 0.f, 0.f};
        cur = nxt; cA = nA; cB = nB; ++ui;
        if (wr == 1) PG8_BAR;
    }
    PG8_WAIT_V(0);
    PG8_BAR;
#undef PG8_SA
#undef PG8_SB
#undef PG8_STAGE
#undef PG8_LDA
#undef PG8_LDB
#undef PG8_MMA
#undef PG8_WAIT_V
#undef PG8_WAIT_L
#undef PG8_BAR
#undef PG8_SCHED
}
}
using pg8::Unit;

#define XB_TMO      128
#define XB_XCNT(j)  (256  + 64 * (j))
#define XB_XSUB(j)  (1280 + 64 * (j))
#define XB_XGEN(j)  (2304 + 64 * (j))
#define XB_TOP      3328
#define XB_TOPGEN   3392
#define XCD_BAR_WORDS 3456
#define XB_SPIN_CAP (1u << 18)
__device__ __forceinline__ unsigned xb_ld(unsigned* p)              { return __hip_atomic_load(p, __ATOMIC_RELAXED, __HIP_MEMORY_SCOPE_AGENT); }
__device__ __forceinline__ unsigned xb_add(unsigned* p, unsigned v) { return __hip_atomic_fetch_add(p, v, __ATOMIC_RELAXED, __HIP_MEMORY_SCOPE_AGENT); }
__device__ __forceinline__ unsigned xb_xcc_id() { return (unsigned)__builtin_amdgcn_s_getreg((3 << 11) | 20) & 0xFu; }
#define XB_SPIN(cond, bar) do { unsigned _sp = 0; while (cond) { __builtin_amdgcn_s_sleep(1); \
    if ((++_sp & 255u) == 0u) { if (xb_ld(&(bar)[XB_TMO])) break; if (_sp > XB_SPIN_CAP) { atomicAdd(&(bar)[XB_TMO], 1u); break; } } } } while (0)
struct XcdBarrier { unsigned* bar; unsigned x; volatile LAS unsigned* st; };
__device__ __forceinline__ XcdBarrier xcd_barrier_post(unsigned* bar, volatile LAS unsigned* st) {
    XcdBarrier b; b.bar = bar; b.x = xb_xcc_id(); b.st = st;
    if (threadIdx.x == 0) (void)xb_add(&bar[XB_XCNT(b.x)], 1u);
    return b;
}
__device__ __forceinline__ void xcd_barrier_complete(unsigned* bar, unsigned x, unsigned& nloc, unsigned& nx) {
    const unsigned G = gridDim.x * gridDim.y * gridDim.z;
    unsigned sum, cnt, mine, sp = 0u;
    for (;;) {
        sum = 0u; cnt = 0u; mine = 0u;
#pragma unroll
        for (unsigned j = 0; j < 16; ++j) { const unsigned c = xb_ld(&bar[XB_XCNT(j)]); sum += c; cnt += (c > 0u) ? 1u : 0u; mine = (j == x) ? c : mine; }
        if (sum == G) break;
        __builtin_amdgcn_s_sleep(1);
        if ((++sp & 255u) == 0u) { if (xb_ld(&bar[XB_TMO])) break; if (sp > XB_SPIN_CAP) { atomicAdd(&bar[XB_TMO], 1u); break; } }
    }
    nloc = mine > 0u ? mine : 1u; nx = cnt > 0u ? cnt : 1u;
}
__device__ __forceinline__ void xcd_barrier(unsigned* bar, unsigned bx, volatile LAS unsigned* st) {
    asm volatile("s_waitcnt vmcnt(0)" ::: "memory");
    __syncthreads();
    if (threadIdx.x == 0) {
        __builtin_amdgcn_s_waitcnt(0);
        unsigned nloc = st[0], nx = st[1];
        if (nloc == 0u) { xcd_barrier_complete(bar, bx, nloc, nx); st[0] = nloc; st[1] = nx; }
        const unsigned old = xb_add(&bar[XB_XSUB(bx)], 1u);
        const unsigned gen = old / nloc;
        if (old + 1u == (gen + 1u) * nloc) {
            __builtin_amdgcn_fence(__ATOMIC_RELEASE, "agent");
            asm volatile("s_waitcnt vmcnt(0)" ::: "memory");
            const unsigned og = xb_add(&bar[XB_TOP], 1u);
            const unsigned tg = og / nx;
            if (og + 1u == (tg + 1u) * nx) xb_add(&bar[XB_TOPGEN], 1u);
            else XB_SPIN(xb_ld(&bar[XB_TOPGEN]) == tg, bar);
            __builtin_amdgcn_fence(__ATOMIC_ACQUIRE, "agent");
            xb_add(&bar[XB_XGEN(bx)], 1u);
            asm volatile("s_waitcnt vmcnt(0)" ::: "memory");
        } else {
            XB_SPIN(xb_ld(&bar[XB_XGEN(bx)]) == gen, bar);
            __builtin_amdgcn_fence(__ATOMIC_ACQUIRE, "agent");
            asm volatile("s_waitcnt vmcnt(0)" ::: "memory");
        }
    }
    __syncthreads();
}

struct SchedP1 {
    int G, c; const char* A; const char* Bt;
    __device__ __forceinline__ bool next(int i, Unit& u) const {
        const int L = i * G + c; if (L >= 2192) return false;
        u.br = 0; u.sl = 0;
        if (L >= 2160) { const int idx = L - 2160; u.pm = 36 + (idx >> 3); u.pn = 60 + (idx & 7); return true; }
        pg8::tile_of(L, 36, 60, u.pm, u.pn); return true;
    }
    __device__ __forceinline__ const char* a_base(const Unit& u) const { return A + (size_t)u.pm * (256 * 2048 * 2); }
    __device__ __forceinline__ const char* b_base(const Unit& u) const { return Bt + (size_t)u.pn * (256 * 2048 * 2); }
    __device__ __forceinline__ int nt(const Unit&) const { return 32; }
};
struct EpiP1 {
    bf16_t* proj; bf16_t* gate; float* F; const float* lb; const float* b_gate; float* out; bf16_t* mkb; bf16_t* mvt;
    __device__ __forceinline__ bool operator()(f32x4 (&acc)[2][2][4][2], const Unit& u, int wr, int wc, int fr, int fq) const {
        const int rloc = wr * 64 + fr, cloc = wc * 32 + 8 * fq;
        if (u.pn < 36) {
            const int seg = u.pn >> 2;
#pragma unroll
            for (int bj = 0; bj < 2; ++bj) {
                const int col = u.pn * 256 + bj * 128 + cloc;
                f32x4 l0 = (f32x4){0.f, 0.f, 0.f, 0.f}, l1 = l0;
                if (seg == 4) { l0 = *(const f32x4*)(lb + (col - C_HF)); l1 = *(const f32x4*)(lb + (col - C_HF) + 4); }
#pragma unroll
                for (int ai = 0; ai < 2; ++ai)
#pragma unroll
                    for (int m = 0; m < 4; ++m) {
                        const size_t row = (size_t)u.pm * 256 + ai * 128 + m * 16 + rloc;
                        f32x4 v0 = acc[ai][bj][m][0], v1 = acc[ai][bj][m][1];
                        if (seg == 4) {
#pragma unroll
                            for (int e = 0; e < 4; ++e) { v0[e] = l0[e] + (1.f - l0[e]) * sigm(v0[e]); v1[e] = l1[e] + (1.f - l1[e]) * sigm(v1[e]); }
                            float* fp = F + row * 1024 + (col - C_HF);
                            st_nt((f32x4*)fp, v0); st_nt((f32x4*)(fp + 4), v1);
                        } else {
                            if (seg == 1) {
#pragma unroll
                                for (int e = 0; e < 4; ++e) { v0[e] = sigm(v0[e]); v1[e] = sigm(v1[e]); }
                            } else if (seg == 2 || seg == 6 || seg == 8) {
#pragma unroll
                                for (int e = 0; e < 4; ++e) { v0[e] = siluf(v0[e]); v1[e] = siluf(v1[e]); }
                            } else if (seg == 3) { v0 *= 0.08838834764831845f; v1 *= 0.08838834764831845f; }
                            else if (seg == 7) { v0 *= 0.0625f; v1 *= 0.0625f; }
                            u32x4 o; o.x = pk2(v0[0], v0[1]); o.y = pk2(v0[2], v0[3]); o.z = pk2(v1[0], v1[1]); o.w = pk2(v1[2], v1[3]);
                            st_nt((u32x4*)(proj + row * LDP + col), o);
                        }
                    }
            }
        } else if (u.pn < 60) {
            const int etid = (wr * 4 + wc) * 64 + fq * 16 + fr;
#pragma unroll
            for (int bj = 0; bj < 2; ++bj) {
                const int col = (u.pn - 36) * 256 + bj * 128 + cloc;
                const f32x4 b0 = *(const f32x4*)(b_gate + col), b1 = *(const f32x4*)(b_gate + col + 4);
#pragma unroll
                for (int ai = 0; ai < 2; ++ai)
#pragma unroll
                    for (int m = 0; m < 4; ++m) {
                        const size_t row = (size_t)u.pm * 256 + ai * 128 + m * 16 + rloc;
                        f32x4 v0 = acc[ai][bj][m][0] + b0, v1 = acc[ai][bj][m][1] + b1;
#pragma unroll
                        for (int e = 0; e < 4; ++e) { v0[e] = fmaxf(sigm(v0[e]), 1e-6f); v1[e] = fmaxf(sigm(v1[e]), 1e-6f); }
                        u32x4 o; o.x = pk2(v0[0], v0[1]); o.y = pk2(v0[2], v0[3]); o.z = pk2(v1[0], v1[1]); o.w = pk2(v1[2], v1[3]);
                        st_nt((u32x4*)(gate + ((((size_t)u.pm * 24 + (u.pn - 36)) * 16 + (ai * 8 + m * 2 + bj)) * 512 + etid) * 8), o);
                    }
            }
        } else {
            const int n = u.pm - 36, isv = (u.pn >= 64) ? 1 : 0, h = (u.pn - 60) & 3;
            float* ob = out + (isv ? O_MV : O_MK);
#pragma unroll
            for (int bj = 0; bj < 2; ++bj) {
                const int d = bj * 128 + cloc;
#pragma unroll
                for (int ai = 0; ai < 2; ++ai)
#pragma unroll
                    for (int m = 0; m < 4; ++m) {
                        const int key = ai * 128 + m * 16 + rloc;
                        const f32x4 v0 = acc[ai][bj][m][0], v1 = acc[ai][bj][m][1];
                        float* op = ob + ((size_t)(n * 256 + key) * 4 + h) * 256 + d;
                        st_nt((f32x4*)op, v0); st_nt((f32x4*)(op + 4), v1);
                        if (!isv) {
                            u32x4 o; o.x = pk2(v0[0], v0[1]); o.y = pk2(v0[2], v0[3]); o.z = pk2(v1[0], v1[1]); o.w = pk2(v1[2], v1[3]);
                            *(u32x4*)(mkb + ((size_t)(n * 4 + h) * 256 + key) * 256 + d) = o;
                        } else {
                            bf16_t* vp = mvt + ((size_t)(n * 4 + h) * 256 + d) * 256 + key;
#pragma unroll
                            for (int e = 0; e < 4; ++e) { vp[(size_t)e * 256] = (bf16_t)f2bf(v0[e]); vp[(size_t)(e + 4) * 256] = (bf16_t)f2bf(v1[e]); }
                        }
                    }
            }
        }
        return false;
    }
};

struct SchedP4 {
    int G, c; const char* A; const char* Bt;
    __device__ __forceinline__ bool next(int i, Unit& u) const {
        int tri = i / 3; const int b = i - tri * 3;
        if (c < 128 && G == 256) tri ^= 1;
        const int L = tri * G + c;
        u.br = b;
        if (L < 256) { u.sl = 0; pg8::tile_of(L, 32, 8, u.pm, u.pn); return true; }
        const int j = L - 256; if (j >= 128) return false;
        const int tj = j >> 2; u.sl = 1 + (j & 3); u.pm = 32 + (tj >> 3); u.pn = tj & 7; return true;
    }
    __device__ __forceinline__ const char* a_base(const Unit& u) const {
        return A + (size_t)u.br * ((size_t)9216 * 1024 * 2) + (size_t)u.pm * (256 * 1024 * 2) + (u.sl ? (size_t)(u.sl - 1) * (4 * 32768) : 0); }
    __device__ __forceinline__ const char* b_base(const Unit& u) const {
        return Bt + (size_t)u.br * ((size_t)2048 * 1024 * 2) + (size_t)u.pn * (256 * 1024 * 2) + (u.sl ? (size_t)(u.sl - 1) * (4 * 32768) : 0); }
    __device__ __forceinline__ int nt(const Unit& u) const { return u.sl ? 4 : 16; }
};
struct EpiP4 {
    const bf16_t* gate; bf16_t* merged; float* partm;
    __device__ __forceinline__ bool operator()(f32x4 (&acc)[2][2][4][2], const Unit& u, int wr, int wc, int fr, int fq) const {
        const int rloc = wr * 64 + fr, cloc = wc * 32 + 8 * fq;
        const int sl = u.sl, ubr = u.br;
        const int etid = (wr * 4 + wc) * 64 + fq * 16 + fr;
        const bf16_t* gt = gate + (((size_t)u.pm * 24 + (ubr * 8 + u.pn)) * 16) * 4096 + etid * 8;
        if (ubr < 2) {
#pragma unroll
            for (int bj = 0; bj < 2; ++bj) {
                u32x4 gv[8], hv[8];
#pragma unroll
                for (int q = 0; q < 8; ++q) { const bf16_t* gp = gt + (size_t)((q >> 2) * 8 + (q & 3) * 2 + bj) * 4096;
                    gv[q] = ld_nt16(gp); hv[q] = ld_nt16(gp + (size_t)8 * 16 * 4096); }
#pragma unroll
                for (int q = 0; q < 8; ++q) { const int ai = q >> 2, m = q & 3; const u32x4 g = gv[q], h = hv[q];
                    f32x4 s0, s1;
                    s0[0] = bflo(g.x) * __builtin_amdgcn_rcpf(bflo(h.x)); s0[1] = bfhi(g.x) * __builtin_amdgcn_rcpf(bfhi(h.x));
                    s0[2] = bflo(g.y) * __builtin_amdgcn_rcpf(bflo(h.y)); s0[3] = bfhi(g.y) * __builtin_amdgcn_rcpf(bfhi(h.y));
                    s1[0] = bflo(g.z) * __builtin_amdgcn_rcpf(bflo(h.z)); s1[1] = bfhi(g.z) * __builtin_amdgcn_rcpf(bfhi(h.z));
                    s1[2] = bflo(g.w) * __builtin_amdgcn_rcpf(bflo(h.w)); s1[3] = bfhi(g.w) * __builtin_amdgcn_rcpf(bfhi(h.w));
                    acc[ai][bj][m][0] *= s0; acc[ai][bj][m][1] *= s1; }
            }
            return true;
        }
        bf16_t* mbase = merged + tl((size_t)u.pm * 256 + rloc, u.pn * 256 + cloc, 2048);
        float* pbase = partm + ((size_t)(sl ? sl - 1 : 0) * 1024 + (size_t)((u.pm >= 32 ? u.pm - 32 : 0) * 256 + rloc)) * 2048 + u.pn * 256 + cloc;
#pragma unroll
        for (int bj = 0; bj < 2; ++bj) {
            u32x4 gv[8];
#pragma unroll
            for (int q = 0; q < 8; ++q) gv[q] = ld_nt16(gt + (size_t)((q >> 2) * 8 + (q & 3) * 2 + bj) * 4096);
#pragma unroll
            for (int q = 0; q < 8; ++q) { const int ai = q >> 2, m = q & 3; const u32x4 g = gv[q];
                const f32x4 v0 = acc[ai][bj][m][0] * (f32x4){bflo(g.x), bfhi(g.x), bflo(g.y), bfhi(g.y)}, v1 = acc[ai][bj][m][1] * (f32x4){bflo(g.z), bfhi(g.z), bflo(g.w), bfhi(g.w)};
                if (sl == 0) { u32x4 o; o.x = pk2(v0[0], v0[1]); o.y = pk2(v0[2], v0[3]); o.z = pk2(v1[0], v1[1]); o.w = pk2(v1[2], v1[3]);
                    *(u32x4*)(mbase + bj * 32768 + (ai * 128 + m * 16) * 64) = o; }
                else { float* op = pbase + (ai * 128 + m * 16) * 2048 + bj * 128; *(f32x4*)op = v0; *(f32x4*)(op + 4) = v1; } }
        }
        return false;
    }
};

struct SchedP5 {
    int G, c; const char* A; const char* Bt;
    __device__ __forceinline__ bool next(int i, Unit& u) const {
        if (i >= 2) return false;
        const int L = (i ^ 1) * G + c; if (L >= 512) return false;
        u.sl = 0;
        if (L < 256) { u.br = 0; pg8::tile_of(L, 32, 8, u.pm, u.pn); return true; }
        const int j = L - 256, tj = j >> 3; u.br = 1 + (j & 7); u.pm = 32 + (tj >> 3); u.pn = tj & 7; return true;
    }
    __device__ __forceinline__ const char* a_base(const Unit& u) const { return A + (size_t)u.pm * (256 * 2048 * 2) + (u.br ? (size_t)(u.br - 1) * (4 * 32768) : 0); }
    __device__ __forceinline__ const char* b_base(const Unit& u) const { return Bt + (size_t)u.pn * (256 * 2048 * 2) + (u.br ? (size_t)(u.br - 1) * (4 * 32768) : 0); }
    __device__ __forceinline__ int nt(const Unit& u) const { return u.br ? 4 : 32; }
};
struct EpiP5 {
    const float* xp; const float* xs; float* out; float* part;
    float* rs; const float* gfin; unsigned* xbar; unsigned xbx; volatile LAS unsigned* xst;
    __device__ __forceinline__ bool operator()(f32x4 (&acc)[2][2][4][2], const Unit& u, int wr, int wc, int fr, int fq) const {
        const int rloc = wr * 64 + fr, cloc = wc * 32 + 8 * fq;
        if (u.br == 0) {
#pragma unroll
            for (int ai = 0; ai < 2; ++ai) {
                f32x4 xv[4][2][2];
#pragma unroll
                for (int m = 0; m < 4; ++m)
#pragma unroll
                    for (int bj = 0; bj < 2; ++bj) { const float* xr = xp + ((size_t)u.pm * 256 + ai * 128 + m * 16 + rloc) * 2048 + u.pn * 256 + bj * 128 + cloc;
                        xv[m][bj][0] = ld_nt(xr); xv[m][bj][1] = ld_nt(xr + 4); }
#pragma unroll
                for (int m = 0; m < 4; ++m) {
                    const size_t row = (size_t)u.pm * 256 + ai * 128 + m * 16 + rloc;
                    float ss = 0.f;
#pragma unroll
                    for (int bj = 0; bj < 2; ++bj) {
                        acc[ai][bj][m][0] += xv[m][bj][0]; acc[ai][bj][m][1] += xv[m][bj][1];
                        const f32x4 a = acc[ai][bj][m][0], b = acc[ai][bj][m][1];
                        ss += (a[0] * a[0] + a[1] * a[1]) + (a[2] * a[2] + a[3] * a[3]) + (b[0] * b[0] + b[1] * b[1]) + (b[2] * b[2] + b[3] * b[3]); }
                    ss += __shfl_xor(ss, 16); ss += __shfl_xor(ss, 32);
                    if (fq == 0) (void)__hip_atomic_fetch_add(rs + row, ss, __ATOMIC_RELAXED, __HIP_MEMORY_SCOPE_AGENT);
                }
            }
            xcd_barrier(xbar, xbx, xst);
            float rsv[8]; f32x4 gf[2][2];
#pragma unroll
            for (int q = 0; q < 8; ++q) rsv[q] = __hip_atomic_load(rs + (size_t)u.pm * 256 + (q >> 2) * 128 + (q & 3) * 16 + rloc, __ATOMIC_RELAXED, __HIP_MEMORY_SCOPE_AGENT);
#pragma unroll
            for (int bj = 0; bj < 2; ++bj) { const int col = u.pn * 256 + bj * 128 + cloc; gf[bj][0] = *(const f32x4*)(gfin + col); gf[bj][1] = *(const f32x4*)(gfin + col + 4); }
#pragma unroll
            for (int ai = 0; ai < 2; ++ai)
#pragma unroll
                for (int m = 0; m < 4; ++m) {
                    const size_t row = (size_t)u.pm * 256 + ai * 128 + m * 16 + rloc;
                    const float rinv = rsqrtf(rsv[ai * 4 + m] * (1.f / 2048.f) + EPS);
#pragma unroll
                    for (int bj = 0; bj < 2; ++bj) { const int col = u.pn * 256 + bj * 128 + cloc;
                        const f32x4 g0 = gf[bj][0], g1 = gf[bj][1];
                        float* op = out + row * 2048 + col;
                        st_nt((f32x4*)op, acc[ai][bj][m][0] * rinv * g0); st_nt((f32x4*)(op + 4), acc[ai][bj][m][1] * rinv * g1); }
                }
        } else {
#pragma unroll
            for (int bj = 0; bj < 2; ++bj) {
                const int col = u.pn * 256 + bj * 128 + cloc;
#pragma unroll
                for (int ai = 0; ai < 2; ++ai)
#pragma unroll
                    for (int m = 0; m < 4; ++m) {
                        const size_t row = (size_t)u.pm * 256 + ai * 128 + m * 16 + rloc;
                        float* op = part + ((size_t)(u.br - 1) * 1024 + (row - NTP)) * 2048 + col;
                        *(f32x4*)op = acc[ai][bj][m][0]; *(f32x4*)(op + 4) = acc[ai][bj][m][1];
                    }
            }
        }
        return false;
    }
};
struct EpiNull {
    __device__ __forceinline__ bool operator()(f32x4 (&acc)[2][2][4][2], const Unit& u, int wr, int wc, int fr, int fq) const {
        f32x4 t = (f32x4){0.f, 0.f, 0.f, 0.f};
#pragma unroll
        for (int ai = 0; ai < 2; ++ai)
#pragma unroll
            for (int bj = 0; bj < 2; ++bj)
#pragma unroll
                for (int m = 0; m < 4; ++m) t += acc[ai][bj][m][0] + acc[ai][bj][m][1];
        asm volatile("" :: "v"(t[0]), "v"(t[1]), "v"(t[2]), "v"(t[3]));
        return false;
    }
};
#define P0_DESC(it_, W_, WT_, K_, N_, ro_, kb_, nb_) do { int r_ = (it_); \
    if (r_ < 1920) { W_ = p.w_in; WT_ = WT1; K_ = 2048; N_ = 15360; ro_ = 0; kb_ = r_ / 120; nb_ = r_ % 120; } \
    else if (r_ < 2176) { r_ -= 1920; W_ = p.w_mem_kv; WT_ = WT1; K_ = 2048; N_ = 2048; ro_ = 15360; kb_ = r_ >> 4; nb_ = r_ & 15; } \
    else if (r_ < 2304) { r_ -= 2176; W_ = p.w_conv_out; WT_ = WT3; K_ = 1024; N_ = 2048; ro_ = 0; kb_ = r_ >> 4; nb_ = r_ & 15; } \
    else if (r_ < 2432) { r_ -= 2304; W_ = p.w_hgrn_out; WT_ = WT3 + (size_t)2048 * 1024; K_ = 1024; N_ = 2048; ro_ = 0; kb_ = r_ >> 4; nb_ = r_ & 15; } \
    else if (r_ < 2560) { r_ -= 2432; W_ = p.w_attn_out; WT_ = WT3 + (size_t)2 * 2048 * 1024; K_ = 1024; N_ = 2048; ro_ = 0; kb_ = r_ >> 4; nb_ = r_ & 15; } \
    else { r_ -= 2560; W_ = p.w_out; WT_ = WTO; K_ = 2048; N_ = 2048; ro_ = 0; kb_ = r_ >> 4; nb_ = r_ & 15; } } while (0)
__device__ __forceinline__ void p0_prologue(const Params& p, LAS unsigned char* lds) {
    const int tid = threadIdx.x, lane = tid & 63, wave = tid >> 6, G = gridDim.x, c = blockIdx.x;
    LAS unsigned* T32 = (LAS unsigned*)lds;
    constexpr int T_ALL = 1920 + 256 + 3 * 128 + 256;
    const int nq = tid & 31, kp0 = tid >> 5;
    f32x4 r0[4], r1[4];
#define P0_LOAD(W_, N_, kb_, nb_) do { _Pragma("unroll") for (int i = 0; i < 4; ++i) { const int kpair = kp0 + 16 * i; \
        const float* src = (W_) + (size_t)((kb_) * 128 + 2 * kpair) * (N_) + (nb_) * 128 + 4 * nq; r0[i] = ld_nt(src); r1[i] = ld_nt(src + (N_)); } } while (0)
    bf16_t* WT1 = (bf16_t*)(p.ws + WS_WT1); bf16_t* WT3 = (bf16_t*)(p.ws + WS_WT3); bf16_t* WTO = (bf16_t*)(p.ws + WS_WTO);
    int it = c;
    const float* dW = p.w_in; bf16_t* dWT = WT1; int dK = 2048, dN = 15360, dro = 0, dkb = 0, dnb = 0;
    if (it < T_ALL) { P0_DESC(it, dW, dWT, dK, dN, dro, dkb, dnb); P0_LOAD(dW, dN, dkb, dnb); }
    while (it < T_ALL) {
#pragma unroll
        for (int i = 0; i < 4; ++i) { const int kpair = kp0 + 16 * i;
            T32[(4 * nq + 0) * 65 + kpair] = pk2(r0[i][0], r1[i][0]); T32[(4 * nq + 1) * 65 + kpair] = pk2(r0[i][1], r1[i][1]);
            T32[(4 * nq + 2) * 65 + kpair] = pk2(r0[i][2], r1[i][2]); T32[(4 * nq + 3) * 65 + kpair] = pk2(r0[i][3], r1[i][3]); }
        __syncthreads();
        const int itn = it + G;
        const float* nW = dW; bf16_t* nWT = dWT; int nK = dK, nN = dN, nro = dro, nkb = dkb, nnb = dnb;
        if (itn < T_ALL) { P0_DESC(itn, nW, nWT, nK, nN, nro, nkb, nnb); P0_LOAD(nW, nN, nkb, nnb); }
#pragma unroll
        for (int i = 0; i < 4; ++i) {
            const int id = tid + 512 * i, n = id >> 4, cc = id & 15;
            u32x4 o; o.x = T32[n * 65 + 4 * cc]; o.y = T32[n * 65 + 4 * cc + 1]; o.z = T32[n * 65 + 4 * cc + 2]; o.w = T32[n * 65 + 4 * cc + 3];
            *(u32x4*)(dWT + tl((size_t)(dro + dnb * 128 + n), dkb * 128 + 8 * cc, dK)) = o;
        }
        __syncthreads();
        it = itn; dW = nW; dWT = nWT; dK = nK; dN = nN; dro = nro; dkb = nkb; dnb = nnb;
    }
#undef P0_LOAD
#undef P0_DESC
    bf16_t* HA = (bf16_t*)(p.ws + WS_HA);
    const int gw = c * 8 + wave, NGW = G * 8;
#define P0_ROWPTR(m) ((m) < NTP ? p.x_prompt + (size_t)(m) * 2048 : ((m) < NTOK ? p.x_sample + (size_t)((m) - NTP) * 2048 : p.mem_prompt + (size_t)((m) - NTOK) * 2048))
    f32x4 v[8];
    int m = gw;
    if (m < 10240) { const float* xr = P0_ROWPTR(m);
#pragma unroll
        for (int j = 0; j < 8; ++j) v[j] = ((const f32x4*)xr)[lane + 64 * j]; }
    while (m < 10240) {
        const int mn = m + NGW; f32x4 vn[8];
        if (mn < 10240) { const float* xr = P0_ROWPTR(mn);
#pragma unroll
            for (int j = 0; j < 8; ++j) vn[j] = ((const f32x4*)xr)[lane + 64 * j]; }
        const float* g = (m < NTOK) ? p.g_pre : p.g_mem;
        f32x4 ggv[8];
#pragma unroll
        for (int j = 0; j < 8; ++j) ggv[j] = ((const f32x4*)g)[lane + 64 * j];
        float ss = 0.f;
#pragma unroll
        for (int j = 0; j < 8; ++j) ss += (v[j][0] * v[j][0] + v[j][1] * v[j][1]) + (v[j][2] * v[j][2] + v[j][3] * v[j][3]);
        ss = wave_sum(ss);
        const float rinv = rsqrtf(ss * (1.f / 2048.f) + EPS);
#pragma unroll
        for (int j = 0; j < 8; ++j) { const f32x4 gg = ggv[j];
            u32x2 o; o.x = pk2(v[j][0] * rinv * gg[0], v[j][1] * rinv * gg[1]); o.y = pk2(v[j][2] * rinv * gg[2], v[j][3] * rinv * gg[3]);
            *(u32x2*)(HA + tl((size_t)m, 4 * (lane + 64 * j), 2048)) = o; }
        if (mn < 10240) {
#pragma unroll
            for (int j = 0; j < 8; ++j) v[j] = vn[j]; }
        m = mn;
    }
#undef P0_ROWPTR
    if (c == 0) { float* LB = (float*)(p.ws + WS_LB);
        for (int i = tid; i < 1024; i += 512) LB[i] = 1.f / (1.f + __expf(p.lb_logits[1024 + i] - p.lb_logits[i])); }
}

constexpr int HG_GS = 0, HG_SEG = 32768, HG_VT = 36864, HG_QB = 53248, HG_KB = 69632, HG_SSQ = 86016;
__device__ __forceinline__ void hg_prep(const float* F, size_t row0, int h, LAS unsigned char* lds, int tid, f32x4 (&fr)[4]) {
    LAS float* Gs = (LAS float*)(lds + HG_GS); LAS float* SEG = (LAS float*)(lds + HG_SEG);
    const int er = tid >> 5, k4 = (tid & 31) * 4;
#pragma unroll
    for (int i = 0; i < 4; ++i) { const int t = 2 * er + (i & 1) + 32 * (i >> 1); fr[i] = *(const f32x4*)(F + (row0 + t) * 1024 + h * 128 + k4); }
#pragma unroll
    for (int i = 0; i < 4; ++i) { const int t = 2 * er + (i & 1) + 32 * (i >> 1);
        *(LAS f32x4*)(Gs + t * 128 + k4) = (f32x4){__logf(fr[i][0]), __logf(fr[i][1]), __logf(fr[i][2]), __logf(fr[i][3])}; }
    __syncthreads();
    const int k = tid & 127, seg = tid >> 7;
    { float g[16];
#pragma unroll
      for (int i = 0; i < 16; ++i) g[i] = Gs[(seg * 16 + i) * 128 + k];
#pragma unroll
      for (int i = 1; i < 16; ++i) g[i] += g[i - 1];
      SEG[seg * 128 + k] = g[15];
      __syncthreads();
      float off = 0.f;
#pragma unroll
      for (int s2 = 0; s2 < 3; ++s2) off += (s2 < seg) ? SEG[s2 * 128 + k] : 0.f;
#pragma unroll
      for (int i = 0; i < 16; ++i) Gs[(seg * 16 + i) * 128 + k] = g[i] + off; }
    __syncthreads();
}
__device__ __forceinline__ void hg_load_v(const bf16_t* proj, size_t row0, int h, int tid, unsigned (&a)[4], unsigned (&b)[4]) {
    const int d2 = (tid & 63) * 2;
#pragma unroll
    for (int i = 0; i < 4; ++i) { const int t = 2 * ((tid >> 6) + 8 * i);
        a[i] = *(const unsigned*)(proj + (row0 + t) * LDP + C_HI + h * 128 + d2); b[i] = *(const unsigned*)(proj + (row0 + t + 1) * LDP + C_HI + h * 128 + d2); }
}
__device__ __forceinline__ void hg_stage_vt(const unsigned (&a)[4], const unsigned (&b)[4], LAS unsigned char* lds, int tid) {
    LAS bf16_t* VT = (LAS bf16_t*)(lds + HG_VT);
    const int d2 = (tid & 63) * 2;
#pragma unroll
    for (int i = 0; i < 4; ++i) { const int t = 2 * ((tid >> 6) + 8 * i);
        const int c0 = ((t >> 3) ^ ((d2 >> 1) & 7)) * 8 + (t & 7);
        *(LAS unsigned*)(VT + d2 * 64 + c0) = (a[i] & 0xffffu) | (b[i] << 16);
        *(LAS unsigned*)(VT + (d2 + 1) * 64 + c0) = (a[i] >> 16) | (b[i] & 0xffff0000u); }
}
__device__ __forceinline__ void hgrn_h1_item(const Params& p, int item, LAS unsigned char* lds, int tid) {
    const int s = item >> 5, c = item & 31, n = s >> 3, h = s & 7;
    const size_t row0 = (size_t)n * SEQ + c * 64;
    const bf16_t* proj = (const bf16_t*)(p.ws + WS_PROJ9); const float* F = (const float*)(p.ws + WS_F);
    LAS float* Gs = (LAS float*)(lds + HG_GS); LAS bf16_t* KDT = (LAS bf16_t*)(lds + HG_QB); LAS bf16_t* VT = (LAS bf16_t*)(lds + HG_VT);
    f32x4 fr[4]; unsigned va[4], vb[4];
    hg_load_v(proj, row0, h, tid, va, vb);
    hg_prep(F, row0, h, lds, tid, fr);
    hg_stage_vt(va, vb, lds, tid);
    { const int er = tid >> 5, k4 = (tid & 31) * 4;
      const f32x4 bc = *(const LAS f32x4*)(Gs + 63 * 128 + k4);
      if (er == 0) *(f32x4*)((float*)(p.ws + WS_DD) + (size_t)item * 128 + k4) = (f32x4){__expf(bc[0]), __expf(bc[1]), __expf(bc[2]), __expf(bc[3])};
#pragma unroll
      for (int ip = 0; ip < 2; ++ip) { const int t = 2 * er + 32 * ip;
          const f32x4 b0 = *(const LAS f32x4*)(Gs + t * 128 + k4), b1 = *(const LAS f32x4*)(Gs + (t + 1) * 128 + k4);
#pragma unroll
          for (int e = 0; e < 4; ++e) { const int k = k4 + e;
              const float kd0 = (1.f - fr[2 * ip][e]) * __expf(bc[e] - b0[e]), kd1 = (1.f - fr[2 * ip + 1][e]) * __expf(bc[e] - b1[e]);
              *(LAS unsigned*)(KDT + k * 64 + (((t >> 3) ^ ((k >> 1) & 7)) * 8 + (t & 7))) = pk2(kd0, kd1); } } }
    __syncthreads();
    { const int lane = tid & 63, w = tid >> 6, l15 = lane & 15, quad = lane >> 4;
      const int d = 16 * w + l15;
      bf16x8 av[2];
#pragma unroll
      for (int s2 = 0; s2 < 2; ++s2) av[s2] = *(const LAS bf16x8*)(VT + d * 64 + (((4 * s2 + quad) ^ ((d >> 1) & 7)) * 8));
      float* ut = (float*)(p.ws + WS_UT) + ((size_t)item * 128 + 16 * w + quad * 4) * 128 + l15;
#pragma unroll
      for (int kt = 0; kt < 8; ++kt) { const int k = 16 * kt + l15;
          f32x4 acc = (f32x4){0.f, 0.f, 0.f, 0.f};
#pragma unroll
          for (int s2 = 0; s2 < 2; ++s2) { const bf16x8 bk = *(const LAS bf16x8*)(KDT + k * 64 + (((4 * s2 + quad) ^ ((k >> 1) & 7)) * 8));
              acc = __builtin_amdgcn_mfma_f32_16x16x32_bf16(av[s2], bk, acc, 0, 0, 0); }
          ut[kt * 16] = acc[0]; ut[kt * 16 + 128] = acc[1]; ut[kt * 16 + 256] = acc[2]; ut[kt * 16 + 384] = acc[3]; } }
    __syncthreads();
}
__device__ __forceinline__ void hgrn_h2_scan(const Params& p) {
    const float* UT = (const float*)(p.ws + WS_UT); const float* DD = (const float*)(p.ws + WS_DD); bf16_t* ST = (bf16_t*)(p.ws + WS_ST);
    for (int idx = blockIdx.x * 512 + threadIdx.x; idx < 32 * 128 * 32; idx += gridDim.x * 512) {
        const int s = idx >> 12, d = (idx >> 5) & 127, k4 = (idx & 31) * 4;
        f32x4 S = (f32x4){0.f, 0.f, 0.f, 0.f};
#pragma unroll 1
        for (int c0 = 0; c0 < 32; c0 += 8) {
            f32x4 uv[8], dv[8];
#pragma unroll
            for (int i = 0; i < 8; ++i) { const size_t item = (size_t)s * 32 + c0 + i; uv[i] = *(const f32x4*)(UT + (item * 128 + d) * 128 + k4); dv[i] = *(const f32x4*)(DD + item * 128 + k4); }
#pragma unroll
            for (int i = 0; i < 8; ++i) { const size_t item = (size_t)s * 32 + c0 + i;
                u32x2 o; o.x = pk2(S[0], S[1]); o.y = pk2(S[2], S[3]);
                *(u32x2*)(ST + (item * 128 + d) * 128 + k4) = o;
                S = dv[i] * S + uv[i]; }
        }
        float* so = p.out + O_HGRN_P + ((size_t)s * 128 + k4) * 128 + d;
        so[0] = S[0]; so[128] = S[1]; so[256] = S[2]; so[384] = S[3];
    }
}
__device__ __forceinline__ void hgrn_h3_item(const Params& p, int item, LAS unsigned char* lds, int tid) {
    const int s = item >> 5, c = item & 31, n = s >> 3, h = s & 7;
    const size_t row0 = (size_t)n * SEQ + c * 64;
    const bf16_t* proj = (const bf16_t*)(p.ws + WS_PROJ9); const float* F = (const float*)(p.ws + WS_F);
    LAS float* Gs = (LAS float*)(lds + HG_GS); LAS bf16_t* QB = (LAS bf16_t*)(lds + HG_QB); LAS bf16_t* KB = (LAS bf16_t*)(lds + HG_KB); LAS bf16_t* VT = (LAS bf16_t*)(lds + HG_VT);
    LAS float* SSQ = (LAS float*)(lds + HG_SSQ);
    const int lane = tid & 63, w = tid >> 6, l15 = lane & 15, quad = lane >> 4, tt = w & 3, dh = w >> 2;
    const bf16_t* st = (const bf16_t*)(p.ws + WS_ST) + ((size_t)item * 128 + 64 * dh + l15) * 128 + quad * 8;
    bf16x8 sf[4][4];
#pragma unroll
    for (int dt = 0; dt < 4; ++dt)
#pragma unroll
        for (int ks = 0; ks < 4; ++ks) sf[dt][ks] = *(const bf16x8*)(st + (size_t)dt * 16 * 128 + ks * 32);
    f32x4 fr[4]; unsigned va[4], vb[4]; u32x2 qws[4];
    hg_load_v(proj, row0, h, tid, va, vb);
#pragma unroll
    for (int i = 0; i < 4; ++i) { const int t = 2 * (tid >> 5) + (i & 1) + 32 * (i >> 1); qws[i] = *(const u32x2*)(proj + (row0 + t) * LDP + C_HQ + h * 128 + (tid & 31) * 4); }
    hg_prep(F, row0, h, lds, tid, fr);
    hg_stage_vt(va, vb, lds, tid);
    { const int er = tid >> 5, k4 = (tid & 31) * 4;
#pragma unroll
      for (int i = 0; i < 4; ++i) { const int t = 2 * er + (i & 1) + 32 * (i >> 1);
          const f32x4 b = *(const LAS f32x4*)(Gs + t * 128 + k4);
          const u32x2 qw = qws[i];
          const float e0 = __expf(b[0]), e1 = __expf(b[1]), e2 = __expf(b[2]), e3 = __expf(b[3]);
          u32x2 qo, ko;
          qo.x = pk2(bflo(qw.x) * e0, bfhi(qw.x) * e1); qo.y = pk2(bflo(qw.y) * e2, bfhi(qw.y) * e3);
          ko.x = pk2((1.f - fr[i][0]) * __builtin_amdgcn_rcpf(e0), (1.f - fr[i][1]) * __builtin_amdgcn_rcpf(e1));
          ko.y = pk2((1.f - fr[i][2]) * __builtin_amdgcn_rcpf(e2), (1.f - fr[i][3]) * __builtin_amdgcn_rcpf(e3));
          const int off = t * 128 + (((k4 >> 3) ^ (t & 15)) * 8) + (k4 & 7);
          *(LAS u32x2*)(QB + off) = qo; *(LAS u32x2*)(KB + off) = ko; } }
    __syncthreads();
    bf16x8 qf[4];
#pragma unroll
    for (int ks = 0; ks < 4; ++ks) qf[ks] = *(const LAS bf16x8*)(QB + (16 * tt + l15) * 128 + (((4 * ks + quad) ^ l15) * 8));
    f32x4 at[4];
#pragma unroll
    for (int st4 = 0; st4 < 4; ++st4) {
        at[st4] = (f32x4){0.f, 0.f, 0.f, 0.f};
        if (st4 <= tt) {
#pragma unroll
            for (int ks = 0; ks < 4; ++ks) { const bf16x8 kf = *(const LAS bf16x8*)(KB + (16 * st4 + l15) * 128 + (((4 * ks + quad) ^ l15) * 8));
                at[st4] = __builtin_amdgcn_mfma_f32_16x16x32_bf16(kf, qf[ks], at[st4], 0, 0, 0); }
            if (st4 == tt) {
#pragma unroll
                for (int j = 0; j < 4; ++j) at[st4][j] = (quad * 4 + j <= l15) ? at[st4][j] : 0.f;
            }
        }
    }
    bf16x8 pb[2];
#pragma unroll
    for (int s2 = 0; s2 < 2; ++s2) { u32x4 wv; wv.x = pk2(at[2 * s2][0], at[2 * s2][1]); wv.y = pk2(at[2 * s2][2], at[2 * s2][3]);
        wv.z = pk2(at[2 * s2 + 1][0], at[2 * s2 + 1][1]); wv.w = pk2(at[2 * s2 + 1][2], at[2 * s2 + 1][3]); pb[s2] = __builtin_bit_cast(bf16x8, wv); }
    f32x4 oacc[4]; float ssq = 0.f;
#pragma unroll
    for (int dt = 0; dt < 4; ++dt) {
        const int d = 16 * (4 * dh + dt) + l15;
        oacc[dt] = (f32x4){0.f, 0.f, 0.f, 0.f};
#pragma unroll
        for (int ks = 0; ks < 4; ++ks) oacc[dt] = __builtin_amdgcn_mfma_f32_16x16x32_bf16(sf[dt][ks], qf[ks], oacc[dt], 0, 0, 0);
#pragma unroll
        for (int s2 = 0; s2 < 2; ++s2) {
            const int ch = 4 * s2 + (quad >> 1), sw = (d >> 1) & 7;
            const u32x2 lo = *(const LAS u32x2*)(VT + d * 64 + ((ch ^ sw) * 8) + (quad & 1) * 4), hi = *(const LAS u32x2*)(VT + d * 64 + (((ch + 2) ^ sw) * 8) + (quad & 1) * 4);
            u32x4 wv; wv.x = lo.x; wv.y = lo.y; wv.z = hi.x; wv.w = hi.y;
            oacc[dt] = __builtin_amdgcn_mfma_f32_16x16x32_bf16(__builtin_bit_cast(bf16x8, wv), pb[s2], oacc[dt], 0, 0, 0);
        }
        ssq += (oacc[dt][0] * oacc[dt][0] + oacc[dt][1] * oacc[dt][1]) + (oacc[dt][2] * oacc[dt][2] + oacc[dt][3] * oacc[dt][3]);
    }
    ssq += __shfl_xor(ssq, 16); ssq += __shfl_xor(ssq, 32);
    if (quad == 0) SSQ[dh * 64 + 16 * tt + l15] = ssq;
    __syncthreads();
    { const float tot = SSQ[16 * tt + l15] + SSQ[64 + 16 * tt + l15], rinv = rsqrtf(tot * (1.f / 128.f) + EPS);
      const size_t row = row0 + 16 * tt + l15;
      bf16_t* og = (bf16_t*)(p.ws + WS_ACT3) + (size_t)9216 * 1024;
      f32x4 gnv[4]; u32x2 hgv[4];
#pragma unroll
      for (int dt = 0; dt < 4; ++dt) { const int d0 = 16 * (4 * dh + dt) + quad * 4; gnv[dt] = *(const f32x4*)(p.g_hgrn + h * 128 + d0); hgv[dt] = *(const u32x2*)(proj + row * LDP + C_HOG + h * 128 + d0); }
#pragma unroll
      for (int dt = 0; dt < 4; ++dt) { const int d0 = 16 * (4 * dh + dt) + quad * 4;
          const f32x4 gn = gnv[dt];
          const u32x2 hg = hgv[dt];
          u32x2 o; o.x = pk2(oacc[dt][0] * rinv * gn[0] * bflo(hg.x), oacc[dt][1] * rinv * gn[1] * bfhi(hg.x)); o.y = pk2(oacc[dt][2] * rinv * gn[2] * bflo(hg.y), oacc[dt][3] * rinv * gn[3] * bfhi(hg.y));
          *(u32x2*)(og + tl(row, h * 128 + d0, 1024)) = o; } }
    __syncthreads();
}

__device__ __forceinline__ void hgrn_sample_item(const Params& p, int item, LAS unsigned char* lds, int tid) {
    LAS float* qs = (LAS float*)lds;
    LAS float* fs = qs + 1024;
    LAS float* vs = fs + 1024;
    LAS float* opart = vs + 1024;
    const int n = item >> 3, h = item & 7, lane = tid & 63, wave = tid >> 6;
    const bf16_t* proj = (const bf16_t*)(p.ws + WS_PROJ9);
    const float* F = (const float*)(p.ws + WS_F);
    const size_t row0 = (size_t)NTP + (size_t)n * 8;
    { const int tt = tid >> 6, k2 = (tid & 63) * 2; const size_t r = row0 + tt;
      const unsigned qw = *(const unsigned*)(proj + r * LDP + C_HQ + h * 128 + k2); const f32x2 ff = *(const f32x2*)(F + r * 1024 + h * 128 + k2);
      const unsigned vw = *(const unsigned*)(proj + r * LDP + C_HI + h * 128 + k2);
      qs[tt * 128 + k2] = bflo(qw); qs[tt * 128 + k2 + 1] = bfhi(qw); fs[tt * 128 + k2] = ff[0]; fs[tt * 128 + k2 + 1] = ff[1];
      vs[tt * 128 + k2] = bflo(vw); vs[tt * 128 + k2 + 1] = bfhi(vw); }
    const int v4 = tid & 31, kg = tid >> 5;
    const size_t sbase = ((size_t)(n * 8 + h) * 128 + kg * 8) * 128 + v4 * 4;
    f32x4 S[8];
#pragma unroll
    for (int i = 0; i < 8; ++i) S[i] = ld_nt(p.state_hgrn + sbase + (size_t)i * 128);
    __syncthreads();
#pragma unroll
    for (int tt = 0; tt < 8; ++tt) {
        const f32x4 fa = *(const LAS f32x4*)(fs + tt * 128 + kg * 8), fb = *(const LAS f32x4*)(fs + tt * 128 + kg * 8 + 4);
        const f32x4 qa = *(const LAS f32x4*)(qs + tt * 128 + kg * 8), qb = *(const LAS f32x4*)(qs + tt * 128 + kg * 8 + 4);
        const f32x4 vv = *(const LAS f32x4*)(vs + tt * 128 + v4 * 4);
        f32x4 po = (f32x4){0.f, 0.f, 0.f, 0.f};
#pragma unroll
        for (int i = 0; i < 8; ++i) { const float f = (i < 4) ? fa[i & 3] : fb[i & 3], q = (i < 4) ? qa[i & 3] : qb[i & 3];
            S[i] = S[i] * f + vv * (1.f - f); po += S[i] * q; }
#pragma unroll
        for (int e = 0; e < 4; ++e) po[e] += __shfl_xor(po[e], 32);
        if (lane < 32) *(LAS f32x4*)(opart + (tt * 8 + wave) * 128 + v4 * 4) = po;
    }
    float* so = p.out + O_HGRN_S + sbase;
#pragma unroll
    for (int i = 0; i < 8; ++i) st_nt((f32x4*)(so + (size_t)i * 128), S[i]);
    __syncthreads();
    { const int tt = tid >> 6, v = (tid & 63) * 2; float o0 = 0.f, o1 = 0.f;
#pragma unroll
      for (int w = 0; w < 8; ++w) { const f32x2 t = *(const LAS f32x2*)(opart + (tt * 8 + w) * 128 + v); o0 += t[0]; o1 += t[1]; }
      const float ss = wave_sum(o0 * o0 + o1 * o1), rinv = rsqrtf(ss * (1.f / 128.f) + EPS);
      const size_t r = row0 + tt; const f32x2 gg = *(const f32x2*)(p.g_hgrn + h * 128 + v);
      const unsigned gw = *(const unsigned*)(proj + r * LDP + C_HOG + h * 128 + v);
      bf16_t* og = (bf16_t*)(p.ws + WS_ACT3) + (size_t)9216 * 1024 + tl(r, h * 128 + v, 1024);
      *(unsigned*)og = pk2(o0 * rinv * gg[0] * bflo(gw), o1 * rinv * gg[1] * bfhi(gw)); }
    __syncthreads();
}

template <bool SAMPLE>
__device__ __forceinline__ void conv_item(const Params& p, int item, LAS unsigned char* lds, int tid) {
    constexpr int T = SAMPLE ? 8 : 32;
    constexpr int GP = 4, NG = (T + 32) / GP, G0 = 32 / GP;
    LAS float* dcs = (LAS float*)lds;
    const bf16_t* proj = (const bf16_t*)(p.ws + WS_PROJ9);
    const int n = SAMPLE ? item : (item >> 6), t0 = SAMPLE ? 0 : (item & 63) * 32;
    const size_t rowb = SAMPLE ? ((size_t)NTP + (size_t)n * 8) : ((size_t)n * SEQ);
    const int c0 = 2 * tid;
    f32x2 wv[31], xv[31];
#pragma unroll
    for (int j = 0; j < 31; ++j) { wv[j] = *(const f32x2*)(p.conv_w + j * 1024 + c0); xv[j] = (f32x2){0.f, 0.f}; }
    const f32x2 bias = *(const f32x2*)(p.conv_b + c0);
    unsigned ra[GP], rg[GP];
#define CONV_ISSUE(g) do { \
        if (SAMPLE && (g) < G0) { _Pragma("unroll") for (int i = 0; i < GP; ++i) { const int ti = -2 + GP * (g) + i; \
            const unsigned* tp = (const unsigned*)(p.state_conv + ((size_t)n * 30 + (ti < 0 ? 0 : ti)) * 1024 + c0); ra[i] = tp[0]; rg[i] = tp[1]; } } \
        else { _Pragma("unroll") for (int i = 0; i < GP; ++i) { const int t = t0 - 32 + GP * (g) + i; const bf16_t* rp = proj + (rowb + (t < 0 ? 0 : t)) * LDP + c0; \
            ra[i] = *(const unsigned*)(rp + C_CV); rg[i] = *(const unsigned*)(rp + C_CG); } } } while (0)
    CONV_ISSUE(0);
#pragma unroll 1
    for (int g = 0; g < NG; ++g) {
        float u0[GP], u1[GP];
        if (SAMPLE && g < G0) {
#pragma unroll
            for (int i = 0; i < GP; ++i) { const bool ok = (-2 + GP * g + i) >= 0; u0[i] = ok ? __builtin_bit_cast(float, ra[i]) : 0.f; u1[i] = ok ? __builtin_bit_cast(float, rg[i]) : 0.f; }
        } else {
#pragma unroll
            for (int i = 0; i < GP; ++i) { const bool ok = (t0 - 32 + GP * g + i) >= 0; u0[i] = ok ? bflo(ra[i]) * bflo(rg[i]) : 0.f; u1[i] = ok ? bfhi(ra[i]) * bfhi(rg[i]) : 0.f; }
        }
        if (g + 1 < NG) CONV_ISSUE(g + 1);
#pragma unroll
        for (int i = 0; i < GP; ++i) {
            const int pp = -32 + GP * g + i, t = t0 + pp;
            if (SAMPLE) { if (pp >= -22) *(f32x2*)(p.out + O_CONV_S + ((size_t)n * 30 + (pp + 22)) * 1024 + c0) = (f32x2){u0[i], u1[i]}; }
            else { if (t >= SEQ - 30) *(f32x2*)(p.out + O_CONV_P + ((size_t)n * 30 + (t - (SEQ - 30))) * 1024 + c0) = (f32x2){u0[i], u1[i]}; }
#pragma unroll
            for (int j = 0; j < 30; ++j) xv[j] = xv[j + 1];
            xv[30] = (f32x2){u0[i], u1[i]};
            if (g >= G0) {
                f32x2 da = bias, db = (f32x2){0.f, 0.f};
#pragma unroll
                for (int j = 0; j < 30; j += 2) { da += wv[j] * xv[j]; db += wv[j + 1] * xv[j + 1]; }
                da += wv[30] * xv[30];
                *(LAS f32x2*)(dcs + (pp) * 1024 + c0) = da + db;
            }
        }
    }
#undef CONV_ISSUE
    __syncthreads();
    { const int lane = tid & 63, wave = tid >> 6;
      bf16_t* aact = (bf16_t*)(p.ws + WS_ACT3);
      for (int pp = wave; pp < T; pp += 8) {
          f32x4 v[4]; float s = 0.f;
#pragma unroll
          for (int j = 0; j < 4; ++j) { v[j] = *(const LAS f32x4*)(dcs + pp * 1024 + j * 256 + lane * 4); s += (v[j][0] + v[j][1]) + (v[j][2] + v[j][3]); }
          const float mean = wave_sum(s) * (1.f / 1024.f); float s2 = 0.f;
#pragma unroll
          for (int j = 0; j < 4; ++j) { v[j] = v[j] - mean; s2 += (v[j][0] * v[j][0] + v[j][1] * v[j][1]) + (v[j][2] * v[j][2] + v[j][3] * v[j][3]); }
          const float rstd = rsqrtf(wave_sum(s2) * (1.f / 1024.f) + EPS);
          const size_t r = rowb + t0 + pp;
          bf16_t* arow = aact + tl(r, lane * 4, 1024);
          f32x4 lgv[4], lbvv[4]; u32x2 sgv[4];
#pragma unroll
          for (int j = 0; j < 4; ++j) { const int c = j * 256 + lane * 4; lgv[j] = *(const f32x4*)(p.ln_g + c); lbvv[j] = *(const f32x4*)(p.ln_b + c); sgv[j] = *(const u32x2*)(proj + r * LDP + C_CS + c); }
#pragma unroll
          for (int j = 0; j < 4; ++j) {
              const f32x4 lg = lgv[j], lbv = lbvv[j];
              const u32x2 sg = sgv[j];
              const float y0 = siluf(v[j][0] * rstd * lg[0] + lbv[0]) * bflo(sg.x), y1 = siluf(v[j][1] * rstd * lg[1] + lbv[1]) * bfhi(sg.x);
              const float y2 = siluf(v[j][2] * rstd * lg[2] + lbv[2]) * bflo(sg.y), y3 = siluf(v[j][3] * rstd * lg[3] + lbv[3]) * bfhi(sg.y);
              u32x2 o; o.x = pk2(y0, y1); o.y = pk2(y2, y3);
              *(u32x2*)(arow + j * 65536) = o; }
      } }
    __syncthreads();
}

__device__ __forceinline__ void attn_prompt_item(const Params& p, int item, LAS unsigned char* lds, int tid) {
    const int lane = tid & 63, wave = tid >> 6, l15 = lane & 15, quad = lane >> 4;
    const int n = item >> 6, h = (item >> 4) & 3, qt = item & 15;
    const bf16_t* proj = (const bf16_t*)(p.ws + WS_PROJ9);
    const bf16_t* kb = (const bf16_t*)(p.ws + WS_MKB) + (size_t)(n * 4 + h) * 65536;
    const bf16_t* vt = (const bf16_t*)(p.ws + WS_MVT) + (size_t)(n * 4 + h) * 65536;
    const size_t qrow = (size_t)n * SEQ + qt * 128 + wave * 16 + l15;
    u32x4 st[16];
#pragma unroll
    for (int i = 0; i < 16; ++i) st[i] = *(const u32x4*)(kb + (size_t)(tid + 512 * i) * 8);
    bf16x8 qf[8];
#pragma unroll
    for (int s = 0; s < 8; ++s) qf[s] = *(const bf16x8*)(proj + qrow * LDP + C_AQ + h * 256 + s * 32 + quad * 8);
#pragma unroll
    for (int i = 0; i < 16; ++i) { const int id = tid + 512 * i, r = id >> 5, c = id & 31; *(LAS u32x4*)(lds + r * 512 + ((c ^ (r & 15)) * 16)) = st[i]; }
    __syncthreads();
    f32x4 sc[16];
#pragma unroll
    for (int T = 0; T < 16; ++T) {
        sc[T] = (f32x4){0.f, 0.f, 0.f, 0.f};
        const LAS unsigned char* kr = lds + (T * 16 + l15) * 512;
#pragma unroll
        for (int s = 0; s < 8; ++s) { const bf16x8 a = *(const LAS bf16x8*)(kr + (((s * 4 + quad) ^ l15) * 16)); sc[T] = __builtin_amdgcn_mfma_f32_16x16x32_bf16(a, qf[s], sc[T], 0, 0, 0); }
    }
#pragma unroll
    for (int i = 0; i < 16; ++i) st[i] = *(const u32x4*)(vt + (size_t)(tid + 512 * i) * 8);
    __syncthreads();
    float mx = -3.0e38f;
#pragma unroll
    for (int T = 0; T < 16; ++T) mx = fmaxf(mx, fmaxf(fmaxf(sc[T][0], sc[T][1]), fmaxf(sc[T][2], sc[T][3])));
    mx = fmaxf(mx, __shfl_xor(mx, 16)); mx = fmaxf(mx, __shfl_xor(mx, 32));
    float sum = 0.f;
#pragma unroll
    for (int T = 0; T < 16; ++T) {
#pragma unroll
        for (int e = 0; e < 4; ++e) { sc[T][e] = __expf(sc[T][e] - mx); sum += sc[T][e]; } }
    sum += __shfl_xor(sum, 16); sum += __shfl_xor(sum, 32);
    const float rs = 1.f / sum;
    bf16x8 pb[8];
#pragma unroll
    for (int s2 = 0; s2 < 8; ++s2) {
        u32x4 w; w.x = pk2(sc[2 * s2][0], sc[2 * s2][1]); w.y = pk2(sc[2 * s2][2], sc[2 * s2][3]); w.z = pk2(sc[2 * s2 + 1][0], sc[2 * s2 + 1][1]); w.w = pk2(sc[2 * s2 + 1][2], sc[2 * s2 + 1][3]);
        pb[s2] = __builtin_bit_cast(bf16x8, w);
    }
#pragma unroll
    for (int i = 0; i < 16; ++i) { const int id = tid + 512 * i, r = id >> 5, c = id & 31; *(LAS u32x4*)(lds + r * 512 + ((c ^ (r & 15)) * 16)) = st[i]; }
    __syncthreads();
    bf16_t* aog_row = (bf16_t*)(p.ws + WS_ACT3) + (size_t)2 * 9216 * 1024 + tl(qrow, h * 256 + quad * 4, 1024);
    f32x4 oacc[16];
#pragma unroll
    for (int Tv = 0; Tv < 16; ++Tv) {
        oacc[Tv] = (f32x4){0.f, 0.f, 0.f, 0.f};
        const LAS unsigned char* vr = lds + (Tv * 16 + l15) * 512 + (quad & 1) * 8;
#pragma unroll
        for (int s2 = 0; s2 < 8; ++s2) {
            const int ch = 4 * s2 + (quad >> 1);
            const u32x2 lo = *(const LAS u32x2*)(vr + ((ch ^ l15) * 16)), hi = *(const LAS u32x2*)(vr + (((ch + 2) ^ l15) * 16));
            u32x4 w; w.x = lo.x; w.y = lo.y; w.z = hi.x; w.w = hi.y;
            oacc[Tv] = __builtin_amdgcn_mfma_f32_16x16x32_bf16(__builtin_bit_cast(bf16x8, w), pb[s2], oacc[Tv], 0, 0, 0);
        }
    }
    u32x2 sgv[16];
#pragma unroll
    for (int Tv = 0; Tv < 16; ++Tv) sgv[Tv] = *(const u32x2*)(proj + qrow * LDP + C_AS + h * 256 + Tv * 16 + quad * 4);
#pragma unroll
    for (int Tv = 0; Tv < 16; ++Tv) {
        const u32x2 sg = sgv[Tv];
        u32x2 o; o.x = pk2(oacc[Tv][0] * rs * bflo(sg.x), oacc[Tv][1] * rs * bfhi(sg.x)); o.y = pk2(oacc[Tv][2] * rs * bflo(sg.y), oacc[Tv][3] * rs * bfhi(sg.y));
        *(u32x2*)(aog_row + (Tv >> 2) * 16384 + (Tv & 3) * 16) = o;
    }
    __syncthreads();
}

__device__ __forceinline__ void attn_sample_item(const Params& p, int item, LAS unsigned char* lds, int tid) {
    LAS float* Ssh = (LAS float*)lds;
    LAS float* Psh = Ssh + 2048;
    LAS float* Opart = Psh + 2048;
    const int lane = tid & 63, wave = tid >> 6, l15 = lane & 15, quad = lane >> 4;
    const int n = item >> 2, h = item & 3;
    const bf16_t* proj = (const bf16_t*)(p.ws + WS_PROJ9);
    const size_t row0 = (size_t)NTP + (size_t)n * 8;
    const float* kc = p.cache_k + ((size_t)n * 256 * 4 + h) * 256;
    const float* vc = p.cache_v + ((size_t)n * 256 * 4 + h) * 256;
    {
        bf16x8 qf[8];
        const size_t qrow = row0 + (lane & 7);
#pragma unroll
        for (int s = 0; s < 8; ++s) qf[s] = *(const bf16x8*)(proj + qrow * LDP + C_AQ + h * 256 + s * 32 + quad * 8);
#pragma unroll
        for (int tl = 0; tl < 2; ++tl) {
            const int T = wave * 2 + tl;
            f32x4 sc = (f32x4){0.f, 0.f, 0.f, 0.f};
            const float* kr = kc + (size_t)(T * 16 + l15) * 1024 + quad * 8;
#pragma unroll
            for (int s = 0; s < 8; ++s) {
                const f32x4 k0 = ld_nt(kr + s * 32), k1 = ld_nt(kr + s * 32 + 4);
                u32x4 w; w.x = pk2(k0[0], k0[1]); w.y = pk2(k0[2], k0[3]); w.z = pk2(k1[0], k1[1]); w.w = pk2(k1[2], k1[3]);
                sc = __builtin_amdgcn_mfma_f32_16x16x32_bf16(__builtin_bit_cast(bf16x8, w), qf[s], sc, 0, 0, 0);
            }
            if (l15 < 8) {
#pragma unroll
                for (int e = 0; e < 4; ++e) Ssh[l15 * 256 + T * 16 + quad * 4 + e] = sc[e];
            }
        }
    }
    const float* vr = vc + (size_t)(wave * 32) * 1024 + lane * 4;
    f32x4 vpre[16];
#pragma unroll
    for (int kk = 0; kk < 16; ++kk) vpre[kk] = ld_nt(vr + (size_t)kk * 1024);
    __syncthreads();
    {
        const f32x4 s4 = *(const LAS f32x4*)(Ssh + wave * 256 + lane * 4);
        const float mx = wave_max(fmaxf(fmaxf(s4[0], s4[1]), fmaxf(s4[2], s4[3])));
        f32x4 e4; e4[0] = __expf(s4[0] - mx); e4[1] = __expf(s4[1] - mx); e4[2] = __expf(s4[2] - mx); e4[3] = __expf(s4[3] - mx);
        const float rs = 1.f / wave_sum((e4[0] + e4[1]) + (e4[2] + e4[3]));
#pragma unroll
        for (int e = 0; e < 4; ++e) Psh[(lane * 4 + e) * 8 + wave] = e4[e] * rs;
    }
    __syncthreads();
    {
        f32x4 acc[8];
#pragma unroll
        for (int q = 0; q < 8; ++q) acc[q] = (f32x4){0.f, 0.f, 0.f, 0.f};
        f32x4 vpost[16];
#pragma unroll
        for (int kk = 0; kk < 16; ++kk) vpost[kk] = ld_nt(vr + (size_t)(16 + kk) * 1024);
#pragma unroll
        for (int kk = 0; kk < 32; ++kk) {
            const f32x4 v4 = (kk < 16) ? vpre[kk & 15] : vpost[kk & 15];
            const f32x4 pa = *(const LAS f32x4*)(Psh + (wave * 32 + kk) * 8), pb = *(const LAS f32x4*)(Psh + (wave * 32 + kk) * 8 + 4);
            acc[0] += v4 * pa[0]; acc[1] += v4 * pa[1]; acc[2] += v4 * pa[2]; acc[3] += v4 * pa[3];
            acc[4] += v4 * pb[0]; acc[5] += v4 * pb[1]; acc[6] += v4 * pb[2]; acc[7] += v4 * pb[3];
        }
#pragma unroll
        for (int q = 0; q < 8; ++q) *(LAS f32x4*)(Opart + (wave * 8 + q) * 256 + lane * 4) = acc[q];
    }
    __syncthreads();
    {
        f32x4 o = (f32x4){0.f, 0.f, 0.f, 0.f};
#pragma unroll
        for (int w = 0; w < 8; ++w) o += *(const LAS f32x4*)(Opart + (w * 8 + wave) * 256 + lane * 4);
        const size_t r = row0 + wave;
        const u32x2 sg = *(const u32x2*)(proj + r * LDP + C_AS + h * 256 + lane * 4);
        u32x2 ov; ov.x = pk2(o[0] * bflo(sg.x), o[1] * bfhi(sg.x)); ov.y = pk2(o[2] * bflo(sg.y), o[3] * bfhi(sg.y));
        bf16_t* aog = (bf16_t*)(p.ws + WS_ACT3) + (size_t)2 * 9216 * 1024;
        *(u32x2*)(aog + tl(r, h * 256 + lane * 4, 1024)) = ov;
    }
    __syncthreads();
}

__device__ __forceinline__ void p2_mixers(const Params& p, LAS unsigned char* lds) {
    const int tid = threadIdx.x, G = gridDim.x, c = blockIdx.x, mask = p.pad;
    if ((mask & 1) && !(c & 1)) for (int it = c; it < 1024; it += G) hgrn_h1_item(p, it, lds, tid);
    if (mask & 2) { for (int it = c; it < 256; it += G) conv_item<false>(p, it, lds, tid);
                    for (int it = c; it < 128; it += G) conv_item<true>(p, it, lds, tid); }
    if (mask & 4) for (int it = c; it < 256; it += G) attn_prompt_item(p, it, lds, tid);
    if (mask & 8) for (int it = c; it < 512; it += G) attn_sample_item(p, it, lds, tid);
    if (mask & 16) for (int it = c; it < 1024; it += G) hgrn_sample_item(p, it, lds, tid);
    if ((mask & 1) && (c & 1)) for (int it = c; it < 1024; it += G) hgrn_h1_item(p, it, lds, tid);
}

__device__ __forceinline__ void p4b_merge(const Params& p) {
    const float* pm = (const float*)(p.ws + WS_MF); bf16_t* merged = (bf16_t*)(p.ws + WS_MERGED);
    for (int idx = blockIdx.x * 512 + threadIdx.x; idx < 1024 * 256; idx += gridDim.x * 512) {
        const int r = idx >> 8, c8 = (idx & 255) * 8;
        f32x4 a0 = (f32x4){0.f, 0.f, 0.f, 0.f}, a1 = a0;
#pragma unroll
        for (int q = 0; q < 4; ++q) { const float* src = pm + ((size_t)q * 1024 + r) * 2048 + c8; a0 += *(const f32x4*)src; a1 += *(const f32x4*)(src + 4); }
        u32x4 o; o.x = pk2(a0[0], a0[1]); o.y = pk2(a0[2], a0[3]); o.z = pk2(a1[0], a1[1]); o.w = pk2(a1[2], a1[3]);
        *(u32x4*)(merged + tl((size_t)NTP + r, c8, 2048)) = o;
    }
}

__device__ __forceinline__ void p6_final_norm(const Params& p) {
    const int tid = threadIdx.x, lane = tid & 63, gw = blockIdx.x * 8 + (tid >> 6), NGW = gridDim.x * 8;
    for (int r = NTP + gw; r < NTOK; r += NGW) {
        float* zr = p.out + (size_t)r * 2048;
        f32x4 v[8]; float ss = 0.f;
        if (r < NTP) {
#pragma unroll
            for (int j = 0; j < 8; ++j) v[j] = ((const f32x4*)zr)[lane + 64 * j];
        } else {
            const float* xr = p.x_sample + (size_t)(r - NTP) * 2048; const float* pr = (const float*)(p.ws + WS_MF) + (size_t)(r - NTP) * 2048;
#pragma unroll
            for (int j = 0; j < 8; ++j) v[j] = ((const f32x4*)xr)[lane + 64 * j];
#pragma unroll 2
            for (int ks = 0; ks < 8; ++ks) {
#pragma unroll
                for (int j = 0; j < 8; ++j) v[j] += ((const f32x4*)(pr + (size_t)ks * 1024 * 2048))[lane + 64 * j]; }
        }
#pragma unroll
        for (int j = 0; j < 8; ++j) ss += (v[j][0] * v[j][0] + v[j][1] * v[j][1]) + (v[j][2] * v[j][2] + v[j][3] * v[j][3]);
        ss = wave_sum(ss);
        const float rinv = rsqrtf(ss * (1.f / 2048.f) + EPS);
#pragma unroll
        for (int j = 0; j < 8; ++j) { const f32x4 gg = ((const f32x4*)p.g_final)[lane + 64 * j]; ((f32x4*)zr)[lane + 64 * j] = v[j] * rinv * gg; }
    }
}

__global__ void __launch_bounds__(512, 2) fwd_megakernel(Params p) {
    extern __shared__ __attribute__((aligned(16))) unsigned char shm[];
    LAS unsigned char* lds = (LAS unsigned char*)shm;
    cg::grid_group grid = cg::this_grid();
    const int G = gridDim.x, c = blockIdx.x;
    volatile LAS unsigned* xst = (volatile LAS unsigned*)(lds + LDS_PHASE_BYTES);
    unsigned* xbar = (unsigned*)(p.ws + WS_BAR); unsigned xbx = 0u;
    if (p.coop) { if (threadIdx.x == 0) { xst[0] = 0u; xst[1] = 0u; } __syncthreads(); const XcdBarrier xb = xcd_barrier_post(xbar, xst); xbx = xb.x;
        grid.sync(); }
#define SEAM(ph) do { if (p.coop && (ph) + 1 < p.ph_hi) xcd_barrier(xbar, xbx, xst); } while (0)
#define RUNS(ph) (p.ph_lo <= (ph) && (ph) < p.ph_hi)
    if (RUNS(0)) { p0_prologue(p, lds); SEAM(0); }
    if (RUNS(1)) {
        SchedP1 S; S.G = G; S.c = c; S.A = (const char*)(p.ws + WS_HA); S.Bt = (const char*)(p.ws + WS_WT1);
        EpiP1 E; E.proj = (bf16_t*)(p.ws + WS_PROJ9); E.gate = (bf16_t*)(p.ws + WS_GATE); E.F = (float*)(p.ws + WS_F); E.lb = (const float*)(p.ws + WS_LB);
        E.b_gate = p.b_gate; E.out = p.out; E.mkb = (bf16_t*)(p.ws + WS_MKB); E.mvt = (bf16_t*)(p.ws + WS_MVT);
        pg8::gemm_phase(lds, 2048, S, E); SEAM(1);
    }
    if (RUNS(2)) { p2_mixers(p, lds); SEAM(2); }
    if (RUNS(3)) { hgrn_h2_scan(p); SEAM(3); }
    if (RUNS(4)) { for (int it = c; it < 1024; it += G) hgrn_h3_item(p, it, lds, threadIdx.x); SEAM(4); }
    if (RUNS(5)) {
        SchedP4 S; S.G = G; S.c = c; S.A = (const char*)(p.ws + WS_ACT3); S.Bt = (const char*)(p.ws + WS_WT3);
        EpiP4 E; E.gate = (const bf16_t*)(p.ws + WS_GATE); E.merged = (bf16_t*)(p.ws + WS_MERGED); E.partm = (float*)(p.ws + WS_MF);
        pg8::gemm_phase(lds, 1024, S, E); SEAM(5);
    }
    if (RUNS(6)) { p4b_merge(p); SEAM(6); }
    if (RUNS(7)) {
        SchedP5 S; S.G = G; S.c = c; S.A = (const char*)(p.ws + WS_MERGED); S.Bt = (const char*)(p.ws + WS_WTO);
        EpiP5 E; E.xp = p.x_prompt; E.xs = p.x_sample; E.out = p.out; E.part = (float*)(p.ws + WS_MF);
        E.rs = (float*)(p.ws + WS_RS); E.gfin = p.g_final; E.xbar = xbar; E.xbx = xbx; E.xst = xst;
        pg8::gemm_phase(lds, 2048, S, E); SEAM(7);
    }
    if (RUNS(8)) { p6_final_norm(p); }
#undef RUNS
#undef SEAM
}

extern "C" void kernel_launch(void* const* d_in, const int* in_sizes, int n_in, void* d_out, int out_size, void* d_ws, size_t ws_size, hipStream_t stream) {
    static int grid = 0;
    if (grid == 0) {
        if (n_in != 23 || ws_size < WS_END) { fprintf(stderr, "kernel_launch: expected 23 inputs and >= %zu bytes of workspace, got %d / %zu\n", (size_t)WS_END, n_in, ws_size); grid = -1; return; }
        int dev = 0, cus = 0, per_cu = 0;
        hipGetDevice(&dev); hipDeviceGetAttribute(&cus, hipDeviceAttributeMultiprocessorCount, dev);
        if (hipFuncSetAttribute((const void*)fwd_megakernel, hipFuncAttributeMaxDynamicSharedMemorySize, LDS_BYTES) != hipSuccess) { fprintf(stderr, "kernel_launch: hipFuncSetAttribute failed\n"); grid = -1; return; }
        if (hipOccupancyMaxActiveBlocksPerMultiprocessor(&per_cu, (const void*)fwd_megakernel, 512, LDS_BYTES) != hipSuccess || per_cu < 1) { fprintf(stderr, "kernel_launch: occupancy query failed (%d)\n", per_cu); (void)hipGetLastError(); per_cu = 1; }
        grid = cus * 1;
        if (grid != 256) { fprintf(stderr, "kernel_launch: built for a 256-CU device (every CU owns exactly one prompt tile of the output GEMM); found %d CUs\n", cus); grid = -1; return; }
    }
    if (grid < 0) return;
    Params p{};
    const float** pp = (const float**)&p;
    for (int i = 0; i < 23; ++i) pp[i] = (const float*)d_in[i];
    p.out = (float*)d_out; p.ws = (unsigned char*)d_ws; p.pad = 31;
#if N_LAUNCH_MODE != 1
#error "the output GEMM's epilogue contains a grid barrier: only the one-launch cooperative build is supported"
#endif
#if N_LAUNCH_MODE == 1
    p.ph_lo = 0; p.ph_hi = N_PHASES; p.coop = 1;
    if (hipMemsetAsync((char*)d_ws + WS_BAR, 0, WS_ZERO_BYTES, stream) != hipSuccess) { fprintf(stderr, "kernel_launch: memset of the barrier words failed\n"); return; }
    void* args[] = {&p};
    hipError_t e = hipLaunchCooperativeKernel((const void*)fwd_megakernel, dim3(grid), dim3(512), args, LDS_BYTES, stream);
    if (e != hipSuccess) fprintf(stderr, "cooperative launch failed: %s (grid %d)\n", hipGetErrorString(e), grid);
#else
    for (int ph = 0; ph < N_PHASES; ++ph) {
        p.ph_lo = ph; p.ph_hi = ph + 1; p.coop = 0;
        hipLaunchKernelGGL(fwd_megakernel, dim3(grid), dim3(512), LDS_BYTES, stream, p);
        if ((REP_MASK >> ph) & 1) { if (ph == 2) p.pad = P2_SUBMASK; hipLaunchKernelGGL(fwd_megakernel, dim3(grid), dim3(512), LDS_BYTES, stream, p); p.pad = 31; }
    }
#endif
}
```

```cpp
#include <hip/hip_runtime.h>
#include <hip/hip_cooperative_groups.h>
#include <cstdio>
namespace cg = cooperative_groups;

#define LAS __attribute__((address_space(3)))
typedef unsigned short bf16_t;
typedef short bf16x8 __attribute__((ext_vector_type(8)));
typedef float f32x4 __attribute__((ext_vector_type(4)));
typedef float f32x2 __attribute__((ext_vector_type(2)));
typedef unsigned u32x4 __attribute__((ext_vector_type(4)));
typedef unsigned u32x2 __attribute__((ext_vector_type(2)));

#ifndef REP_MASK
#define REP_MASK 0
#endif
#ifndef P2_SUBMASK
#define P2_SUBMASK 31
#endif
#ifndef N_LAUNCH_MODE
#define N_LAUNCH_MODE 1
#endif

constexpr int DM = 2048, NTP = 8192, NTS = 1024, NTOK = 9216, SEQ = 2048;
constexpr int LDP = 9216;
constexpr int C_CV = 0, C_CG = 1024, C_CS = 2048, C_HQ = 3072, C_HF = 4096, C_HI = 5120, C_HOG = 6144, C_AQ = 7168, C_AS = 8192;
constexpr int LDG = 6144;
constexpr float EPS = 1e-6f;
constexpr size_t O_YP = 0, O_YS = 16777216, O_CONV_P = 18874368, O_HGRN_P = 18997248, O_MK = 19521536, O_MV = 20570112, O_CONV_S = 21618688, O_HGRN_S = 25550848;
constexpr size_t WS_WT1 = 0;
constexpr size_t WS_WT3 = WS_WT1 + (size_t)17408 * 2048 * 2;
constexpr size_t WS_WTO = WS_WT3 + (size_t)3 * 2048 * 1024 * 2;
constexpr size_t WS_HA = WS_WTO + (size_t)2048 * 2048 * 2;
constexpr size_t WS_ST = WS_HA;
constexpr size_t WS_DD = WS_HA + (size_t)33554432;
constexpr size_t WS_UT = WS_WT1;
constexpr size_t WS_PROJ9 = WS_HA + (size_t)10240 * 2048 * 2;
constexpr size_t WS_MF = WS_PROJ9;
constexpr size_t WS_MERGED = WS_MF + (size_t)9216 * 2048 * 4;
constexpr size_t WS_GATE = WS_PROJ9 + (size_t)9216 * 9216 * 2;
constexpr size_t WS_F = WS_GATE + (size_t)9216 * 6144 * 2;
constexpr size_t WS_MKB = WS_F + (size_t)9216 * 1024 * 4;
constexpr size_t WS_MVT = WS_MKB + (size_t)2097152;
constexpr size_t WS_ACT3 = WS_MVT + (size_t)2097152;
constexpr size_t WS_LB = WS_ACT3 + (size_t)3 * 9216 * 1024 * 2;
constexpr size_t WS_BAR = WS_LB + 4096;
constexpr size_t WS_BAR_BYTES = 16384;
constexpr size_t WS_RS = WS_BAR + WS_BAR_BYTES;
constexpr size_t WS_ZERO_BYTES = WS_BAR_BYTES + 32768;
constexpr size_t WS_END = WS_BAR + WS_ZERO_BYTES;
constexpr int LDS_PHASE_BYTES = 131072, LDS_BYTES = LDS_PHASE_BYTES + 64;
constexpr int N_PHASES = 9;

struct Params {
    const float *x_prompt, *x_sample, *state_conv, *state_hgrn, *cache_k, *cache_v, *mem_prompt, *g_pre, *w_in, *conv_w, *conv_b, *ln_g, *ln_b,
        *w_conv_out, *lb_logits, *g_hgrn, *w_hgrn_out, *g_mem, *w_mem_kv, *w_attn_out, *b_gate, *w_out, *g_final;
    float* out; unsigned char* ws; int ph_lo, ph_hi, coop, pad;
};

__device__ __forceinline__ unsigned f2bf(float f) { unsigned u = __builtin_bit_cast(unsigned, f); return (u + 0x7fffu + ((u >> 16) & 1u)) >> 16; }
typedef __bf16 bf16x2_t __attribute__((ext_vector_type(2)));
__device__ __forceinline__ unsigned pk2(float lo, float hi) { const f32x2 v = {lo, hi}; const bf16x2_t r = __builtin_convertvector(v, bf16x2_t); return __builtin_bit_cast(unsigned, r); }
__device__ __forceinline__ float bflo(unsigned w) { return __builtin_bit_cast(float, w << 16); }
__device__ __forceinline__ float bfhi(unsigned w) { return __builtin_bit_cast(float, w & 0xffff0000u); }
__device__ __forceinline__ float bf2f(unsigned short b) { return __builtin_bit_cast(float, ((unsigned)b) << 16); }
__device__ __forceinline__ float sigm(float x) { return __builtin_amdgcn_rcpf(1.f + __expf(-x)); }
__device__ __forceinline__ float siluf(float x) { return x * sigm(x); }
__device__ __forceinline__ size_t tl(size_t row, int col, int K) { return (row >> 8) * ((size_t)256 * K) + (size_t)(col >> 6) * (256 * 64) + (row & 255) * 64 + (col & 63); }
__device__ __forceinline__ float wave_sum(float v) {
#pragma unroll
    for (int o = 1; o < 64; o <<= 1) v += __shfl_xor(v, o);
    return v;
}
__device__ __forceinline__ void st_nt(u32x4* p, u32x4 v) { __builtin_nontemporal_store(v, p); }
__device__ __forceinline__ void st_nt(f32x4* p, f32x4 v) { __builtin_nontemporal_store(v, p); }
__device__ __forceinline__ f32x4 ld_nt(const float* p) { return __builtin_nontemporal_load((const f32x4*)p); }
__device__ __forceinline__ float wave_max(float v) {
#pragma unroll
    for (int o = 1; o < 64; o <<= 1) v = fmaxf(v, __shfl_xor(v, o));
    return v;
}

namespace pg8 {
constexpr int BM = 256, BK = 64, HALF = 128, HTB = HALF * BK * 2, STAGE_BYTES = 8 * HTB, NXCD = 8, WGM = 8;
__host__ __device__ __forceinline__ int lds_byte(int r, int c) { const int st = (r >> 4) * 2 + (c >> 5), rr = r & 15, cc = c & 31, ob = rr * 64 + cc * 2; return st * 1024 + (ob ^ (((ob >> 9) & 1) << 5)); }
__host__ __device__ __forceinline__ void stage_rc(int b, int& R, int& C) { const int st = b / 1024, sb = b % 1024, swz = sb ^ (((sb >> 9) & 1) << 5); R = (st >> 1) * 16 + swz / 64; C = (st & 1) * 32 + (swz % 64) / 2; }
__host__ __device__ __forceinline__ int perm32(int rho) { const int n = rho >> 4, i = rho & 15; return 8 * (i >> 2) + 4 * n + (i & 3); }
struct Unit { int pm, pn, br, sl; };
__device__ __forceinline__ void tile_of(int wgid, int nM, int nN, int& pm, int& pn) {
    const int nwg = nM * nN;
    { const int q = nwg / NXCD, r = nwg % NXCD, xcd = wgid % NXCD, off = wgid / NXCD; wgid = (xcd < r ? xcd * (q + 1) : r * (q + 1) + (xcd - r) * q) + off; }
    const int nig = WGM * nN, gid = wgid / nig, fm = gid * WGM, gsz = (nM - fm) < WGM ? (nM - fm) : WGM;
    pm = fm + ((wgid % nig) % gsz); pn = (wgid % nig) / gsz;
}

template <class Epi, class Sched>
__device__ __forceinline__ void gemm_phase(LAS unsigned char* lds, const int K, const Sched& S, const Epi& E) {
    const int tid = threadIdx.x, wid = __builtin_amdgcn_readfirstlane(tid >> 6), lane = tid & 63, wr = wid >> 2, wc = wid & 3, fr = lane & 15, fq = lane >> 4;
    unsigned voffA[2], voffB[2];
#pragma unroll
    for (int i = 0; i < 2; ++i) { int R, C; stage_rc(tid * 16 + i * 8192, R, C); const int Rb = (R & ~31) + perm32(R & 31);
        voffA[i] = (unsigned)(R * BK + C) * 2u; voffB[i] = (unsigned)(Rb * BK + C) * 2u; }
    const size_t kstep = (size_t)(BM * BK * 2);
    const size_t hstep = (size_t)HALF * BK * 2;
    const unsigned ldsw = (unsigned)wid * 1024u;
    const int aoff = lds_byte(wr * 64 + fr, fq * 8), boff = lds_byte(wc * 32 + fr, fq * 8);
#define PG8_SA(b, h) (((b) * 2 + (h)) * HTB)
#define PG8_SB(b, h) ((4 + (b) * 2 + (h)) * HTB)
#define PG8_STAGE(bufoff, gbase, voff) do { _Pragma("unroll") for (int _i = 0; _i < 2; ++_i) \
        __builtin_amdgcn_global_load_lds((const unsigned*)((const char*)(gbase) + (voff)[_i]), (LAS unsigned*)(lds + (bufoff) + ldsw + _i * 8192), 16, 0, 0); } while (0)
#define PG8_LDA(dst, b, h) do { _Pragma("unroll") for (int m = 0; m < 4; ++m) _Pragma("unroll") for (int k = 0; k < 2; ++k) dst[m][k] = *(const LAS bf16x8*)(lds + PG8_SA(b, h) + aoff + m * 2048 + k * 1024); } while (0)
#define PG8_LDB(dst, b, h) do { _Pragma("unroll") for (int n = 0; n < 2; ++n) _Pragma("unroll") for (int k = 0; k < 2; ++k) dst[n][k] = *(const LAS bf16x8*)(lds + PG8_SB(b, h) + boff + n * 2048 + k * 1024); } while (0)
#define PG8_MMA(ai, bj, At, Bt) do { __builtin_amdgcn_s_setprio(1); _Pragma("unroll") for (int m = 0; m < 4; ++m) _Pragma("unroll") for (int n = 0; n < 2; ++n) _Pragma("unroll") for (int k = 0; k < 2; ++k) \
        acc[ai][bj][m][n] = __builtin_amdgcn_mfma_f32_16x16x32_bf16(Bt[n][k], At[m][k], acc[ai][bj][m][n], 0, 0, 0); __builtin_amdgcn_s_setprio(0); } while (0)
#define PG8_WAIT_V(n) asm volatile("s_waitcnt vmcnt(" #n ")" ::: "memory")
#define PG8_WAIT_L(n) asm volatile("s_waitcnt lgkmcnt(" #n ")" ::: "memory")
#define PG8_BAR __builtin_amdgcn_s_barrier()
#define PG8_SCHED __builtin_amdgcn_sched_barrier(0)
    Unit cur, nxt; int ui = 0;
    if (!S.next(0, cur)) return;
    f32x4 acc[2][2][4][2];
#pragma unroll
    for (int a = 0; a < 2; ++a)
#pragma unroll
        for (int b = 0; b < 2; ++b)
#pragma unroll
            for (int m = 0; m < 4; ++m)
#pragma unroll
                for (int n = 0; n < 2; ++n) acc[a][b][m][n] = (f32x4){0.f, 0.f, 0.f, 0.f};
    bf16x8 At[4][2], B0[2][2], B1[2][2];
    const char* cA = S.a_base(cur); const char* cB = S.b_base(cur);
    PG8_STAGE(PG8_SB(0, 0), cB, voffB); PG8_STAGE(PG8_SB(0, 1), cB + hstep, voffB); PG8_STAGE(PG8_SA(0, 0), cA, voffA); PG8_STAGE(PG8_SA(0, 1), cA + hstep, voffA);
    if (wr == 1) PG8_BAR;
    PG8_WAIT_V(2); PG8_BAR;
    PG8_STAGE(PG8_SB(1, 0), cB + kstep, voffB); PG8_STAGE(PG8_SA(1, 0), cA + kstep, voffA); PG8_STAGE(PG8_SB(1, 1), cB + hstep + kstep, voffB);
    PG8_WAIT_V(6); PG8_BAR;
    for (;;) {
        const bool has_next = S.next(ui + 1, nxt);
        const char* nA = has_next ? S.a_base(nxt) : cA; const char* nB = has_next ? S.b_base(nxt) : cB;
        const int nt = S.nt(cur);
        for (int t = 0; t < nt; t += 2) {
            const bool last = (t == nt - 2);
            const char* a1 = cA + (size_t)(t + 1) * kstep;
            const char* a2 = last ? nA : cA + (size_t)(t + 2) * kstep; const char* b2 = last ? nB : cB + (size_t)(t + 2) * kstep;
            const char* a3 = a2 + kstep; const char* b3 = b2 + kstep;
            PG8_LDB(B0, 0, 0); PG8_LDB(B1, 0, 1); PG8_SCHED; PG8_LDA(At, 0, 0); PG8_STAGE(PG8_SA(1, 1), a1 + hstep, voffA);
            PG8_WAIT_V(8); PG8_WAIT_L(0); PG8_BAR; PG8_MMA(0, 0, At, B0); PG8_MMA(0, 1, At, B1); PG8_BAR; PG8_SCHED;
            PG8_LDA(At, 0, 1); PG8_STAGE(PG8_SB(0, 0), b2, voffB); PG8_STAGE(PG8_SB(0, 1), b2 + hstep, voffB); PG8_STAGE(PG8_SA(0, 0), a2, voffA);
            PG8_WAIT_V(8); PG8_WAIT_L(0); PG8_BAR; PG8_MMA(1, 0, At, B0); PG8_MMA(1, 1, At, B1); PG8_BAR; PG8_SCHED;
            PG8_LDB(B0, 1, 0); PG8_LDB(B1, 1, 1); PG8_SCHED; PG8_LDA(At, 1, 0); PG8_STAGE(PG8_SA(0, 1), a2 + hstep, voffA);
            PG8_WAIT_V(8); PG8_WAIT_L(0); PG8_BAR; PG8_MMA(0, 0, At, B0); PG8_MMA(0, 1, At, B1); PG8_BAR; PG8_SCHED;
            PG8_LDA(At, 1, 1); PG8_STAGE(PG8_SB(1, 0), b3, voffB); PG8_STAGE(PG8_SB(1, 1), b3 + hstep, voffB); PG8_STAGE(PG8_SA(1, 0), a3, voffA);
            PG8_WAIT_V(8); PG8_WAIT_L(0); PG8_BAR; PG8_MMA(1, 0, At, B0); PG8_MMA(1, 1, At, B1); PG8_BAR; PG8_SCHED;
        }
        if (wr == 0) PG8_BAR;
        const bool keep = E(acc, cur, wr, wc, fr, fq);
        if (!has_next) break;
        if (!keep)
#pragma unroll
        for (int a = 0; a < 2; ++a)
#pragma unroll
            for (int b = 0; b < 2; ++b)
#pragma unroll
                for (int m = 0; m < 4; ++m)
#pragma unroll
                    for (int n = 0; n < 2; ++n) acc[a][b][m][n] = (f32x4){0.f, 0.f, 0.f, 0.f};
        cur = nxt; cA = nA; cB = nB; ++ui;
        if (wr == 1) PG8_BAR;
    }
    PG8_WAIT_V(0);
    PG8_BAR;
#undef PG8_SA
#undef PG8_SB
#undef PG8_STAGE
#undef PG8_LDA
#undef PG8_LDB
#undef PG8_MMA
#undef PG8_WAIT_V
#undef PG8_WAIT_L
#undef PG8_BAR
#undef PG8_SCHED
}
}
using pg8::Unit;

#define XB_TMO      128
#define XB_XCNT(j)  (256  + 64 * (j))
#define XB_XSUB(j)  (1280 + 64 * (j))
#define XB_XGEN(j)  (2304 + 64 * (j))
#define XB_TOP      3328
#define XB_TOPGEN   3392
#define XCD_BAR_WORDS 3456
#define XB_SPIN_CAP (1u << 18)
__device__ __forceinline__ unsigned xb_ld(unsigned* p)              { return __hip_atomic_load(p, __ATOMIC_RELAXED, __HIP_MEMORY_SCOPE_AGENT); }
__device__ __forceinline__ unsigned xb_add(unsigned* p, unsigned v) { return __hip_atomic_fetch_add(p, v, __ATOMIC_RELAXED, __HIP_MEMORY_SCOPE_AGENT); }
__device__ __forceinline__ unsigned xb_xcc_id() { return (unsigned)__builtin_amdgcn_s_getreg((3 << 11) | 20) & 0xFu; }
#define XB_SPIN(cond, bar) do { unsigned _sp = 0; while (cond) { __builtin_amdgcn_s_sleep(1); \
    if ((++_sp & 255u) == 0u) { if (xb_ld(&(bar)[XB_TMO])) break; if (_sp > XB_SPIN_CAP) { atomicAdd(&(bar)[XB_TMO], 1u); break; } } } } while (0)
struct XcdBarrier { unsigned* bar; unsigned x; volatile LAS unsigned* st; };
__device__ __forceinline__ XcdBarrier xcd_barrier_post(unsigned* bar, volatile LAS unsigned* st) {
    XcdBarrier b; b.bar = bar; b.x = xb_xcc_id(); b.st = st;
    if (threadIdx.x == 0) (void)xb_add(&bar[XB_XCNT(b.x)], 1u);
    return b;
}
__device__ __forceinline__ void xcd_barrier_complete(unsigned* bar, unsigned x, unsigned& nloc, unsigned& nx) {
    const unsigned G = gridDim.x * gridDim.y * gridDim.z;
    unsigned sum, cnt, mine, sp = 0u;
    for (;;) {
        sum = 0u; cnt = 0u; mine = 0u;
#pragma unroll
        for (unsigned j = 0; j < 16; ++j) { const unsigned c = xb_ld(&bar[XB_XCNT(j)]); sum += c; cnt += (c > 0u) ? 1u : 0u; mine = (j == x) ? c : mine; }
        if (sum == G) break;
        __builtin_amdgcn_s_sleep(1);
        if ((++sp & 255u) == 0u) { if (xb_ld(&bar[XB_TMO])) break; if (sp > XB_SPIN_CAP) { atomicAdd(&bar[XB_TMO], 1u); break; } }
    }
    nloc = mine > 0u ? mine : 1u; nx = cnt > 0u ? cnt : 1u;
}
__device__ __forceinline__ void xcd_barrier(unsigned* bar, unsigned bx, volatile LAS unsigned* st) {
    asm volatile("s_waitcnt vmcnt(0)" ::: "memory");
    __syncthreads();
    if (threadIdx.x == 0) {
        __builtin_amdgcn_s_waitcnt(0);
        unsigned nloc = st[0], nx = st[1];
        if (nloc == 0u) { xcd_barrier_complete(bar, bx, nloc, nx); st[0] = nloc; st[1] = nx; }
        const unsigned old = xb_add(&bar[XB_XSUB(bx)], 1u);
        const unsigned gen = old / nloc;
        if (old + 1u == (gen + 1u) * nloc) {
            __builtin_amdgcn_fence(__ATOMIC_RELEASE, "agent");
            asm volatile("s_waitcnt vmcnt(0)" ::: "memory");
            const unsigned og = xb_add(&bar[XB_TOP], 1u);
            const unsigned tg = og / nx;
            if (og + 1u == (tg + 1u) * nx) xb_add(&bar[XB_TOPGEN], 1u);
            else XB_SPIN(xb_ld(&bar[XB_TOPGEN]) == tg, bar);
            __builtin_amdgcn_fence(__ATOMIC_ACQUIRE, "agent");
            xb_add(&bar[XB_XGEN(bx)], 1u);
            asm volatile("s_waitcnt vmcnt(0)" ::: "memory");
        } else {
            XB_SPIN(xb_ld(&bar[XB_XGEN(bx)]) == gen, bar);
            __builtin_amdgcn_fence(__ATOMIC_ACQUIRE, "agent");
            asm volatile("s_waitcnt vmcnt(0)" ::: "memory");
        }
    }
    __syncthreads();
}

struct SchedP1 {
    int G, c; const char* A; const char* Bt;
    __device__ __forceinline__ bool next(int i, Unit& u) const {
        const int L = i * G + c; if (L >= 2192) return false;
        u.br = 0; u.sl = 0;
        if (L >= 2160) { const int idx = L - 2160; u.pm = 36 + (idx >> 3); u.pn = 60 + (idx & 7); return true; }
        pg8::tile_of(L, 36, 60, u.pm, u.pn); return true;
    }
    __device__ __forceinline__ const char* a_base(const Unit& u) const { return A + (size_t)u.pm * (256 * 2048 * 2); }
    __device__ __forceinline__ const char* b_base(const Unit& u) const { return Bt + (size_t)u.pn * (256 * 2048 * 2); }
    __device__ __forceinline__ int nt(const Unit&) const { return 32; }
};
struct EpiP1 {
    bf16_t* proj; bf16_t* gate; float* F; const float* lb; const float* b_gate; float* out; bf16_t* mkb; bf16_t* mvt;
    __device__ __forceinline__ bool operator()(f32x4 (&acc)[2][2][4][2], const Unit& u, int wr, int wc, int fr, int fq) const {
        const int rloc = wr * 64 + fr, cloc = wc * 32 + 8 * fq;
        if (u.pn < 36) {
            const int seg = u.pn >> 2;
#pragma unroll
            for (int bj = 0; bj < 2; ++bj) {
                const int col = u.pn * 256 + bj * 128 + cloc;
                f32x4 l0 = (f32x4){0.f, 0.f, 0.f, 0.f}, l1 = l0;
                if (seg == 4) { l0 = *(const f32x4*)(lb + (col - C_HF)); l1 = *(const f32x4*)(lb + (col - C_HF) + 4); }
#pragma unroll
                for (int ai = 0; ai < 2; ++ai)
#pragma unroll
                    for (int m = 0; m < 4; ++m) {
                        const size_t row = (size_t)u.pm * 256 + ai * 128 + m * 16 + rloc;
                        f32x4 v0 = acc[ai][bj][m][0], v1 = acc[ai][bj][m][1];
                        if (seg == 4) {
#pragma unroll
                            for (int e = 0; e < 4; ++e) { v0[e] = l0[e] + (1.f - l0[e]) * sigm(v0[e]); v1[e] = l1[e] + (1.f - l1[e]) * sigm(v1[e]); }
                            float* fp = F + row * 1024 + (col - C_HF);
                            st_nt((f32x4*)fp, v0); st_nt((f32x4*)(fp + 4), v1);
                        } else {
                            if (seg == 1) {
#pragma unroll
                                for (int e = 0; e < 4; ++e) { v0[e] = sigm(v0[e]); v1[e] = sigm(v1[e]); }
                            } else if (seg == 2 || seg == 6 || seg == 8) {
#pragma unroll
                                for (int e = 0; e < 4; ++e) { v0[e] = siluf(v0[e]); v1[e] = siluf(v1[e]); }
                            } else if (seg == 3) { v0 *= 0.08838834764831845f; v1 *= 0.08838834764831845f; }
                            else if (seg == 7) { v0 *= 0.0625f; v1 *= 0.0625f; }
                            u32x4 o; o.x = pk2(v0[0], v0[1]); o.y = pk2(v0[2], v0[3]); o.z = pk2(v1[0], v1[1]); o.w = pk2(v1[2], v1[3]);
                            st_nt((u32x4*)(proj + row * LDP + col), o);
                        }
                    }
            }
        } else if (u.pn < 60) {
            const int etid = (wr * 4 + wc) * 64 + fq * 16 + fr;
#pragma unroll
            for (int bj = 0; bj < 2; ++bj) {
                const int col = (u.pn - 36) * 256 + bj * 128 + cloc;
                const f32x4 b0 = *(const f32x4*)(b_gate + col), b1 = *(const f32x4*)(b_gate + col + 4);
#pragma unroll
                for (int ai = 0; ai < 2; ++ai)
#pragma unroll
                    for (int m = 0; m < 4; ++m) {
                        const size_t row = (size_t)u.pm * 256 + ai * 128 + m * 16 + rloc;
                        f32x4 v0 = acc[ai][bj][m][0] + b0, v1 = acc[ai][bj][m][1] + b1;
#pragma unroll
                        for (int e = 0; e < 4; ++e) { v0[e] = fmaxf(sigm(v0[e]), 1e-6f); v1[e] = fmaxf(sigm(v1[e]), 1e-6f); }
                        u32x4 o; o.x = pk2(v0[0], v0[1]); o.y = pk2(v0[2], v0[3]); o.z = pk2(v1[0], v1[1]); o.w = pk2(v1[2], v1[3]);
                        st_nt((u32x4*)(gate + ((((size_t)u.pm * 24 + (u.pn - 36)) * 16 + (ai * 8 + m * 2 + bj)) * 512 + etid) * 8), o);
                    }
            }
        } else {
            const int n = u.pm - 36, isv = (u.pn >= 64) ? 1 : 0, h = (u.pn - 60) & 3;
            float* ob = out + (isv ? O_MV : O_MK);
#pragma unroll
            for (int bj = 0; bj < 2; ++bj) {
                const int d = bj * 128 + cloc;
#pragma unroll
                for (int ai = 0; ai < 2; ++ai)
#pragma unroll
                    for (int m = 0; m < 4; ++m) {
                        const int key = ai * 128 + m * 16 + rloc;
                        const f32x4 v0 = acc[ai][bj][m][0], v1 = acc[ai][bj][m][1];
                        float* op = ob + ((size_t)(n * 256 + key) * 4 + h) * 256 + d;
                        st_nt((f32x4*)op, v0); st_nt((f32x4*)(op + 4), v1);
                        if (!isv) {
                            u32x4 o; o.x = pk2(v0[0], v0[1]); o.y = pk2(v0[2], v0[3]); o.z = pk2(v1[0], v1[1]); o.w = pk2(v1[2], v1[3]);
                            *(u32x4*)(mkb + ((size_t)(n * 4 + h) * 256 + key) * 256 + d) = o;
                        } else {
                            bf16_t* vp = mvt + ((size_t)(n * 4 + h) * 256 + d) * 256 + key;
#pragma unroll
                            for (int e = 0; e < 4; ++e) { vp[(size_t)e * 256] = (bf16_t)f2bf(v0[e]); vp[(size_t)(e + 4) * 256] = (bf16_t)f2bf(v1[e]); }
                        }
                    }
            }
        }
        return false;
    }
};

struct SchedP4 {
    int G, c; const char* A; const char* Bt;
    __device__ __forceinline__ bool next(int i, Unit& u) const {
        int tri = i / 3; const int b = i - tri * 3;
        if (c < 128 && G == 256) tri ^= 1;
        const int L = tri * G + c;
        u.br = b;
        if (L < 256) { u.sl = 0; pg8::tile_of(L, 32, 8, u.pm, u.pn); return true; }
        const int j = L - 256; if (j >= 128) return false;
        const int tj = j >> 2; u.sl = 1 + (j & 3); u.pm = 32 + (tj >> 3); u.pn = tj & 7; return true;
    }
    __device__ __forceinline__ const char* a_base(const Unit& u) const {
        return A + (size_t)u.br * ((size_t)9216 * 1024 * 2) + (size_t)u.pm * (256 * 1024 * 2) + (u.sl ? (size_t)(u.sl - 1) * (4 * 32768) : 0); }
    __device__ __forceinline__ const char* b_base(const Unit& u) const {
        return Bt + (size_t)u.br * ((size_t)2048 * 1024 * 2) + (size_t)u.pn * (256 * 1024 * 2) + (u.sl ? (size_t)(u.sl - 1) * (4 * 32768) : 0); }
    __device__ __forceinline__ int nt(const Unit& u) const { return u.sl ? 4 : 16; }
};
struct EpiP4 {
    const bf16_t* gate; bf16_t* merged; float* partm;
    __device__ __forceinline__ bool operator()(f32x4 (&acc)[2][2][4][2], const Unit& u, int wr, int wc, int fr, int fq) const {
        const int rloc = wr * 64 + fr, cloc = wc * 32 + 8 * fq;
        const int sl = u.sl, ubr = u.br;
        const int etid = (wr * 4 + wc) * 64 + fq * 16 + fr;
        const bf16_t* gt = gate + (((size_t)u.pm * 24 + (ubr * 8 + u.pn)) * 16) * 4096 + etid * 8;
        if (ubr < 2) {
#pragma unroll
            for (int bj = 0; bj < 2; ++bj) {
                u32x4 gv[8], hv[8];
#pragma unroll
                for (int q = 0; q < 8; ++q) { const bf16_t* gp = gt + (size_t)((q >> 2) * 8 + (q & 3) * 2 + bj) * 4096;
                    gv[q] = *(const u32x4*)gp; hv[q] = *(const u32x4*)(gp + (size_t)8 * 16 * 4096); }
#pragma unroll
                for (int q = 0; q < 8; ++q) { const int ai = q >> 2, m = q & 3; const u32x4 g = gv[q], h = hv[q];
                    f32x4 s0, s1;
                    s0[0] = bflo(g.x) * __builtin_amdgcn_rcpf(bflo(h.x)); s0[1] = bfhi(g.x) * __builtin_amdgcn_rcpf(bfhi(h.x));
                    s0[2] = bflo(g.y) * __builtin_amdgcn_rcpf(bflo(h.y)); s0[3] = bfhi(g.y) * __builtin_amdgcn_rcpf(bfhi(h.y));
                    s1[0] = bflo(g.z) * __builtin_amdgcn_rcpf(bflo(h.z)); s1[1] = bfhi(g.z) * __builtin_amdgcn_rcpf(bfhi(h.z));
                    s1[2] = bflo(g.w) * __builtin_amdgcn_rcpf(bflo(h.w)); s1[3] = bfhi(g.w) * __builtin_amdgcn_rcpf(bfhi(h.w));
                    acc[ai][bj][m][0] *= s0; acc[ai][bj][m][1] *= s1; }
            }
            return true;
        }
        bf16_t* mbase = merged + tl((size_t)u.pm * 256 + rloc, u.pn * 256 + cloc, 2048);
        float* pbase = partm + ((size_t)(sl ? sl - 1 : 0) * 1024 + (size_t)((u.pm >= 32 ? u.pm - 32 : 0) * 256 + rloc)) * 2048 + u.pn * 256 + cloc;
#pragma unroll
        for (int bj = 0; bj < 2; ++bj) {
            u32x4 gv[8];
#pragma unroll
            for (int q = 0; q < 8; ++q) gv[q] = *(const u32x4*)(gt + (size_t)((q >> 2) * 8 + (q & 3) * 2 + bj) * 4096);
#pragma unroll
            for (int q = 0; q < 8; ++q) { const int ai = q >> 2, m = q & 3; const u32x4 g = gv[q];
                const f32x4 v0 = acc[ai][bj][m][0] * (f32x4){bflo(g.x), bfhi(g.x), bflo(g.y), bfhi(g.y)}, v1 = acc[ai][bj][m][1] * (f32x4){bflo(g.z), bfhi(g.z), bflo(g.w), bfhi(g.w)};
                if (sl == 0) { u32x4 o; o.x = pk2(v0[0], v0[1]); o.y = pk2(v0[2], v0[3]); o.z = pk2(v1[0], v1[1]); o.w = pk2(v1[2], v1[3]);
                    *(u32x4*)(mbase + bj * 32768 + (ai * 128 + m * 16) * 64) = o; }
                else { float* op = pbase + (ai * 128 + m * 16) * 2048 + bj * 128; *(f32x4*)op = v0; *(f32x4*)(op + 4) = v1; } }
        }
        return false;
    }
};

struct SchedP5 {
    int G, c; const char* A; const char* Bt;
    __device__ __forceinline__ bool next(int i, Unit& u) const {
        if (i >= 2) return false;
        const int L = (i ^ 1) * G + c; if (L >= 512) return false;
        u.sl = 0;
        if (L < 256) { u.br = 0; pg8::tile_of(L, 32, 8, u.pm, u.pn); return true; }
        const int j = L - 256, tj = j >> 3; u.br = 1 + (j & 7); u.pm = 32 + (tj >> 3); u.pn = tj & 7; return true;
    }
    __device__ __forceinline__ const char* a_base(const Unit& u) const { return A + (size_t)u.pm * (256 * 2048 * 2) + (u.br ? (size_t)(u.br - 1) * (4 * 32768) : 0); }
    __device__ __forceinline__ const char* b_base(const Unit& u) const { return Bt + (size_t)u.pn * (256 * 2048 * 2) + (u.br ? (size_t)(u.br - 1) * (4 * 32768) : 0); }
    __device__ __forceinline__ int nt(const Unit& u) const { return u.br ? 4 : 32; }
};
struct EpiP5 {
    const float* xp; const float* xs; float* out; float* part;
    float* rs; const float* gfin; unsigned* xbar; unsigned xbx; volatile LAS unsigned* xst;
    __device__ __forceinline__ bool operator()(f32x4 (&acc)[2][2][4][2], const Unit& u, int wr, int wc, int fr, int fq) const {
        const int rloc = wr * 64 + fr, cloc = wc * 32 + 8 * fq;
        if (u.br == 0) {
#pragma unroll
            for (int ai = 0; ai < 2; ++ai) {
                f32x4 xv[4][2][2];
#pragma unroll
                for (int m = 0; m < 4; ++m)
#pragma unroll
                    for (int bj = 0; bj < 2; ++bj) { const float* xr = xp + ((size_t)u.pm * 256 + ai * 128 + m * 16 + rloc) * 2048 + u.pn * 256 + bj * 128 + cloc;
                        xv[m][bj][0] = *(const f32x4*)xr; xv[m][bj][1] = *(const f32x4*)(xr + 4); }
#pragma unroll
                for (int m = 0; m < 4; ++m) {
                    const size_t row = (size_t)u.pm * 256 + ai * 128 + m * 16 + rloc;
                    float ss = 0.f;
#pragma unroll
                    for (int bj = 0; bj < 2; ++bj) {
                        acc[ai][bj][m][0] += xv[m][bj][0]; acc[ai][bj][m][1] += xv[m][bj][1];
                        const f32x4 a = acc[ai][bj][m][0], b = acc[ai][bj][m][1];
                        ss += (a[0] * a[0] + a[1] * a[1]) + (a[2] * a[2] + a[3] * a[3]) + (b[0] * b[0] + b[1] * b[1]) + (b[2] * b[2] + b[3] * b[3]); }
                    ss += __shfl_xor(ss, 16); ss += __shfl_xor(ss, 32);
                    if (fq == 0) (void)__hip_atomic_fetch_add(rs + row, ss, __ATOMIC_RELAXED, __HIP_MEMORY_SCOPE_AGENT);
                }
            }
            xcd_barrier(xbar, xbx, xst);
            float rsv[8]; f32x4 gf[2][2];
#pragma unroll
            for (int q = 0; q < 8; ++q) rsv[q] = __hip_atomic_load(rs + (size_t)u.pm * 256 + (q >> 2) * 128 + (q & 3) * 16 + rloc, __ATOMIC_RELAXED, __HIP_MEMORY_SCOPE_AGENT);
#pragma unroll
            for (int bj = 0; bj < 2; ++bj) { const int col = u.pn * 256 + bj * 128 + cloc; gf[bj][0] = *(const f32x4*)(gfin + col); gf[bj][1] = *(const f32x4*)(gfin + col + 4); }
#pragma unroll
            for (int ai = 0; ai < 2; ++ai)
#pragma unroll
                for (int m = 0; m < 4; ++m) {
                    const size_t row = (size_t)u.pm * 256 + ai * 128 + m * 16 + rloc;
                    const float rinv = rsqrtf(rsv[ai * 4 + m] * (1.f / 2048.f) + EPS);
#pragma unroll
                    for (int bj = 0; bj < 2; ++bj) { const int col = u.pn * 256 + bj * 128 + cloc;
                        const f32x4 g0 = gf[bj][0], g1 = gf[bj][1];
                        float* op = out + row * 2048 + col;
                        *(f32x4*)op = acc[ai][bj][m][0] * rinv * g0; *(f32x4*)(op + 4) = acc[ai][bj][m][1] * rinv * g1; }
                }
        } else {
#pragma unroll
            for (int bj = 0; bj < 2; ++bj) {
                const int col = u.pn * 256 + bj * 128 + cloc;
#pragma unroll
                for (int ai = 0; ai < 2; ++ai)
#pragma unroll
                    for (int m = 0; m < 4; ++m) {
                        const size_t row = (size_t)u.pm * 256 + ai * 128 + m * 16 + rloc;
                        float* op = part + ((size_t)(u.br - 1) * 1024 + (row - NTP)) * 2048 + col;
                        *(f32x4*)op = acc[ai][bj][m][0]; *(f32x4*)(op + 4) = acc[ai][bj][m][1];
                    }
            }
        }
        return false;
    }
};
struct EpiNull {
    __device__ __forceinline__ bool operator()(f32x4 (&acc)[2][2][4][2], const Unit& u, int wr, int wc, int fr, int fq) const {
        f32x4 t = (f32x4){0.f, 0.f, 0.f, 0.f};
#pragma unroll
        for (int ai = 0; ai < 2; ++ai)
#pragma unroll
            for (int bj = 0; bj < 2; ++bj)
#pragma unroll
                for (int m = 0; m < 4; ++m) t += acc[ai][bj][m][0] + acc[ai][bj][m][1];
        asm volatile("" :: "v"(t[0]), "v"(t[1]), "v"(t[2]), "v"(t[3]));
        return false;
    }
};
#define P0_DESC(it_, W_, WT_, K_, N_, ro_, kb_, nb_) do { int r_ = (it_); \
    if (r_ < 1920) { W_ = p.w_in; WT_ = WT1; K_ = 2048; N_ = 15360; ro_ = 0; kb_ = r_ / 120; nb_ = r_ % 120; } \
    else if (r_ < 2176) { r_ -= 1920; W_ = p.w_mem_kv; WT_ = WT1; K_ = 2048; N_ = 2048; ro_ = 15360; kb_ = r_ >> 4; nb_ = r_ & 15; } \
    else if (r_ < 2304) { r_ -= 2176; W_ = p.w_conv_out; WT_ = WT3; K_ = 1024; N_ = 2048; ro_ = 0; kb_ = r_ >> 4; nb_ = r_ & 15; } \
    else if (r_ < 2432) { r_ -= 2304; W_ = p.w_hgrn_out; WT_ = WT3 + (size_t)2048 * 1024; K_ = 1024; N_ = 2048; ro_ = 0; kb_ = r_ >> 4; nb_ = r_ & 15; } \
    else if (r_ < 2560) { r_ -= 2432; W_ = p.w_attn_out; WT_ = WT3 + (size_t)2 * 2048 * 1024; K_ = 1024; N_ = 2048; ro_ = 0; kb_ = r_ >> 4; nb_ = r_ & 15; } \
    else { r_ -= 2560; W_ = p.w_out; WT_ = WTO; K_ = 2048; N_ = 2048; ro_ = 0; kb_ = r_ >> 4; nb_ = r_ & 15; } } while (0)
__device__ __forceinline__ void p0_prologue(const Params& p, LAS unsigned char* lds) {
    const int tid = threadIdx.x, lane = tid & 63, wave = tid >> 6, G = gridDim.x, c = blockIdx.x;
    LAS unsigned* T32 = (LAS unsigned*)lds;
    constexpr int T_ALL = 1920 + 256 + 3 * 128 + 256;
    const int nq = tid & 31, kp0 = tid >> 5;
    f32x4 r0[4], r1[4];
#define P0_LOAD(W_, N_, kb_, nb_) do { _Pragma("unroll") for (int i = 0; i < 4; ++i) { const int kpair = kp0 + 16 * i; \
        const float* src = (W_) + (size_t)((kb_) * 128 + 2 * kpair) * (N_) + (nb_) * 128 + 4 * nq; r0[i] = *(const f32x4*)src; r1[i] = *(const f32x4*)(src + (N_)); } } while (0)
    bf16_t* WT1 = (bf16_t*)(p.ws + WS_WT1); bf16_t* WT3 = (bf16_t*)(p.ws + WS_WT3); bf16_t* WTO = (bf16_t*)(p.ws + WS_WTO);
    int it = c;
    const float* dW = p.w_in; bf16_t* dWT = WT1; int dK = 2048, dN = 15360, dro = 0, dkb = 0, dnb = 0;
    if (it < T_ALL) { P0_DESC(it, dW, dWT, dK, dN, dro, dkb, dnb); P0_LOAD(dW, dN, dkb, dnb); }
    while (it < T_ALL) {
#pragma unroll
        for (int i = 0; i < 4; ++i) { const int kpair = kp0 + 16 * i;
            T32[(4 * nq + 0) * 65 + kpair] = pk2(r0[i][0], r1[i][0]); T32[(4 * nq + 1) * 65 + kpair] = pk2(r0[i][1], r1[i][1]);
            T32[(4 * nq + 2) * 65 + kpair] = pk2(r0[i][2], r1[i][2]); T32[(4 * nq + 3) * 65 + kpair] = pk2(r0[i][3], r1[i][3]); }
        __syncthreads();
        const int itn = it + G;
        const float* nW = dW; bf16_t* nWT = dWT; int nK = dK, nN = dN, nro = dro, nkb = dkb, nnb = dnb;
        if (itn < T_ALL) { P0_DESC(itn, nW, nWT, nK, nN, nro, nkb, nnb); P0_LOAD(nW, nN, nkb, nnb); }
#pragma unroll
        for (int i = 0; i < 4; ++i) {
            const int id = tid + 512 * i, n = id >> 4, cc = id & 15;
            u32x4 o; o.x = T32[n * 65 + 4 * cc]; o.y = T32[n * 65 + 4 * cc + 1]; o.z = T32[n * 65 + 4 * cc + 2]; o.w = T32[n * 65 + 4 * cc + 3];
            *(u32x4*)(dWT + tl((size_t)(dro + dnb * 128 + n), dkb * 128 + 8 * cc, dK)) = o;
        }
        __syncthreads();
        it = itn; dW = nW; dWT = nWT; dK = nK; dN = nN; dro = nro; dkb = nkb; dnb = nnb;
    }
#undef P0_LOAD
#undef P0_DESC
    bf16_t* HA = (bf16_t*)(p.ws + WS_HA);
    const int gw = c * 8 + wave, NGW = G * 8;
#define P0_ROWPTR(m) ((m) < NTP ? p.x_prompt + (size_t)(m) * 2048 : ((m) < NTOK ? p.x_sample + (size_t)((m) - NTP) * 2048 : p.mem_prompt + (size_t)((m) - NTOK) * 2048))
    f32x4 v[8];
    int m = gw;
    if (m < 10240) { const float* xr = P0_ROWPTR(m);
#pragma unroll
        for (int j = 0; j < 8; ++j) v[j] = ((const f32x4*)xr)[lane + 64 * j]; }
    while (m < 10240) {
        const int mn = m + NGW; f32x4 vn[8];
        if (mn < 10240) { const float* xr = P0_ROWPTR(mn);
#pragma unroll
            for (int j = 0; j < 8; ++j) vn[j] = ((const f32x4*)xr)[lane + 64 * j]; }
        const float* g = (m < NTOK) ? p.g_pre : p.g_mem;
        f32x4 ggv[8];
#pragma unroll
        for (int j = 0; j < 8; ++j) ggv[j] = ((const f32x4*)g)[lane + 64 * j];
        float ss = 0.f;
#pragma unroll
        for (int j = 0; j < 8; ++j) ss += (v[j][0] * v[j][0] + v[j][1] * v[j][1]) + (v[j][2] * v[j][2] + v[j][3] * v[j][3]);
        ss = wave_sum(ss);
        const float rinv = rsqrtf(ss * (1.f / 2048.f) + EPS);
#pragma unroll
        for (int j = 0; j < 8; ++j) { const f32x4 gg = ggv[j];
            u32x2 o; o.x = pk2(v[j][0] * rinv * gg[0], v[j][1] * rinv * gg[1]); o.y = pk2(v[j][2] * rinv * gg[2], v[j][3] * rinv * gg[3]);
            *(u32x2*)(HA + tl((size_t)m, 4 * (lane + 64 * j), 2048)) = o; }
        if (mn < 10240) {
#pragma unroll
            for (int j = 0; j < 8; ++j) v[j] = vn[j]; }
        m = mn;
    }
#undef P0_ROWPTR
    if (c == 0) { float* LB = (float*)(p.ws + WS_LB);
        for (int i = tid; i < 1024; i += 512) LB[i] = 1.f / (1.f + __expf(p.lb_logits[1024 + i] - p.lb_logits[i])); }
}

constexpr int HG_GS = 0, HG_SEG = 32768, HG_VT = 36864, HG_QB = 53248, HG_KB = 69632, HG_SSQ = 86016;
__device__ __forceinline__ void hg_prep(const float* F, size_t row0, int h, LAS unsigned char* lds, int tid, f32x4 (&fr)[4]) {
    LAS float* Gs = (LAS float*)(lds + HG_GS); LAS float* SEG = (LAS float*)(lds + HG_SEG);
    const int er = tid >> 5, k4 = (tid & 31) * 4;
#pragma unroll
    for (int i = 0; i < 4; ++i) { const int t = 2 * er + (i & 1) + 32 * (i >> 1); fr[i] = *(const f32x4*)(F + (row0 + t) * 1024 + h * 128 + k4); }
#pragma unroll
    for (int i = 0; i < 4; ++i) { const int t = 2 * er + (i & 1) + 32 * (i >> 1);
        *(LAS f32x4*)(Gs + t * 128 + k4) = (f32x4){__logf(fr[i][0]), __logf(fr[i][1]), __logf(fr[i][2]), __logf(fr[i][3])}; }
    __syncthreads();
    const int k = tid & 127, seg = tid >> 7;
    { float g[16];
#pragma unroll
      for (int i = 0; i < 16; ++i) g[i] = Gs[(seg * 16 + i) * 128 + k];
#pragma unroll
      for (int i = 1; i < 16; ++i) g[i] += g[i - 1];
      SEG[seg * 128 + k] = g[15];
      __syncthreads();
      float off = 0.f;
#pragma unroll
      for (int s2 = 0; s2 < 3; ++s2) off += (s2 < seg) ? SEG[s2 * 128 + k] : 0.f;
#pragma unroll
      for (int i = 0; i < 16; ++i) Gs[(seg * 16 + i) * 128 + k] = g[i] + off; }
    __syncthreads();
}
__device__ __forceinline__ void hg_load_v(const bf16_t* proj, size_t row0, int h, int tid, unsigned (&a)[4], unsigned (&b)[4]) {
    const int d2 = (tid & 63) * 2;
#pragma unroll
    for (int i = 0; i < 4; ++i) { const int t = 2 * ((tid >> 6) + 8 * i);
        a[i] = *(const unsigned*)(proj + (row0 + t) * LDP + C_HI + h * 128 + d2); b[i] = *(const unsigned*)(proj + (row0 + t + 1) * LDP + C_HI + h * 128 + d2); }
}
__device__ __forceinline__ void hg_stage_vt(const unsigned (&a)[4], const unsigned (&b)[4], LAS unsigned char* lds, int tid) {
    LAS bf16_t* VT = (LAS bf16_t*)(lds + HG_VT);
    const int d2 = (tid & 63) * 2;
#pragma unroll
    for (int i = 0; i < 4; ++i) { const int t = 2 * ((tid >> 6) + 8 * i);
        const int c0 = ((t >> 3) ^ ((d2 >> 1) & 7)) * 8 + (t & 7);
        *(LAS unsigned*)(VT + d2 * 64 + c0) = (a[i] & 0xffffu) | (b[i] << 16);
        *(LAS unsigned*)(VT + (d2 + 1) * 64 + c0) = (a[i] >> 16) | (b[i] & 0xffff0000u); }
}
__device__ __forceinline__ void hgrn_h1_item(const Params& p, int item, LAS unsigned char* lds, int tid) {
    const int s = item >> 5, c = item & 31, n = s >> 3, h = s & 7;
    const size_t row0 = (size_t)n * SEQ + c * 64;
    const bf16_t* proj = (const bf16_t*)(p.ws + WS_PROJ9); const float* F = (const float*)(p.ws + WS_F);
    LAS float* Gs = (LAS float*)(lds + HG_GS); LAS bf16_t* KDT = (LAS bf16_t*)(lds + HG_QB); LAS bf16_t* VT = (LAS bf16_t*)(lds + HG_VT);
    f32x4 fr[4]; unsigned va[4], vb[4];
    hg_load_v(proj, row0, h, tid, va, vb);
    hg_prep(F, row0, h, lds, tid, fr);
    hg_stage_vt(va, vb, lds, tid);
    { const int er = tid >> 5, k4 = (tid & 31) * 4;
      const f32x4 bc = *(const LAS f32x4*)(Gs + 63 * 128 + k4);
      if (er == 0) *(f32x4*)((float*)(p.ws + WS_DD) + (size_t)item * 128 + k4) = (f32x4){__expf(bc[0]), __expf(bc[1]), __expf(bc[2]), __expf(bc[3])};
#pragma unroll
      for (int ip = 0; ip < 2; ++ip) { const int t = 2 * er + 32 * ip;
          const f32x4 b0 = *(const LAS f32x4*)(Gs + t * 128 + k4), b1 = *(const LAS f32x4*)(Gs + (t + 1) * 128 + k4);
#pragma unroll
          for (int e = 0; e < 4; ++e) { const int k = k4 + e;
              const float kd0 = (1.f - fr[2 * ip][e]) * __expf(bc[e] - b0[e]), kd1 = (1.f - fr[2 * ip + 1][e]) * __expf(bc[e] - b1[e]);
              *(LAS unsigned*)(KDT + k * 64 + (((t >> 3) ^ ((k >> 1) & 7)) * 8 + (t & 7))) = pk2(kd0, kd1); } } }
    __syncthreads();
    { const int lane = tid & 63, w = tid >> 6, l15 = lane & 15, quad = lane >> 4;
      const int d = 16 * w + l15;
      bf16x8 av[2];
#pragma unroll
      for (int s2 = 0; s2 < 2; ++s2) av[s2] = *(const LAS bf16x8*)(VT + d * 64 + (((4 * s2 + quad) ^ ((d >> 1) & 7)) * 8));
      float* ut = (float*)(p.ws + WS_UT) + ((size_t)item * 128 + 16 * w + quad * 4) * 128 + l15;
#pragma unroll
      for (int kt = 0; kt < 8; ++kt) { const int k = 16 * kt + l15;
          f32x4 acc = (f32x4){0.f, 0.f, 0.f, 0.f};
#pragma unroll
          for (int s2 = 0; s2 < 2; ++s2) { const bf16x8 bk = *(const LAS bf16x8*)(KDT + k * 64 + (((4 * s2 + quad) ^ ((k >> 1) & 7)) * 8));
              acc = __builtin_amdgcn_mfma_f32_16x16x32_bf16(av[s2], bk, acc, 0, 0, 0); }
          ut[kt * 16] = acc[0]; ut[kt * 16 + 128] = acc[1]; ut[kt * 16 + 256] = acc[2]; ut[kt * 16 + 384] = acc[3]; } }
    __syncthreads();
}
__device__ __forceinline__ void hgrn_h2_scan(const Params& p) {
    const float* UT = (const float*)(p.ws + WS_UT); const float* DD = (const float*)(p.ws + WS_DD); bf16_t* ST = (bf16_t*)(p.ws + WS_ST);
    for (int idx = blockIdx.x * 512 + threadIdx.x; idx < 32 * 128 * 32; idx += gridDim.x * 512) {
        const int s = idx >> 12, d = (idx >> 5) & 127, k4 = (idx & 31) * 4;
        f32x4 S = (f32x4){0.f, 0.f, 0.f, 0.f};
#pragma unroll 1
        for (int c0 = 0; c0 < 32; c0 += 8) {
            f32x4 uv[8], dv[8];
#pragma unroll
            for (int i = 0; i < 8; ++i) { const size_t item = (size_t)s * 32 + c0 + i; uv[i] = *(const f32x4*)(UT + (item * 128 + d) * 128 + k4); dv[i] = *(const f32x4*)(DD + item * 128 + k4); }
#pragma unroll
            for (int i = 0; i < 8; ++i) { const size_t item = (size_t)s * 32 + c0 + i;
                u32x2 o; o.x = pk2(S[0], S[1]); o.y = pk2(S[2], S[3]);
                *(u32x2*)(ST + (item * 128 + d) * 128 + k4) = o;
                S = dv[i] * S + uv[i]; }
        }
        float* so = p.out + O_HGRN_P + ((size_t)s * 128 + k4) * 128 + d;
        so[0] = S[0]; so[128] = S[1]; so[256] = S[2]; so[384] = S[3];
    }
}
__device__ __forceinline__ void hgrn_h3_item(const Params& p, int item, LAS unsigned char* lds, int tid) {
    const int s = item >> 5, c = item & 31, n = s >> 3, h = s & 7;
    const size_t row0 = (size_t)n * SEQ + c * 64;
    const bf16_t* proj = (const bf16_t*)(p.ws + WS_PROJ9); const float* F = (const float*)(p.ws + WS_F);
    LAS float* Gs = (LAS float*)(lds + HG_GS); LAS bf16_t* QB = (LAS bf16_t*)(lds + HG_QB); LAS bf16_t* KB = (LAS bf16_t*)(lds + HG_KB); LAS bf16_t* VT = (LAS bf16_t*)(lds + HG_VT);
    LAS float* SSQ = (LAS float*)(lds + HG_SSQ);
    const int lane = tid & 63, w = tid >> 6, l15 = lane & 15, quad = lane >> 4, tt = w & 3, dh = w >> 2;
    const bf16_t* st = (const bf16_t*)(p.ws + WS_ST) + ((size_t)item * 128 + 64 * dh + l15) * 128 + quad * 8;
    bf16x8 sf[4][4];
#pragma unroll
    for (int dt = 0; dt < 4; ++dt)
#pragma unroll
        for (int ks = 0; ks < 4; ++ks) sf[dt][ks] = *(const bf16x8*)(st + (size_t)dt * 16 * 128 + ks * 32);
    f32x4 fr[4]; unsigned va[4], vb[4]; u32x2 qws[4];
    hg_load_v(proj, row0, h, tid, va, vb);
#pragma unroll
    for (int i = 0; i < 4; ++i) { const int t = 2 * (tid >> 5) + (i & 1) + 32 * (i >> 1); qws[i] = *(const u32x2*)(proj + (row0 + t) * LDP + C_HQ + h * 128 + (tid & 31) * 4); }
    hg_prep(F, row0, h, lds, tid, fr);
    hg_stage_vt(va, vb, lds, tid);
    { const int er = tid >> 5, k4 = (tid & 31) * 4;
#pragma unroll
      for (int i = 0; i < 4; ++i) { const int t = 2 * er + (i & 1) + 32 * (i >> 1);
          const f32x4 b = *(const LAS f32x4*)(Gs + t * 128 + k4);
          const u32x2 qw = qws[i];
          const float e0 = __expf(b[0]), e1 = __expf(b[1]), e2 = __expf(b[2]), e3 = __expf(b[3]);
          u32x2 qo, ko;
          qo.x = pk2(bflo(qw.x) * e0, bfhi(qw.x) * e1); qo.y = pk2(bflo(qw.y) * e2, bfhi(qw.y) * e3);
          ko.x = pk2((1.f - fr[i][0]) * __builtin_amdgcn_rcpf(e0), (1.f - fr[i][1]) * __builtin_amdgcn_rcpf(e1));
          ko.y = pk2((1.f - fr[i][2]) * __builtin_amdgcn_rcpf(e2), (1.f - fr[i][3]) * __builtin_amdgcn_rcpf(e3));
          const int off = t * 128 + (((k4 >> 3) ^ (t & 15)) * 8) + (k4 & 7);
          *(LAS u32x2*)(QB + off) = qo; *(LAS u32x2*)(KB + off) = ko; } }
    __syncthreads();
    bf16x8 qf[4];
#pragma unroll
    for (int ks = 0; ks < 4; ++ks) qf[ks] = *(const LAS bf16x8*)(QB + (16 * tt + l15) * 128 + (((4 * ks + quad) ^ l15) * 8));
    f32x4 at[4];
#pragma unroll
    for (int st4 = 0; st4 < 4; ++st4) {
        at[st4] = (f32x4){0.f, 0.f, 0.f, 0.f};
        if (st4 <= tt) {
#pragma unroll
            for (int ks = 0; ks < 4; ++ks) { const bf16x8 kf = *(const LAS bf16x8*)(KB + (16 * st4 + l15) * 128 + (((4 * ks + quad) ^ l15) * 8));
                at[st4] = __builtin_amdgcn_mfma_f32_16x16x32_bf16(kf, qf[ks], at[st4], 0, 0, 0); }
            if (st4 == tt) {
#pragma unroll
                for (int j = 0; j < 4; ++j) at[st4][j] = (quad * 4 + j <= l15) ? at[st4][j] : 0.f;
            }
        }
    }
    bf16x8 pb[2];
#pragma unroll
    for (int s2 = 0; s2 < 2; ++s2) { u32x4 wv; wv.x = pk2(at[2 * s2][0], at[2 * s2][1]); wv.y = pk2(at[2 * s2][2], at[2 * s2][3]);
        wv.z = pk2(at[2 * s2 + 1][0], at[2 * s2 + 1][1]); wv.w = pk2(at[2 * s2 + 1][2], at[2 * s2 + 1][3]); pb[s2] = __builtin_bit_cast(bf16x8, wv); }
    f32x4 oacc[4]; float ssq = 0.f;
#pragma unroll
    for (int dt = 0; dt < 4; ++dt) {
        const int d = 16 * (4 * dh + dt) + l15;
        oacc[dt] = (f32x4){0.f, 0.f, 0.f, 0.f};
#pragma unroll
        for (int ks = 0; ks < 4; ++ks) oacc[dt] = __builtin_amdgcn_mfma_f32_16x16x32_bf16(sf[dt][ks], qf[ks], oacc[dt], 0, 0, 0);
#pragma unroll
        for (int s2 = 0; s2 < 2; ++s2) {
            const int ch = 4 * s2 + (quad >> 1), sw = (d >> 1) & 7;
            const u32x2 lo = *(const LAS u32x2*)(VT + d * 64 + ((ch ^ sw) * 8) + (quad & 1) * 4), hi = *(const LAS u32x2*)(VT + d * 64 + (((ch + 2) ^ sw) * 8) + (quad & 1) * 4);
            u32x4 wv; wv.x = lo.x; wv.y = lo.y; wv.z = hi.x; wv.w = hi.y;
            oacc[dt] = __builtin_amdgcn_mfma_f32_16x16x32_bf16(__builtin_bit_cast(bf16x8, wv), pb[s2], oacc[dt], 0, 0, 0);
        }
        ssq += (oacc[dt][0] * oacc[dt][0] + oacc[dt][1] * oacc[dt][1]) + (oacc[dt][2] * oacc[dt][2] + oacc[dt][3] * oacc[dt][3]);
    }
    ssq += __shfl_xor(ssq, 16); ssq += __shfl_xor(ssq, 32);
    if (quad == 0) SSQ[dh * 64 + 16 * tt + l15] = ssq;
    __syncthreads();
    { const float tot = SSQ[16 * tt + l15] + SSQ[64 + 16 * tt + l15], rinv = rsqrtf(tot * (1.f / 128.f) + EPS);
      const size_t row = row0 + 16 * tt + l15;
      bf16_t* og = (bf16_t*)(p.ws + WS_ACT3) + (size_t)9216 * 1024;
      f32x4 gnv[4]; u32x2 hgv[4];
#pragma unroll
      for (int dt = 0; dt < 4; ++dt) { const int d0 = 16 * (4 * dh + dt) + quad * 4; gnv[dt] = *(const f32x4*)(p.g_hgrn + h * 128 + d0); hgv[dt] = *(const u32x2*)(proj + row * LDP + C_HOG + h * 128 + d0); }
#pragma unroll
      for (int dt = 0; dt < 4; ++dt) { const int d0 = 16 * (4 * dh + dt) + quad * 4;
          const f32x4 gn = gnv[dt];
          const u32x2 hg = hgv[dt];
          u32x2 o; o.x = pk2(oacc[dt][0] * rinv * gn[0] * bflo(hg.x), oacc[dt][1] * rinv * gn[1] * bfhi(hg.x)); o.y = pk2(oacc[dt][2] * rinv * gn[2] * bflo(hg.y), oacc[dt][3] * rinv * gn[3] * bfhi(hg.y));
          *(u32x2*)(og + tl(row, h * 128 + d0, 1024)) = o; } }
    __syncthreads();
}

__device__ __forceinline__ void hgrn_sample_item(const Params& p, int item, LAS unsigned char* lds, int tid) {
    LAS float* qs = (LAS float*)lds;
    LAS float* fs = qs + 1024;
    LAS float* vs = fs + 1024;
    LAS float* opart = vs + 1024;
    const int n = item >> 3, h = item & 7, lane = tid & 63, wave = tid >> 6;
    const bf16_t* proj = (const bf16_t*)(p.ws + WS_PROJ9);
    const float* F = (const float*)(p.ws + WS_F);
    const size_t row0 = (size_t)NTP + (size_t)n * 8;
    { const int tt = tid >> 6, k2 = (tid & 63) * 2; const size_t r = row0 + tt;
      const unsigned qw = *(const unsigned*)(proj + r * LDP + C_HQ + h * 128 + k2); const f32x2 ff = *(const f32x2*)(F + r * 1024 + h * 128 + k2);
      const unsigned vw = *(const unsigned*)(proj + r * LDP + C_HI + h * 128 + k2);
      qs[tt * 128 + k2] = bflo(qw); qs[tt * 128 + k2 + 1] = bfhi(qw); fs[tt * 128 + k2] = ff[0]; fs[tt * 128 + k2 + 1] = ff[1];
      vs[tt * 128 + k2] = bflo(vw); vs[tt * 128 + k2 + 1] = bfhi(vw); }
    const int v4 = tid & 31, kg = tid >> 5;
    const size_t sbase = ((size_t)(n * 8 + h) * 128 + kg * 8) * 128 + v4 * 4;
    f32x4 S[8];
#pragma unroll
    for (int i = 0; i < 8; ++i) S[i] = ld_nt(p.state_hgrn + sbase + (size_t)i * 128);
    __syncthreads();
#pragma unroll
    for (int tt = 0; tt < 8; ++tt) {
        const f32x4 fa = *(const LAS f32x4*)(fs + tt * 128 + kg * 8), fb = *(const LAS f32x4*)(fs + tt * 128 + kg * 8 + 4);
        const f32x4 qa = *(const LAS f32x4*)(qs + tt * 128 + kg * 8), qb = *(const LAS f32x4*)(qs + tt * 128 + kg * 8 + 4);
        const f32x4 vv = *(const LAS f32x4*)(vs + tt * 128 + v4 * 4);
        f32x4 po = (f32x4){0.f, 0.f, 0.f, 0.f};
#pragma unroll
        for (int i = 0; i < 8; ++i) { const float f = (i < 4) ? fa[i & 3] : fb[i & 3], q = (i < 4) ? qa[i & 3] : qb[i & 3];
            S[i] = S[i] * f + vv * (1.f - f); po += S[i] * q; }
#pragma unroll
        for (int e = 0; e < 4; ++e) po[e] += __shfl_xor(po[e], 32);
        if (lane < 32) *(LAS f32x4*)(opart + (tt * 8 + wave) * 128 + v4 * 4) = po;
    }
    float* so = p.out + O_HGRN_S + sbase;
#pragma unroll
    for (int i = 0; i < 8; ++i) st_nt((f32x4*)(so + (size_t)i * 128), S[i]);
    __syncthreads();
    { const int tt = tid >> 6, v = (tid & 63) * 2; float o0 = 0.f, o1 = 0.f;
#pragma unroll
      for (int w = 0; w < 8; ++w) { const f32x2 t = *(const LAS f32x2*)(opart + (tt * 8 + w) * 128 + v); o0 += t[0]; o1 += t[1]; }
      const float ss = wave_sum(o0 * o0 + o1 * o1), rinv = rsqrtf(ss * (1.f / 128.f) + EPS);
      const size_t r = row0 + tt; const f32x2 gg = *(const f32x2*)(p.g_hgrn + h * 128 + v);
      const unsigned gw = *(const unsigned*)(proj + r * LDP + C_HOG + h * 128 + v);
      bf16_t* og = (bf16_t*)(p.ws + WS_ACT3) + (size_t)9216 * 1024 + tl(r, h * 128 + v, 1024);
      *(unsigned*)og = pk2(o0 * rinv * gg[0] * bflo(gw), o1 * rinv * gg[1] * bfhi(gw)); }
    __syncthreads();
}

template <bool SAMPLE>
__device__ __forceinline__ void conv_item(const Params& p, int item, LAS unsigned char* lds, int tid) {
    constexpr int T = SAMPLE ? 8 : 32;
    constexpr int GP = 4, NG = (T + 32) / GP, G0 = 32 / GP;
    LAS float* dcs = (LAS float*)lds;
    const bf16_t* proj = (const bf16_t*)(p.ws + WS_PROJ9);
    const int n = SAMPLE ? item : (item >> 6), t0 = SAMPLE ? 0 : (item & 63) * 32;
    const size_t rowb = SAMPLE ? ((size_t)NTP + (size_t)n * 8) : ((size_t)n * SEQ);
    const int c0 = 2 * tid;
    f32x2 wv[31], xv[31];
#pragma unroll
    for (int j = 0; j < 31; ++j) { wv[j] = *(const f32x2*)(p.conv_w + j * 1024 + c0); xv[j] = (f32x2){0.f, 0.f}; }
    const f32x2 bias = *(const f32x2*)(p.conv_b + c0);
    unsigned ra[GP], rg[GP];
#define CONV_ISSUE(g) do { \
        if (SAMPLE && (g) < G0) { _Pragma("unroll") for (int i = 0; i < GP; ++i) { const int ti = -2 + GP * (g) + i; \
            const unsigned* tp = (const unsigned*)(p.state_conv + ((size_t)n * 30 + (ti < 0 ? 0 : ti)) * 1024 + c0); ra[i] = tp[0]; rg[i] = tp[1]; } } \
        else { _Pragma("unroll") for (int i = 0; i < GP; ++i) { const int t = t0 - 32 + GP * (g) + i; const bf16_t* rp = proj + (rowb + (t < 0 ? 0 : t)) * LDP + c0; \
            ra[i] = *(const unsigned*)(rp + C_CV); rg[i] = *(const unsigned*)(rp + C_CG); } } } while (0)
    CONV_ISSUE(0);
#pragma unroll 1
    for (int g = 0; g < NG; ++g) {
        float u0[GP], u1[GP];
        if (SAMPLE && g < G0) {
#pragma unroll
            for (int i = 0; i < GP; ++i) { const bool ok = (-2 + GP * g + i) >= 0; u0[i] = ok ? __builtin_bit_cast(float, ra[i]) : 0.f; u1[i] = ok ? __builtin_bit_cast(float, rg[i]) : 0.f; }
        } else {
#pragma unroll
            for (int i = 0; i < GP; ++i) { const bool ok = (t0 - 32 + GP * g + i) >= 0; u0[i] = ok ? bflo(ra[i]) * bflo(rg[i]) : 0.f; u1[i] = ok ? bfhi(ra[i]) * bfhi(rg[i]) : 0.f; }
        }
        if (g + 1 < NG) CONV_ISSUE(g + 1);
#pragma unroll
        for (int i = 0; i < GP; ++i) {
            const int pp = -32 + GP * g + i, t = t0 + pp;
            if (SAMPLE) { if (pp >= -22) *(f32x2*)(p.out + O_CONV_S + ((size_t)n * 30 + (pp + 22)) * 1024 + c0) = (f32x2){u0[i], u1[i]}; }
            else { if (t >= SEQ - 30) *(f32x2*)(p.out + O_CONV_P + ((size_t)n * 30 + (t - (SEQ - 30))) * 1024 + c0) = (f32x2){u0[i], u1[i]}; }
#pragma unroll
            for (int j = 0; j < 30; ++j) xv[j] = xv[j + 1];
            xv[30] = (f32x2){u0[i], u1[i]};
            if (g >= G0) {
                f32x2 da = bias, db = (f32x2){0.f, 0.f};
#pragma unroll
                for (int j = 0; j < 30; j += 2) { da += wv[j] * xv[j]; db += wv[j + 1] * xv[j + 1]; }
                da += wv[30] * xv[30];
                *(LAS f32x2*)(dcs + (pp) * 1024 + c0) = da + db;
            }
        }
    }
#undef CONV_ISSUE
    __syncthreads();
    { const int lane = tid & 63, wave = tid >> 6;
      bf16_t* aact = (bf16_t*)(p.ws + WS_ACT3);
      for (int pp = wave; pp < T; pp += 8) {
          f32x4 v[4]; float s = 0.f;
#pragma unroll
          for (int j = 0; j < 4; ++j) { v[j] = *(const LAS f32x4*)(dcs + pp * 1024 + j * 256 + lane * 4); s += (v[j][0] + v[j][1]) + (v[j][2] + v[j][3]); }
          const float mean = wave_sum(s) * (1.f / 1024.f); float s2 = 0.f;
#pragma unroll
          for (int j = 0; j < 4; ++j) { v[j] = v[j] - mean; s2 += (v[j][0] * v[j][0] + v[j][1] * v[j][1]) + (v[j][2] * v[j][2] + v[j][3] * v[j][3]); }
          const float rstd = rsqrtf(wave_sum(s2) * (1.f / 1024.f) + EPS);
          const size_t r = rowb + t0 + pp;
          bf16_t* arow = aact + tl(r, lane * 4, 1024);
          f32x4 lgv[4], lbvv[4]; u32x2 sgv[4];
#pragma unroll
          for (int j = 0; j < 4; ++j) { const int c = j * 256 + lane * 4; lgv[j] = *(const f32x4*)(p.ln_g + c); lbvv[j] = *(const f32x4*)(p.ln_b + c); sgv[j] = *(const u32x2*)(proj + r * LDP + C_CS + c); }
#pragma unroll
          for (int j = 0; j < 4; ++j) {
              const f32x4 lg = lgv[j], lbv = lbvv[j];
              const u32x2 sg = sgv[j];
              const float y0 = siluf(v[j][0] * rstd * lg[0] + lbv[0]) * bflo(sg.x), y1 = siluf(v[j][1] * rstd * lg[1] + lbv[1]) * bfhi(sg.x);
              const float y2 = siluf(v[j][2] * rstd * lg[2] + lbv[2]) * bflo(sg.y), y3 = siluf(v[j][3] * rstd * lg[3] + lbv[3]) * bfhi(sg.y);
              u32x2 o; o.x = pk2(y0, y1); o.y = pk2(y2, y3);
              *(u32x2*)(arow + j * 65536) = o; }
      } }
    __syncthreads();
}

__device__ __forceinline__ void attn_prompt_item(const Params& p, int item, LAS unsigned char* lds, int tid) {
    const int lane = tid & 63, wave = tid >> 6, l15 = lane & 15, quad = lane >> 4;
    const int n = item >> 6, h = (item >> 4) & 3, qt = item & 15;
    const bf16_t* proj = (const bf16_t*)(p.ws + WS_PROJ9);
    const bf16_t* kb = (const bf16_t*)(p.ws + WS_MKB) + (size_t)(n * 4 + h) * 65536;
    const bf16_t* vt = (const bf16_t*)(p.ws + WS_MVT) + (size_t)(n * 4 + h) * 65536;
    const size_t qrow = (size_t)n * SEQ + qt * 128 + wave * 16 + l15;
    u32x4 st[16];
#pragma unroll
    for (int i = 0; i < 16; ++i) st[i] = *(const u32x4*)(kb + (size_t)(tid + 512 * i) * 8);
    bf16x8 qf[8];
#pragma unroll
    for (int s = 0; s < 8; ++s) qf[s] = *(const bf16x8*)(proj + qrow * LDP + C_AQ + h * 256 + s * 32 + quad * 8);
#pragma unroll
    for (int i = 0; i < 16; ++i) { const int id = tid + 512 * i, r = id >> 5, c = id & 31; *(LAS u32x4*)(lds + r * 512 + ((c ^ (r & 15)) * 16)) = st[i]; }
    __syncthreads();
    f32x4 sc[16];
#pragma unroll
    for (int T = 0; T < 16; ++T) {
        sc[T] = (f32x4){0.f, 0.f, 0.f, 0.f};
        const LAS unsigned char* kr = lds + (T * 16 + l15) * 512;
#pragma unroll
        for (int s = 0; s < 8; ++s) { const bf16x8 a = *(const LAS bf16x8*)(kr + (((s * 4 + quad) ^ l15) * 16)); sc[T] = __builtin_amdgcn_mfma_f32_16x16x32_bf16(a, qf[s], sc[T], 0, 0, 0); }
    }
#pragma unroll
    for (int i = 0; i < 16; ++i) st[i] = *(const u32x4*)(vt + (size_t)(tid + 512 * i) * 8);
    __syncthreads();
    float mx = -3.0e38f;
#pragma unroll
    for (int T = 0; T < 16; ++T) mx = fmaxf(mx, fmaxf(fmaxf(sc[T][0], sc[T][1]), fmaxf(sc[T][2], sc[T][3])));
    mx = fmaxf(mx, __shfl_xor(mx, 16)); mx = fmaxf(mx, __shfl_xor(mx, 32));
    float sum = 0.f;
#pragma unroll
    for (int T = 0; T < 16; ++T) {
#pragma unroll
        for (int e = 0; e < 4; ++e) { sc[T][e] = __expf(sc[T][e] - mx); sum += sc[T][e]; } }
    sum += __shfl_xor(sum, 16); sum += __shfl_xor(sum, 32);
    const float rs = 1.f / sum;
    bf16x8 pb[8];
#pragma unroll
    for (int s2 = 0; s2 < 8; ++s2) {
        u32x4 w; w.x = pk2(sc[2 * s2][0], sc[2 * s2][1]); w.y = pk2(sc[2 * s2][2], sc[2 * s2][3]); w.z = pk2(sc[2 * s2 + 1][0], sc[2 * s2 + 1][1]); w.w = pk2(sc[2 * s2 + 1][2], sc[2 * s2 + 1][3]);
        pb[s2] = __builtin_bit_cast(bf16x8, w);
    }
#pragma unroll
    for (int i = 0; i < 16; ++i) { const int id = tid + 512 * i, r = id >> 5, c = id & 31; *(LAS u32x4*)(lds + r * 512 + ((c ^ (r & 15)) * 16)) = st[i]; }
    __syncthreads();
    bf16_t* aog_row = (bf16_t*)(p.ws + WS_ACT3) + (size_t)2 * 9216 * 1024 + tl(qrow, h * 256 + quad * 4, 1024);
    f32x4 oacc[16];
#pragma unroll
    for (int Tv = 0; Tv < 16; ++Tv) {
        oacc[Tv] = (f32x4){0.f, 0.f, 0.f, 0.f};
        const LAS unsigned char* vr = lds + (Tv * 16 + l15) * 512 + (quad & 1) * 8;
#pragma unroll
        for (int s2 = 0; s2 < 8; ++s2) {
            const int ch = 4 * s2 + (quad >> 1);
            const u32x2 lo = *(const LAS u32x2*)(vr + ((ch ^ l15) * 16)), hi = *(const LAS u32x2*)(vr + (((ch + 2) ^ l15) * 16));
            u32x4 w; w.x = lo.x; w.y = lo.y; w.z = hi.x; w.w = hi.y;
            oacc[Tv] = __builtin_amdgcn_mfma_f32_16x16x32_bf16(__builtin_bit_cast(bf16x8, w), pb[s2], oacc[Tv], 0, 0, 0);
        }
    }
    u32x2 sgv[16];
#pragma unroll
    for (int Tv = 0; Tv < 16; ++Tv) sgv[Tv] = *(const u32x2*)(proj + qrow * LDP + C_AS + h * 256 + Tv * 16 + quad * 4);
#pragma unroll
    for (int Tv = 0; Tv < 16; ++Tv) {
        const u32x2 sg = sgv[Tv];
        u32x2 o; o.x = pk2(oacc[Tv][0] * rs * bflo(sg.x), oacc[Tv][1] * rs * bfhi(sg.x)); o.y = pk2(oacc[Tv][2] * rs * bflo(sg.y), oacc[Tv][3] * rs * bfhi(sg.y));
        *(u32x2*)(aog_row + (Tv >> 2) * 16384 + (Tv & 3) * 16) = o;
    }
    __syncthreads();
}

__device__ __forceinline__ void attn_sample_item(const Params& p, int item, LAS unsigned char* lds, int tid) {
    LAS float* Ssh = (LAS float*)lds;
    LAS float* Psh = Ssh + 2048;
    LAS float* Opart = Psh + 2048;
    const int lane = tid & 63, wave = tid >> 6, l15 = lane & 15, quad = lane >> 4;
    const int n = item >> 2, h = item & 3;
    const bf16_t* proj = (const bf16_t*)(p.ws + WS_PROJ9);
    const size_t row0 = (size_t)NTP + (size_t)n * 8;
    const float* kc = p.cache_k + ((size_t)n * 256 * 4 + h) * 256;
    const float* vc = p.cache_v + ((size_t)n * 256 * 4 + h) * 256;
    {
        bf16x8 qf[8];
        const size_t qrow = row0 + (lane & 7);
#pragma unroll
        for (int s = 0; s < 8; ++s) qf[s] = *(const bf16x8*)(proj + qrow * LDP + C_AQ + h * 256 + s * 32 + quad * 8);
#pragma unroll
        for (int tl = 0; tl < 2; ++tl) {
            const int T = wave * 2 + tl;
            f32x4 sc = (f32x4){0.f, 0.f, 0.f, 0.f};
            const float* kr = kc + (size_t)(T * 16 + l15) * 1024 + quad * 8;
#pragma unroll
            for (int s = 0; s < 8; ++s) {
                const f32x4 k0 = ld_nt(kr + s * 32), k1 = ld_nt(kr + s * 32 + 4);
                u32x4 w; w.x = pk2(k0[0], k0[1]); w.y = pk2(k0[2], k0[3]); w.z = pk2(k1[0], k1[1]); w.w = pk2(k1[2], k1[3]);
                sc = __builtin_amdgcn_mfma_f32_16x16x32_bf16(__builtin_bit_cast(bf16x8, w), qf[s], sc, 0, 0, 0);
            }
            if (l15 < 8) {
#pragma unroll
                for (int e = 0; e < 4; ++e) Ssh[l15 * 256 + T * 16 + quad * 4 + e] = sc[e];
            }
        }
    }
    const float* vr = vc + (size_t)(wave * 32) * 1024 + lane * 4;
    f32x4 vpre[16];
#pragma unroll
    for (int kk = 0; kk < 16; ++kk) vpre[kk] = ld_nt(vr + (size_t)kk * 1024);
    __syncthreads();
    {
        const f32x4 s4 = *(const LAS f32x4*)(Ssh + wave * 256 + lane * 4);
        const float mx = wave_max(fmaxf(fmaxf(s4[0], s4[1]), fmaxf(s4[2], s4[3])));
        f32x4 e4; e4[0] = __expf(s4[0] - mx); e4[1] = __expf(s4[1] - mx); e4[2] = __expf(s4[2] - mx); e4[3] = __expf(s4[3] - mx);
        const float rs = 1.f / wave_sum((e4[0] + e4[1]) + (e4[2] + e4[3]));
#pragma unroll
        for (int e = 0; e < 4; ++e) Psh[(lane * 4 + e) * 8 + wave] = e4[e] * rs;
    }
    __syncthreads();
    {
        f32x4 acc[8];
#pragma unroll
        for (int q = 0; q < 8; ++q) acc[q] = (f32x4){0.f, 0.f, 0.f, 0.f};
        f32x4 vpost[16];
#pragma unroll
        for (int kk = 0; kk < 16; ++kk) vpost[kk] = ld_nt(vr + (size_t)(16 + kk) * 1024);
#pragma unroll
        for (int kk = 0; kk < 32; ++kk) {
            const f32x4 v4 = (kk < 16) ? vpre[kk & 15] : vpost[kk & 15];
            const f32x4 pa = *(const LAS f32x4*)(Psh + (wave * 32 + kk) * 8), pb = *(const LAS f32x4*)(Psh + (wave * 32 + kk) * 8 + 4);
            acc[0] += v4 * pa[0]; acc[1] += v4 * pa[1]; acc[2] += v4 * pa[2]; acc[3] += v4 * pa[3];
            acc[4] += v4 * pb[0]; acc[5] += v4 * pb[1]; acc[6] += v4 * pb[2]; acc[7] += v4 * pb[3];
        }
#pragma unroll
        for (int q = 0; q < 8; ++q) *(LAS f32x4*)(Opart + (wave * 8 + q) * 256 + lane * 4) = acc[q];
    }
    __syncthreads();
    {
        f32x4 o = (f32x4){0.f, 0.f, 0.f, 0.f};
#pragma unroll
        for (int w = 0; w < 8; ++w) o += *(const LAS f32x4*)(Opart + (w * 8 + wave) * 256 + lane * 4);
        const size_t r = row0 + wave;
        const u32x2 sg = *(const u32x2*)(proj + r * LDP + C_AS + h * 256 + lane * 4);
        u32x2 ov; ov.x = pk2(o[0] * bflo(sg.x), o[1] * bfhi(sg.x)); ov.y = pk2(o[2] * bflo(sg.y), o[3] * bfhi(sg.y));
        bf16_t* aog = (bf16_t*)(p.ws + WS_ACT3) + (size_t)2 * 9216 * 1024;
        *(u32x2*)(aog + tl(r, h * 256 + lane * 4, 1024)) = ov;
    }
    __syncthreads();
}

__device__ __forceinline__ void p2_mixers(const Params& p, LAS unsigned char* lds) {
    const int tid = threadIdx.x, G = gridDim.x, c = blockIdx.x, mask = p.pad;
    if ((mask & 1) && !(c & 1)) for (int it = c; it < 1024; it += G) hgrn_h1_item(p, it, lds, tid);
    if (mask & 2) { for (int it = c; it < 256; it += G) conv_item<false>(p, it, lds, tid);
                    for (int it = c; it < 128; it += G) conv_item<true>(p, it, lds, tid); }
    if (mask & 4) for (int it = c; it < 256; it += G) { const int pos = it >> 3, x = it & 7; attn_prompt_item(p, (G == 256) ? ((((x << 1) | (pos >> 4)) << 4) | (pos & 15)) : it, lds, tid); }
    if (mask & 8) for (int it = c; it < 512; it += G) attn_sample_item(p, it, lds, tid);
    if (mask & 16) for (int it = c; it < 1024; it += G) hgrn_sample_item(p, it, lds, tid);
    if ((mask & 1) && (c & 1)) for (int it = c; it < 1024; it += G) hgrn_h1_item(p, it, lds, tid);
}

__device__ __forceinline__ void p4b_merge(const Params& p) {
    const float* pm = (const float*)(p.ws + WS_MF); bf16_t* merged = (bf16_t*)(p.ws + WS_MERGED);
    for (int idx = blockIdx.x * 512 + threadIdx.x; idx < 1024 * 256; idx += gridDim.x * 512) {
        const int r = idx >> 8, c8 = (idx & 255) * 8;
        f32x4 a0 = (f32x4){0.f, 0.f, 0.f, 0.f}, a1 = a0;
#pragma unroll
        for (int q = 0; q < 4; ++q) { const float* src = pm + ((size_t)q * 1024 + r) * 2048 + c8; a0 += *(const f32x4*)src; a1 += *(const f32x4*)(src + 4); }
        u32x4 o; o.x = pk2(a0[0], a0[1]); o.y = pk2(a0[2], a0[3]); o.z = pk2(a1[0], a1[1]); o.w = pk2(a1[2], a1[3]);
        *(u32x4*)(merged + tl((size_t)NTP + r, c8, 2048)) = o;
    }
}

__device__ __forceinline__ void p6_final_norm(const Params& p) {
    const int tid = threadIdx.x, lane = tid & 63, gw = blockIdx.x * 8 + (tid >> 6), NGW = gridDim.x * 8;
    for (int r = NTP + gw; r < NTOK; r += NGW) {
        float* zr = p.out + (size_t)r * 2048;
        f32x4 v[8]; float ss = 0.f;
        if (r < NTP) {
#pragma unroll
            for (int j = 0; j < 8; ++j) v[j] = ((const f32x4*)zr)[lane + 64 * j];
        } else {
            const float* xr = p.x_sample + (size_t)(r - NTP) * 2048; const float* pr = (const float*)(p.ws + WS_MF) + (size_t)(r - NTP) * 2048;
#pragma unroll
            for (int j = 0; j < 8; ++j) v[j] = ((const f32x4*)xr)[lane + 64 * j];
#pragma unroll 2
            for (int ks = 0; ks < 8; ++ks) {
#pragma unroll
                for (int j = 0; j < 8; ++j) v[j] += ((const f32x4*)(pr + (size_t)ks * 1024 * 2048))[lane + 64 * j]; }
        }
#pragma unroll
        for (int j = 0; j < 8; ++j) ss += (v[j][0] * v[j][0] + v[j][1] * v[j][1]) + (v[j][2] * v[j][2] + v[j][3] * v[j][3]);
        ss = wave_sum(ss);
        const float rinv = rsqrtf(ss * (1.f / 2048.f) + EPS);
#pragma unroll
        for (int j = 0; j < 8; ++j) { const f32x4 gg = ((const f32x4*)p.g_final)[lane + 64 * j]; ((f32x4*)zr)[lane + 64 * j] = v[j] * rinv * gg; }
    }
}

__global__ void __launch_bounds__(512, 2) fwd_megakernel(Params p) {
    extern __shared__ __attribute__((aligned(16))) unsigned char shm[];
    LAS unsigned char* lds = (LAS unsigned char*)shm;
    cg::grid_group grid = cg::this_grid();
    const int G = gridDim.x, c = blockIdx.x;
    volatile LAS unsigned* xst = (volatile LAS unsigned*)(lds + LDS_PHASE_BYTES);
    unsigned* xbar = (unsigned*)(p.ws + WS_BAR); unsigned xbx = 0u;
    if (p.coop) { if (threadIdx.x == 0) { xst[0] = 0u; xst[1] = 0u; } __syncthreads(); const XcdBarrier xb = xcd_barrier_post(xbar, xst); xbx = xb.x;
        grid.sync(); }
#define SEAM(ph) do { if (p.coop && (ph) + 1 < p.ph_hi) xcd_barrier(xbar, xbx, xst); } while (0)
#define RUNS(ph) (p.ph_lo <= (ph) && (ph) < p.ph_hi)
    if (RUNS(0)) { p0_prologue(p, lds); SEAM(0); }
    if (RUNS(1)) {
        SchedP1 S; S.G = G; S.c = c; S.A = (const char*)(p.ws + WS_HA); S.Bt = (const char*)(p.ws + WS_WT1);
        EpiP1 E; E.proj = (bf16_t*)(p.ws + WS_PROJ9); E.gate = (bf16_t*)(p.ws + WS_GATE); E.F = (float*)(p.ws + WS_F); E.lb = (const float*)(p.ws + WS_LB);
        E.b_gate = p.b_gate; E.out = p.out; E.mkb = (bf16_t*)(p.ws + WS_MKB); E.mvt = (bf16_t*)(p.ws + WS_MVT);
        pg8::gemm_phase(lds, 2048, S, E); SEAM(1);
    }
    if (RUNS(2)) { p2_mixers(p, lds); SEAM(2); }
    if (RUNS(3)) { hgrn_h2_scan(p); SEAM(3); }
    if (RUNS(4)) { for (int it = c; it < 1024; it += G) hgrn_h3_item(p, it, lds, threadIdx.x); SEAM(4); }
    if (RUNS(5)) {
        SchedP4 S; S.G = G; S.c = c; S.A = (const char*)(p.ws + WS_ACT3); S.Bt = (const char*)(p.ws + WS_WT3);
        EpiP4 E; E.gate = (const bf16_t*)(p.ws + WS_GATE); E.merged = (bf16_t*)(p.ws + WS_MERGED); E.partm = (float*)(p.ws + WS_MF);
        pg8::gemm_phase(lds, 1024, S, E); SEAM(5);
    }
    if (RUNS(6)) { p4b_merge(p); SEAM(6); }
    if (RUNS(7)) {
        SchedP5 S; S.G = G; S.c = c; S.A = (const char*)(p.ws + WS_MERGED); S.Bt = (const char*)(p.ws + WS_WTO);
        EpiP5 E; E.xp = p.x_prompt; E.xs = p.x_sample; E.out = p.out; E.part = (float*)(p.ws + WS_MF);
        E.rs = (float*)(p.ws + WS_RS); E.gfin = p.g_final; E.xbar = xbar; E.xbx = xbx; E.xst = xst;
        pg8::gemm_phase(lds, 2048, S, E); SEAM(7);
    }
    if (RUNS(8)) { p6_final_norm(p); }
#undef RUNS
#undef SEAM
}

extern "C" void kernel_launch(void* const* d_in, const int* in_sizes, int n_in, void* d_out, int out_size, void* d_ws, size_t ws_size, hipStream_t stream) {
    static int grid = 0;
    if (grid == 0) {
        if (n_in != 23 || ws_size < WS_END) { fprintf(stderr, "kernel_launch: expected 23 inputs and >= %zu bytes of workspace, got %d / %zu\n", (size_t)WS_END, n_in, ws_size); grid = -1; return; }
        int dev = 0, cus = 0, per_cu = 0;
        hipGetDevice(&dev); hipDeviceGetAttribute(&cus, hipDeviceAttributeMultiprocessorCount, dev);
        if (hipFuncSetAttribute((const void*)fwd_megakernel, hipFuncAttributeMaxDynamicSharedMemorySize, LDS_BYTES) != hipSuccess) { fprintf(stderr, "kernel_launch: hipFuncSetAttribute failed\n"); grid = -1; return; }
        if (hipOccupancyMaxActiveBlocksPerMultiprocessor(&per_cu, (const void*)fwd_megakernel, 512, LDS_BYTES) != hipSuccess || per_cu < 1) { fprintf(stderr, "kernel_launch: occupancy query failed (%d)\n", per_cu); (void)hipGetLastError(); per_cu = 1; }
        grid = cus * 1;
        if (grid != 256) { fprintf(stderr, "kernel_launch: built for a 256-CU device (every CU owns exactly one prompt tile of the output GEMM); found %d CUs\n", cus); grid = -1; return; }
    }
    if (grid < 0) return;
    Params p{};
    const float** pp = (const float**)&p;
    for (int i = 0; i < 23; ++i) pp[i] = (const float*)d_in[i];
    p.out = (float*)d_out; p.ws = (unsigned char*)d_ws; p.pad = 31;
#if N_LAUNCH_MODE != 1
#error "the output GEMM's epilogue contains a grid barrier: only the one-launch cooperative build is supported"
#endif
#if N_LAUNCH_MODE == 1
    p.ph_lo = 0; p.ph_hi = N_PHASES; p.coop = 1;
    if (hipMemsetAsync((char*)d_ws + WS_BAR, 0, WS_ZERO_BYTES, stream) != hipSuccess) { fprintf(stderr, "kernel_launch: memset of the barrier words failed\n"); return; }
    void* args[] = {&p};
    hipError_t e = hipLaunchCooperativeKernel((const void*)fwd_megakernel, dim3(grid), dim3(512), args, LDS_BYTES, stream);
    if (e != hipSuccess) fprintf(stderr, "cooperative launch failed: %s (grid %d)\n", hipGetErrorString(e), grid);
#else
    for (int ph = 0; ph < N_PHASES; ++ph) {
        p.ph_lo = ph; p.ph_hi = ph + 1; p.coop = 0;
        hipLaunchKernelGGL(fwd_megakernel, dim3(grid), dim3(512), LDS_BYTES, stream, p);
        if ((REP_MASK >> ph) & 1) { if (ph == 2) p.pad = P2_SUBMASK; hipLaunchKernelGGL(fwd_megakernel, dim3(grid), dim3(512), LDS_BYTES, stream, p); p.pad = 31; }
    }
#endif
}
```
